# Optimizing an MI355X kernel written in HIP

```python
import jax, jax.numpy as jnp
from jax import lax
import numpy as np

D_MODEL = 1024
BATCH = 4
SEQ = 8192
DEPTH = 2
DEC_BATCH = 32
DEC_SEQ = 64
PAST_LEN = 4096

CHUNK = 64
Q_BLOCK = 128
EPS = 1e-6
NEG_INF = -1e30
ROPE_THETA = 10000.0
MLA_HEADS = 8
MLA_NOPE = 64
MLA_ROPE = 32
MLA_V = 64
MLA_Q_RANK = 256
MLA_KV_RANK = 256
MLA_WIDTH = MLA_HEADS * MLA_V
MLA_SCALE = (MLA_NOPE + MLA_ROPE) ** -0.5
HG_HEADS = 4
HG_DK = 64
HG_DV = 64
HG_WIDTH = HG_HEADS * HG_DV
GLA_HEADS = 4
GLA_DK = 32
GLA_DV = 64
GLA_RANK = 16
GLA_TAU = 16.0
GLA_WIDTH = GLA_HEADS * GLA_DV
MIX_WIDTH = MLA_WIDTH + HG_WIDTH + GLA_WIDTH
IN_SIZES = (MLA_Q_RANK, MLA_KV_RANK, MLA_ROPE,
            HG_HEADS * HG_DK, HG_HEADS * HG_DK, HG_WIDTH, HG_WIDTH,
            GLA_HEADS * GLA_DK, GLA_HEADS * GLA_DK, GLA_WIDTH, GLA_WIDTH, GLA_RANK)
IN_COLS = sum(IN_SIZES)
D_FF = -(-8 * D_MODEL // (3 * 256)) * 256

kernel_name = 'hymba_mla_hgrn2_gla_stream'


def rmsnorm(x, g):
    xf = x.astype(jnp.float32)
    y = xf * lax.rsqrt(jnp.mean(xf * xf, axis=-1, keepdims=True) + EPS)
    return (y * g.astype(jnp.float32)).astype(x.dtype)


def split_projection(z):
    idx = [int(v) for v in np.cumsum(IN_SIZES)[:-1]]
    return jnp.split(z, idx, axis=-1)


def rope_angles(pos):
    inv = ROPE_THETA ** (-(jnp.arange(0, MLA_ROPE, 2, dtype=jnp.float32) / MLA_ROPE))
    ang = pos.astype(jnp.float32)[:, None] * inv[None, :]
    return jnp.cos(ang), jnp.sin(ang)


def apply_rope(x, cos, sin):
    xf = x.astype(jnp.float32)
    half = xf.shape[-1] // 2
    x1, x2 = xf[..., :half], xf[..., half:]
    return jnp.concatenate([x1 * cos - x2 * sin, x2 * cos + x1 * sin], axis=-1).astype(x.dtype)


def chunk_recurrence(q, k, v, log_f, s0):
    B, T, H, _ = q.shape
    dv = v.shape[-1]
    c = min(CHUNK, T)
    n = T // c

    def to_chunks(a):
        return jnp.moveaxis(a.astype(jnp.float32).reshape(B, n, c, H, a.shape[-1]), 1, 0)

    tril = jnp.tril(jnp.ones((c, c), dtype=bool))

    def step(S, xs):
        qc, kc, vc, gc = xs
        b = jnp.cumsum(gc, axis=1)
        o_inter = jnp.einsum('bchk,bhkv->bchv', qc * jnp.exp(b), S)
        diff = b[:, :, None] - b[:, None, :]
        decay = jnp.exp(jnp.where(tril[None, :, :, None, None], diff, -jnp.inf))
        scores = jnp.sum(qc[:, :, None] * kc[:, None] * decay, axis=-1)
        o_intra = jnp.einsum('bijh,bjhv->bihv', scores, vc)
        b_last = b[:, -1]
        S = jnp.exp(b_last)[..., None] * S + jnp.einsum(
            'bjhk,bjhv->bhkv', kc * jnp.exp(b_last[:, None] - b), vc)
        return S, o_inter + o_intra

    S, o = lax.scan(step, s0.astype(jnp.float32),
                    (to_chunks(q), to_chunks(k), to_chunks(v), to_chunks(log_f)))
    o = jnp.moveaxis(o, 0, 1).reshape(B, T, H, dv)
    return o.astype(v.dtype), S.astype(s0.dtype)


def mla_block(q_nope, q_rope, q_pos, k_nope, k_rope, ckv, k_pos, w_uv):
    s = (jnp.einsum('bqhd,bkhd->bhqk', q_nope, k_nope)
         + jnp.einsum('bqhd,bkd->bhqk', q_rope, k_rope)).astype(jnp.float32) * MLA_SCALE
    visible = (k_pos // CHUNK)[None, :] <= (q_pos // CHUNK)[:, None]
    s = jnp.where(visible[None, None], s, NEG_INF)
    p = jax.nn.softmax(s, axis=-1).astype(ckv.dtype)
    o_lat = jnp.einsum('bhqk,bkr->bqhr', p, ckv)
    return jnp.einsum('bqhr,rhd->bqhd', o_lat, w_uv)


def mla_attention(q_nope, q_rope, pos, k_nope, k_rope, ckv, k_pos, w_uv):
    B, T = q_nope.shape[:2]
    qb = min(Q_BLOCK, T)
    nb = T // qb

    def blocks(a):
        return jnp.moveaxis(a.reshape((B, nb, qb) + a.shape[2:]), 1, 0)

    out = lax.map(lambda xs: mla_block(xs[0], xs[1], xs[2], k_nope, k_rope, ckv, k_pos, w_uv),
                  (blocks(q_nope), blocks(q_rope), pos.reshape(nb, qb)))
    return jnp.moveaxis(out, 0, 1).reshape(B, T, MLA_WIDTH)


def trunk_layer(x, c, pos, ckv_past, krope_past, s_hg, s_gla, lp):
    B, T, _ = x.shape
    P = ckv_past.shape[1]
    mod = jax.nn.silu(c) @ lp['w_mod'] + lp['b_mod']
    sh1, sc1, g1, sh2, sc2, g2 = jnp.split(mod[:, None, :], 6, axis=-1)
    h = rmsnorm(x, lp['norm_mix']) * (1.0 + sc1) + sh1
    cq, ckv, kr, hq, hf, hi, hg, gq, gk, gv, gg, ga = split_projection(h @ lp['w_in'])

    cq = rmsnorm(cq, lp['mla_cq_norm'])
    ckv = rmsnorm(ckv, lp['mla_ckv_norm'])
    q = jnp.einsum('btr,rhd->bthd', cq, lp['mla_w_uq'])
    cos, sin = rope_angles(pos)
    q_nope = rmsnorm(q[..., :MLA_NOPE], lp['mla_q_norm'][:MLA_NOPE])
    q_rope = apply_rope(rmsnorm(q[..., MLA_NOPE:], lp['mla_q_norm'][MLA_NOPE:]), cos[:, None], sin[:, None])
    k_rope = apply_rope(rmsnorm(kr, lp['mla_k_norm'][MLA_NOPE:]), cos, sin)
    ckv_all = jnp.concatenate([ckv_past, ckv], axis=1)
    krope_all = jnp.concatenate([krope_past, k_rope], axis=1)
    k_pos = jnp.concatenate([jnp.arange(P, dtype=jnp.int32), pos])
    k_nope = rmsnorm(jnp.einsum('bsr,rhd->bshd', ckv_all, lp['mla_w_uk']), lp['mla_k_norm'][:MLA_NOPE])
    o_mla = rmsnorm(mla_attention(q_nope, q_rope, pos, k_nope, krope_all, ckv_all, k_pos, lp['mla_w_uv']),
                    lp['mla_out_norm'])

    lb = lp['hg_lb'].reshape(HG_HEADS, HG_DK)
    f = lb + (1.0 - lb) * jax.nn.sigmoid(hf.reshape(B, T, HG_HEADS, HG_DK).astype(jnp.float32))
    o_hg, s_hg_new = chunk_recurrence(hq.reshape(B, T, HG_HEADS, HG_DK), 1.0 - f,
                                      hi.reshape(B, T, HG_HEADS, HG_DV), jnp.log(f), s_hg)
    o_hg = rmsnorm(o_hg, lp['hg_out_norm']).reshape(B, T, HG_WIDTH) * jax.nn.silu(hg)

    log_a = jax.nn.log_sigmoid((ga @ lp['gla_w_a2'] + lp['gla_b_a']).astype(jnp.float32)) / GLA_TAU
    o_gla, s_gla_new = chunk_recurrence(gq.reshape(B, T, GLA_HEADS, GLA_DK) * GLA_DK ** -0.5,
                                        gk.reshape(B, T, GLA_HEADS, GLA_DK),
                                        gv.reshape(B, T, GLA_HEADS, GLA_DV),
                                        log_a.reshape(B, T, GLA_HEADS, GLA_DK), s_gla)
    o_gla = rmsnorm(o_gla, lp['gla_out_norm']).reshape(B, T, GLA_WIDTH) * jax.nn.silu(gg)

    mix = jnp.concatenate([o_mla, o_hg, o_gla], axis=-1) @ lp['w_o']
    x = x + g1 * mix

    h2 = rmsnorm(x, lp['norm_ffn']) * (1.0 + sc2) + sh2
    a, u = jnp.split(h2 @ lp['w_ffn_in'], 2, axis=-1)
    x = x + g2 * ((jax.nn.silu(a) * u) @ lp['w_ffn_out'])
    return x, ckv, k_rope, s_hg_new, s_gla_new


def setup_inputs(seed: int = 0) -> dict:
    key = jax.random.key(seed)
    ks = jax.random.split(key, 32)

    def nrm(k, shape, scale):
        return jax.random.normal(k, shape, jnp.float32) * scale

    def gain(k, shape):
        return 1.0 + 0.02 * jax.random.normal(k, shape, jnp.float32)

    return {
        'x_prompt': nrm(ks[0], (BATCH, SEQ, D_MODEL), 1.0),
        'x_sample': nrm(ks[1], (DEC_BATCH, DEC_SEQ, D_MODEL), 1.0),
        'c_prompt': nrm(ks[2], (BATCH, D_MODEL), 1.0),
        'c_sample': nrm(ks[3], (DEC_BATCH, D_MODEL), 1.0),
        'cache_mla_ckv': nrm(ks[4], (DEPTH, DEC_BATCH, PAST_LEN, MLA_KV_RANK), 1.0),
        'cache_mla_krope': nrm(ks[5], (DEPTH, DEC_BATCH, PAST_LEN, MLA_ROPE), 1.0),
        'state_hgrn': nrm(ks[6], (DEPTH, DEC_BATCH, HG_HEADS, HG_DK, HG_DV), 0.5),
        'state_gla': nrm(ks[7], (DEPTH, DEC_BATCH, GLA_HEADS, GLA_DK, GLA_DV), 0.5),
        'w_mod': nrm(ks[8], (DEPTH, D_MODEL, 6 * D_MODEL), D_MODEL ** -0.5),
        'b_mod': nrm(ks[9], (DEPTH, 6 * D_MODEL), 0.02),
        'norm_mix': gain(ks[10], (DEPTH, D_MODEL)),
        'norm_ffn': gain(ks[11], (DEPTH, D_MODEL)),
        'w_in': nrm(ks[12], (DEPTH, D_MODEL, IN_COLS), D_MODEL ** -0.5),
        'mla_cq_norm': gain(ks[13], (DEPTH, MLA_Q_RANK)),
        'mla_ckv_norm': gain(ks[14], (DEPTH, MLA_KV_RANK)),
        'mla_w_uq': nrm(ks[15], (DEPTH, MLA_Q_RANK, MLA_HEADS, MLA_NOPE + MLA_ROPE), MLA_Q_RANK ** -0.5),
        'mla_w_uk': nrm(ks[16], (DEPTH, MLA_KV_RANK, MLA_HEADS, MLA_NOPE), MLA_KV_RANK ** -0.5),
        'mla_w_uv': nrm(ks[17], (DEPTH, MLA_KV_RANK, MLA_HEADS, MLA_V), MLA_KV_RANK ** -0.5),
        'mla_q_norm': gain(ks[18], (DEPTH, MLA_NOPE + MLA_ROPE)),
        'mla_k_norm': gain(ks[19], (DEPTH, MLA_NOPE + MLA_ROPE)),
        'mla_out_norm': gain(ks[20], (DEPTH, MLA_WIDTH)),
        'hg_lb_logits': nrm(ks[21], (DEPTH, HG_HEADS * HG_DK), 0.5),
        'hg_out_norm': gain(ks[22], (DEPTH, HG_DV)),
        'gla_w_a2': nrm(ks[23], (DEPTH, GLA_RANK, GLA_HEADS * GLA_DK), GLA_RANK ** -0.5),
        'gla_b_a': nrm(ks[24], (DEPTH, GLA_HEADS * GLA_DK), 0.1),
        'gla_out_norm': gain(ks[25], (DEPTH, GLA_DV)),
        'w_o': nrm(ks[26], (DEPTH, MIX_WIDTH, D_MODEL), MIX_WIDTH ** -0.5),
        'w_ffn_in': nrm(ks[27], (DEPTH, D_MODEL, 2 * D_FF), D_MODEL ** -0.5),
        'w_ffn_out': nrm(ks[28], (DEPTH, D_FF, D_MODEL), D_FF ** -0.5),
    }


def reference(x_prompt, x_sample, c_prompt, c_sample, cache_mla_ckv, cache_mla_krope, state_hgrn, state_gla,
              w_mod, b_mod, norm_mix, norm_ffn, w_in, mla_cq_norm, mla_ckv_norm, mla_w_uq, mla_w_uk, mla_w_uv,
              mla_q_norm, mla_k_norm, mla_out_norm, hg_lb_logits, hg_out_norm, gla_w_a2, gla_b_a, gla_out_norm,
              w_o, w_ffn_in, w_ffn_out):
    Bp, T_p = x_prompt.shape[:2]
    T_s = x_sample.shape[1]
    pos_p = jnp.arange(T_p, dtype=jnp.int32)
    pos_s = PAST_LEN + jnp.arange(T_s, dtype=jnp.int32)
    p_lb = jax.nn.softmax(hg_lb_logits.astype(jnp.float32), axis=0)
    lb_all = jnp.cumsum(p_lb, axis=0) - p_lb[0:1]

    dt = x_prompt.dtype
    ckv0 = jnp.zeros((Bp, 0, MLA_KV_RANK), dt)
    kr0 = jnp.zeros((Bp, 0, MLA_ROPE), dt)
    shg0 = jnp.zeros((Bp, HG_HEADS, HG_DK, HG_DV), dt)
    sgla0 = jnp.zeros((Bp, GLA_HEADS, GLA_DK, GLA_DV), dt)

    xp, xs = x_prompt, x_sample
    ckv_p, kr_p, hg_p, gla_p = [], [], [], []
    ckv_s, kr_s, hg_s, gla_s = [], [], [], []
    for l in range(DEPTH):
        lp = {'w_mod': w_mod[l], 'b_mod': b_mod[l], 'norm_mix': norm_mix[l], 'norm_ffn': norm_ffn[l],
              'w_in': w_in[l], 'mla_cq_norm': mla_cq_norm[l], 'mla_ckv_norm': mla_ckv_norm[l],
              'mla_w_uq': mla_w_uq[l], 'mla_w_uk': mla_w_uk[l], 'mla_w_uv': mla_w_uv[l],
              'mla_q_norm': mla_q_norm[l], 'mla_k_norm': mla_k_norm[l], 'mla_out_norm': mla_out_norm[l],
              'hg_lb': lb_all[l], 'hg_out_norm': hg_out_norm[l], 'gla_w_a2': gla_w_a2[l],
              'gla_b_a': gla_b_a[l], 'gla_out_norm': gla_out_norm[l], 'w_o': w_o[l],
              'w_ffn_in': w_ffn_in[l], 'w_ffn_out': w_ffn_out[l]}
        xp, a, b, cc, d = trunk_layer(xp, c_prompt, pos_p, ckv0, kr0, shg0, sgla0, lp)
        ckv_p.append(a); kr_p.append(b); hg_p.append(cc); gla_p.append(d)
        xs, a, b, cc, d = trunk_layer(xs, c_sample, pos_s, cache_mla_ckv[l], cache_mla_krope[l],
                                      state_hgrn[l], state_gla[l], lp)
        ckv_s.append(a); kr_s.append(b); hg_s.append(cc); gla_s.append(d)

    new_ckv_prompt = jnp.stack(ckv_p)
    new_krope_prompt = jnp.stack(kr_p)
    new_hgrn_prompt = jnp.stack(hg_p)
    new_gla_prompt = jnp.stack(gla_p)
    new_ckv_sample = jnp.stack(ckv_s)
    new_krope_sample = jnp.stack(kr_s)
    new_hgrn_sample = jnp.stack(hg_s)
    new_gla_sample = jnp.stack(gla_s)
    return (xp, xs, new_ckv_prompt, new_krope_prompt, new_hgrn_prompt, new_gla_prompt,
            new_ckv_sample, new_krope_sample, new_hgrn_sample, new_gla_sample)
```

```cpp
#include <hip/hip_runtime.h>
#include <hip/hip_cooperative_groups.h>
#include <cstdio>
namespace cg = cooperative_groups;
namespace pg8 {
#define PG8_LAS __attribute__((address_space(3)))
typedef unsigned short bf16_t;
typedef short bf16x8 __attribute__((ext_vector_type(8)));
typedef float f32x4 __attribute__((ext_vector_type(4)));
typedef unsigned u32x4 __attribute__((ext_vector_type(4)));
constexpr int BM = 256, BK = 64, HALF = 128, HTB = HALF * BK * 2  , STAGE_BYTES = 8 * HTB, NXCD = 8, WGM = 8;

__host__ __device__ __forceinline__ int lds_byte(int r, int c) { const int st = (r >> 4) * 2 + (c >> 5), rr = r & 15, cc = c & 31, ob = rr * 64 + cc * 2; return st * 1024 + (ob ^ (((ob >> 9) & 1) << 5)); }
__host__ __device__ __forceinline__ void stage_rc(int b, int& R, int& C) { const int st = b / 1024, sb = b % 1024, swz = sb ^ (((sb >> 9) & 1) << 5); R = (st >> 1) * 16 + swz / 64; C = (st & 1) * 32 + (swz % 64) / 2; }
__host__ __device__ __forceinline__ int perm32(int rho) { const int n = rho >> 4, i = rho & 15; return 8 * (i >> 2) + 4 * n + (i & 3); }

struct Unit { int pm, pn; };
struct Gemm { const bf16_t* A; const bf16_t* Bt; int M, N, K; };

struct StaticOrder {
    int nM, nN, nwg, G, c;
    __host__ __device__ void init(int M, int N, int G_, int c_) { nM = M / BM; nN = N / BM; nwg = nM * nN; G = G_; c = c_; }
    __host__ __device__ bool next(int i, Unit& u) const {
        const long L = (long)i * G + c; if (L >= nwg) return false;
        int wgid = (int)L; { const int q = nwg / NXCD, r = nwg % NXCD, xcd = wgid % NXCD, off = wgid / NXCD; wgid = (xcd < r ? xcd * (q + 1) : r * (q + 1) + (xcd - r) * q) + off; }
        const int nig = WGM * nN, gid = wgid / nig, fm = gid * WGM, gsz = (nM - fm) < WGM ? (nM - fm) : WGM;
        u.pm = fm + ((wgid % nig) % gsz); u.pn = (wgid % nig) / gsz; return true;
    }
    __device__ __forceinline__ void a_ready(const Unit&) const {}
    __device__ __forceinline__ void done(const Unit&) const {}
};
template <class Epi, class Sched, bool STAMP = false>
__device__ __forceinline__ void gemm_phase(PG8_LAS unsigned char* lds, const Gemm g, const Sched& S, const Epi& E, unsigned long long* stamps) {
    int tid = threadIdx.x; asm volatile("" : "+v"(tid)); const int wid = __builtin_amdgcn_readfirstlane(tid >> 6), lane = tid & 63, wr = wid >> 2, wc = wid & 3, fr = lane & 15, fq = lane >> 4;
    const int K = g.K, nt = K / BK;
    int ts_lo = 0, ts_hi = 0, nts = 0; const unsigned long long rt_entry = STAMP ? (unsigned long long)wall_clock64() : 0ull;
#define PG8_STAMP() do { if (STAMP && wid == 0 && nts < 64) { const unsigned long long _c = (unsigned long long)clock64(); \
        ts_lo = (lane == nts) ? (int)(unsigned)_c : ts_lo; ts_hi = (lane == nts) ? (int)(unsigned)(_c >> 32) : ts_hi; ++nts; } } while (0)
    PG8_STAMP();
    unsigned voffA[2], voffB[2];
#pragma unroll
    for (int i = 0; i < 2; ++i) { int R, C; stage_rc(tid * 16 + i * 8192, R, C); const int Rb = Epi::PERM ? ((R & ~31) + perm32(R & 31)) : R;
        voffA[i] = (unsigned)(R * K + C) * 2u; voffB[i] = (unsigned)(Rb * K + C) * 2u; }
    const size_t kstep = (size_t)(BK * 2);
    const size_t hstep = (size_t)HALF * K * 2;
    const size_t tstep = 2 * hstep;
    const unsigned ldsw = (unsigned)wid * 1024u;
    const int aoff = lds_byte(wr * 64 + fr, fq * 8), boff = lds_byte(wc * 32 + fr, fq * 8);
#define PG8_SA(b, h) (((b) * 2 + (h)) * HTB)
#define PG8_SB(b, h) ((4 + (b) * 2 + (h)) * HTB)
#define PG8_STAGE(bufoff, gbase, voff) do { _Pragma("unroll") for (int _i = 0; _i < 2; ++_i) \
        __builtin_amdgcn_global_load_lds((const unsigned*)((const char*)(gbase) + (voff)[_i]), (PG8_LAS unsigned*)(lds + (bufoff) + ldsw + _i * 8192), 16, 0, 0); } while (0)
#define PG8_LDA(dst, b, h) do { _Pragma("unroll") for (int m = 0; m < 4; ++m) _Pragma("unroll") for (int k = 0; k < 2; ++k) dst[m][k] = *(const PG8_LAS bf16x8*)(lds + PG8_SA(b, h) + aoff + m * 2048 + k * 1024); } while (0)
#define PG8_LDB(dst, b, h) do { _Pragma("unroll") for (int n = 0; n < 2; ++n) _Pragma("unroll") for (int k = 0; k < 2; ++k) dst[n][k] = *(const PG8_LAS bf16x8*)(lds + PG8_SB(b, h) + boff + n * 2048 + k * 1024); } while (0)
#define PG8_MMA(ai, bj, At, Bt) do { __builtin_amdgcn_s_setprio(1); _Pragma("unroll") for (int m = 0; m < 4; ++m) _Pragma("unroll") for (int n = 0; n < 2; ++n) _Pragma("unroll") for (int k = 0; k < 2; ++k) \
        acc[ai][bj][m][n] = __builtin_amdgcn_mfma_f32_16x16x32_bf16(Bt[n][k], At[m][k], acc[ai][bj][m][n], 0, 0, 0); __builtin_amdgcn_s_setprio(0); } while (0)
#define PG8_WAIT_V(n) asm volatile("s_waitcnt vmcnt(" #n ")" ::: "memory")
#define PG8_WAIT_L(n) asm volatile("s_waitcnt lgkmcnt(" #n ")" ::: "memory")
#define PG8_BAR __builtin_amdgcn_s_barrier()
#define PG8_SCHED __builtin_amdgcn_sched_barrier(0)
    Unit cur, nxt; int ui = 0;
    if (!S.next(0, cur)) return;
    f32x4 acc[2][2][4][2];
#pragma unroll
    for (int a = 0; a < 2; ++a)
#pragma unroll
        for (int b = 0; b < 2; ++b)
#pragma unroll
            for (int m = 0; m < 4; ++m)
#pragma unroll
                for (int n = 0; n < 2; ++n) acc[a][b][m][n] = (f32x4){0.f, 0.f, 0.f, 0.f};
    bf16x8 At[4][2], B0[2][2], B1[2][2];
    const char* cA = (const char*)g.A + (size_t)cur.pm * tstep; const char* cB = (const char*)g.Bt + (size_t)cur.pn * tstep;
    S.a_ready(cur);
    PG8_STAGE(PG8_SB(0, 0), cB, voffB); PG8_STAGE(PG8_SA(0, 0), cA, voffA); PG8_STAGE(PG8_SB(0, 1), cB + hstep, voffB); PG8_STAGE(PG8_SA(0, 1), cA + hstep, voffA);
    if (wr == 1) PG8_BAR;
    PG8_WAIT_V(4); PG8_BAR;
    PG8_STAGE(PG8_SB(1, 0), cB + kstep, voffB); PG8_STAGE(PG8_SA(1, 0), cA + kstep, voffA); PG8_STAGE(PG8_SB(1, 1), cB + hstep + kstep, voffB);
    PG8_WAIT_V(6); PG8_BAR;
    PG8_STAMP();
    for (;;) {
        const bool has_next = S.next(ui + 1, nxt);
        const char* nA = has_next ? (const char*)g.A + (size_t)nxt.pm * tstep : cA; const char* nB = has_next ? (const char*)g.Bt + (size_t)nxt.pn * tstep : cB;
        for (int t = 0; t < nt; t += 2) {
            const bool last = (t == nt - 2);
            const char* a1 = cA + (size_t)(t + 1) * kstep;
            const char* a2 = last ? nA : cA + (size_t)(t + 2) * kstep; const char* b2 = last ? nB : cB + (size_t)(t + 2) * kstep;
            const char* a3 = a2 + kstep; const char* b3 = b2 + kstep;
            if (last && has_next) S.a_ready(nxt);
            PG8_LDB(B0, 0, 0); PG8_SCHED; PG8_LDA(At, 0, 0); PG8_STAGE(PG8_SA(1, 1), a1 + hstep, voffA);
            PG8_WAIT_L(8); PG8_BAR; PG8_WAIT_L(0); PG8_MMA(0, 0, At, B0); PG8_BAR; PG8_SCHED;
            PG8_LDB(B1, 0, 1); PG8_STAGE(PG8_SB(0, 0), b2, voffB);
            PG8_BAR; PG8_WAIT_L(0); PG8_MMA(0, 1, At, B1); PG8_BAR;
            PG8_LDA(At, 0, 1); PG8_STAGE(PG8_SA(0, 0), a2, voffA);
            PG8_BAR; PG8_WAIT_L(0); PG8_MMA(1, 0, At, B0); PG8_BAR; PG8_SCHED;
            PG8_STAGE(PG8_SB(0, 1), b2 + hstep, voffB);
            PG8_WAIT_V(6); PG8_BAR; PG8_MMA(1, 1, At, B1); PG8_BAR;
            PG8_LDB(B0, 1, 0); PG8_SCHED; PG8_LDA(At, 1, 0); PG8_STAGE(PG8_SA(0, 1), a2 + hstep, voffA);
            PG8_WAIT_L(8); PG8_BAR; PG8_WAIT_L(0); PG8_MMA(0, 0, At, B0); PG8_BAR; PG8_SCHED;
            PG8_LDB(B1, 1, 1); PG8_STAGE(PG8_SB(1, 0), b3, voffB);
            PG8_BAR; PG8_WAIT_L(0); PG8_MMA(0, 1, At, B1); PG8_BAR;
            PG8_LDA(At, 1, 1); PG8_STAGE(PG8_SA(1, 0), a3, voffA);
            PG8_BAR; PG8_WAIT_L(0); PG8_MMA(1, 0, At, B0); PG8_BAR; PG8_SCHED;
            PG8_STAGE(PG8_SB(1, 1), b3 + hstep, voffB);
            PG8_WAIT_V(6); PG8_BAR; PG8_MMA(1, 1, At, B1); PG8_BAR;
        }
        PG8_STAMP();
        if constexpr (!Epi::AFTER_DRAIN) { E(acc, cur, wr, wc, fr, fq); S.done(cur); }
        PG8_STAMP();
        if (!has_next) break;
#pragma unroll
        for (int a = 0; a < 2; ++a)
#pragma unroll
            for (int b = 0; b < 2; ++b)
#pragma unroll
                for (int m = 0; m < 4; ++m)
#pragma unroll
                    for (int n = 0; n < 2; ++n) acc[a][b][m][n] = (f32x4){0.f, 0.f, 0.f, 0.f};
        cur = nxt; cA = nA; cB = nB; ++ui;
    }
    PG8_WAIT_V(0);
    if (wr == 0) PG8_BAR;
    PG8_BAR;
    if constexpr (Epi::AFTER_DRAIN) { E.fused(acc, cur, wr, wc, fr, fq, lds, wid, lane); S.done(cur); }
    PG8_STAMP();
    if (STAMP && wid == 0) { stamps[lane] = lane < nts ? (((unsigned long long)(unsigned)ts_hi << 32) | (unsigned)ts_lo) : 0ull;
        if (lane == 62) stamps[62] = rt_entry; if (lane == 63) stamps[63] = (unsigned long long)wall_clock64(); }
#undef PG8_STAMP
#undef PG8_SA
#undef PG8_SB
#undef PG8_STAGE
#undef PG8_LDA
#undef PG8_LDB
#undef PG8_MMA
#undef PG8_WAIT_V
#undef PG8_WAIT_L
#undef PG8_BAR
#undef PG8_SCHED
}
}
using namespace pg8;
typedef float f32x16 __attribute__((ext_vector_type(16)));
typedef unsigned u32x2 __attribute__((ext_vector_type(2)));
#define LAS PG8_LAS
#define DI __device__ __forceinline__

constexpr int NT = 512;
constexpr int MP = 32768, MS = 2048, MT = MP + MS;
constexpr int KEYS_S = 4352;
constexpr int KR_ROWS = MP + 32 * KEYS_S;
constexpr int ZLD = 2560;
constexpr float EPS = 1e-6f;
constexpr float QSCALE = 0.10206207261596577f * 1.4426950408889634f;
constexpr int LDS_BYTES = 160 * 1024;

constexpr size_t SZ_WIN = 2560ull * 1024 * 2, SZ_WUQ = 768ull * 256 * 2, SZ_WUK = 512ull * 256 * 2, SZ_WUV = 512ull * 256 * 2,
                 SZ_WO = 1024ull * 1024 * 2, SZ_WFI = 5632ull * 1024 * 2, SZ_WFO = 1024ull * 2816 * 2;
constexpr size_t WOFF_IN = 0, WOFF_UQ = WOFF_IN + SZ_WIN, WOFF_UK = WOFF_UQ + SZ_WUQ, WOFF_UV = WOFF_UK + SZ_WUK, WOFF_O = WOFF_UV + SZ_WUV,
                 WOFF_FI = WOFF_O + SZ_WO, WOFF_FO = WOFF_FI + SZ_WFI, WL = WOFF_FO + SZ_WFO;
constexpr size_t OFF_W = 0;
constexpr size_t OFF_MOD = OFF_W + 2 * WL;
constexpr size_t OFF_ROPE = OFF_MOD + 2ull * 36 * 6144 * 4;
constexpr size_t OFF_H = OFF_ROPE + 8192ull * 16 * 2 * 4;
constexpr size_t OFF_Z = OFF_H + (size_t)MT * 1024 * 2;
constexpr size_t OFF_CQN = OFF_Z + (size_t)MT * ZLD * 2;
constexpr size_t OFF_CKV = OFF_CQN + (size_t)MT * 256 * 2;
constexpr size_t OFF_KROPE = OFF_CKV + (size_t)KR_ROWS * 256 * 2;
constexpr size_t OFF_Q = OFF_KROPE + (size_t)KR_ROWS * 32 * 2;
constexpr size_t OFF_KN = OFF_Q + (size_t)MT * 768 * 2;
constexpr size_t OFF_VT = OFF_KN + (size_t)KR_ROWS * 512 * 2;
constexpr size_t OFF_O = OFF_VT + (size_t)KR_ROWS * 512 * 2;
constexpr size_t OFF_PART = OFF_O + (size_t)MP * 512 * 2;
constexpr size_t OFF_UHG = OFF_PART + 32ull * 8 * 4 * 64 * 66 * 4;
constexpr size_t OFF_DHG = OFF_UHG + 544ull * 4 * 64 * 64 * 4;
constexpr size_t OFF_UGL = OFF_DHG + 544ull * 4 * 64 * 4;
constexpr size_t OFF_DGL = OFF_UGL + 544ull * 4 * 32 * 64 * 4;
constexpr size_t WS_END = OFF_DGL + 544ull * 4 * 32 * 4;
constexpr size_t OFF_ACT = OFF_KN;
static_assert((size_t)MT * 2816 * 2 <= 2 * (size_t)KR_ROWS * 512 * 2, "act alias");

constexpr size_t OUT_Y = 0, OUT_CKVP = 35651584, OUT_KRP = 52428800, OUT_HGP = 54525952, OUT_GLP = 54657024,
                 OUT_CKVS = 54722560, OUT_KRS = 55771136, OUT_HGS = 55902208, OUT_GLS = 56950784;

DI int tid_() { int t = threadIdx.x; asm volatile("" : "+v"(t)); return t; }
DI int bid_() { int b = blockIdx.x; asm volatile("" : "+s"(b)); return b; }
struct Params { const float* in[29]; float* out; unsigned char* ws; };

DI bf16_t f2bf(float f) { unsigned u = __float_as_uint(f); u += 0x7FFFu + ((u >> 16) & 1u); return (bf16_t)(u >> 16); }
DI float bf2f(bf16_t b) { return __uint_as_float(((unsigned)b) << 16); }
DI unsigned pack2(float a, float b) { return (unsigned)f2bf(a) | ((unsigned)f2bf(b) << 16); }
DI float bflo(unsigned u) { return __uint_as_float(u << 16); }
DI float bfhi(unsigned u) { return __uint_as_float(u & 0xFFFF0000u); }
DI float wave_sum(float v) { v += __shfl_xor(v, 32); v += __shfl_xor(v, 16); v += __shfl_xor(v, 8); v += __shfl_xor(v, 4); v += __shfl_xor(v, 2); v += __shfl_xor(v, 1); return v; }
DI float sigmoidf_(float x) { return 1.f / (1.f + expf(-x)); }
DI int row_bi(int row) { return row < MP ? (row >> 13) : 4 + ((row - MP) >> 6); }

struct EpiZ {
    static constexpr bool PERM = false, AFTER_DRAIN = false;
    bf16_t* O; int ldc;
    DI void operator()(const f32x4 (&acc)[2][2][4][2], const Unit& u, int wr, int wc, int fr, int fq) const {
        const int row0 = u.pm * 256 + wr * 64 + fr, col0 = u.pn * 256 + wc * 32 + 4 * fq;
#pragma unroll
        for (int ai = 0; ai < 2; ++ai)
#pragma unroll
            for (int m = 0; m < 4; ++m) { bf16_t* rowp = O + (size_t)(row0 + ai * 128 + m * 16) * ldc + col0;
#pragma unroll
                for (int bj = 0; bj < 2; ++bj)
#pragma unroll
                    for (int n = 0; n < 2; ++n) { const f32x4 v = acc[ai][bj][m][n]; uint2 w; w.x = pack2(v[0], v[1]); w.y = pack2(v[2], v[3]); *(uint2*)(rowp + bj * 128 + n * 16) = w; } }
    }
};
struct EpiQ {
    static constexpr bool PERM = false, AFTER_DRAIN = false;
    bf16_t* Q; const float* qn_; const float* rope_;
    DI void operator()(const f32x4 (&acc)[2][2][4][2], const Unit& u, int wr, int wc, int fr, int fq) const {
        const float* qn = qn_; const float* rope = rope_; asm volatile("" : "+s"(qn), "+s"(rope));
        const int row0 = u.pm * 256 + wr * 64 + fr;
#pragma unroll
        for (int ai = 0; ai < 2; ++ai)
#pragma unroll
            for (int m = 0; m < 4; ++m) {
                __builtin_amdgcn_sched_barrier(0);
                const int row = row0 + ai * 128 + m * 16;
                int pos; size_t base, hs;
                if (row < MP) { const int b = row >> 13, t = row & 8191; pos = t; base = ((size_t)(b * 8) * 8192 + t) * 96; hs = 8192 * 96; }
                else { const int r = row - MP, b = r >> 6, t = r & 63; pos = 4096 + t; base = (size_t)MP * 768 + ((size_t)(b * 8) * 64 + t) * 96; hs = 64 * 96; }
                if (u.pn < 2) {
                    const int head = 4 * u.pn + wc;
                    float ss = 0.f;
#pragma unroll
                    for (int bj = 0; bj < 2; ++bj)
#pragma unroll
                        for (int n = 0; n < 2; ++n) { const f32x4 v = acc[ai][bj][m][n]; ss += v[0] * v[0] + v[1] * v[1] + v[2] * v[2] + v[3] * v[3]; }
                    ss += __shfl_xor(ss, 16); ss += __shfl_xor(ss, 32);
                    const float rs = rsqrtf(ss * (1.f / 64.f) + EPS) * QSCALE;
#pragma unroll
                    for (int bj = 0; bj < 2; ++bj)
#pragma unroll
                        for (int n = 0; n < 2; ++n) { const int d = 32 * bj + 16 * n + 4 * fq; const f32x4 v = acc[ai][bj][m][n]; const float4 g = *(const float4*)(qn + d);
                            uint2 w; w.x = pack2(v[0] * rs * g.x, v[1] * rs * g.y); w.y = pack2(v[2] * rs * g.z, v[3] * rs * g.w); *(uint2*)(Q + base + head * hs + d) = w; }
                } else {
#pragma unroll
                    for (int bj = 0; bj < 2; ++bj) {
                        const int head = 2 * wc + bj;
                        const f32x4 v1 = acc[ai][bj][m][0], v2 = acc[ai][bj][m][1];
                        float ss = v1[0] * v1[0] + v1[1] * v1[1] + v1[2] * v1[2] + v1[3] * v1[3] + v2[0] * v2[0] + v2[1] * v2[1] + v2[2] * v2[2] + v2[3] * v2[3];
                        ss += __shfl_xor(ss, 16); ss += __shfl_xor(ss, 32);
                        const float rs = rsqrtf(ss * (1.f / 32.f) + EPS);
                        const float4 g1 = *(const float4*)(qn + 64 + 4 * fq), g2 = *(const float4*)(qn + 80 + 4 * fq);
                        const float4 cs0 = *(const float4*)(rope + ((size_t)pos * 16 + 4 * fq) * 2), cs1 = *(const float4*)(rope + ((size_t)pos * 16 + 4 * fq) * 2 + 4);
                        const float x10 = v1[0] * rs * g1.x, x11 = v1[1] * rs * g1.y, x12 = v1[2] * rs * g1.z, x13 = v1[3] * rs * g1.w;
                        const float x20 = v2[0] * rs * g2.x, x21 = v2[1] * rs * g2.y, x22 = v2[2] * rs * g2.z, x23 = v2[3] * rs * g2.w;
                        uint2 w1, w2;
                        w1.x = pack2((x10 * cs0.x - x20 * cs0.y) * QSCALE, (x11 * cs0.z - x21 * cs0.w) * QSCALE);
                        w1.y = pack2((x12 * cs1.x - x22 * cs1.y) * QSCALE, (x13 * cs1.z - x23 * cs1.w) * QSCALE);
                        w2.x = pack2((x20 * cs0.x + x10 * cs0.y) * QSCALE, (x21 * cs0.z + x11 * cs0.w) * QSCALE);
                        w2.y = pack2((x22 * cs1.x + x12 * cs1.y) * QSCALE, (x23 * cs1.z + x13 * cs1.w) * QSCALE);
                        *(uint2*)(Q + base + head * hs + 64 + 4 * fq) = w1; *(uint2*)(Q + base + head * hs + 80 + 4 * fq) = w2;
                    }
                }
            }
    }
};
struct EpiKN {
    static constexpr bool PERM = false, AFTER_DRAIN = false;
    bf16_t* KN; const float* kn_;
    DI void operator()(const f32x4 (&acc)[2][2][4][2], const Unit& u, int wr, int wc, int fr, int fq) const {
        const float* kn = kn_; asm volatile("" : "+s"(kn));
        size_t base, hs;
        if (u.pm < 128) { const int b = u.pm >> 5, key0 = (u.pm & 31) * 256; base = ((size_t)(b * 8) * 8192 + key0) * 64; hs = (size_t)8192 * 64; }
        else { const int q = u.pm - 128, b = q / 17, key0 = (q % 17) * 256; base = (size_t)MP * 512 + ((size_t)(b * 8) * KEYS_S + key0) * 64; hs = (size_t)KEYS_S * 64; }
        const int head = 4 * u.pn + wc;
#pragma unroll
        for (int ai = 0; ai < 2; ++ai)
#pragma unroll
            for (int m = 0; m < 4; ++m) {
                __builtin_amdgcn_sched_barrier(0);
                const int key = 128 * ai + 64 * wr + 16 * m + fr;
                float ss = 0.f;
#pragma unroll
                for (int bj = 0; bj < 2; ++bj)
#pragma unroll
                    for (int n = 0; n < 2; ++n) { const f32x4 v = acc[ai][bj][m][n]; ss += v[0] * v[0] + v[1] * v[1] + v[2] * v[2] + v[3] * v[3]; }
                ss += __shfl_xor(ss, 16); ss += __shfl_xor(ss, 32);
                const float rs = rsqrtf(ss * (1.f / 64.f) + EPS);
#pragma unroll
                for (int bj = 0; bj < 2; ++bj)
#pragma unroll
                    for (int n = 0; n < 2; ++n) { const int d = 32 * bj + 16 * n + 4 * fq; const f32x4 v = acc[ai][bj][m][n]; const float4 g = *(const float4*)(kn + d);
                        uint2 w; w.x = pack2(v[0] * rs * g.x, v[1] * rs * g.y); w.y = pack2(v[2] * rs * g.z, v[3] * rs * g.w); *(uint2*)(KN + base + head * hs + (size_t)key * 64 + d) = w; }
            }
    }
};
struct EpiVT {
    static constexpr bool PERM = false, AFTER_DRAIN = false;
    bf16_t* VT;
    DI void operator()(const f32x4 (&acc)[2][2][4][2], const Unit& u, int wr, int wc, int fr, int fq) const {
        size_t base; int KL;
        if (u.pn < 128) { const int b = u.pn >> 5, key0 = (u.pn & 31) * 256; base = (size_t)(b * 8) * 64 * 8192 + key0; KL = 8192; }
        else { const int q = u.pn - 128, b = q / 17, key0 = (q % 17) * 256; base = (size_t)MP * 512 + (size_t)(b * 8) * 64 * KEYS_S + key0; KL = KEYS_S; }
#pragma unroll
        for (int ai = 0; ai < 2; ++ai)
#pragma unroll
            for (int m = 0; m < 4; ++m) {
                __builtin_amdgcn_sched_barrier(0);
                const int r = 256 * u.pm + 128 * ai + 64 * wr + 16 * m + fr;
                bf16_t* rowp = VT + base + (size_t)r * KL + 32 * wc + 4 * fq;
#pragma unroll
                for (int bj = 0; bj < 2; ++bj)
#pragma unroll
                    for (int n = 0; n < 2; ++n) { const f32x4 v = acc[ai][bj][m][n]; uint2 w; w.x = pack2(v[0], v[1]); w.y = pack2(v[2], v[3]); *(uint2*)(rowp + 128 * bj + 16 * n) = w; }
            }
    }
};
struct EpiRes {
    static constexpr bool PERM = false, AFTER_DRAIN = false;
    const float* xa; const float* xb; float* out; const float* gate;
    DI void operator()(const f32x4 (&acc)[2][2][4][2], const Unit& u, int wr, int wc, int fr, int fq) const {
        const int row0 = u.pm * 256 + wr * 64 + fr, col0 = u.pn * 256 + wc * 32 + 4 * fq;
#pragma unroll
        for (int ai = 0; ai < 2; ++ai)
#pragma unroll
            for (int m = 0; m < 4; ++m) {
                const int row = row0 + ai * 128 + m * 16;
                const float* xr = (row < MP ? xa + (size_t)row * 1024 : xb + (size_t)(row - MP) * 1024) + col0;
                const float* gr = gate + (size_t)row_bi(row) * 6144 + col0;
                float* orow = out + (size_t)row * 1024 + col0;
#pragma unroll
                for (int bj = 0; bj < 2; ++bj)
#pragma unroll
                    for (int n = 0; n < 2; ++n) { const int c = bj * 128 + n * 16; const f32x4 x = *(const f32x4*)(xr + c), g = *(const f32x4*)(gr + c); *(f32x4*)(orow + c) = x + g * acc[ai][bj][m][n]; }
            }
    }
};
struct EpiSwi {
    static constexpr bool PERM = false, AFTER_DRAIN = false;
    bf16_t* ACT;
    DI void operator()(const f32x4 (&acc)[2][2][4][2], const Unit& u, int wr, int wc, int fr, int fq) const {
        const int row0 = u.pm * 256 + wr * 64 + fr, col0 = u.pn * 128 + wc * 32 + 4 * fq;
#pragma unroll
        for (int ai = 0; ai < 2; ++ai)
#pragma unroll
            for (int m = 0; m < 4; ++m) { bf16_t* rowp = ACT + (size_t)(row0 + ai * 128 + m * 16) * 2816 + col0;
#pragma unroll
                for (int n = 0; n < 2; ++n) { const f32x4 a = acc[ai][0][m][n], g = acc[ai][1][m][n]; float r[4];
#pragma unroll
                    for (int j = 0; j < 4; ++j) r[j] = a[j] / (1.f + __expf(-a[j])) * g[j];
                    uint2 w; w.x = pack2(r[0], r[1]); w.y = pack2(r[2], r[3]); *(uint2*)(rowp + n * 16) = w; } }
    }
};
template <class Epi> DI void run_gemm(LAS unsigned char* lds, const bf16_t* A, const bf16_t* Bt, int M, int N, int K, const Epi& E) {
    asm volatile("" : "+s"(M), "+s"(N), "+s"(K));
    Gemm g{A, Bt, M, N, K}; StaticOrder S; S.init(M, N, (int)gridDim.x, (int)bid_());
    gemm_phase<Epi, StaticOrder, false>(lds, g, S, E, nullptr);
}

DI int colmap(int w, int n) {
    if (w == 0) return n < 2352 ? n : -1;
    if (w == 1) { const int pn = n >> 8, c = n & 255, bj = c >> 7, wc = (c >> 5) & 3, cc = c & 31; return pn < 2 ? (4 * pn + wc) * 96 + 32 * bj + cc : (2 * wc + bj) * 96 + 64 + cc; }
    if (w == 2) { const int pn = n >> 8, c = n & 255, bj = c >> 7, wc = (c >> 5) & 3, cc = c & 31; return (4 * pn + wc) * 64 + 32 * bj + cc; }
    if (w == 5) { const int pn = n >> 8, c = n & 255; return c < 128 ? 128 * pn + c : 2816 + 128 * pn + (c - 128); }
    return n;
}
DI void phase_prep(const Params& p, LAS unsigned char* lds) {
    const int tid = tid_();
    LAS bf16_t* T = (LAS bf16_t*)lds;
    for (int ti = bid_(); ti < 2 * 3120; ti += gridDim.x) {
        const int l = ti / 3120, r = ti % 3120;
        int w, t0, K, ld; size_t doff; const float* src;
        if (r < 640) { w = 0; t0 = 0; K = 1024; ld = 2352; doff = WOFF_IN; src = p.in[12]; }
        else if (r < 688) { w = 1; t0 = 640; K = 256; ld = 768; doff = WOFF_UQ; src = p.in[15]; }
        else if (r < 720) { w = 2; t0 = 688; K = 256; ld = 512; doff = WOFF_UK; src = p.in[16]; }
        else if (r < 752) { w = 3; t0 = 720; K = 256; ld = 512; doff = WOFF_UV; src = p.in[17]; }
        else if (r < 1008) { w = 4; t0 = 752; K = 1024; ld = 1024; doff = WOFF_O; src = p.in[26]; }
        else if (r < 2416) { w = 5; t0 = 1008; K = 1024; ld = 5632; doff = WOFF_FI; src = p.in[27]; }
        else { w = 6; t0 = 2416; K = 2816; ld = 1024; doff = WOFF_FO; src = p.in[28]; }
        src += (size_t)l * K * ld;
        const int kt = K >> 6, tr = r - t0, n0 = (tr / kt) * 64, k0 = (tr % kt) * 64;
        bf16_t* dst = (bf16_t*)(p.ws + OFF_W + (size_t)l * WL + doff);
#pragma unroll
        for (int i = 0; i < 8; ++i) { const int e = tid + 512 * i, kk = e >> 6, nn = e & 63, col = colmap(w, n0 + nn);
            const float v = col >= 0 ? src[(size_t)(k0 + kk) * ld + col] : 0.f; T[nn * 66 + kk] = f2bf(v); }
        __syncthreads();
        { const int row = tid >> 3, seg = tid & 7; const LAS unsigned* tp = (const LAS unsigned*)(T + row * 66 + seg * 8);
          uint4 o; o.x = tp[0]; o.y = tp[1]; o.z = tp[2]; o.w = tp[3]; *(uint4*)(dst + (size_t)(n0 + row) * K + k0 + seg * 8) = o; }
        __syncthreads();
    }
    float* mod = (float*)(p.ws + OFF_MOD);
    for (int it = bid_(); it < 192; it += gridDim.x) {
        const int l = it / 96, cgp = it % 96;
        LAS float* sl = (LAS float*)lds;
        for (int i = tid; i < 36 * 1024; i += NT) { const int bi = i >> 10, k = i & 1023; const float c = bi < 4 ? p.in[2][bi * 1024 + k] : p.in[3][(bi - 4) * 1024 + k]; sl[i] = c / (1.f + expf(-c)); }
        __syncthreads();
        const int cl = tid & 63, kq = tid >> 6;
        float acc[36];
#pragma unroll
        for (int bi = 0; bi < 36; ++bi) acc[bi] = 0.f;
        const float* wm = p.in[8] + (size_t)l * 1024 * 6144 + cgp * 64 + cl;
        for (int k = kq * 128; k < kq * 128 + 128; k += 4) {
            const float w0 = wm[(size_t)k * 6144], w1 = wm[(size_t)(k + 1) * 6144], w2 = wm[(size_t)(k + 2) * 6144], w3 = wm[(size_t)(k + 3) * 6144];
#pragma unroll
            for (int bi = 0; bi < 36; ++bi) { const f32x4 s = *(const LAS f32x4*)(sl + bi * 1024 + k); acc[bi] += s[0] * w0 + s[1] * w1 + s[2] * w2 + s[3] * w3; }
        }
        __syncthreads();
        LAS float* red = (LAS float*)lds;
#pragma unroll
        for (int bi = 0; bi < 36; ++bi) red[(kq * 36 + bi) * 64 + cl] = acc[bi];
        __syncthreads();
        for (int o = tid; o < 36 * 64; o += NT) { const int bi = o >> 6, c = o & 63; float s = 0.f;
#pragma unroll
            for (int q = 0; q < 8; ++q) s += red[(q * 36 + bi) * 64 + c];
            const int colg = cgp * 64 + c; mod[((size_t)l * 36 + bi) * 6144 + colg] = s + p.in[9][l * 6144 + colg]; }
        __syncthreads();
    }
    float* rope = (float*)(p.ws + OFF_ROPE);
    for (int i = bid_() * NT + tid; i < 8192 * 16; i += gridDim.x * NT) { const int pos = i >> 4, j = i & 15;
        const float inv = exp2f(-(float)j * (13.287712379549449f / 16.f)); const float ang = (float)pos * inv; rope[2 * i] = cosf(ang); rope[2 * i + 1] = sinf(ang); }
}

DI void phase_hrows(const Params& p, int l, const float* xa, const float* xb, const float* g, int shoff, int scoff) {
    const int tid = tid_(), lane = tid & 63, wid = __builtin_amdgcn_readfirstlane(tid >> 6);
    const float* mod = (const float*)(p.ws + OFF_MOD) + (size_t)l * 36 * 6144;
    bf16_t* H = (bf16_t*)(p.ws + OFF_H);
    for (int row = bid_() * 8 + wid; row < MT; row += gridDim.x * 8) {
        const float* xr = row < MP ? xa + (size_t)row * 1024 : xb + (size_t)(row - MP) * 1024;
        float4 v[4]; float ss = 0.f;
#pragma unroll
        for (int i = 0; i < 4; ++i) { v[i] = *(const float4*)(xr + i * 256 + lane * 4); ss += v[i].x * v[i].x + v[i].y * v[i].y + v[i].z * v[i].z + v[i].w * v[i].w; }
        ss = wave_sum(ss);
        const float rs = rsqrtf(ss * (1.f / 1024.f) + EPS);
        const float* mp = mod + (size_t)row_bi(row) * 6144;
#pragma unroll
        for (int i = 0; i < 4; ++i) { const int col = i * 256 + lane * 4;
            const float4 gg = *(const float4*)(g + col), sc = *(const float4*)(mp + scoff + col), sh = *(const float4*)(mp + shoff + col);
            uint2 w; w.x = pack2(v[i].x * rs * gg.x * (1.f + sc.x) + sh.x, v[i].y * rs * gg.y * (1.f + sc.y) + sh.y);
            w.y = pack2(v[i].z * rs * gg.z * (1.f + sc.z) + sh.z, v[i].w * rs * gg.w * (1.f + sc.w) + sh.w);
            *(uint2*)(H + (size_t)row * 1024 + col) = w; }
    }
}
DI void phase_cache(const Params& p, int l) {
    const size_t gt = (size_t)bid_() * NT + tid_(), gs = (size_t)gridDim.x * NT;
    bf16_t* ckv_s = (bf16_t*)(p.ws + OFF_CKV) + (size_t)MP * 256;
    bf16_t* kr_s = (bf16_t*)(p.ws + OFF_KROPE) + (size_t)MP * 32;
    const float4* s1 = (const float4*)(p.in[4] + (size_t)l * 32 * 4096 * 256);
    for (size_t i = gt; i < 8388608; i += gs) { const size_t e = i * 4, b = e >> 20, rem = e & 1048575; const float4 v = s1[i];
        uint2 w; w.x = pack2(v.x, v.y); w.y = pack2(v.z, v.w); *(uint2*)(ckv_s + b * KEYS_S * 256 + rem) = w; }
    for (size_t i = gt; i < 393216; i += gs) { const size_t e = i * 4, b = e / 49152, rem = e % 49152; uint2 w; w.x = 0; w.y = 0; *(uint2*)(ckv_s + b * KEYS_S * 256 + 4160 * 256 + rem) = w; }
    const float4* s2 = (const float4*)(p.in[5] + (size_t)l * 32 * 4096 * 32);
    for (size_t i = gt; i < 1048576; i += gs) { const size_t e = i * 4, b = e >> 17, rem = e & 131071; const float4 v = s2[i];
        uint2 w; w.x = pack2(v.x, v.y); w.y = pack2(v.z, v.w); *(uint2*)(kr_s + b * KEYS_S * 32 + rem) = w; }
}
DI void phase_post(const Params& p, int l) {
    const int tid = tid_(), lane = tid & 63, wid = __builtin_amdgcn_readfirstlane(tid >> 6);
    const bf16_t* Z = (const bf16_t*)(p.ws + OFF_Z);
    bf16_t* CQN = (bf16_t*)(p.ws + OFF_CQN); bf16_t* CKV = (bf16_t*)(p.ws + OFF_CKV); bf16_t* KRO = (bf16_t*)(p.ws + OFF_KROPE);
    const float* rope = (const float*)(p.ws + OFF_ROPE);
    const float* gcq = p.in[13] + l * 256; const float* gckv = p.in[14] + l * 256; const float* gk = p.in[19] + l * 96 + 64;
    for (int row = bid_() * 8 + wid; row < MT; row += gridDim.x * 8) {
        const bf16_t* zr = Z + (size_t)row * ZLD;
        int pos; size_t grow; float* o_ckv; float* o_kr;
        if (row < MP) { const int b = row >> 13, t = row & 8191; pos = t; grow = row; o_ckv = p.out + OUT_CKVP + ((size_t)(l * 4 + b) * 8192 + t) * 256; o_kr = p.out + OUT_KRP + ((size_t)(l * 4 + b) * 8192 + t) * 32; }
        else { const int r = row - MP, b = r >> 6, t = r & 63; pos = 4096 + t; grow = (size_t)MP + (size_t)b * KEYS_S + 4096 + t; o_ckv = p.out + OUT_CKVS + ((size_t)(l * 32 + b) * 64 + t) * 256; o_kr = p.out + OUT_KRS + ((size_t)(l * 32 + b) * 64 + t) * 32; }
        { const uint2 u = *(const uint2*)(zr + 4 * lane); const float a0 = bflo(u.x), a1 = bfhi(u.x), a2 = bflo(u.y), a3 = bfhi(u.y);
          const float ss = wave_sum(a0 * a0 + a1 * a1 + a2 * a2 + a3 * a3); const float rs = rsqrtf(ss * (1.f / 256.f) + EPS); const float4 g = *(const float4*)(gcq + 4 * lane);
          uint2 w; w.x = pack2(a0 * rs * g.x, a1 * rs * g.y); w.y = pack2(a2 * rs * g.z, a3 * rs * g.w); *(uint2*)(CQN + (size_t)row * 256 + 4 * lane) = w; }
        { const uint2 u = *(const uint2*)(zr + 256 + 4 * lane); const float a0 = bflo(u.x), a1 = bfhi(u.x), a2 = bflo(u.y), a3 = bfhi(u.y);
          const float ss = wave_sum(a0 * a0 + a1 * a1 + a2 * a2 + a3 * a3); const float rs = rsqrtf(ss * (1.f / 256.f) + EPS); const float4 g = *(const float4*)(gckv + 4 * lane);
          float4 o; o.x = a0 * rs * g.x; o.y = a1 * rs * g.y; o.z = a2 * rs * g.z; o.w = a3 * rs * g.w; *(float4*)(o_ckv + 4 * lane) = o;
          uint2 w; w.x = pack2(o.x, o.y); w.y = pack2(o.z, o.w); *(uint2*)(CKV + grow * 256 + 4 * lane) = w; }
        { const int i = lane & 31; const float a = bf2f(zr[512 + i]); float ss = a * a; ss += __shfl_xor(ss, 16); ss += __shfl_xor(ss, 8); ss += __shfl_xor(ss, 4); ss += __shfl_xor(ss, 2); ss += __shfl_xor(ss, 1);
          const float xn = a * rsqrtf(ss * (1.f / 32.f) + EPS) * gk[i]; const float other = __shfl_xor(xn, 16);
          const float2 cs = *(const float2*)(rope + ((size_t)pos * 16 + (i & 15)) * 2);
          const float o = i < 16 ? xn * cs.x - other * cs.y : xn * cs.x + other * cs.y;
          if (lane < 32) { o_kr[i] = o; KRO[grow * 32 + i] = f2bf(o); } }
    }
}

DI f32x16 mfma32(bf16x8 a, bf16x8 b, f32x16 c) { return __builtin_amdgcn_mfma_f32_32x32x16_bf16(a, b, c, 0, 0, 0); }
DI f32x4 mfma16(bf16x8 a, bf16x8 b, f32x4 c) { return __builtin_amdgcn_mfma_f32_16x16x32_bf16(a, b, c, 0, 0, 0); }
DI bf16x8 pack8(const f32x16& s, int b) { u32x4 r; r[0] = pack2(s[b], s[b + 1]); r[1] = pack2(s[b + 2], s[b + 3]); r[2] = pack2(s[b + 4], s[b + 5]); r[3] = pack2(s[b + 6], s[b + 7]); return __builtin_bit_cast(bf16x8, r); }

template <int NH>
DI void attn_core(LAS unsigned char* lds, const bf16_t* qptr, const bf16_t* kn, size_t kn_hs, const bf16_t* kr, const bf16_t* vt, size_t vt_hs, int KL,
                  int kt0, int kstep, int nit, int nvalid, int tile_lim, int hh, f32x16 (&o)[2], float& m_run, float& l_run) {
    constexpr int BUFSZ = NH * 17920 + 5120;
    const int tid = tid_(), lane = tid & 63, r = lane & 31, h = lane >> 5;
    bf16x8 qf[6];
#pragma unroll
    for (int ks = 0; ks < 6; ++ks) qf[ks] = *(const bf16x8*)(qptr + ks * 16 + h * 8);
#pragma unroll
    for (int i = 0; i < 16; ++i) { o[0][i] = 0.f; o[1][i] = 0.f; }
    m_run = -1e30f; l_run = 0.f;
    u32x4 rkn[NH], rvt[NH], rkr = {0u, 0u, 0u, 0u};
    const int lrow = tid >> 3, lseg = tid & 7;
#define ATT_GLOAD(kt) do { const size_t key0_ = (size_t)(kt) * 64; \
        _Pragma("unroll") for (int hx = 0; hx < NH; ++hx) { rkn[hx] = *(const u32x4*)(kn + hx * kn_hs + (key0_ + lrow) * 64 + lseg * 8); rvt[hx] = *(const u32x4*)(vt + hx * vt_hs + (size_t)lrow * KL + key0_ + lseg * 8); } \
        if (tid < 256) rkr = *(const u32x4*)(kr + (key0_ + (tid >> 2)) * 32 + (tid & 3) * 8); } while (0)
#define ATT_LSTORE(buf) do { LAS unsigned char* B_ = lds + (buf) * BUFSZ; \
        _Pragma("unroll") for (int hx = 0; hx < NH; ++hx) { *(LAS u32x4*)(B_ + hx * 9216 + lrow * 144 + lseg * 16) = rkn[hx]; \
            LAS u32x2* pv_ = (LAS u32x2*)(B_ + NH * 9216 + 5120 + hx * 8704 + lrow * 136 + lseg * 16); u32x2 a_, b_; a_[0] = rvt[hx][0]; a_[1] = rvt[hx][1]; b_[0] = rvt[hx][2]; b_[1] = rvt[hx][3]; pv_[0] = a_; pv_[1] = b_; } \
        if (tid < 256) *(LAS u32x4*)(B_ + NH * 9216 + (tid >> 2) * 80 + (tid & 3) * 16) = rkr; } while (0)
    ATT_GLOAD(kt0); ATT_LSTORE(0);
    __syncthreads();
    for (int it = 0; it < nit; ++it) {
        const int ktn = kt0 + (it + 1) * kstep;
        const bool more = (it + 1 < nit) && (ktn < tile_lim);
        if (more) ATT_GLOAD(ktn);
        if (it < nvalid) {
            const LAS unsigned char* B = lds + (it & 1) * BUFSZ;
            const LAS unsigned char* knb = B + hh * 9216; const LAS unsigned char* krb = B + NH * 9216; const LAS unsigned char* vtb = B + NH * 9216 + 5120 + hh * 8704;
            f32x16 s0, s1;
#pragma unroll
            for (int i = 0; i < 16; ++i) { s0[i] = 0.f; s1[i] = 0.f; }
#pragma unroll
            for (int ks = 0; ks < 4; ++ks) { const bf16x8 a0 = *(const LAS bf16x8*)(knb + r * 144 + ks * 32 + h * 16), a1 = *(const LAS bf16x8*)(knb + (32 + r) * 144 + ks * 32 + h * 16);
                s0 = mfma32(a0, qf[ks], s0); s1 = mfma32(a1, qf[ks], s1); }
#pragma unroll
            for (int ks = 0; ks < 2; ++ks) { const bf16x8 a0 = *(const LAS bf16x8*)(krb + r * 80 + ks * 32 + h * 16), a1 = *(const LAS bf16x8*)(krb + (32 + r) * 80 + ks * 32 + h * 16);
                s0 = mfma32(a0, qf[4 + ks], s0); s1 = mfma32(a1, qf[4 + ks], s1); }
            float mx = s0[0];
#pragma unroll
            for (int i = 0; i < 16; ++i) { mx = fmaxf(mx, s0[i]); mx = fmaxf(mx, s1[i]); }
            mx = fmaxf(mx, __shfl_xor(mx, 32));
            const float mnew = fmaxf(m_run, mx), alpha = __builtin_amdgcn_exp2f(m_run - mnew);
            m_run = mnew;
            float ps = 0.f;
#pragma unroll
            for (int i = 0; i < 16; ++i) { s0[i] = __builtin_amdgcn_exp2f(s0[i] - mnew); s1[i] = __builtin_amdgcn_exp2f(s1[i] - mnew); ps += s0[i] + s1[i]; }
            l_run = l_run * alpha + ps;
#pragma unroll
            for (int i = 0; i < 16; ++i) { o[0][i] *= alpha; o[1][i] *= alpha; }
            bf16x8 pf[4];
            pf[0] = pack8(s0, 0); pf[1] = pack8(s0, 8); pf[2] = pack8(s1, 0); pf[3] = pack8(s1, 8);
#pragma unroll
            for (int dh = 0; dh < 2; ++dh)
#pragma unroll
                for (int s4 = 0; s4 < 4; ++s4) { const LAS u32x2* pa = (const LAS u32x2*)(vtb + (32 * dh + r) * 136 + (16 * s4 + 4 * h) * 2); const u32x2 lo = pa[0], hi = pa[2];
                    u32x4 av; av[0] = lo[0]; av[1] = lo[1]; av[2] = hi[0]; av[3] = hi[1]; o[dh] = mfma32(__builtin_bit_cast(bf16x8, av), pf[s4], o[dh]); }
        }
        if (more) ATT_LSTORE((it + 1) & 1);
        __syncthreads();
    }
#undef ATT_GLOAD
#undef ATT_LSTORE
}
DI void phase_attn_p(const Params& p, LAS unsigned char* lds) {
    const int tid = tid_(), lane = tid & 63, wid = __builtin_amdgcn_readfirstlane(tid >> 6), r = lane & 31, h = lane >> 5;
    const bf16_t* Q = (const bf16_t*)(p.ws + OFF_Q); const bf16_t* KN = (const bf16_t*)(p.ws + OFF_KN); const bf16_t* VT = (const bf16_t*)(p.ws + OFF_VT);
    const bf16_t* KRO = (const bf16_t*)(p.ws + OFF_KROPE); bf16_t* O = (bf16_t*)(p.ws + OFF_O);
    for (int pair = bid_(); pair < 512; pair += gridDim.x) {
        const int bh = pair >> 4, qa = pair & 15, b = bh >> 3, hd = bh & 7;
        for (int sub = 0; sub < 2; ++sub) {
            const int qb = sub ? qa : 31 - qa;
            const int t = qb * 256 + wid * 32 + r;
            f32x16 o[2]; float m_run, l_run;
            attn_core<1>(lds, Q + ((size_t)bh * 8192 + t) * 96, KN + (size_t)bh * 8192 * 64, 0, KRO + (size_t)b * 8192 * 32, VT + (size_t)bh * 64 * 8192, 0, 8192,
                         0, 1, 4 * qb + 4, 4 * qb + (wid >> 1) + 1, 1 << 30, 0, o, m_run, l_run);
            const float inv = 1.f / (l_run + __shfl_xor(l_run, 32));
            bf16_t* orow = O + ((size_t)b * 8192 + t) * 512 + hd * 64;
#pragma unroll
            for (int dh = 0; dh < 2; ++dh)
#pragma unroll
                for (int g = 0; g < 4; ++g) { uint2 w; w.x = pack2(o[dh][4 * g] * inv, o[dh][4 * g + 1] * inv); w.y = pack2(o[dh][4 * g + 2] * inv, o[dh][4 * g + 3] * inv); *(uint2*)(orow + 32 * dh + 8 * g + 4 * h) = w; }
        }
    }
}
DI void phase_attn_s(const Params& p, LAS unsigned char* lds) {
    const int tid = tid_(), lane = tid & 63, wid = __builtin_amdgcn_readfirstlane(tid >> 6), r = lane & 31, h = lane >> 5;
    const bf16_t* Q = (const bf16_t*)(p.ws + OFF_Q); const bf16_t* KN = (const bf16_t*)(p.ws + OFF_KN); const bf16_t* VT = (const bf16_t*)(p.ws + OFF_VT);
    const bf16_t* KRO = (const bf16_t*)(p.ws + OFF_KROPE); float* PART = (float*)(p.ws + OFF_PART);
    for (int c = bid_(); c < 256; c += gridDim.x) {
        const int b = c >> 3, hg = (c >> 2) & 1, split = c & 3, hh = wid >> 1, head = hg * 4 + hh, t = (wid & 1) * 32 + r;
        f32x16 o[2]; float m_run, l_run;
        attn_core<4>(lds, Q + (size_t)MP * 768 + ((size_t)(b * 8 + head) * 64 + t) * 96, KN + (size_t)MP * 512 + (size_t)(b * 8 + hg * 4) * KEYS_S * 64, (size_t)KEYS_S * 64,
                     KRO + (size_t)MP * 32 + (size_t)b * KEYS_S * 32, VT + (size_t)MP * 512 + (size_t)(b * 8 + hg * 4) * 64 * KEYS_S, (size_t)64 * KEYS_S, KEYS_S,
                     split, 4, 17, split == 0 ? 17 : 16, 65, hh, o, m_run, l_run);
        const float lt = l_run + __shfl_xor(l_run, 32);
        float* pr = PART + (((size_t)(b * 8 + head) * 4 + split) * 64 + t) * 66;
#pragma unroll
        for (int dh = 0; dh < 2; ++dh)
#pragma unroll
            for (int g = 0; g < 4; ++g) { float2 a, bb; a.x = o[dh][4 * g]; a.y = o[dh][4 * g + 1]; bb.x = o[dh][4 * g + 2]; bb.y = o[dh][4 * g + 3]; float* d = pr + 32 * dh + 8 * g + 4 * h; *(float2*)d = a; *(float2*)(d + 2) = bb; }
        if (h == 0) { float2 ml; ml.x = m_run; ml.y = lt; *(float2*)(pr + 64) = ml; }
    }
}

constexpr int R_QF = 0, R_KF = 16384, R_G = 32768, R_VTI = 49152, R_KTI = 58368, R_QTI = 67584, R_STI = 76800, R_PPI = 86016, R_QHI = 95232, R_KHI = 102144,
              R_GA = 115968, R_WA = 120064, R_SEG = 122240, R_OF = 0;
template <int DK, bool HG>
DI void rec_load(const Params& p, int l, LAS unsigned char* lds, int cid, int hd, bool need_q) {
    const int tid = tid_();
    const bf16_t* Z = (const bf16_t*)(p.ws + OFF_Z);
    const size_t row0 = (size_t)cid * 64;
    LAS float* QF = (LAS float*)(lds + R_QF); LAS float* KF = (LAS float*)(lds + R_KF); LAS float* G = (LAS float*)(lds + R_G);
    LAS bf16_t* VTI = (LAS bf16_t*)(lds + R_VTI); LAS float* GA = (LAS float*)(lds + R_GA); LAS float* WA = (LAS float*)(lds + R_WA); LAS float* SEG = (LAS float*)(lds + R_SEG);
    if (HG) {
        if (tid < 64) { float lb = 0.f; if (l == 1) { const float l0 = p.in[21][hd * 64 + tid], l1 = p.in[21][256 + hd * 64 + tid]; lb = 1.f / (1.f + expf(l0 - l1)); } WA[tid] = lb; }
    } else {
        for (int i = tid; i < 64 * 16; i += NT) { const int j = i >> 4, r = i & 15; GA[i] = bf2f(Z[(row0 + j) * ZLD + 2336 + r]); }
        { const int r = tid >> 5, k = tid & 31; WA[tid] = p.in[23][(l * 16 + r) * 128 + hd * 32 + k]; }
        if (tid < 32) WA[512 + tid] = p.in[24][l * 128 + hd * 32 + tid];
    }
    __syncthreads();
    for (int e = tid; e < 64 * DK; e += NT) {
        const int j = e / DK, k = e % DK; const bf16_t* zr = Z + (row0 + j) * ZLD;
        if (HG) { const float hf = bf2f(zr[800 + hd * 64 + k]), lb = WA[k], s = sigmoidf_(hf); G[e] = logf(lb + (1.f - lb) * s); KF[e] = (1.f - lb) * sigmoidf_(-hf);
            if (need_q) QF[e] = bf2f(zr[544 + hd * 64 + k]); }
        else { float x = WA[512 + k];
#pragma unroll
            for (int r = 0; r < 16; ++r) x += GA[j * 16 + r] * WA[r * 32 + k];
            const float ls = fminf(x, 0.f) - log1pf(expf(-fabsf(x))); G[e] = ls * (1.f / 16.f); KF[e] = bf2f(zr[1696 + hd * 32 + k]);
            if (need_q) QF[e] = bf2f(zr[1568 + hd * 32 + k]) * 0.17677669529663687f; }
    }
    const int voff = HG ? 1056 : 1824;
    for (int e = tid; e < 4096; e += NT) { const int j = e >> 6, v = e & 63; VTI[v * 72 + j] = Z[(row0 + j) * ZLD + voff + hd * 64 + v]; }
    __syncthreads();
    constexpr int NSEG = NT / DK, JS = 64 / NSEG;
    const int seg = tid / DK, k = tid % DK;
    float loc[JS]; float s = 0.f;
#pragma unroll
    for (int jj = 0; jj < JS; ++jj) { s += G[(seg * JS + jj) * DK + k]; loc[jj] = s; }
    SEG[seg * DK + k] = s;
    __syncthreads();
    float off = 0.f;
#pragma unroll
    for (int s2 = 0; s2 < NSEG; ++s2) { const float t = SEG[s2 * DK + k]; off += s2 < seg ? t : 0.f; }
#pragma unroll
    for (int jj = 0; jj < JS; ++jj) G[(seg * JS + jj) * DK + k] = loc[jj] + off;
    __syncthreads();
}
template <int DK, bool HG>
DI void rec_passA_item(const Params& p, int l, LAS unsigned char* lds, int cid, int hd) {
    const int tid = tid_(), lane = tid & 63, wid = __builtin_amdgcn_readfirstlane(tid >> 6), fr = lane & 15, fq = lane >> 4;
    rec_load<DK, HG>(p, l, lds, cid, hd, false);
    LAS float* KF = (LAS float*)(lds + R_KF); LAS float* G = (LAS float*)(lds + R_G);
    LAS bf16_t* VTI = (LAS bf16_t*)(lds + R_VTI); LAS bf16_t* KTI = (LAS bf16_t*)(lds + R_KTI);
    float* U = (float*)(p.ws + (HG ? OFF_UHG : OFF_UGL)); float* D = (float*)(p.ws + (HG ? OFF_DHG : OFF_DGL));
    for (int e = tid; e < 64 * DK; e += NT) { const int j = e / DK, k = e % DK; KTI[k * 72 + j] = f2bf(KF[e] * expf(G[63 * DK + k] - G[e])); }
    if (tid < DK) D[((size_t)cid * 4 + hd) * DK + tid] = expf(G[63 * DK + tid]);
    __syncthreads();
    for (int tile = wid; tile < (DK / 16) * 4; tile += 8) {
        const int tk = tile >> 2, tv = tile & 3; f32x4 acc = {0.f, 0.f, 0.f, 0.f};
#pragma unroll
        for (int s = 0; s < 2; ++s) { const bf16x8 a = *(const LAS bf16x8*)(KTI + (16 * tk + fr) * 72 + 32 * s + 8 * fq), b = *(const LAS bf16x8*)(VTI + (16 * tv + fr) * 72 + 32 * s + 8 * fq); acc = mfma16(a, b, acc); }
#pragma unroll
        for (int reg = 0; reg < 4; ++reg) U[(((size_t)cid * 4 + hd) * DK + 16 * tk + 4 * fq + reg) * 64 + 16 * tv + fr] = acc[reg];
    }
    __syncthreads();
}
template <int DK, bool HG>
DI void rec_passC_item(const Params& p, int l, LAS unsigned char* lds, int cid, int hd) {
    const int tid = tid_(), lane = tid & 63, wid = __builtin_amdgcn_readfirstlane(tid >> 6), fr = lane & 15, fq = lane >> 4;
    rec_load<DK, HG>(p, l, lds, cid, hd, true);
    LAS float* QF = (LAS float*)(lds + R_QF); LAS float* KF = (LAS float*)(lds + R_KF); LAS float* G = (LAS float*)(lds + R_G); LAS float* OF = (LAS float*)(lds + R_OF);
    LAS bf16_t* VTI = (LAS bf16_t*)(lds + R_VTI); LAS bf16_t* QTI = (LAS bf16_t*)(lds + R_QTI); LAS bf16_t* STI = (LAS bf16_t*)(lds + R_STI);
    LAS bf16_t* PPI = (LAS bf16_t*)(lds + R_PPI); LAS bf16_t* QHI = (LAS bf16_t*)(lds + R_QHI); LAS bf16_t* KHI = (LAS bf16_t*)(lds + R_KHI);
    const float* S = (const float*)(p.ws + (HG ? OFF_UHG : OFF_UGL)) + ((size_t)cid * 4 + hd) * DK * 64;
    const bf16_t* Z = (const bf16_t*)(p.ws + OFF_Z); bf16_t* H = (bf16_t*)(p.ws + OFF_H);
    for (int e = tid; e < 64 * DK; e += NT) { const int i = e / DK, k = e % DK; QTI[i * 72 + k] = f2bf(QF[e] * expf(G[e])); }
    for (int e = tid; e < DK * 64; e += NT) { const int k = e >> 6, v = e & 63; STI[v * 72 + k] = f2bf(S[e]); }
    for (int e = tid; e < 48 * DK; e += NT) { const int ii = e / DK, k = e % DK, I = 1 + (ii >> 4), i = 16 + ii; const float ref = G[(16 * I - 1) * DK + k];
        QHI[ii * 72 + k] = f2bf(QF[i * DK + k] * expf(G[i * DK + k] - ref)); }
    for (int e = tid; e < 96 * DK; e += NT) { const int rr = e / DK, k = e % DK, I = rr < 16 ? 1 : (rr < 48 ? 2 : 3), j = rr - 8 * I * (I - 1); const float ref = G[(16 * I - 1) * DK + k];
        KHI[rr * 72 + k] = f2bf(KF[j * DK + k] * expf(ref - G[j * DK + k])); }
    { const int blk = tid >> 7, e = tid & 127, il = e >> 3, jp = e & 7, i = 16 * blk + il;
#pragma unroll
      for (int jj = 0; jj < 2; ++jj) { const int jl = 2 * jp + jj, j = 16 * blk + jl; float pv = 0.f;
          if (jl <= il) { for (int k = 0; k < DK; k += 4) { const f32x4 q4 = *(const LAS f32x4*)(QF + i * DK + k), gi = *(const LAS f32x4*)(G + i * DK + k), k4 = *(const LAS f32x4*)(KF + j * DK + k), gj = *(const LAS f32x4*)(G + j * DK + k);
              pv += q4[0] * k4[0] * expf(gi[0] - gj[0]) + q4[1] * k4[1] * expf(gi[1] - gj[1]) + q4[2] * k4[2] * expf(gi[2] - gj[2]) + q4[3] * k4[3] * expf(gi[3] - gj[3]); } }
          PPI[i * 72 + j] = f2bf(pv); } }
    for (int e = tid; e < 1536; e += NT) { const int bidx = e >> 8, w = e & 255; const int I = bidx < 3 ? 0 : (bidx < 5 ? 1 : 2), J = bidx < 3 ? bidx + 1 : (bidx < 5 ? bidx - 1 : 3);
        PPI[(16 * I + (w >> 4)) * 72 + 16 * J + (w & 15)] = 0; }
    __syncthreads();
    if (wid < 6) { const int I = wid < 1 ? 1 : (wid < 3 ? 2 : 3), J = wid < 1 ? 0 : (wid < 3 ? wid - 1 : wid - 3); f32x4 acc = {0.f, 0.f, 0.f, 0.f};
#pragma unroll
        for (int s = 0; s < DK / 32; ++s) { const bf16x8 a = *(const LAS bf16x8*)(QHI + ((I - 1) * 16 + fr) * 72 + 32 * s + 8 * fq), b = *(const LAS bf16x8*)(KHI + (8 * I * (I - 1) + 16 * J + fr) * 72 + 32 * s + 8 * fq); acc = mfma16(a, b, acc); }
#pragma unroll
        for (int reg = 0; reg < 4; ++reg) PPI[(16 * I + 4 * fq + reg) * 72 + 16 * J + fr] = f2bf(acc[reg]); }
    __syncthreads();
#pragma unroll
    for (int tt = 0; tt < 2; ++tt) { const int tile = wid * 2 + tt, ti = tile >> 2, tv = tile & 3; f32x4 acc = {0.f, 0.f, 0.f, 0.f};
#pragma unroll
        for (int s = 0; s < DK / 32; ++s) { const bf16x8 a = *(const LAS bf16x8*)(QTI + (16 * ti + fr) * 72 + 32 * s + 8 * fq), b = *(const LAS bf16x8*)(STI + (16 * tv + fr) * 72 + 32 * s + 8 * fq); acc = mfma16(a, b, acc); }
#pragma unroll
        for (int s = 0; s < 2; ++s) { const bf16x8 a = *(const LAS bf16x8*)(PPI + (16 * ti + fr) * 72 + 32 * s + 8 * fq), b = *(const LAS bf16x8*)(VTI + (16 * tv + fr) * 72 + 32 * s + 8 * fq); acc = mfma16(a, b, acc); }
#pragma unroll
        for (int reg = 0; reg < 4; ++reg) OF[(16 * ti + 4 * fq + reg) * 65 + 16 * tv + fr] = acc[reg]; }
    __syncthreads();
    { const int i = tid >> 3, part = tid & 7; float v[8]; float ss = 0.f;
#pragma unroll
      for (int x = 0; x < 8; ++x) { v[x] = OF[i * 65 + part * 8 + x]; ss += v[x] * v[x]; }
      ss += __shfl_xor(ss, 1); ss += __shfl_xor(ss, 2); ss += __shfl_xor(ss, 4);
      const float rs = rsqrtf(ss * (1.f / 64.f) + EPS);
      const size_t row = (size_t)cid * 64 + i;
      const uint4 gz = *(const uint4*)(Z + row * ZLD + (HG ? 1312 : 2080) + hd * 64 + part * 8);
      const float* go = p.in[HG ? 22 : 25] + l * 64 + part * 8;
      const float gt[8] = {bflo(gz.x), bfhi(gz.x), bflo(gz.y), bfhi(gz.y), bflo(gz.z), bfhi(gz.z), bflo(gz.w), bfhi(gz.w)};
      float r[8];
#pragma unroll
      for (int x = 0; x < 8; ++x) r[x] = v[x] * rs * go[x] * (gt[x] / (1.f + expf(-gt[x])));
      uint4 w; w.x = pack2(r[0], r[1]); w.y = pack2(r[2], r[3]); w.z = pack2(r[4], r[5]); w.w = pack2(r[6], r[7]);
      *(uint4*)(H + row * 1024 + 512 + (HG ? 0 : 256) + hd * 64 + part * 8) = w; }
    __syncthreads();
}
template <int DK>
DI void scan_prompt(float* U, const float* D, float* outp, int e) {
    const int v = e & 63, k = (e >> 6) % DK, hd = (e / (64 * DK)) & 3, b = e / (256 * DK);
    float S = 0.f;
    for (int n0 = 0; n0 < 128; n0 += 8) {
        float u[8], d[8];
#pragma unroll
        for (int i = 0; i < 8; ++i) { const size_t ch = ((size_t)(b * 128 + n0 + i) * 4 + hd); u[i] = U[(ch * DK + k) * 64 + v]; d[i] = D[ch * DK + k]; }
#pragma unroll
        for (int i = 0; i < 8; ++i) { const size_t ch = ((size_t)(b * 128 + n0 + i) * 4 + hd); U[(ch * DK + k) * 64 + v] = S; S = d[i] * S + u[i]; }
    }
    outp[e] = S;
}
template <int DK>
DI void scan_sample(float* U, const float* D, const float* s0p, float* outp, int e) {
    const int v = e & 63, k = (e >> 6) % DK, hd = (e / (64 * DK)) & 3, b = e / (256 * DK);
    const size_t ch = (size_t)(512 + b) * 4 + hd; const size_t idx = (ch * DK + k) * 64 + v;
    const float s0 = s0p[e], u = U[idx], d = D[ch * DK + k];
    U[idx] = s0; outp[e] = d * s0 + u;
}
DI void phase_scan(const Params& p, int l) {
    const int g = bid_() * NT + tid_(), gs = gridDim.x * NT;
    float* UH = (float*)(p.ws + OFF_UHG); const float* DH = (const float*)(p.ws + OFF_DHG); float* UG = (float*)(p.ws + OFF_UGL); const float* DG = (const float*)(p.ws + OFF_DGL);
    for (int e = g; e < 98304; e += gs) {
        if (e < 65536) scan_prompt<64>(UH, DH, p.out + OUT_HGP + (size_t)l * 65536, e);
        else scan_prompt<32>(UG, DG, p.out + OUT_GLP + (size_t)l * 32768, e - 65536);
    }
    for (int e = g; e < 786432; e += gs) {
        if (e < 524288) scan_sample<64>(UH, DH, p.in[6] + (size_t)l * 524288, p.out + OUT_HGS + (size_t)l * 524288, e);
        else scan_sample<32>(UG, DG, p.in[7] + (size_t)l * 262144, p.out + OUT_GLS + (size_t)l * 262144, e - 524288);
    }
}
DI void phase_mlaout(const Params& p, int l) {
    const int tid = tid_(), lane = tid & 63, wid = __builtin_amdgcn_readfirstlane(tid >> 6);
    const bf16_t* O = (const bf16_t*)(p.ws + OFF_O); const float* PART = (const float*)(p.ws + OFF_PART); bf16_t* H = (bf16_t*)(p.ws + OFF_H);
    const float* g = p.in[20] + l * 512 + 8 * lane;
    for (int row = bid_() * 8 + wid; row < MT; row += gridDim.x * 8) {
        float v[8];
        if (row < MP) { const uint4 u = *(const uint4*)(O + (size_t)row * 512 + 8 * lane);
            v[0] = bflo(u.x); v[1] = bfhi(u.x); v[2] = bflo(u.y); v[3] = bfhi(u.y); v[4] = bflo(u.z); v[5] = bfhi(u.z); v[6] = bflo(u.w); v[7] = bfhi(u.w); }
        else { const int r = row - MP, b = r >> 6, t = r & 63, head = lane >> 3, dv0 = (lane & 7) * 8;
            const float* pb = PART + (((size_t)(b * 8 + head) * 4) * 64 + t) * 66;
            float m[4], lsum[4]; float M = -1e30f;
#pragma unroll
            for (int s = 0; s < 4; ++s) { m[s] = pb[(size_t)s * 64 * 66 + 64]; lsum[s] = pb[(size_t)s * 64 * 66 + 65]; M = fmaxf(M, m[s]); }
            float L = 0.f;
#pragma unroll
            for (int x = 0; x < 8; ++x) v[x] = 0.f;
#pragma unroll
            for (int s = 0; s < 4; ++s) { const float w = exp2f(m[s] - M); L += w * lsum[s];
#pragma unroll
                for (int x = 0; x < 8; ++x) v[x] += w * pb[(size_t)s * 64 * 66 + dv0 + x]; }
            const float inv = 1.f / L;
#pragma unroll
            for (int x = 0; x < 8; ++x) v[x] *= inv; }
        float ss = 0.f;
#pragma unroll
        for (int x = 0; x < 8; ++x) ss += v[x] * v[x];
        ss = wave_sum(ss);
        const float rs = rsqrtf(ss * (1.f / 512.f) + EPS);
        uint4 w; w.x = pack2(v[0] * rs * g[0], v[1] * rs * g[1]); w.y = pack2(v[2] * rs * g[2], v[3] * rs * g[3]); w.z = pack2(v[4] * rs * g[4], v[5] * rs * g[5]); w.w = pack2(v[6] * rs * g[6], v[7] * rs * g[7]);
        *(uint4*)(H + (size_t)row * 1024 + 8 * lane) = w;
    }
}

__global__ void __launch_bounds__(512, 2) mk_fwd(Params p) {
    extern __shared__ __attribute__((aligned(16))) unsigned char shm[];
    LAS unsigned char* lds = (LAS unsigned char*)shm;
    cg::grid_group grid = cg::this_grid();
    bf16_t* H = (bf16_t*)(p.ws + OFF_H); bf16_t* Z = (bf16_t*)(p.ws + OFF_Z); bf16_t* CQN = (bf16_t*)(p.ws + OFF_CQN); bf16_t* CKV = (bf16_t*)(p.ws + OFF_CKV);
    bf16_t* Q = (bf16_t*)(p.ws + OFF_Q); bf16_t* KN = (bf16_t*)(p.ws + OFF_KN); bf16_t* VT = (bf16_t*)(p.ws + OFF_VT); bf16_t* ACT = (bf16_t*)(p.ws + OFF_ACT);
    const float* rope = (const float*)(p.ws + OFF_ROPE);
    phase_prep(p, lds);
    grid.sync();
#pragma unroll 1
    for (int l = 0; l < 2; ++l) {
        const float* xa = l == 0 ? p.in[0] : p.out; const float* xb = l == 0 ? p.in[1] : p.out + (size_t)MP * 1024;
        const unsigned char* W = p.ws + OFF_W + (size_t)l * WL;
        const float* modl = (const float*)(p.ws + OFF_MOD) + (size_t)l * 36 * 6144;
        phase_hrows(p, l, xa, xb, p.in[10] + l * 1024, 0, 1024);
        phase_cache(p, l);
        grid.sync();
        run_gemm(lds, H, (const bf16_t*)(W + WOFF_IN), MT, 2560, 1024, EpiZ{Z, ZLD});
        grid.sync();
        phase_post(p, l);
        grid.sync();
        run_gemm(lds, CQN, (const bf16_t*)(W + WOFF_UQ), MT, 768, 256, EpiQ{Q, p.in[18] + l * 96, rope});
        run_gemm(lds, CKV, (const bf16_t*)(W + WOFF_UK), KR_ROWS, 512, 256, EpiKN{KN, p.in[19] + l * 96});
        run_gemm(lds, (const bf16_t*)(W + WOFF_UV), CKV, 512, KR_ROWS, 256, EpiVT{VT});
        grid.sync();
        phase_attn_p(p, lds);
        phase_attn_s(p, lds);
        for (int it = bid_(); it < 2176; it += gridDim.x) rec_passA_item<64, true>(p, l, lds, it >> 2, it & 3);
        for (int it = bid_(); it < 2176; it += gridDim.x) rec_passA_item<32, false>(p, l, lds, it >> 2, it & 3);
        grid.sync();
        phase_scan(p, l);
        grid.sync();
        for (int it = bid_(); it < 2176; it += gridDim.x) rec_passC_item<64, true>(p, l, lds, it >> 2, it & 3);
        for (int it = bid_(); it < 2176; it += gridDim.x) rec_passC_item<32, false>(p, l, lds, it >> 2, it & 3);
        phase_mlaout(p, l);
        grid.sync();
        run_gemm(lds, H, (const bf16_t*)(W + WOFF_O), MT, 1024, 1024, EpiRes{xa, xb, p.out, modl + 2048});
        grid.sync();
        phase_hrows(p, l, p.out, p.out + (size_t)MP * 1024, p.in[11] + l * 1024, 3072, 4096);
        grid.sync();
        run_gemm(lds, H, (const bf16_t*)(W + WOFF_FI), MT, 5632, 1024, EpiSwi{ACT});
        grid.sync();
        run_gemm(lds, ACT, (const bf16_t*)(W + WOFF_FO), MT, 1024, 2816, EpiRes{p.out, p.out + (size_t)MP * 1024, p.out, modl + 5120});
        grid.sync();
    }
}

extern "C" void kernel_launch(void* const* d_in, const int* in_sizes, int n_in, void* d_out, int out_size, void* d_ws, size_t ws_size, hipStream_t stream) {
    static int grid = 0;
    if (grid == 0) {
        int dev = 0, cus = 0, per_cu = 0;
        hipGetDevice(&dev);
        hipDeviceGetAttribute(&cus, hipDeviceAttributeMultiprocessorCount, dev);
        hipFuncSetAttribute((const void*)mk_fwd, hipFuncAttributeMaxDynamicSharedMemorySize, LDS_BYTES);
        hipOccupancyMaxActiveBlocksPerMultiprocessor(&per_cu, (const void*)mk_fwd, NT, LDS_BYTES);
        if (per_cu < 1) { fprintf(stderr, "kernel_launch: occupancy query says %d blocks per CU\n", per_cu); per_cu = 1; }
        (void)hipGetLastError();
        grid = cus;
        if (ws_size < WS_END) { fprintf(stderr, "kernel_launch: workspace too small: %zu < %zu\n", ws_size, (size_t)WS_END); grid = -1; }
    }
    if (grid < 0) return;
    Params p{};
    for (int i = 0; i < 29; ++i) p.in[i] = (const float*)d_in[i];
    p.out = (float*)d_out; p.ws = (unsigned char*)d_ws;
    void* args[] = {&p};
    hipError_t e = hipLaunchCooperativeKernel((const void*)mk_fwd, dim3(grid), dim3(NT), args, LDS_BYTES, stream);
    if (e != hipSuccess) fprintf(stderr, "cooperative launch failed: %s (grid %d)\n", hipGetErrorString(e), grid);
}
```

```cpp
#include <hip/hip_runtime.h>
#include <hip/hip_cooperative_groups.h>
#include <cstdio>
namespace cg = cooperative_groups;
namespace pg8 {
#define PG8_LAS __attribute__((address_space(3)))
typedef unsigned short bf16_t;
typedef short bf16x8 __attribute__((ext_vector_type(8)));
typedef float f32x4 __attribute__((ext_vector_type(4)));
typedef unsigned u32x4 __attribute__((ext_vector_type(4)));
constexpr int BM = 256, BK = 64, HALF = 128, HTB = HALF * BK * 2  , STAGE_BYTES = 8 * HTB, NXCD = 8, WGM = 8;

__host__ __device__ __forceinline__ int lds_byte(int r, int c) { const int st = (r >> 4) * 2 + (c >> 5), rr = r & 15, cc = c & 31, ob = rr * 64 + cc * 2; return st * 1024 + (ob ^ (((ob >> 9) & 1) << 5)); }
__host__ __device__ __forceinline__ void stage_rc(int b, int& R, int& C) { const int st = b / 1024, sb = b % 1024, swz = sb ^ (((sb >> 9) & 1) << 5); R = (st >> 1) * 16 + swz / 64; C = (st & 1) * 32 + (swz % 64) / 2; }
__host__ __device__ __forceinline__ int perm32(int rho) { const int n = rho >> 4, i = rho & 15; return 8 * (i >> 2) + 4 * n + (i & 3); }

struct Unit { int pm, pn; };
struct Gemm { const bf16_t* A; const bf16_t* Bt; int M, N, K; };

struct StaticOrder {
    int nM, nN, nwg, G, c;
    __host__ __device__ void init(int M, int N, int G_, int c_) { nM = M / BM; nN = N / BM; nwg = nM * nN; G = G_; c = c_; }
    __host__ __device__ bool next(int i, Unit& u) const {
        const long L = (long)i * G + c; if (L >= nwg) return false;
        int wgid = (int)L; { const int q = nwg / NXCD, r = nwg % NXCD, xcd = wgid % NXCD, off = wgid / NXCD; wgid = (xcd < r ? xcd * (q + 1) : r * (q + 1) + (xcd - r) * q) + off; }
        const int nig = WGM * nN, gid = wgid / nig, fm = gid * WGM, gsz = (nM - fm) < WGM ? (nM - fm) : WGM;
        u.pm = fm + ((wgid % nig) % gsz); u.pn = (wgid % nig) / gsz; return true;
    }
    __device__ __forceinline__ void a_ready(const Unit&) const {}
    __device__ __forceinline__ void done(const Unit&) const {}
};
template <class Epi, class Sched, bool STAMP = false>
__device__ __forceinline__ void gemm_phase(PG8_LAS unsigned char* lds, const Gemm g, const Sched& S, const Epi& E, unsigned long long* stamps) {
    int tid = threadIdx.x; asm volatile("" : "+v"(tid)); const int wid = __builtin_amdgcn_readfirstlane(tid >> 6), lane = tid & 63, wr = wid >> 2, wc = wid & 3, fr = lane & 15, fq = lane >> 4;
    const int K = g.K, nt = K / BK;
    int ts_lo = 0, ts_hi = 0, nts = 0; const unsigned long long rt_entry = STAMP ? (unsigned long long)wall_clock64() : 0ull;
#define PG8_STAMP() do { if (STAMP && wid == 0 && nts < 64) { const unsigned long long _c = (unsigned long long)clock64(); \
        ts_lo = (lane == nts) ? (int)(unsigned)_c : ts_lo; ts_hi = (lane == nts) ? (int)(unsigned)(_c >> 32) : ts_hi; ++nts; } } while (0)
    PG8_STAMP();
    unsigned voffA[2], voffB[2];
#pragma unroll
    for (int i = 0; i < 2; ++i) { int R, C; stage_rc(tid * 16 + i * 8192, R, C); const int Rb = Epi::PERM ? ((R & ~31) + perm32(R & 31)) : R;
        voffA[i] = (unsigned)(R * K + C) * 2u; voffB[i] = (unsigned)(Rb * K + C) * 2u; }
    const size_t kstep = (size_t)(BK * 2);
    const size_t hstep = (size_t)HALF * K * 2;
    const size_t tstep = 2 * hstep;
    const unsigned ldsw = (unsigned)wid * 1024u;
    const int aoff = lds_byte(wr * 64 + fr, fq * 8), boff = lds_byte(wc * 32 + fr, fq * 8);
#define PG8_SA(b, h) (((b) * 2 + (h)) * HTB)
#define PG8_SB(b, h) ((4 + (b) * 2 + (h)) * HTB)
#define PG8_STAGE(bufoff, gbase, voff) do { _Pragma("unroll") for (int _i = 0; _i < 2; ++_i) \
        __builtin_amdgcn_global_load_lds((const unsigned*)((const char*)(gbase) + (voff)[_i]), (PG8_LAS unsigned*)(lds + (bufoff) + ldsw + _i * 8192), 16, 0, 0); } while (0)
#define PG8_LDA(dst, b, h) do { _Pragma("unroll") for (int m = 0; m < 4; ++m) _Pragma("unroll") for (int k = 0; k < 2; ++k) dst[m][k] = *(const PG8_LAS bf16x8*)(lds + PG8_SA(b, h) + aoff + m * 2048 + k * 1024); } while (0)
#define PG8_LDB(dst, b, h) do { _Pragma("unroll") for (int n = 0; n < 2; ++n) _Pragma("unroll") for (int k = 0; k < 2; ++k) dst[n][k] = *(const PG8_LAS bf16x8*)(lds + PG8_SB(b, h) + boff + n * 2048 + k * 1024); } while (0)
#define PG8_MMA(ai, bj, At, Bt) do { __builtin_amdgcn_s_setprio(1); _Pragma("unroll") for (int m = 0; m < 4; ++m) _Pragma("unroll") for (int n = 0; n < 2; ++n) _Pragma("unroll") for (int k = 0; k < 2; ++k) \
        acc[ai][bj][m][n] = __builtin_amdgcn_mfma_f32_16x16x32_bf16(Bt[n][k], At[m][k], acc[ai][bj][m][n], 0, 0, 0); __builtin_amdgcn_s_setprio(0); } while (0)
#define PG8_WAIT_V(n) asm volatile("s_waitcnt vmcnt(" #n ")" ::: "memory")
#define PG8_WAIT_L(n) asm volatile("s_waitcnt lgkmcnt(" #n ")" ::: "memory")
#define PG8_BAR __builtin_amdgcn_s_barrier()
#define PG8_SCHED __builtin_amdgcn_sched_barrier(0)
    Unit cur, nxt; int ui = 0;
    if (!S.next(0, cur)) return;
    f32x4 acc[2][2][4][2];
#pragma unroll
    for (int a = 0; a < 2; ++a)
#pragma unroll
        for (int b = 0; b < 2; ++b)
#pragma unroll
            for (int m = 0; m < 4; ++m)
#pragma unroll
                for (int n = 0; n < 2; ++n) acc[a][b][m][n] = (f32x4){0.f, 0.f, 0.f, 0.f};
    bf16x8 At[4][2], B0[2][2], B1[2][2];
    const char* cA = (const char*)g.A + (size_t)cur.pm * tstep; const char* cB = (const char*)g.Bt + (size_t)cur.pn * tstep;
    S.a_ready(cur);
    PG8_STAGE(PG8_SB(0, 0), cB, voffB); PG8_STAGE(PG8_SA(0, 0), cA, voffA); PG8_STAGE(PG8_SB(0, 1), cB + hstep, voffB); PG8_STAGE(PG8_SA(0, 1), cA + hstep, voffA);
    if (wr == 1) PG8_BAR;
    PG8_WAIT_V(4); PG8_BAR;
    PG8_STAGE(PG8_SB(1, 0), cB + kstep, voffB); PG8_STAGE(PG8_SA(1, 0), cA + kstep, voffA); PG8_STAGE(PG8_SB(1, 1), cB + hstep + kstep, voffB);
    PG8_WAIT_V(6); PG8_BAR;
    PG8_STAMP();
    for (;;) {
        const bool has_next = S.next(ui + 1, nxt);
        const char* nA = has_next ? (const char*)g.A + (size_t)nxt.pm * tstep : cA; const char* nB = has_next ? (const char*)g.Bt + (size_t)nxt.pn * tstep : cB;
        for (int t = 0; t < nt; t += 2) {
            const bool last = (t == nt - 2);
            const char* a1 = cA + (size_t)(t + 1) * kstep;
            const char* a2 = last ? nA : cA + (size_t)(t + 2) * kstep; const char* b2 = last ? nB : cB + (size_t)(t + 2) * kstep;
            const char* a3 = a2 + kstep; const char* b3 = b2 + kstep;
            if (last && has_next) S.a_ready(nxt);
            PG8_LDB(B0, 0, 0); PG8_SCHED; PG8_LDA(At, 0, 0); PG8_STAGE(PG8_SA(1, 1), a1 + hstep, voffA);
            PG8_WAIT_L(8); PG8_BAR; PG8_WAIT_L(0); PG8_MMA(0, 0, At, B0); PG8_BAR; PG8_SCHED;
            PG8_LDB(B1, 0, 1); PG8_STAGE(PG8_SB(0, 0), b2, voffB);
            PG8_BAR; PG8_WAIT_L(0); PG8_MMA(0, 1, At, B1); PG8_BAR;
            PG8_LDA(At, 0, 1); PG8_STAGE(PG8_SA(0, 0), a2, voffA);
            PG8_BAR; PG8_WAIT_L(0); PG8_MMA(1, 0, At, B0); PG8_BAR; PG8_SCHED;
            PG8_STAGE(PG8_SB(0, 1), b2 + hstep, voffB);
            PG8_WAIT_V(6); PG8_BAR; PG8_MMA(1, 1, At, B1); PG8_BAR;
            PG8_LDB(B0, 1, 0); PG8_SCHED; PG8_LDA(At, 1, 0); PG8_STAGE(PG8_SA(0, 1), a2 + hstep, voffA);
            PG8_WAIT_L(8); PG8_BAR; PG8_WAIT_L(0); PG8_MMA(0, 0, At, B0); PG8_BAR; PG8_SCHED;
            PG8_LDB(B1, 1, 1); PG8_STAGE(PG8_SB(1, 0), b3, voffB);
            PG8_BAR; PG8_WAIT_L(0); PG8_MMA(0, 1, At, B1); PG8_BAR;
            PG8_LDA(At, 1, 1); PG8_STAGE(PG8_SA(1, 0), a3, voffA);
            PG8_BAR; PG8_WAIT_L(0); PG8_MMA(1, 0, At, B0); PG8_BAR; PG8_SCHED;
            PG8_STAGE(PG8_SB(1, 1), b3 + hstep, voffB);
            PG8_WAIT_V(6); PG8_BAR; PG8_MMA(1, 1, At, B1); PG8_BAR;
        }
        PG8_STAMP();
        if constexpr (!Epi::AFTER_DRAIN) { E(acc, cur, wr, wc, fr, fq); S.done(cur); }
        PG8_STAMP();
        if (!has_next) break;
#pragma unroll
        for (int a = 0; a < 2; ++a)
#pragma unroll
            for (int b = 0; b < 2; ++b)
#pragma unroll
                for (int m = 0; m < 4; ++m)
#pragma unroll
                    for (int n = 0; n < 2; ++n) acc[a][b][m][n] = (f32x4){0.f, 0.f, 0.f, 0.f};
        cur = nxt; cA = nA; cB = nB; ++ui;
    }
    PG8_WAIT_V(0);
    if (wr == 0) PG8_BAR;
    PG8_BAR;
    if constexpr (Epi::AFTER_DRAIN) { E.fused(acc, cur, wr, wc, fr, fq, lds, wid, lane); S.done(cur); }
    PG8_STAMP();
    if (STAMP && wid == 0) { stamps[lane] = lane < nts ? (((unsigned long long)(unsigned)ts_hi << 32) | (unsigned)ts_lo) : 0ull;
        if (lane == 62) stamps[62] = rt_entry; if (lane == 63) stamps[63] = (unsigned long long)wall_clock64(); }
#undef PG8_STAMP
#undef PG8_SA
#undef PG8_SB
#undef PG8_STAGE
#undef PG8_LDA
#undef PG8_LDB
#undef PG8_MMA
#undef PG8_WAIT_V
#undef PG8_WAIT_L
#undef PG8_BAR
#undef PG8_SCHED
}
}
#define XB_TMO      128
#define XB_XCNT(j)  (256  + 64 * (j))
#define XB_XSUB(j)  (1280 + 64 * (j))
#define XB_XGEN(j)  (2304 + 64 * (j))
#define XB_TOP      3328
#define XB_TOPGEN   3392
#define XCD_BAR_WORDS 3456
#define XB_SPIN_CAP (1u << 22)

__device__ __forceinline__ unsigned xb_ld(unsigned* p)              { return __hip_atomic_load(p, __ATOMIC_RELAXED, __HIP_MEMORY_SCOPE_AGENT); }
__device__ __forceinline__ unsigned xb_add(unsigned* p, unsigned v) { return __hip_atomic_fetch_add(p, v, __ATOMIC_RELAXED, __HIP_MEMORY_SCOPE_AGENT); }
__device__ __forceinline__ unsigned xb_xcc_id() { return (unsigned)__builtin_amdgcn_s_getreg((3 << 11) | 20) & 0xFu; }
#define XB_SPIN(cond, bar) do { unsigned _sp = 0; while (cond) { __builtin_amdgcn_s_sleep(1); \
    if ((++_sp & 255u) == 0u) { if (xb_ld(&(bar)[XB_TMO])) break; if (_sp > XB_SPIN_CAP) { atomicAdd(&(bar)[XB_TMO], 1u); break; } } } } while (0)

struct XcdBarrier {
    unsigned* bar; unsigned x;
    volatile PG8_LAS unsigned* st;
};

__device__ __forceinline__ XcdBarrier xcd_barrier_post(unsigned* bar, volatile PG8_LAS unsigned* st) {
    XcdBarrier b; b.bar = bar; b.x = xb_xcc_id(); b.st = st;
    if (threadIdx.x == 0) (void)xb_add(&bar[XB_XCNT(b.x)], 1u);
    return b;
}
__device__ __forceinline__ void xcd_barrier_complete(unsigned* bar, unsigned x, unsigned& nloc, unsigned& nx) {
    const unsigned G = gridDim.x * gridDim.y * gridDim.z;
    unsigned sum, cnt, mine, sp = 0u;
    for (;;) {
        sum = 0u; cnt = 0u; mine = 0u;
#pragma unroll
        for (unsigned j = 0; j < 16; ++j) { const unsigned c = xb_ld(&bar[XB_XCNT(j)]); sum += c; cnt += (c > 0u) ? 1u : 0u; mine = (j == x) ? c : mine; }
        if (sum == G) break;
        __builtin_amdgcn_s_sleep(1);
        if ((++sp & 255u) == 0u) { if (xb_ld(&bar[XB_TMO])) break; if (sp > XB_SPIN_CAP) { atomicAdd(&bar[XB_TMO], 1u); break; } }
    }
    nloc = mine > 0u ? mine : 1u; nx = cnt > 0u ? cnt : 1u;
}

__device__ __forceinline__ void xcd_barrier(const XcdBarrier& b) {
    asm volatile("s_waitcnt vmcnt(0)" ::: "memory");
    __syncthreads();
    if (threadIdx.x == 0) {
        unsigned* bar = b.bar;
        __builtin_amdgcn_s_waitcnt(0);
        unsigned nloc = b.st[0], nx = b.st[1];
        if (nloc == 0u) { xcd_barrier_complete(bar, b.x, nloc, nx); b.st[0] = nloc; b.st[1] = nx; }
        const unsigned old = xb_add(&bar[XB_XSUB(b.x)], 1u);
        const unsigned gen = old / nloc;
        if (old + 1u == (gen + 1u) * nloc) {
            __builtin_amdgcn_fence(__ATOMIC_RELEASE, "agent");
            asm volatile("s_waitcnt vmcnt(0)" ::: "memory");
            const unsigned og = xb_add(&bar[XB_TOP], 1u);
            const unsigned tg = og / nx;
            if (og + 1u == (tg + 1u) * nx) xb_add(&bar[XB_TOPGEN], 1u);
            else XB_SPIN(xb_ld(&bar[XB_TOPGEN]) == tg, bar);
            __builtin_amdgcn_fence(__ATOMIC_ACQUIRE, "agent");
            xb_add(&bar[XB_XGEN(b.x)], 1u);
            asm volatile("s_waitcnt vmcnt(0)" ::: "memory");
        } else {
            XB_SPIN(xb_ld(&bar[XB_XGEN(b.x)]) == gen, bar);
            __builtin_amdgcn_fence(__ATOMIC_ACQUIRE, "agent");
            asm volatile("s_waitcnt vmcnt(0)" ::: "memory");
        }
    }
    __syncthreads();
}

using namespace pg8;
typedef float f32x16 __attribute__((ext_vector_type(16)));
typedef unsigned u32x2 __attribute__((ext_vector_type(2)));
#define LAS PG8_LAS
#define DI __device__ __forceinline__

constexpr int NT = 512;
constexpr int MP = 32768, MS = 2048, MT = MP + MS;
constexpr int KEYS_S = 4352;
constexpr int KR_ROWS = MP + 32 * KEYS_S;
constexpr int ZLD = 2560;
constexpr float EPS = 1e-6f;
constexpr float QSCALE = 0.10206207261596577f * 1.4426950408889634f;
constexpr int LDS_BYTES = 160 * 1024;

constexpr size_t SZ_WIN = 2560ull * 1024 * 2, SZ_WUQ = 768ull * 256 * 2, SZ_WUK = 512ull * 256 * 2, SZ_WUV = 512ull * 256 * 2,
                 SZ_WO = 1024ull * 1024 * 2, SZ_WFI = 5632ull * 1024 * 2, SZ_WFO = 1024ull * 2816 * 2;
constexpr size_t WOFF_IN = 0, WOFF_UQ = WOFF_IN + SZ_WIN, WOFF_UK = WOFF_UQ + SZ_WUQ, WOFF_UV = WOFF_UK + SZ_WUK, WOFF_O = WOFF_UV + SZ_WUV,
                 WOFF_FI = WOFF_O + SZ_WO, WOFF_FO = WOFF_FI + SZ_WFI, WL = WOFF_FO + SZ_WFO;
constexpr size_t OFF_W = 0;
constexpr size_t OFF_MOD = OFF_W + 2 * WL;
constexpr size_t OFF_ROPE = OFF_MOD + 2ull * 36 * 6144 * 4;
constexpr size_t OFF_H = OFF_ROPE + 8192ull * 16 * 2 * 4;
constexpr size_t OFF_Z = OFF_H + (size_t)MT * 1024 * 2;
constexpr size_t OFF_CQN = OFF_Z + (size_t)MT * ZLD * 2;
constexpr size_t OFF_CKV = OFF_CQN + (size_t)MT * 256 * 2;
constexpr size_t OFF_KROPE = OFF_CKV + (size_t)KR_ROWS * 256 * 2;
constexpr size_t OFF_Q = OFF_KROPE + (size_t)KR_ROWS * 32 * 2;
constexpr size_t OFF_KN = OFF_Q + (size_t)MT * 768 * 2;
constexpr size_t OFF_VT = OFF_KN + (size_t)KR_ROWS * 512 * 2;
constexpr size_t OFF_O = OFF_VT + (size_t)KR_ROWS * 512 * 2;
constexpr size_t OFF_PART = OFF_O + (size_t)MP * 512 * 2;
constexpr size_t OFF_UHG = OFF_PART + 32ull * 8 * 4 * 64 * 66 * 4;
constexpr size_t OFF_DHG = OFF_UHG + 544ull * 4 * 64 * 64 * 4;
constexpr size_t OFF_UGL = OFF_DHG + 544ull * 4 * 64 * 4;
constexpr size_t OFF_DGL = OFF_UGL + 544ull * 4 * 32 * 64 * 4;
constexpr size_t OFF_BAR = OFF_DGL + 544ull * 4 * 32 * 4;
constexpr size_t OFF_XB = OFF_BAR + 16384;
constexpr size_t WS_END = OFF_XB + (size_t)MT * 1024 * 2;
constexpr size_t OFF_ACT = OFF_KN;
static_assert((size_t)MT * 2816 * 2 <= 2 * (size_t)KR_ROWS * 512 * 2, "act alias");

constexpr size_t OUT_Y = 0, OUT_CKVP = 35651584, OUT_KRP = 52428800, OUT_HGP = 54525952, OUT_GLP = 54657024,
                 OUT_CKVS = 54722560, OUT_KRS = 55771136, OUT_HGS = 55902208, OUT_GLS = 56950784;

DI int tid_() { int t = threadIdx.x; asm volatile("" : "+v"(t)); return t; }
DI int bid_() { int b = blockIdx.x; asm volatile("" : "+s"(b)); return b; }
DI float neg_big() { float v = -1e30f; asm volatile("" : "+v"(v)); return v; }
struct Params { const float* in[29]; float* out; unsigned char* ws; };

typedef __bf16 hbf2 __attribute__((ext_vector_type(2)));
typedef float f32x2_ __attribute__((ext_vector_type(2)));
DI unsigned pack2(float a, float b) { f32x2_ v = {a, b}; return __builtin_bit_cast(unsigned, __builtin_convertvector(v, hbf2)); }
DI bf16_t f2bf(float f) { return (bf16_t)(pack2(f, f) & 0xFFFFu); }
DI float bf2f(bf16_t b) { return __uint_as_float(((unsigned)b) << 16); }
DI float bflo(unsigned u) { return __uint_as_float(u << 16); }
DI float bfhi(unsigned u) { return __uint_as_float(u & 0xFFFF0000u); }
DI float wave_sum(float v) { v += __shfl_xor(v, 32); v += __shfl_xor(v, 16); v += __shfl_xor(v, 8); v += __shfl_xor(v, 4); v += __shfl_xor(v, 2); v += __shfl_xor(v, 1); return v; }
DI float sigmoidf_(float x) { return 1.f / (1.f + expf(-x)); }
DI int row_bi(int row) { return row < MP ? (row >> 13) : 4 + ((row - MP) >> 6); }

struct EpiZ {
    static constexpr bool PERM = true, AFTER_DRAIN = false;
    bf16_t* O; int ldc;
    DI void operator()(const f32x4 (&acc)[2][2][4][2], const Unit& u, int wr, int wc, int fr, int fq) const {
        const int row0 = u.pm * 256 + wr * 64 + fr, col0 = u.pn * 256 + wc * 32 + 8 * fq;
#pragma unroll
        for (int ai = 0; ai < 2; ++ai)
#pragma unroll
            for (int m = 0; m < 4; ++m) { bf16_t* rowp = O + (size_t)(row0 + ai * 128 + m * 16) * ldc + col0;
#pragma unroll
                for (int bj = 0; bj < 2; ++bj) { const f32x4 v0 = acc[ai][bj][m][0], v1 = acc[ai][bj][m][1]; uint4 w; w.x = pack2(v0[0], v0[1]); w.y = pack2(v0[2], v0[3]); w.z = pack2(v1[0], v1[1]); w.w = pack2(v1[2], v1[3]); *(uint4*)(rowp + bj * 128) = w; } }
    }
};
struct EpiQ {
    static constexpr bool PERM = false, AFTER_DRAIN = false;
    bf16_t* Q; const float* qn_; const float* rope_;
    DI void operator()(const f32x4 (&acc)[2][2][4][2], const Unit& u, int wr, int wc, int fr, int fq) const {
        const float* qn = qn_; const float* rope = rope_; asm volatile("" : "+s"(qn), "+s"(rope));
        float eps_ = EPS; asm volatile("" : "+v"(eps_));
        const int row0 = u.pm * 256 + wr * 64 + fr;
#pragma unroll
        for (int ai = 0; ai < 2; ++ai)
#pragma unroll
            for (int m = 0; m < 4; ++m) {
                const int row = row0 + ai * 128 + m * 16;
                int pos; size_t base, hs;
                if (row < MP) { const int b = row >> 13, t = row & 8191; pos = t; base = ((size_t)(b * 8) * 8192 + t) * 96; hs = 8192 * 96; }
                else { const int r = row - MP, b = r >> 6, t = r & 63; pos = 4096 + t; base = (size_t)MP * 768 + ((size_t)(b * 8) * 64 + t) * 96; hs = 64 * 96; }
                if (u.pn < 2) {
                    const int head = 4 * u.pn + wc;
                    float ss = 0.f;
#pragma unroll
                    for (int bj = 0; bj < 2; ++bj)
#pragma unroll
                        for (int n = 0; n < 2; ++n) { const f32x4 v = acc[ai][bj][m][n]; ss += v[0] * v[0] + v[1] * v[1] + v[2] * v[2] + v[3] * v[3]; }
                    ss += __shfl_xor(ss, 16); ss += __shfl_xor(ss, 32);
                    const float rs = rsqrtf(ss * (1.f / 64.f) + eps_) * QSCALE;
#pragma unroll
                    for (int bj = 0; bj < 2; ++bj)
#pragma unroll
                        for (int n = 0; n < 2; ++n) { const int d = 32 * bj + 16 * n + 4 * fq; const f32x4 v = acc[ai][bj][m][n]; const float4 g = *(const float4*)(qn + d);
                            uint2 w; w.x = pack2(v[0] * rs * g.x, v[1] * rs * g.y); w.y = pack2(v[2] * rs * g.z, v[3] * rs * g.w); *(uint2*)(Q + base + head * hs + d) = w; }
                } else {
#pragma unroll
                    for (int bj = 0; bj < 2; ++bj) {
                        const int head = 2 * wc + bj;
                        const f32x4 v1 = acc[ai][bj][m][0], v2 = acc[ai][bj][m][1];
                        float ss = v1[0] * v1[0] + v1[1] * v1[1] + v1[2] * v1[2] + v1[3] * v1[3] + v2[0] * v2[0] + v2[1] * v2[1] + v2[2] * v2[2] + v2[3] * v2[3];
                        ss += __shfl_xor(ss, 16); ss += __shfl_xor(ss, 32);
                        const float rs = rsqrtf(ss * (1.f / 32.f) + eps_);
                        const float4 g1 = *(const float4*)(qn + 64 + 4 * fq), g2 = *(const float4*)(qn + 80 + 4 * fq);
                        const float4 cs0 = *(const float4*)(rope + ((size_t)pos * 16 + 4 * fq) * 2), cs1 = *(const float4*)(rope + ((size_t)pos * 16 + 4 * fq) * 2 + 4);
                        const float x10 = v1[0] * rs * g1.x, x11 = v1[1] * rs * g1.y, x12 = v1[2] * rs * g1.z, x13 = v1[3] * rs * g1.w;
                        const float x20 = v2[0] * rs * g2.x, x21 = v2[1] * rs * g2.y, x22 = v2[2] * rs * g2.z, x23 = v2[3] * rs * g2.w;
                        uint2 w1, w2;
                        w1.x = pack2((x10 * cs0.x - x20 * cs0.y) * QSCALE, (x11 * cs0.z - x21 * cs0.w) * QSCALE);
                        w1.y = pack2((x12 * cs1.x - x22 * cs1.y) * QSCALE, (x13 * cs1.z - x23 * cs1.w) * QSCALE);
                        w2.x = pack2((x20 * cs0.x + x10 * cs0.y) * QSCALE, (x21 * cs0.z + x11 * cs0.w) * QSCALE);
                        w2.y = pack2((x22 * cs1.x + x12 * cs1.y) * QSCALE, (x23 * cs1.z + x13 * cs1.w) * QSCALE);
                        *(uint2*)(Q + base + head * hs + 64 + 4 * fq) = w1; *(uint2*)(Q + base + head * hs + 80 + 4 * fq) = w2;
                    }
                }
            }
    }
};
struct EpiKN {
    static constexpr bool PERM = true, AFTER_DRAIN = false;
    bf16_t* KN; const float* kn_;
    DI void operator()(const f32x4 (&acc)[2][2][4][2], const Unit& u, int wr, int wc, int fr, int fq) const {
        const float* kn = kn_; asm volatile("" : "+s"(kn));
        float eps_ = EPS; asm volatile("" : "+v"(eps_));
        float4 gk[2][2];
#pragma unroll
        for (int bj = 0; bj < 2; ++bj)
#pragma unroll
            for (int n = 0; n < 2; ++n) gk[bj][n] = *(const float4*)(kn + 32 * bj + 8 * fq + 4 * n);
        size_t base, hs;
        if (u.pm < 128) { const int b = u.pm >> 5, key0 = (u.pm & 31) * 256; base = ((size_t)(b * 8) * 8192 + key0) * 64; hs = (size_t)8192 * 64; }
        else { const int q = u.pm - 128, b = q / 17, key0 = (q % 17) * 256; base = (size_t)MP * 512 + ((size_t)(b * 8) * KEYS_S + key0) * 64; hs = (size_t)KEYS_S * 64; }
        const int head = 4 * u.pn + wc;
#pragma unroll
        for (int ai = 0; ai < 2; ++ai)
#pragma unroll
            for (int m = 0; m < 4; ++m) {
                const int key = 128 * ai + 64 * wr + 16 * m + fr;
                float ss = 0.f;
#pragma unroll
                for (int bj = 0; bj < 2; ++bj)
#pragma unroll
                    for (int n = 0; n < 2; ++n) { const f32x4 v = acc[ai][bj][m][n]; ss += v[0] * v[0] + v[1] * v[1] + v[2] * v[2] + v[3] * v[3]; }
                ss += __shfl_xor(ss, 16); ss += __shfl_xor(ss, 32);
                const float rs = rsqrtf(ss * (1.f / 64.f) + eps_);
#pragma unroll
                for (int bj = 0; bj < 2; ++bj) { const f32x4 v0 = acc[ai][bj][m][0], v1 = acc[ai][bj][m][1]; const float4 g0 = gk[bj][0], g1 = gk[bj][1];
                    uint4 w; w.x = pack2(v0[0] * rs * g0.x, v0[1] * rs * g0.y); w.y = pack2(v0[2] * rs * g0.z, v0[3] * rs * g0.w); w.z = pack2(v1[0] * rs * g1.x, v1[1] * rs * g1.y); w.w = pack2(v1[2] * rs * g1.z, v1[3] * rs * g1.w);
                    *(uint4*)(KN + base + head * hs + (size_t)key * 64 + 32 * bj + 8 * fq) = w; }
            }
    }
};
struct EpiVT {
    static constexpr bool PERM = true, AFTER_DRAIN = false;
    bf16_t* VT;
    DI void operator()(const f32x4 (&acc)[2][2][4][2], const Unit& u, int wr, int wc, int fr, int fq) const {
        size_t base; int KL;
        if (u.pn < 128) { const int b = u.pn >> 5, key0 = (u.pn & 31) * 256; base = (size_t)(b * 8) * 64 * 8192 + key0; KL = 8192; }
        else { const int q = u.pn - 128, b = q / 17, key0 = (q % 17) * 256; base = (size_t)MP * 512 + (size_t)(b * 8) * 64 * KEYS_S + key0; KL = KEYS_S; }
#pragma unroll
        for (int ai = 0; ai < 2; ++ai)
#pragma unroll
            for (int m = 0; m < 4; ++m) {
                const int r = 256 * u.pm + 128 * ai + 64 * wr + 16 * m + fr;
                bf16_t* rowp = VT + base + (size_t)r * KL + 32 * wc + 8 * fq;
#pragma unroll
                for (int bj = 0; bj < 2; ++bj) { const f32x4 v0 = acc[ai][bj][m][0], v1 = acc[ai][bj][m][1]; uint4 w; w.x = pack2(v0[0], v0[1]); w.y = pack2(v0[2], v0[3]); w.z = pack2(v1[0], v1[1]); w.w = pack2(v1[2], v1[3]); *(uint4*)(rowp + 128 * bj) = w; }
            }
    }
};
struct EpiRes {
    static constexpr bool PERM = false, AFTER_DRAIN = false;
    bf16_t* XB; float* out; const float* gate; int final;
    DI void operator()(const f32x4 (&acc)[2][2][4][2], const Unit& u, int wr, int wc, int fr, int fq) const {
        const int row0 = u.pm * 256 + wr * 64 + fr, col0 = u.pn * 256 + wc * 32 + 4 * fq;
#pragma unroll
        for (int ai = 0; ai < 2; ++ai) {
            const float* gr = gate + (size_t)row_bi(row0 + ai * 128) * 6144 + col0;
            f32x4 g[2][2]; uint2 x[4][2][2];
#pragma unroll
            for (int bj = 0; bj < 2; ++bj)
#pragma unroll
                for (int n = 0; n < 2; ++n) g[bj][n] = *(const f32x4*)(gr + bj * 128 + n * 16);
#pragma unroll
            for (int m = 0; m < 4; ++m) { const bf16_t* xr = XB + (size_t)(row0 + ai * 128 + m * 16) * 1024 + col0;
#pragma unroll
                for (int bj = 0; bj < 2; ++bj)
#pragma unroll
                    for (int n = 0; n < 2; ++n) x[m][bj][n] = *(const uint2*)(xr + bj * 128 + n * 16); }
#pragma unroll
            for (int m = 0; m < 4; ++m) { const size_t ro = (size_t)(row0 + ai * 128 + m * 16) * 1024 + col0;
#pragma unroll
                for (int bj = 0; bj < 2; ++bj)
#pragma unroll
                    for (int n = 0; n < 2; ++n) { const uint2 xv = x[m][bj][n]; const f32x4 xf = {bflo(xv.x), bfhi(xv.x), bflo(xv.y), bfhi(xv.y)}; const f32x4 r = xf + g[bj][n] * acc[ai][bj][m][n];
                        if (final) *(f32x4*)(out + ro + bj * 128 + n * 16) = r;
                        else { uint2 w; w.x = pack2(r[0], r[1]); w.y = pack2(r[2], r[3]); *(uint2*)(XB + ro + bj * 128 + n * 16) = w; } } }
        }
    }
};
struct EpiSwi {
    static constexpr bool PERM = true, AFTER_DRAIN = false;
    bf16_t* ACT;
    DI void operator()(const f32x4 (&acc)[2][2][4][2], const Unit& u, int wr, int wc, int fr, int fq) const {
        const int row0 = u.pm * 256 + wr * 64 + fr, col0 = u.pn * 128 + wc * 32 + 8 * fq;
#pragma unroll
        for (int ai = 0; ai < 2; ++ai)
#pragma unroll
            for (int m = 0; m < 4; ++m) { bf16_t* rowp = ACT + (size_t)(row0 + ai * 128 + m * 16) * 2816 + col0; float r[8];
#pragma unroll
                for (int n = 0; n < 2; ++n) { const f32x4 a = acc[ai][0][m][n], g = acc[ai][1][m][n];
#pragma unroll
                    for (int j = 0; j < 4; ++j) r[4 * n + j] = a[j] / (1.f + __expf(-a[j])) * g[j]; }
                uint4 w; w.x = pack2(r[0], r[1]); w.y = pack2(r[2], r[3]); w.z = pack2(r[4], r[5]); w.w = pack2(r[6], r[7]); *(uint4*)rowp = w; }
    }
};
template <class Epi> DI void run_gemm(LAS unsigned char* lds, const bf16_t* A, const bf16_t* Bt, int M, int N, int K, const Epi& E) {
    asm volatile("" : "+s"(M), "+s"(N), "+s"(K));
    Gemm g{A, Bt, M, N, K}; StaticOrder S; S.init(M, N, (int)gridDim.x, (int)bid_());
    gemm_phase<Epi, StaticOrder, false>(lds, g, S, E, nullptr);
}

DI int colmap(int w, int n) {
    if (w == 0) return n < 2352 ? n : -1;
    if (w == 1) { const int pn = n >> 8, c = n & 255, bj = c >> 7, wc = (c >> 5) & 3, cc = c & 31; return pn < 2 ? (4 * pn + wc) * 96 + 32 * bj + cc : (2 * wc + bj) * 96 + 64 + cc; }
    if (w == 2) { const int pn = n >> 8, c = n & 255, bj = c >> 7, wc = (c >> 5) & 3, cc = c & 31; return (4 * pn + wc) * 64 + 32 * bj + cc; }
    if (w == 5) { const int pn = n >> 8, c = n & 255; return c < 128 ? 128 * pn + c : 2816 + 128 * pn + (c - 128); }
    return n;
}
DI void phase_prep(const Params& p, LAS unsigned char* lds) {
    const int tid = tid_();
    LAS bf16_t* T = (LAS bf16_t*)lds;
    for (int ti = bid_(); ti < 2 * 1560; ti += gridDim.x) {
        const int l = ti / 1560, r = ti % 1560;
        int w, t0, K, ld; size_t doff; const float* src;
        if (r < 320) { w = 0; t0 = 0; K = 1024; ld = 2352; doff = WOFF_IN; src = p.in[12]; }
        else if (r < 344) { w = 1; t0 = 320; K = 256; ld = 768; doff = WOFF_UQ; src = p.in[15]; }
        else if (r < 360) { w = 2; t0 = 344; K = 256; ld = 512; doff = WOFF_UK; src = p.in[16]; }
        else if (r < 376) { w = 3; t0 = 360; K = 256; ld = 512; doff = WOFF_UV; src = p.in[17]; }
        else if (r < 504) { w = 4; t0 = 376; K = 1024; ld = 1024; doff = WOFF_O; src = p.in[26]; }
        else if (r < 1208) { w = 5; t0 = 504; K = 1024; ld = 5632; doff = WOFF_FI; src = p.in[27]; }
        else { w = 6; t0 = 1208; K = 2816; ld = 1024; doff = WOFF_FO; src = p.in[28]; }
        src += (size_t)l * K * ld;
        const int kt = K >> 7, tr = r - t0, n0 = (tr / kt) * 64, k0 = (tr % kt) * 128;
        bf16_t* dst = (bf16_t*)(p.ws + OFF_W + (size_t)l * WL + doff);
        const int nn = tid & 63, col = colmap(w, n0 + nn);
        float tv[16];
#pragma unroll
        for (int i = 0; i < 16; ++i) { const int kk = (tid >> 6) + 8 * i; tv[i] = col >= 0 ? src[(size_t)(k0 + kk) * ld + col] : 0.f; }
#pragma unroll
        for (int i = 0; i < 16; ++i) { const int kk = (tid >> 6) + 8 * i; T[nn * 130 + kk] = f2bf(tv[i]); }
        __syncthreads();
#pragma unroll
        for (int j = 0; j < 2; ++j) { const int q = tid + 512 * j, row = q >> 4, seg = q & 15; const LAS unsigned* tp = (const LAS unsigned*)(T + row * 130 + seg * 8);
          uint4 o; o.x = tp[0]; o.y = tp[1]; o.z = tp[2]; o.w = tp[3]; *(uint4*)(dst + (size_t)(n0 + row) * K + k0 + seg * 8) = o; }
        __syncthreads();
    }
    float* mod = (float*)(p.ws + OFF_MOD);
    for (int it = bid_(); it < 192; it += gridDim.x) {
        const int l = it / 96, cgp = it % 96;
        LAS float* sl = (LAS float*)lds;
        for (int i = tid; i < 36 * 1024; i += NT) { const int bi = i >> 10, k = i & 1023; const float c = bi < 4 ? p.in[2][bi * 1024 + k] : p.in[3][(bi - 4) * 1024 + k]; sl[i] = c / (1.f + expf(-c)); }
        __syncthreads();
        const int cl = tid & 63, kq = tid >> 6;
        float acc[36];
#pragma unroll
        for (int bi = 0; bi < 36; ++bi) acc[bi] = 0.f;
        const float* wm = p.in[8] + (size_t)l * 1024 * 6144 + cgp * 64 + cl;
#pragma unroll 4
        for (int k = kq * 128; k < kq * 128 + 128; k += 4) {
            const float w0 = wm[(size_t)k * 6144], w1 = wm[(size_t)(k + 1) * 6144], w2 = wm[(size_t)(k + 2) * 6144], w3 = wm[(size_t)(k + 3) * 6144];
#pragma unroll
            for (int bi = 0; bi < 36; ++bi) { const f32x4 s = *(const LAS f32x4*)(sl + bi * 1024 + k); acc[bi] += s[0] * w0 + s[1] * w1 + s[2] * w2 + s[3] * w3; }
        }
        __syncthreads();
        LAS float* red = (LAS float*)lds;
#pragma unroll
        for (int bi = 0; bi < 36; ++bi) red[(kq * 36 + bi) * 64 + cl] = acc[bi];
        __syncthreads();
        for (int o = tid; o < 36 * 64; o += NT) { const int bi = o >> 6, c = o & 63; float s = 0.f;
#pragma unroll
            for (int q = 0; q < 8; ++q) s += red[(q * 36 + bi) * 64 + c];
            const int colg = cgp * 64 + c; mod[((size_t)l * 36 + bi) * 6144 + colg] = s + p.in[9][l * 6144 + colg]; }
        __syncthreads();
    }
    float* rope = (float*)(p.ws + OFF_ROPE);
    for (int i = bid_() * NT + tid; i < 8192 * 16; i += gridDim.x * NT) { const int pos = i >> 4, j = i & 15;
        const float inv = exp2f(-(float)j * (13.287712379549449f / 16.f)); const float ang = (float)pos * inv; rope[2 * i] = cosf(ang); rope[2 * i + 1] = sinf(ang); }
}

template <bool FROM_INPUT>
DI void phase_hrows(const Params& p, int l, const float* xa, const float* xb, const float* g, int shoff, int scoff) {
    const int tid = tid_(), lane = tid & 63, wid = __builtin_amdgcn_readfirstlane(tid >> 6);
    const float* mod = (const float*)(p.ws + OFF_MOD) + (size_t)l * 36 * 6144;
    bf16_t* H = (bf16_t*)(p.ws + OFF_H); bf16_t* XB = (bf16_t*)(p.ws + OFF_XB);
    const int stride = gridDim.x * 8;
    int row = bid_() * 8 + wid;
    float4 v[4];
#define HR_LOAD(dst, rr) do { if (FROM_INPUT) { const float* xr_ = (rr) < MP ? xa + (size_t)(rr) * 1024 : xb + (size_t)((rr) - MP) * 1024; \
            _Pragma("unroll") for (int i = 0; i < 4; ++i) dst[i] = *(const float4*)(xr_ + i * 256 + lane * 4); } \
        else { const bf16_t* xr_ = XB + (size_t)(rr) * 1024; \
            _Pragma("unroll") for (int i = 0; i < 4; ++i) { const uint2 u_ = *(const uint2*)(xr_ + i * 256 + lane * 4); dst[i].x = bflo(u_.x); dst[i].y = bfhi(u_.x); dst[i].z = bflo(u_.y); dst[i].w = bfhi(u_.y); } } } while (0)
    if (row < MT) HR_LOAD(v, row);
    while (row < MT) {
        const int nrow = row + stride; float4 nv[4];
        if (nrow < MT) HR_LOAD(nv, nrow);
        float ss = 0.f;
#pragma unroll
        for (int i = 0; i < 4; ++i) ss += v[i].x * v[i].x + v[i].y * v[i].y + v[i].z * v[i].z + v[i].w * v[i].w;
        ss = wave_sum(ss);
        const float rs = rsqrtf(ss * (1.f / 1024.f) + EPS);
        const float* mp = mod + (size_t)row_bi(row) * 6144;
#pragma unroll
        for (int i = 0; i < 4; ++i) { const int col = i * 256 + lane * 4;
            const float4 gg = *(const float4*)(g + col), sc = *(const float4*)(mp + scoff + col), sh = *(const float4*)(mp + shoff + col);
            uint2 w; w.x = pack2(v[i].x * rs * gg.x * (1.f + sc.x) + sh.x, v[i].y * rs * gg.y * (1.f + sc.y) + sh.y);
            w.y = pack2(v[i].z * rs * gg.z * (1.f + sc.z) + sh.z, v[i].w * rs * gg.w * (1.f + sc.w) + sh.w);
            *(uint2*)(H + (size_t)row * 1024 + col) = w;
            if (FROM_INPUT) { uint2 xw; xw.x = pack2(v[i].x, v[i].y); xw.y = pack2(v[i].z, v[i].w); *(uint2*)(XB + (size_t)row * 1024 + col) = xw; } }
#pragma unroll
        for (int i = 0; i < 4; ++i) v[i] = nv[i];
        row = nrow;
    }
#undef HR_LOAD
}
DI void phase_cache(const Params& p, int l) {
    const size_t gt = (size_t)bid_() * NT + tid_(), gs = (size_t)gridDim.x * NT;
    bf16_t* ckv_s = (bf16_t*)(p.ws + OFF_CKV) + (size_t)MP * 256;
    bf16_t* kr_s = (bf16_t*)(p.ws + OFF_KROPE) + (size_t)MP * 32;
    const float4* s1 = (const float4*)(p.in[4] + (size_t)l * 32 * 4096 * 256);
    for (size_t i0 = gt; i0 < 8388608; i0 += gs * 8) { float4 v[8];
#pragma unroll
        for (int u = 0; u < 8; ++u) { const size_t i = i0 + u * gs; if (i < 8388608) v[u] = s1[i]; }
#pragma unroll
        for (int u = 0; u < 8; ++u) { const size_t i = i0 + u * gs; if (i < 8388608) { const size_t e = i * 4, b = e >> 20, rem = e & 1048575;
            uint2 w; w.x = pack2(v[u].x, v[u].y); w.y = pack2(v[u].z, v[u].w); *(uint2*)(ckv_s + b * KEYS_S * 256 + rem) = w; } } }
    unsigned zz = 0u; asm volatile("" : "+v"(zz));
    for (size_t i = gt; i < 393216; i += gs) { const size_t e = i * 4, b = e / 49152, rem = e % 49152; uint2 w; w.x = zz; w.y = zz; *(uint2*)(ckv_s + b * KEYS_S * 256 + 4160 * 256 + rem) = w; }
    const float4* s2 = (const float4*)(p.in[5] + (size_t)l * 32 * 4096 * 32);
    for (size_t i0 = gt; i0 < 1048576; i0 += gs * 8) { float4 v[8];
#pragma unroll
        for (int u = 0; u < 8; ++u) { const size_t i = i0 + u * gs; if (i < 1048576) v[u] = s2[i]; }
#pragma unroll
        for (int u = 0; u < 8; ++u) { const size_t i = i0 + u * gs; if (i < 1048576) { const size_t e = i * 4, b = e >> 17, rem = e & 131071;
            uint2 w; w.x = pack2(v[u].x, v[u].y); w.y = pack2(v[u].z, v[u].w); *(uint2*)(kr_s + b * KEYS_S * 32 + rem) = w; } } }
}
DI void phase_post(const Params& p, int l) {
    const int tid = tid_(), lane = tid & 63, wid = __builtin_amdgcn_readfirstlane(tid >> 6);
    const bf16_t* Z = (const bf16_t*)(p.ws + OFF_Z);
    bf16_t* CQN = (bf16_t*)(p.ws + OFF_CQN); bf16_t* CKV = (bf16_t*)(p.ws + OFF_CKV); bf16_t* KRO = (bf16_t*)(p.ws + OFF_KROPE);
    const float* rope = (const float*)(p.ws + OFF_ROPE);
    const float* gcq = p.in[13] + l * 256; const float* gckv = p.in[14] + l * 256; const float* gk = p.in[19] + l * 96 + 64;
    const int stride = gridDim.x * 8;
    int row = bid_() * 8 + wid;
    uint2 u1, u2; bf16_t u3;
    if (row < MT) { const bf16_t* zr = Z + (size_t)row * ZLD; u1 = *(const uint2*)(zr + 4 * lane); u2 = *(const uint2*)(zr + 256 + 4 * lane); u3 = zr[512 + (lane & 31)]; }
    while (row < MT) {
        const int nrow = row + stride; uint2 n1, n2; bf16_t n3;
        if (nrow < MT) { const bf16_t* zr = Z + (size_t)nrow * ZLD; n1 = *(const uint2*)(zr + 4 * lane); n2 = *(const uint2*)(zr + 256 + 4 * lane); n3 = zr[512 + (lane & 31)]; }
        int pos; size_t grow; float* o_ckv; float* o_kr;
        if (row < MP) { const int b = row >> 13, t = row & 8191; pos = t; grow = row; o_ckv = p.out + OUT_CKVP + ((size_t)(l * 4 + b) * 8192 + t) * 256; o_kr = p.out + OUT_KRP + ((size_t)(l * 4 + b) * 8192 + t) * 32; }
        else { const int r = row - MP, b = r >> 6, t = r & 63; pos = 4096 + t; grow = (size_t)MP + (size_t)b * KEYS_S + 4096 + t; o_ckv = p.out + OUT_CKVS + ((size_t)(l * 32 + b) * 64 + t) * 256; o_kr = p.out + OUT_KRS + ((size_t)(l * 32 + b) * 64 + t) * 32; }
        { const uint2 u = u1; const float a0 = bflo(u.x), a1 = bfhi(u.x), a2 = bflo(u.y), a3 = bfhi(u.y);
          const float ss = wave_sum(a0 * a0 + a1 * a1 + a2 * a2 + a3 * a3); const float rs = rsqrtf(ss * (1.f / 256.f) + EPS); const float4 g = *(const float4*)(gcq + 4 * lane);
          uint2 w; w.x = pack2(a0 * rs * g.x, a1 * rs * g.y); w.y = pack2(a2 * rs * g.z, a3 * rs * g.w); *(uint2*)(CQN + (size_t)row * 256 + 4 * lane) = w; }
        { const uint2 u = u2; const float a0 = bflo(u.x), a1 = bfhi(u.x), a2 = bflo(u.y), a3 = bfhi(u.y);
          const float ss = wave_sum(a0 * a0 + a1 * a1 + a2 * a2 + a3 * a3); const float rs = rsqrtf(ss * (1.f / 256.f) + EPS); const float4 g = *(const float4*)(gckv + 4 * lane);
          float4 o; o.x = a0 * rs * g.x; o.y = a1 * rs * g.y; o.z = a2 * rs * g.z; o.w = a3 * rs * g.w; *(float4*)(o_ckv + 4 * lane) = o;
          uint2 w; w.x = pack2(o.x, o.y); w.y = pack2(o.z, o.w); *(uint2*)(CKV + grow * 256 + 4 * lane) = w; }
        { const int i = lane & 31; const float a = bf2f(u3); float ss = a * a; ss += __shfl_xor(ss, 16); ss += __shfl_xor(ss, 8); ss += __shfl_xor(ss, 4); ss += __shfl_xor(ss, 2); ss += __shfl_xor(ss, 1);
          const float xn = a * rsqrtf(ss * (1.f / 32.f) + EPS) * gk[i]; const float other = __shfl_xor(xn, 16);
          const float2 cs = *(const float2*)(rope + ((size_t)pos * 16 + (i & 15)) * 2);
          const float o = i < 16 ? xn * cs.x - other * cs.y : xn * cs.x + other * cs.y;
          if (lane < 32) { o_kr[i] = o; KRO[grow * 32 + i] = f2bf(o); } }
        u1 = n1; u2 = n2; u3 = n3; row = nrow;
    }
}

DI f32x16 mfma32(bf16x8 a, bf16x8 b, f32x16 c) { return __builtin_amdgcn_mfma_f32_32x32x16_bf16(a, b, c, 0, 0, 0); }
DI f32x4 mfma16(bf16x8 a, bf16x8 b, f32x4 c) { return __builtin_amdgcn_mfma_f32_16x16x32_bf16(a, b, c, 0, 0, 0); }
DI bf16x8 pack8(const f32x16& s, int b) { u32x4 r; r[0] = pack2(s[b], s[b + 1]); r[1] = pack2(s[b + 2], s[b + 3]); r[2] = pack2(s[b + 4], s[b + 5]); r[3] = pack2(s[b + 6], s[b + 7]); return __builtin_bit_cast(bf16x8, r); }

template <int NH>
DI void attn_core(LAS unsigned char* lds, const bf16_t* qptr, const bf16_t* kn, size_t kn_hs, const bf16_t* kr, const bf16_t* vt, size_t vt_hs, int KL,
                  int kt0, int kstep, int nit, int nvalid, int tile_lim, int hh, f32x16 (&o)[2], float& m_run, float& l_run) {
    constexpr int BUFSZ = NH * 17920 + 5120;
    const int tid = tid_(), lane = tid & 63, r = lane & 31, h = lane >> 5;
    bf16x8 qf[6];
#pragma unroll
    for (int ks = 0; ks < 6; ++ks) qf[ks] = *(const bf16x8*)(qptr + ks * 16 + h * 8);
#pragma unroll
    for (int i = 0; i < 16; ++i) { o[0][i] = 0.f; o[1][i] = 0.f; }
    m_run = neg_big(); l_run = 0.f;
    u32x4 rkn[NH], rvt[NH], rkr = {0u, 0u, 0u, 0u};
    const int lrow = tid >> 3, lseg = tid & 7;
#define ATT_GLOAD(kt) do { const size_t key0_ = (size_t)(kt) * 64; \
        _Pragma("unroll") for (int hx = 0; hx < NH; ++hx) { rkn[hx] = *(const u32x4*)(kn + hx * kn_hs + (key0_ + lrow) * 64 + lseg * 8); rvt[hx] = *(const u32x4*)(vt + hx * vt_hs + (size_t)lrow * KL + key0_ + lseg * 8); } \
        if (tid < 256) rkr = *(const u32x4*)(kr + (key0_ + (tid >> 2)) * 32 + (tid & 3) * 8); } while (0)
#define ATT_LSTORE(buf) do { LAS unsigned char* B_ = lds + (buf) * BUFSZ; \
        _Pragma("unroll") for (int hx = 0; hx < NH; ++hx) { *(LAS u32x4*)(B_ + hx * 9216 + lrow * 144 + lseg * 16) = rkn[hx]; \
            LAS u32x2* pv_ = (LAS u32x2*)(B_ + NH * 9216 + 5120 + hx * 8704 + lrow * 136 + lseg * 16); u32x2 a_, b_; a_[0] = rvt[hx][0]; a_[1] = rvt[hx][1]; b_[0] = rvt[hx][2]; b_[1] = rvt[hx][3]; pv_[0] = a_; pv_[1] = b_; } \
        if (tid < 256) *(LAS u32x4*)(B_ + NH * 9216 + (tid >> 2) * 80 + (tid & 3) * 16) = rkr; } while (0)
    ATT_GLOAD(kt0); ATT_LSTORE(0);
    __syncthreads();
    for (int it = 0; it < nit; ++it) {
        const int ktn = kt0 + (it + 1) * kstep;
        const bool more = (it + 1 < nit) && (ktn < tile_lim);
        if (more) ATT_GLOAD(ktn);
        if (it < nvalid) {
            const LAS unsigned char* B = lds + (it & 1) * BUFSZ;
            const LAS unsigned char* knb = B + hh * 9216; const LAS unsigned char* krb = B + NH * 9216; const LAS unsigned char* vtb = B + NH * 9216 + 5120 + hh * 8704;
            f32x16 s0, s1;
#pragma unroll
            for (int i = 0; i < 16; ++i) { s0[i] = 0.f; s1[i] = 0.f; }
#pragma unroll
            for (int ks = 0; ks < 4; ++ks) { const bf16x8 a0 = *(const LAS bf16x8*)(knb + r * 144 + ks * 32 + h * 16), a1 = *(const LAS bf16x8*)(knb + (32 + r) * 144 + ks * 32 + h * 16);
                s0 = mfma32(a0, qf[ks], s0); s1 = mfma32(a1, qf[ks], s1); }
#pragma unroll
            for (int ks = 0; ks < 2; ++ks) { const bf16x8 a0 = *(const LAS bf16x8*)(krb + r * 80 + ks * 32 + h * 16), a1 = *(const LAS bf16x8*)(krb + (32 + r) * 80 + ks * 32 + h * 16);
                s0 = mfma32(a0, qf[4 + ks], s0); s1 = mfma32(a1, qf[4 + ks], s1); }
            float mx = s0[0];
#pragma unroll
            for (int i = 0; i < 16; ++i) { mx = fmaxf(mx, s0[i]); mx = fmaxf(mx, s1[i]); }
            mx = fmaxf(mx, __shfl_xor(mx, 32));
            const float mnew = fmaxf(m_run, mx), alpha = __builtin_amdgcn_exp2f(m_run - mnew);
            m_run = mnew;
            float ps = 0.f;
#pragma unroll
            for (int i = 0; i < 16; ++i) { s0[i] = __builtin_amdgcn_exp2f(s0[i] - mnew); s1[i] = __builtin_amdgcn_exp2f(s1[i] - mnew); ps += s0[i] + s1[i]; }
            l_run = l_run * alpha + ps;
#pragma unroll
            for (int i = 0; i < 16; ++i) { o[0][i] *= alpha; o[1][i] *= alpha; }
            bf16x8 pf[4];
            pf[0] = pack8(s0, 0); pf[1] = pack8(s0, 8); pf[2] = pack8(s1, 0); pf[3] = pack8(s1, 8);
#pragma unroll
            for (int dh = 0; dh < 2; ++dh)
#pragma unroll
                for (int s4 = 0; s4 < 4; ++s4) { const LAS u32x2* pa = (const LAS u32x2*)(vtb + (32 * dh + r) * 136 + (16 * s4 + 4 * h) * 2); const u32x2 lo = pa[0], hi = pa[2];
                    u32x4 av; av[0] = lo[0]; av[1] = lo[1]; av[2] = hi[0]; av[3] = hi[1]; o[dh] = mfma32(__builtin_bit_cast(bf16x8, av), pf[s4], o[dh]); }
        }
        if (more) ATT_LSTORE((it + 1) & 1);
        __syncthreads();
    }
#undef ATT_GLOAD
#undef ATT_LSTORE
}
DI void attn_core64(LAS unsigned char* lds, const bf16_t* qptr, const bf16_t* kn, const bf16_t* kr, const bf16_t* vt, int KL, int nit, int nvalid,
                    f32x16 (&o)[2][2], float (&m_run)[2], float (&l_run)[2]) {
    constexpr int BUFSZ = 17920 + 5120;
    const int tid = tid_(), lane = tid & 63, r = lane & 31, h = lane >> 5;
    bf16x8 qf[2][2];
    LAS bf16x8* qr = (LAS bf16x8*)(lds + 2 * BUFSZ + (tid >> 6) * 8192) + lane;
#pragma unroll
    for (int g = 0; g < 2; ++g) {
#pragma unroll
        for (int ks = 0; ks < 2; ++ks) qf[g][ks] = *(const bf16x8*)(qptr + g * 32 * 96 + ks * 16 + h * 8);
#pragma unroll
        for (int ks = 0; ks < 4; ++ks) qr[(g * 4 + ks) * 64] = *(const bf16x8*)(qptr + g * 32 * 96 + (2 + ks) * 16 + h * 8); }
#pragma unroll
    for (int g = 0; g < 2; ++g) { m_run[g] = neg_big(); l_run[g] = 0.f;
#pragma unroll
        for (int i = 0; i < 16; ++i) { o[g][0][i] = 0.f; o[g][1][i] = 0.f; } }
    u32x4 rkn, rvt, rkr = {0u, 0u, 0u, 0u};
    const int lrow = tid >> 3, lseg = tid & 7;
#define A64_GLOAD(kt) do { const size_t key0_ = (size_t)(kt) * 64; rkn = *(const u32x4*)(kn + (key0_ + lrow) * 64 + lseg * 8); rvt = *(const u32x4*)(vt + (size_t)lrow * KL + key0_ + lseg * 8); \
        if (tid < 256) rkr = *(const u32x4*)(kr + (key0_ + (tid >> 2)) * 32 + (tid & 3) * 8); } while (0)
#define A64_LSTORE(buf) do { LAS unsigned char* B_ = lds + (buf) * BUFSZ; *(LAS u32x4*)(B_ + lrow * 144 + lseg * 16) = rkn; \
        LAS u32x2* pv_ = (LAS u32x2*)(B_ + 9216 + 5120 + lrow * 136 + lseg * 16); u32x2 a_, b_; a_[0] = rvt[0]; a_[1] = rvt[1]; b_[0] = rvt[2]; b_[1] = rvt[3]; pv_[0] = a_; pv_[1] = b_; \
        if (tid < 256) *(LAS u32x4*)(B_ + 9216 + (tid >> 2) * 80 + (tid & 3) * 16) = rkr; } while (0)
    A64_GLOAD(0); A64_LSTORE(0);
    __syncthreads();
    for (int it = 0; it < nit; ++it) {
        const bool more = (it + 1 < nit);
        if (more) A64_GLOAD(it + 1);
        if (it < nvalid) {
            const LAS unsigned char* B = lds + (it & 1) * BUFSZ;
            const LAS unsigned char* knb = B; const LAS unsigned char* krb = B + 9216; const LAS unsigned char* vtb = B + 9216 + 5120;
            f32x16 s[2][2];
#pragma unroll
            for (int g = 0; g < 2; ++g)
#pragma unroll
                for (int i = 0; i < 16; ++i) { s[g][0][i] = 0.f; s[g][1][i] = 0.f; }
            __builtin_amdgcn_s_setprio(1);
#pragma unroll
            for (int ks = 0; ks < 2; ++ks) { const bf16x8 a0 = *(const LAS bf16x8*)(knb + r * 144 + ks * 32 + h * 16), a1 = *(const LAS bf16x8*)(knb + (32 + r) * 144 + ks * 32 + h * 16);
                s[0][0] = mfma32(a0, qf[0][ks], s[0][0]); s[1][0] = mfma32(a0, qf[1][ks], s[1][0]); s[0][1] = mfma32(a1, qf[0][ks], s[0][1]); s[1][1] = mfma32(a1, qf[1][ks], s[1][1]); }
#pragma unroll
            for (int ks = 2; ks < 4; ++ks) { const bf16x8 a0 = *(const LAS bf16x8*)(knb + r * 144 + ks * 32 + h * 16), a1 = *(const LAS bf16x8*)(knb + (32 + r) * 144 + ks * 32 + h * 16); const bf16x8 q0 = qr[(ks - 2) * 64], q1 = qr[(4 + ks - 2) * 64];
                s[0][0] = mfma32(a0, q0, s[0][0]); s[1][0] = mfma32(a0, q1, s[1][0]); s[0][1] = mfma32(a1, q0, s[0][1]); s[1][1] = mfma32(a1, q1, s[1][1]); }
#pragma unroll
            for (int ks = 0; ks < 2; ++ks) { const bf16x8 a0 = *(const LAS bf16x8*)(krb + r * 80 + ks * 32 + h * 16), a1 = *(const LAS bf16x8*)(krb + (32 + r) * 80 + ks * 32 + h * 16); const bf16x8 q0 = qr[(2 + ks) * 64], q1 = qr[(6 + ks) * 64];
                s[0][0] = mfma32(a0, q0, s[0][0]); s[1][0] = mfma32(a0, q1, s[1][0]); s[0][1] = mfma32(a1, q0, s[0][1]); s[1][1] = mfma32(a1, q1, s[1][1]); }
            __builtin_amdgcn_s_setprio(0);
            __builtin_amdgcn_sched_barrier(0);
            bf16x8 pf[2][4];
#pragma unroll
            for (int g = 0; g < 2; ++g) {
                float mx = s[g][0][0];
#pragma unroll
                for (int i = 0; i < 16; ++i) { mx = fmaxf(mx, s[g][0][i]); mx = fmaxf(mx, s[g][1][i]); }
                mx = fmaxf(mx, __shfl_xor(mx, 32));
                const float mnew = mx > m_run[g] + 8.f ? mx : m_run[g], alpha = __builtin_amdgcn_exp2f(m_run[g] - mnew);
                const bool resc = __builtin_amdgcn_ballot_w64(mnew != m_run[g]) != 0ull;
                m_run[g] = mnew;
                float ps = 0.f;
#pragma unroll
                for (int i = 0; i < 16; ++i) { s[g][0][i] = __builtin_amdgcn_exp2f(s[g][0][i] - mnew); s[g][1][i] = __builtin_amdgcn_exp2f(s[g][1][i] - mnew); ps += s[g][0][i] + s[g][1][i]; }
                l_run[g] = l_run[g] * alpha + ps;
                if (resc) {
#pragma unroll
                    for (int i = 0; i < 16; ++i) { o[g][0][i] *= alpha; o[g][1][i] *= alpha; } }
                pf[g][0] = pack8(s[g][0], 0); pf[g][1] = pack8(s[g][0], 8); pf[g][2] = pack8(s[g][1], 0); pf[g][3] = pack8(s[g][1], 8);
                __builtin_amdgcn_sched_barrier(0);
            }
            __builtin_amdgcn_s_setprio(1);
#pragma unroll
            for (int dh = 0; dh < 2; ++dh)
#pragma unroll
                for (int s4 = 0; s4 < 4; ++s4) { const LAS u32x2* pa = (const LAS u32x2*)(vtb + (32 * dh + r) * 136 + (16 * s4 + 4 * h) * 2); const u32x2 lo = pa[0], hi = pa[2];
                    u32x4 av; av[0] = lo[0]; av[1] = lo[1]; av[2] = hi[0]; av[3] = hi[1]; const bf16x8 avb = __builtin_bit_cast(bf16x8, av);
                    o[0][dh] = mfma32(avb, pf[0][s4], o[0][dh]); o[1][dh] = mfma32(avb, pf[1][s4], o[1][dh]); }
            __builtin_amdgcn_s_setprio(0);
        }
        if (more) A64_LSTORE((it + 1) & 1);
        __syncthreads();
    }
#undef A64_GLOAD
#undef A64_LSTORE
}
DI void phase_attn_p(const Params& p, LAS unsigned char* lds) {
    const int tid = tid_(), lane = tid & 63, wid = __builtin_amdgcn_readfirstlane(tid >> 6), r = lane & 31, h = lane >> 5;
    const bf16_t* Q = (const bf16_t*)(p.ws + OFF_Q); const bf16_t* KN = (const bf16_t*)(p.ws + OFF_KN); const bf16_t* VT = (const bf16_t*)(p.ws + OFF_VT);
    const bf16_t* KRO = (const bf16_t*)(p.ws + OFF_KROPE); bf16_t* O = (bf16_t*)(p.ws + OFF_O);
    for (int pair = bid_(); pair < 256; pair += gridDim.x) {
        const int bh = pair >> 3, qa = pair & 7, b = bh >> 3, hd = bh & 7;
        for (int sub = 0; sub < 2; ++sub) {
            const int qb = sub ? qa : 15 - qa;
            const int t0 = qb * 512 + wid * 64 + r;
            f32x16 o[2][2]; float m_run[2], l_run[2];
            attn_core64(lds, Q + ((size_t)bh * 8192 + t0) * 96, KN + (size_t)bh * 8192 * 64, KRO + (size_t)b * 8192 * 32, VT + (size_t)bh * 64 * 8192, 8192,
                        8 * qb + 8, 8 * qb + wid + 1, o, m_run, l_run);
#pragma unroll
            for (int g = 0; g < 2; ++g) {
                const float inv = 1.f / (l_run[g] + __shfl_xor(l_run[g], 32));
                bf16_t* orow = O + ((size_t)b * 8192 + t0 + g * 32) * 512 + hd * 64;
#pragma unroll
                for (int dh = 0; dh < 2; ++dh)
#pragma unroll
                    for (int q4 = 0; q4 < 4; ++q4) { uint2 w; w.x = pack2(o[g][dh][4 * q4] * inv, o[g][dh][4 * q4 + 1] * inv); w.y = pack2(o[g][dh][4 * q4 + 2] * inv, o[g][dh][4 * q4 + 3] * inv); *(uint2*)(orow + 32 * dh + 8 * q4 + 4 * h) = w; }
            }
        }
    }
}
DI void phase_attn_s(const Params& p, LAS unsigned char* lds) {
    const int tid = tid_(), lane = tid & 63, wid = __builtin_amdgcn_readfirstlane(tid >> 6), r = lane & 31, h = lane >> 5;
    const bf16_t* Q = (const bf16_t*)(p.ws + OFF_Q); const bf16_t* KN = (const bf16_t*)(p.ws + OFF_KN); const bf16_t* VT = (const bf16_t*)(p.ws + OFF_VT);
    const bf16_t* KRO = (const bf16_t*)(p.ws + OFF_KROPE); float* PART = (float*)(p.ws + OFF_PART);
    for (int c = bid_(); c < 256; c += gridDim.x) {
        const int b = c >> 3, hg = (c >> 2) & 1, split = c & 3, hh = wid >> 1, head = hg * 4 + hh, t = (wid & 1) * 32 + r;
        f32x16 o[2]; float m_run, l_run;
        attn_core<4>(lds, Q + (size_t)MP * 768 + ((size_t)(b * 8 + head) * 64 + t) * 96, KN + (size_t)MP * 512 + (size_t)(b * 8 + hg * 4) * KEYS_S * 64, (size_t)KEYS_S * 64,
                     KRO + (size_t)MP * 32 + (size_t)b * KEYS_S * 32, VT + (size_t)MP * 512 + (size_t)(b * 8 + hg * 4) * 64 * KEYS_S, (size_t)64 * KEYS_S, KEYS_S,
                     split, 4, 17, split == 0 ? 17 : 16, 65, hh, o, m_run, l_run);
        const float lt = l_run + __shfl_xor(l_run, 32);
        float* pr = PART + (((size_t)(b * 8 + head) * 4 + split) * 64 + t) * 66;
#pragma unroll
        for (int dh = 0; dh < 2; ++dh)
#pragma unroll
            for (int g = 0; g < 4; ++g) { float2 a, bb; a.x = o[dh][4 * g]; a.y = o[dh][4 * g + 1]; bb.x = o[dh][4 * g + 2]; bb.y = o[dh][4 * g + 3]; float* d = pr + 32 * dh + 8 * g + 4 * h; *(float2*)d = a; *(float2*)(d + 2) = bb; }
        if (h == 0) { float2 ml; ml.x = m_run; ml.y = lt; *(float2*)(pr + 64) = ml; }
    }
}

constexpr int R_QF = 0, R_KF = 16384, R_G = 32768, R_VTI = 49152, R_KTI = 58368, R_QTI = 67584, R_STI = 76800, R_PPI = 86016, R_QHI = 95232, R_KHI = 102144,
              R_GA = 115968, R_WA = 120064, R_SEG = 122240, R_OF = 0, R_WALL = 124288, R_BA = 132480, R_LB = 132992, R_QD = 134016, R_KD = 143232;
struct RecPre { u32x4 uv, ua, uq, ug, gz; f32x4 s0, s1; };
DI uint4 to_u4(u32x4 v) { uint4 r; r.x = v[0]; r.y = v[1]; r.z = v[2]; r.w = v[3]; return r; }
DI float4 to_f4(f32x4 v) { float4 r; r.x = v[0]; r.y = v[1]; r.z = v[2]; r.w = v[3]; return r; }
DI void rec_tables(const Params& p, int l, LAS unsigned char* lds) {
    const int tid = tid_();
    LAS float* WALL = (LAS float*)(lds + R_WALL); LAS float* BA = (LAS float*)(lds + R_BA); LAS float* LB = (LAS float*)(lds + R_LB);
#pragma unroll
    for (int i = 0; i < 4; ++i) WALL[tid + 512 * i] = p.in[23][l * 2048 + tid + 512 * i];
    if (tid < 128) BA[tid] = p.in[24][l * 128 + tid];
    if (tid < 256) { float lb = 0.f; if (l == 1) { const float l0 = p.in[21][tid], l1 = p.in[21][256 + tid]; lb = 1.f / (1.f + expf(l0 - l1)); } LB[tid] = lb; }
    __syncthreads();
}
template <int DK, bool HG>
DI void rec_issue(const Params& p, int cid, int hd, bool passC, RecPre& r) {
    const int tid = tid_();
    const bf16_t* Z = (const bf16_t*)(p.ws + OFF_Z);
    const size_t row0 = (size_t)cid * 64;
    const int lj = tid >> 3, ls8 = (tid & 7) * 8;
    const bf16_t* zr = Z + (row0 + lj) * ZLD;
    r.uv = *(const u32x4*)(zr + (HG ? 1056 : 1824) + hd * 64 + ls8);
    if (HG) { r.ua = *(const u32x4*)(zr + 800 + hd * 64 + ls8); if (passC) r.uq = *(const u32x4*)(zr + 544 + hd * 64 + ls8); }
    else { if (tid < 256) { const bf16_t* z2 = Z + (row0 + (tid >> 2)) * ZLD; r.ua = *(const u32x4*)(z2 + 1696 + hd * 32 + (tid & 3) * 8); if (passC) r.uq = *(const u32x4*)(z2 + 1568 + hd * 32 + (tid & 3) * 8); }
           if (tid < 128) r.ug = *(const u32x4*)(Z + (row0 + (tid >> 1)) * ZLD + 2336 + (tid & 1) * 8); }
    if (passC) {
        const float* S = (const float*)(p.ws + (HG ? OFF_UHG : OFF_UGL)) + ((size_t)cid * 4 + hd) * DK * 64;
            if (tid < DK * 8) { const int k = tid >> 3, v0 = (tid & 7) * 8; r.s0 = *(const f32x4*)(S + k * 64 + v0); r.s1 = *(const f32x4*)(S + k * 64 + v0 + 4); }
        r.gz = *(const u32x4*)(zr + (HG ? 1312 : 2080) + hd * 64 + ls8);
    }
}
template <int DK, bool HG>
DI void rec_load(const RecPre& pre, LAS unsigned char* lds, int hd, bool need_q) {
    const int tid = tid_();
    LAS float* QF = (LAS float*)(lds + R_QF); LAS float* KF = (LAS float*)(lds + R_KF); LAS float* G = (LAS float*)(lds + R_G);
    LAS bf16_t* VTI = (LAS bf16_t*)(lds + R_VTI); LAS float* GA = (LAS float*)(lds + R_GA); LAS float* SEG = (LAS float*)(lds + R_SEG);
    const LAS float* WA = (const LAS float*)(lds + (HG ? R_LB : R_WALL)) + (HG ? hd * 64 : hd * 32);
    const LAS float* BA = (const LAS float*)(lds + R_BA) + hd * 32;
    const int lj = tid >> 3, ls8 = (tid & 7) * 8;
    const uint4 uv = to_u4(pre.uv), ua = to_u4(pre.ua), uq = to_u4(pre.uq);
    if (!HG) {
        if (tid < 128) { const int j = tid >> 1, hf = tid & 1; const uint4 u = to_u4(pre.ug); LAS float* ga = GA + j * 16 + hf * 8;
            ga[0] = bflo(u.x); ga[1] = bfhi(u.x); ga[2] = bflo(u.y); ga[3] = bfhi(u.y); ga[4] = bflo(u.z); ga[5] = bfhi(u.z); ga[6] = bflo(u.w); ga[7] = bfhi(u.w); }
        __syncthreads();
    }
    { const float va[8] = {bflo(ua.x), bfhi(ua.x), bflo(ua.y), bfhi(ua.y), bflo(ua.z), bfhi(ua.z), bflo(ua.w), bfhi(ua.w)};
      const float vq[8] = {bflo(uq.x), bfhi(uq.x), bflo(uq.y), bfhi(uq.y), bflo(uq.z), bfhi(uq.z), bflo(uq.w), bfhi(uq.w)};
      if (HG) { float gg[8], kk[8];
#pragma unroll
          for (int x = 0; x < 8; ++x) { const float lb = WA[ls8 + x], e = __expf(fminf(-va[x], 80.f)), s = 1.f / (1.f + e); gg[x] = logf(lb + (1.f - lb) * s); kk[x] = (1.f - lb) * e * s; }
          LAS f32x4* gp = (LAS f32x4*)(G + lj * 64 + ls8); LAS f32x4* kp = (LAS f32x4*)(KF + lj * 64 + ls8);
          gp[0] = (f32x4){gg[0], gg[1], gg[2], gg[3]}; gp[1] = (f32x4){gg[4], gg[5], gg[6], gg[7]}; kp[0] = (f32x4){kk[0], kk[1], kk[2], kk[3]}; kp[1] = (f32x4){kk[4], kk[5], kk[6], kk[7]};
          if (need_q) { LAS f32x4* qp = (LAS f32x4*)(QF + lj * 64 + ls8); qp[0] = (f32x4){vq[0], vq[1], vq[2], vq[3]}; qp[1] = (f32x4){vq[4], vq[5], vq[6], vq[7]}; } }
      else {
          { const int kq = (tid & 7) * 4; f32x4 x = *(const LAS f32x4*)(BA + kq);
#pragma unroll
            for (int r = 0; r < 16; ++r) { const float ga = GA[lj * 16 + r]; const f32x4 wv = *(const LAS f32x4*)(WA + r * 128 + kq); x += ga * wv; }
            f32x4 o;
#pragma unroll
            for (int y = 0; y < 4; ++y) o[y] = (fminf(x[y], 0.f) - log1pf(__expf(-fabsf(x[y])))) * (1.f / 16.f);
            *(LAS f32x4*)(G + lj * 32 + kq) = o; }
          if (tid < 256) { const int j2 = tid >> 2, k2 = (tid & 3) * 8; LAS f32x4* kp = (LAS f32x4*)(KF + j2 * 32 + k2); kp[0] = (f32x4){va[0], va[1], va[2], va[3]}; kp[1] = (f32x4){va[4], va[5], va[6], va[7]};
              if (need_q) { const float qs = 0.17677669529663687f; LAS f32x4* qp = (LAS f32x4*)(QF + j2 * 32 + k2); qp[0] = (f32x4){vq[0] * qs, vq[1] * qs, vq[2] * qs, vq[3] * qs}; qp[1] = (f32x4){vq[4] * qs, vq[5] * qs, vq[6] * qs, vq[7] * qs}; } } }
      const unsigned vv[4] = {uv.x, uv.y, uv.z, uv.w};
#pragma unroll
      for (int x = 0; x < 4; ++x) { VTI[(ls8 + 2 * x) * 72 + lj] = (bf16_t)(vv[x] & 0xFFFFu); VTI[(ls8 + 2 * x + 1) * 72 + lj] = (bf16_t)(vv[x] >> 16); } }
    __syncthreads();
    constexpr int NSEG = NT / DK, JS = 64 / NSEG;
    const int seg = tid / DK, k = tid % DK;
    float loc[JS]; float s = 0.f;
#pragma unroll
    for (int jj = 0; jj < JS; ++jj) { s += G[(seg * JS + jj) * DK + k]; loc[jj] = s; }
    SEG[seg * DK + k] = s;
    __syncthreads();
    float off = 0.f;
#pragma unroll
    for (int s2 = 0; s2 < NSEG; ++s2) { const float t = SEG[s2 * DK + k]; off += s2 < seg ? t : 0.f; }
#pragma unroll
    for (int jj = 0; jj < JS; ++jj) G[(seg * JS + jj) * DK + k] = loc[jj] + off;
    __syncthreads();
}
template <int DK, bool HG>
DI void rec_passA_item(const Params& p, int l, LAS unsigned char* lds, int cid, int hd, const RecPre& pre) {
    const int tid = tid_(), lane = tid & 63, wid = __builtin_amdgcn_readfirstlane(tid >> 6), fr = lane & 15, fq = lane >> 4;
    rec_load<DK, HG>(pre, lds, hd, false);
    LAS float* KF = (LAS float*)(lds + R_KF); LAS float* G = (LAS float*)(lds + R_G);
    LAS bf16_t* VTI = (LAS bf16_t*)(lds + R_VTI); LAS bf16_t* KTI = (LAS bf16_t*)(lds + R_KTI);
    float* U = (float*)(p.ws + (HG ? OFF_UHG : OFF_UGL)); float* D = (float*)(p.ws + (HG ? OFF_DHG : OFF_DGL));
    for (int e = tid; e < 64 * DK; e += NT) { const int j = e / DK, k = e % DK; KTI[k * 72 + j] = f2bf(KF[e] * __expf(G[63 * DK + k] - G[e])); }
    if (tid < DK) D[((size_t)cid * 4 + hd) * DK + tid] = __expf(G[63 * DK + tid]);
    __syncthreads();
    for (int tile = wid; tile < (DK / 16) * 4; tile += 8) {
        const int tk = tile >> 2, tv = tile & 3; f32x4 acc = {0.f, 0.f, 0.f, 0.f};
#pragma unroll
        for (int s = 0; s < 2; ++s) { const bf16x8 a = *(const LAS bf16x8*)(KTI + (16 * tk + fr) * 72 + 32 * s + 8 * fq), b = *(const LAS bf16x8*)(VTI + (16 * tv + fr) * 72 + 32 * s + 8 * fq); acc = mfma16(a, b, acc); }
#pragma unroll
        for (int reg = 0; reg < 4; ++reg) U[(((size_t)cid * 4 + hd) * DK + 16 * tk + 4 * fq + reg) * 64 + 16 * tv + fr] = acc[reg];
    }
    __syncthreads();
}
template <int DK, bool HG>
DI void rec_passC_item(const Params& p, int l, LAS unsigned char* lds, int cid, int hd, const RecPre& pre) {
    const int tid = tid_(), lane = tid & 63, wid = __builtin_amdgcn_readfirstlane(tid >> 6), fr = lane & 15, fq = lane >> 4;
    rec_load<DK, HG>(pre, lds, hd, true);
    LAS float* QF = (LAS float*)(lds + R_QF); LAS float* KF = (LAS float*)(lds + R_KF); LAS float* G = (LAS float*)(lds + R_G); LAS float* OF = (LAS float*)(lds + R_OF);
    LAS bf16_t* VTI = (LAS bf16_t*)(lds + R_VTI); LAS bf16_t* QTI = (LAS bf16_t*)(lds + R_QTI); LAS bf16_t* STI = (LAS bf16_t*)(lds + R_STI);
    LAS bf16_t* PPI = (LAS bf16_t*)(lds + R_PPI); LAS bf16_t* QHI = (LAS bf16_t*)(lds + R_QHI); LAS bf16_t* KHI = (LAS bf16_t*)(lds + R_KHI);
    const bf16_t* Z = (const bf16_t*)(p.ws + OFF_Z); bf16_t* H = (bf16_t*)(p.ws + OFF_H);
    for (int e = tid; e < 64 * DK; e += NT) { const int i = e / DK, k = e % DK; QTI[i * 72 + k] = f2bf(QF[e] * __expf(G[e])); }
    if (tid < DK * 8) { const int k = tid >> 3, v0 = (tid & 7) * 8; const float4 s0 = to_f4(pre.s0), s1 = to_f4(pre.s1);
        STI[(v0 + 0) * 72 + k] = f2bf(s0.x); STI[(v0 + 1) * 72 + k] = f2bf(s0.y); STI[(v0 + 2) * 72 + k] = f2bf(s0.z); STI[(v0 + 3) * 72 + k] = f2bf(s0.w);
        STI[(v0 + 4) * 72 + k] = f2bf(s1.x); STI[(v0 + 5) * 72 + k] = f2bf(s1.y); STI[(v0 + 6) * 72 + k] = f2bf(s1.z); STI[(v0 + 7) * 72 + k] = f2bf(s1.w); }
    for (int e = tid; e < 48 * DK; e += NT) { const int ii = e / DK, k = e % DK, I = 1 + (ii >> 4), i = 16 + ii; const float ref = G[(16 * I - 1) * DK + k];
        QHI[ii * 72 + k] = f2bf(QF[i * DK + k] * __expf(G[i * DK + k] - ref)); }
    for (int e = tid; e < 96 * DK; e += NT) { const int rr = e / DK, k = e % DK, I = rr < 16 ? 1 : (rr < 48 ? 2 : 3), j = rr - 8 * I * (I - 1); const float ref = G[(16 * I - 1) * DK + k];
        KHI[rr * 72 + k] = f2bf(KF[j * DK + k] * __expf(ref - G[j * DK + k])); }
    { LAS bf16_t* QD = (LAS bf16_t*)(lds + R_QD); LAS bf16_t* KD = (LAS bf16_t*)(lds + R_KD);
      for (int e = tid; e < 64 * DK; e += NT) { const int i = e / DK, k = e % DK; const float ref = G[(16 * (i >> 4) + 7) * DK + k], gi = G[e];
          QD[i * 72 + k] = f2bf(QF[e] * __expf(fminf(fmaxf(gi - ref, -80.f), 80.f))); KD[i * 72 + k] = f2bf(KF[e] * __expf(fminf(fmaxf(ref - gi, -80.f), 80.f))); } }
    for (int e = tid; e < 1536; e += NT) { const int bidx = e >> 8, w = e & 255; const int I = bidx < 3 ? 0 : (bidx < 5 ? 1 : 2), J = bidx < 3 ? bidx + 1 : (bidx < 5 ? bidx - 1 : 3);
        PPI[(16 * I + (w >> 4)) * 72 + 16 * J + (w & 15)] = 0; }
    __syncthreads();
    if (wid >= 6) { const LAS bf16_t* QD = (const LAS bf16_t*)(lds + R_QD); const LAS bf16_t* KD = (const LAS bf16_t*)(lds + R_KD);
#pragma unroll
        for (int t2 = 0; t2 < 2; ++t2) { const int I = (wid - 6) * 2 + t2; f32x4 acc = {0.f, 0.f, 0.f, 0.f};
#pragma unroll
            for (int s = 0; s < DK / 32; ++s) { const bf16x8 a = *(const LAS bf16x8*)(QD + (16 * I + fr) * 72 + 32 * s + 8 * fq), b = *(const LAS bf16x8*)(KD + (16 * I + fr) * 72 + 32 * s + 8 * fq); acc = mfma16(a, b, acc); }
#pragma unroll
            for (int reg = 0; reg < 4; ++reg) PPI[(16 * I + 4 * fq + reg) * 72 + 16 * I + fr] = f2bf(fr <= 4 * fq + reg ? acc[reg] : 0.f); } }
    if (wid < 6) { const int I = wid < 1 ? 1 : (wid < 3 ? 2 : 3), J = wid < 1 ? 0 : (wid < 3 ? wid - 1 : wid - 3); f32x4 acc = {0.f, 0.f, 0.f, 0.f};
#pragma unroll
        for (int s = 0; s < DK / 32; ++s) { const bf16x8 a = *(const LAS bf16x8*)(QHI + ((I - 1) * 16 + fr) * 72 + 32 * s + 8 * fq), b = *(const LAS bf16x8*)(KHI + (8 * I * (I - 1) + 16 * J + fr) * 72 + 32 * s + 8 * fq); acc = mfma16(a, b, acc); }
#pragma unroll
        for (int reg = 0; reg < 4; ++reg) PPI[(16 * I + 4 * fq + reg) * 72 + 16 * J + fr] = f2bf(acc[reg]); }
    __syncthreads();
#pragma unroll
    for (int tt = 0; tt < 2; ++tt) { const int tile = wid * 2 + tt, ti = tile >> 2, tv = tile & 3; f32x4 acc = {0.f, 0.f, 0.f, 0.f};
#pragma unroll
        for (int s = 0; s < DK / 32; ++s) { const bf16x8 a = *(const LAS bf16x8*)(QTI + (16 * ti + fr) * 72 + 32 * s + 8 * fq), b = *(const LAS bf16x8*)(STI + (16 * tv + fr) * 72 + 32 * s + 8 * fq); acc = mfma16(a, b, acc); }
#pragma unroll
        for (int s = 0; s < 2; ++s) { const bf16x8 a = *(const LAS bf16x8*)(PPI + (16 * ti + fr) * 72 + 32 * s + 8 * fq), b = *(const LAS bf16x8*)(VTI + (16 * tv + fr) * 72 + 32 * s + 8 * fq); acc = mfma16(a, b, acc); }
#pragma unroll
        for (int reg = 0; reg < 4; ++reg) OF[(16 * ti + 4 * fq + reg) * 65 + 16 * tv + fr] = acc[reg]; }
    __syncthreads();
    { const int i = tid >> 3, part = tid & 7; float v[8]; float ss = 0.f;
#pragma unroll
      for (int x = 0; x < 8; ++x) { v[x] = OF[i * 65 + part * 8 + x]; ss += v[x] * v[x]; }
      ss += __shfl_xor(ss, 1); ss += __shfl_xor(ss, 2); ss += __shfl_xor(ss, 4);
      const float rs = rsqrtf(ss * (1.f / 64.f) + EPS);
      const size_t row = (size_t)cid * 64 + i;
      const uint4 gz = to_u4(pre.gz);
      const float* go = p.in[HG ? 22 : 25] + l * 64 + part * 8;
      const float gt[8] = {bflo(gz.x), bfhi(gz.x), bflo(gz.y), bfhi(gz.y), bflo(gz.z), bfhi(gz.z), bflo(gz.w), bfhi(gz.w)};
      float r[8];
#pragma unroll
      for (int x = 0; x < 8; ++x) r[x] = v[x] * rs * go[x] * (gt[x] / (1.f + __expf(-gt[x])));
      uint4 w; w.x = pack2(r[0], r[1]); w.y = pack2(r[2], r[3]); w.z = pack2(r[4], r[5]); w.w = pack2(r[6], r[7]);
      *(uint4*)(H + row * 1024 + 512 + (HG ? 0 : 256) + hd * 64 + part * 8) = w; }
    __syncthreads();
}
template <int DK>
DI void scan_prompt(float* U, const float* D, float* outp, int e) {
    const int v = e & 63, k = (e >> 6) % DK, hd = (e / (64 * DK)) & 3, b = e / (256 * DK);
    float S = 0.f;
    for (int n0 = 0; n0 < 128; n0 += 16) {
        float u[16], d[16];
#pragma unroll
        for (int i = 0; i < 16; ++i) { const size_t ch = ((size_t)(b * 128 + n0 + i) * 4 + hd); u[i] = U[(ch * DK + k) * 64 + v]; d[i] = D[ch * DK + k]; }
#pragma unroll
        for (int i = 0; i < 16; ++i) { const size_t ch = ((size_t)(b * 128 + n0 + i) * 4 + hd); U[(ch * DK + k) * 64 + v] = S; S = d[i] * S + u[i]; }
    }
    outp[e] = S;
}
template <int DK>
DI void scan_sample(float* U, const float* D, const float* s0p, float* outp, int e) {
    const int v = e & 63, k = (e >> 6) % DK, hd = (e / (64 * DK)) & 3, b = e / (256 * DK);
    const size_t ch = (size_t)(512 + b) * 4 + hd; const size_t idx = (ch * DK + k) * 64 + v;
    const float s0 = s0p[e], u = U[idx], d = D[ch * DK + k];
    U[idx] = s0; outp[e] = d * s0 + u;
}
DI void phase_scan(const Params& p, int l) {
    const int g = bid_() * NT + tid_(), gs = gridDim.x * NT;
    float* UH = (float*)(p.ws + OFF_UHG); const float* DH = (const float*)(p.ws + OFF_DHG); float* UG = (float*)(p.ws + OFF_UGL); const float* DG = (const float*)(p.ws + OFF_DGL);
    for (int e = g; e < 98304; e += gs) {
        if (e < 65536) scan_prompt<64>(UH, DH, p.out + OUT_HGP + (size_t)l * 65536, e);
        else scan_prompt<32>(UG, DG, p.out + OUT_GLP + (size_t)l * 32768, e - 65536);
    }
    for (int e = g; e < 786432; e += gs) {
        if (e < 524288) scan_sample<64>(UH, DH, p.in[6] + (size_t)l * 524288, p.out + OUT_HGS + (size_t)l * 524288, e);
        else scan_sample<32>(UG, DG, p.in[7] + (size_t)l * 262144, p.out + OUT_GLS + (size_t)l * 262144, e - 524288);
    }
}
DI void phase_mlaout(const Params& p, int l) {
    const int tid = tid_(), lane = tid & 63, wid = __builtin_amdgcn_readfirstlane(tid >> 6);
    const bf16_t* O = (const bf16_t*)(p.ws + OFF_O); const float* PART = (const float*)(p.ws + OFF_PART); bf16_t* H = (bf16_t*)(p.ws + OFF_H);
    const float* g = p.in[20] + l * 512 + 8 * lane;
    for (int row = bid_() * 8 + wid; row < MT; row += gridDim.x * 8) {
        float v[8];
        if (row < MP) { const uint4 u = *(const uint4*)(O + (size_t)row * 512 + 8 * lane);
            v[0] = bflo(u.x); v[1] = bfhi(u.x); v[2] = bflo(u.y); v[3] = bfhi(u.y); v[4] = bflo(u.z); v[5] = bfhi(u.z); v[6] = bflo(u.w); v[7] = bfhi(u.w); }
        else { const int r = row - MP, b = r >> 6, t = r & 63, head = lane >> 3, dv0 = (lane & 7) * 8;
            const float* pb = PART + (((size_t)(b * 8 + head) * 4) * 64 + t) * 66;
            float m[4], lsum[4]; float M = neg_big();
#pragma unroll
            for (int s = 0; s < 4; ++s) { m[s] = pb[(size_t)s * 64 * 66 + 64]; lsum[s] = pb[(size_t)s * 64 * 66 + 65]; M = fmaxf(M, m[s]); }
            float L = 0.f;
#pragma unroll
            for (int x = 0; x < 8; ++x) v[x] = 0.f;
#pragma unroll
            for (int s = 0; s < 4; ++s) { const float w = exp2f(m[s] - M); L += w * lsum[s];
#pragma unroll
                for (int x = 0; x < 8; ++x) v[x] += w * pb[(size_t)s * 64 * 66 + dv0 + x]; }
            const float inv = 1.f / L;
#pragma unroll
            for (int x = 0; x < 8; ++x) v[x] *= inv; }
        float ss = 0.f;
#pragma unroll
        for (int x = 0; x < 8; ++x) ss += v[x] * v[x];
        ss = wave_sum(ss);
        const float rs = rsqrtf(ss * (1.f / 512.f) + EPS);
        uint4 w; w.x = pack2(v[0] * rs * g[0], v[1] * rs * g[1]); w.y = pack2(v[2] * rs * g[2], v[3] * rs * g[3]); w.z = pack2(v[4] * rs * g[4], v[5] * rs * g[5]); w.w = pack2(v[6] * rs * g[6], v[7] * rs * g[7]);
        *(uint4*)(H + (size_t)row * 1024 + 8 * lane) = w;
    }
}

DI void gsync(const Params& p, LAS unsigned char* lds) { XcdBarrier b; b.bar = (unsigned*)(p.ws + OFF_BAR); b.x = xb_xcc_id(); b.st = (volatile LAS unsigned*)(lds + LDS_BYTES - 16); xcd_barrier(b); }
__global__ void __launch_bounds__(512, 2) mk_fwd(Params p) {
    extern __shared__ __attribute__((aligned(16))) unsigned char shm[];
    LAS unsigned char* lds = (LAS unsigned char*)shm;
    cg::grid_group grid = cg::this_grid();
    bf16_t* H = (bf16_t*)(p.ws + OFF_H); bf16_t* Z = (bf16_t*)(p.ws + OFF_Z); bf16_t* CQN = (bf16_t*)(p.ws + OFF_CQN); bf16_t* CKV = (bf16_t*)(p.ws + OFF_CKV);
    bf16_t* Q = (bf16_t*)(p.ws + OFF_Q); bf16_t* KN = (bf16_t*)(p.ws + OFF_KN); bf16_t* VT = (bf16_t*)(p.ws + OFF_VT); bf16_t* ACT = (bf16_t*)(p.ws + OFF_ACT);
    const float* rope = (const float*)(p.ws + OFF_ROPE); bf16_t* XB = (bf16_t*)(p.ws + OFF_XB);
    volatile LAS unsigned* xst = (volatile LAS unsigned*)(lds + LDS_BYTES - 16);
    if (threadIdx.x == 0) { xst[0] = 0u; xst[1] = 0u; }
    __syncthreads();
    (void)xcd_barrier_post((unsigned*)(p.ws + OFF_BAR), xst);
    phase_prep(p, lds);
    grid.sync();
#pragma unroll 1
    for (int l = 0; l < 2; ++l) {
        const unsigned char* W = p.ws + OFF_W + (size_t)l * WL;
        const float* modl = (const float*)(p.ws + OFF_MOD) + (size_t)l * 36 * 6144;
        if (l == 0) phase_hrows<true>(p, l, p.in[0], p.in[1], p.in[10] + l * 1024, 0, 1024); else phase_hrows<false>(p, l, nullptr, nullptr, p.in[10] + l * 1024, 0, 1024);
        phase_cache(p, l);
        gsync(p, lds);
        run_gemm(lds, H, (const bf16_t*)(W + WOFF_IN), MT, 2560, 1024, EpiZ{Z, ZLD});
        gsync(p, lds);
        phase_post(p, l);
        gsync(p, lds);
        run_gemm(lds, CQN, (const bf16_t*)(W + WOFF_UQ), MT, 768, 256, EpiQ{Q, p.in[18] + l * 96, rope});
        run_gemm(lds, CKV, (const bf16_t*)(W + WOFF_UK), KR_ROWS, 512, 256, EpiKN{KN, p.in[19] + l * 96});
        run_gemm(lds, (const bf16_t*)(W + WOFF_UV), CKV, 512, KR_ROWS, 256, EpiVT{VT});
        gsync(p, lds);
        phase_attn_p(p, lds);
        phase_attn_s(p, lds);
        rec_tables(p, l, lds);
        { RecPre pre = {}; int it = bid_(); if (it < 2176) rec_issue<64, true>(p, it >> 2, it & 3, false, pre);
          for (; it < 2176; it += gridDim.x) { const RecPre cur = pre; const int nx = it + gridDim.x; if (nx < 2176) rec_issue<64, true>(p, nx >> 2, nx & 3, false, pre); rec_passA_item<64, true>(p, l, lds, it >> 2, it & 3, cur); } }
        { RecPre pre = {}; int it = bid_(); if (it < 2176) rec_issue<32, false>(p, it >> 2, it & 3, false, pre);
          for (; it < 2176; it += gridDim.x) { const RecPre cur = pre; const int nx = it + gridDim.x; if (nx < 2176) rec_issue<32, false>(p, nx >> 2, nx & 3, false, pre); rec_passA_item<32, false>(p, l, lds, it >> 2, it & 3, cur); } }
        gsync(p, lds);
        phase_scan(p, l);
        gsync(p, lds);
        rec_tables(p, l, lds);
        { RecPre pre = {}; int it = bid_(); if (it < 2176) rec_issue<64, true>(p, it >> 2, it & 3, true, pre);
          for (; it < 2176; it += gridDim.x) { const RecPre cur = pre; const int nx = it + gridDim.x; if (nx < 2176) rec_issue<64, true>(p, nx >> 2, nx & 3, true, pre); rec_passC_item<64, true>(p, l, lds, it >> 2, it & 3, cur); } }
        { RecPre pre = {}; int it = bid_(); if (it < 2176) rec_issue<32, false>(p, it >> 2, it & 3, true, pre);
          for (; it < 2176; it += gridDim.x) { const RecPre cur = pre; const int nx = it + gridDim.x; if (nx < 2176) rec_issue<32, false>(p, nx >> 2, nx & 3, true, pre); rec_passC_item<32, false>(p, l, lds, it >> 2, it & 3, cur); } }
        phase_mlaout(p, l);
        gsync(p, lds);
        run_gemm(lds, H, (const bf16_t*)(W + WOFF_O), MT, 1024, 1024, EpiRes{XB, p.out, modl + 2048, 0});
        gsync(p, lds);
        phase_hrows<false>(p, l, nullptr, nullptr, p.in[11] + l * 1024, 3072, 4096);
        gsync(p, lds);
        run_gemm(lds, H, (const bf16_t*)(W + WOFF_FI), MT, 5632, 1024, EpiSwi{ACT});
        gsync(p, lds);
        run_gemm(lds, ACT, (const bf16_t*)(W + WOFF_FO), MT, 1024, 2816, EpiRes{XB, p.out, modl + 5120, l});
        if (l == 0) gsync(p, lds);
    }
}

extern "C" void kernel_launch(void* const* d_in, const int* in_sizes, int n_in, void* d_out, int out_size, void* d_ws, size_t ws_size, hipStream_t stream) {
    static int grid = 0;
    if (grid == 0) {
        int dev = 0, cus = 0, per_cu = 0;
        hipGetDevice(&dev);
        hipDeviceGetAttribute(&cus, hipDeviceAttributeMultiprocessorCount, dev);
        hipFuncSetAttribute((const void*)mk_fwd, hipFuncAttributeMaxDynamicSharedMemorySize, LDS_BYTES);
        hipOccupancyMaxActiveBlocksPerMultiprocessor(&per_cu, (const void*)mk_fwd, NT, LDS_BYTES);
        if (per_cu < 1) { fprintf(stderr, "kernel_launch: occupancy query says %d blocks per CU\n", per_cu); per_cu = 1; }
        (void)hipGetLastError();
        grid = cus;
        if (ws_size < WS_END) { fprintf(stderr, "kernel_launch: workspace too small: %zu < %zu\n", ws_size, (size_t)WS_END); grid = -1; }
    }
    if (grid < 0) return;
    if (hipMemsetAsync((char*)d_ws + OFF_BAR, 0, XCD_BAR_WORDS * 4, stream) != hipSuccess) { fprintf(stderr, "kernel_launch: memset failed\n"); return; }
    Params p{};
    for (int i = 0; i < 29; ++i) p.in[i] = (const float*)d_in[i];
    p.out = (float*)d_out; p.ws = (unsigned char*)d_ws;
    void* args[] = {&p};
    hipError_t e = hipLaunchCooperativeKernel((const void*)mk_fwd, dim3(grid), dim3(NT), args, LDS_BYTES, stream);
    if (e != hipSuccess) fprintf(stderr, "cooperative launch failed: %s (grid %d)\n", hipGetErrorString(e), grid);
}
```

```cpp
#include <hip/hip_runtime.h>
#include <hip/hip_cooperative_groups.h>
#include <cstdio>
namespace cg = cooperative_groups;
namespace pg8 {
#define PG8_LAS __attribute__((address_space(3)))
typedef unsigned short bf16_t;
typedef short bf16x8 __attribute__((ext_vector_type(8)));
typedef float f32x4 __attribute__((ext_vector_type(4)));
typedef unsigned u32x4 __attribute__((ext_vector_type(4)));
constexpr int BM = 256, BK = 64, HALF = 128, HTB = HALF * BK * 2  , STAGE_BYTES = 8 * HTB, NXCD = 8, WGM = 8;

__host__ __device__ __forceinline__ int lds_byte(int r, int c) { const int st = (r >> 4) * 2 + (c >> 5), rr = r & 15, cc = c & 31, ob = rr * 64 + cc * 2; return st * 1024 + (ob ^ (((ob >> 9) & 1) << 5)); }
__host__ __device__ __forceinline__ void stage_rc(int b, int& R, int& C) { const int st = b / 1024, sb = b % 1024, swz = sb ^ (((sb >> 9) & 1) << 5); R = (st >> 1) * 16 + swz / 64; C = (st & 1) * 32 + (swz % 64) / 2; }
__host__ __device__ __forceinline__ int perm32(int rho) { const int n = rho >> 4, i = rho & 15; return 8 * (i >> 2) + 4 * n + (i & 3); }

struct Unit { int pm, pn; };
struct Gemm { const bf16_t* A; const bf16_t* Bt; int M, N, K; };

struct StaticOrder {
    int nM, nN, nwg, G, c;
    __host__ __device__ void init(int M, int N, int G_, int c_) { nM = M / BM; nN = N / BM; nwg = nM * nN; G = G_; c = c_; }
    __host__ __device__ bool next(int i, Unit& u) const {
        const long L = (long)i * G + c; if (L >= nwg) return false;
        int wgid = (int)L; { const int q = nwg / NXCD, r = nwg % NXCD, xcd = wgid % NXCD, off = wgid / NXCD; wgid = (xcd < r ? xcd * (q + 1) : r * (q + 1) + (xcd - r) * q) + off; }
        const int nig = WGM * nN, gid = wgid / nig, fm = gid * WGM, gsz = (nM - fm) < WGM ? (nM - fm) : WGM;
        u.pm = fm + ((wgid % nig) % gsz); u.pn = (wgid % nig) / gsz; return true;
    }
    __device__ __forceinline__ void a_ready(const Unit&) const {}
    __device__ __forceinline__ void done(const Unit&) const {}
};
template <class Epi, class Sched, bool STAMP = false>
__device__ __forceinline__ void gemm_phase(PG8_LAS unsigned char* lds, const Gemm g, const Sched& S, const Epi& E, unsigned long long* stamps) {
    int tid = threadIdx.x; asm volatile("" : "+v"(tid)); const int wid = __builtin_amdgcn_readfirstlane(tid >> 6), lane = tid & 63, wr = wid >> 2, wc = wid & 3, fr = lane & 15, fq = lane >> 4;
    const int K = g.K, nt = K / BK;
    int ts_lo = 0, ts_hi = 0, nts = 0; const unsigned long long rt_entry = STAMP ? (unsigned long long)wall_clock64() : 0ull;
#define PG8_STAMP() do { if (STAMP && wid == 0 && nts < 64) { const unsigned long long _c = (unsigned long long)clock64(); \
        ts_lo = (lane == nts) ? (int)(unsigned)_c : ts_lo; ts_hi = (lane == nts) ? (int)(unsigned)(_c >> 32) : ts_hi; ++nts; } } while (0)
    PG8_STAMP();
    unsigned voffA[2], voffB[2];
#pragma unroll
    for (int i = 0; i < 2; ++i) { int R, C; stage_rc(tid * 16 + i * 8192, R, C); const int Rb = Epi::PERM ? ((R & ~31) + perm32(R & 31)) : R;
        voffA[i] = (unsigned)(R * K + C) * 2u; voffB[i] = (unsigned)(Rb * K + C) * 2u; }
    const size_t kstep = (size_t)(BK * 2);
    const size_t hstep = (size_t)HALF * K * 2;
    const size_t tstep = 2 * hstep;
    const unsigned ldsw = (unsigned)wid * 1024u;
    const int aoff = lds_byte(wr * 64 + fr, fq * 8), boff = lds_byte(wc * 32 + fr, fq * 8);
#define PG8_SA(b, h) (((b) * 2 + (h)) * HTB)
#define PG8_SB(b, h) ((4 + (b) * 2 + (h)) * HTB)
#define PG8_STAGE(bufoff, gbase, voff) do { _Pragma("unroll") for (int _i = 0; _i < 2; ++_i) \
        __builtin_amdgcn_global_load_lds((const unsigned*)((const char*)(gbase) + (voff)[_i]), (PG8_LAS unsigned*)(lds + (bufoff) + ldsw + _i * 8192), 16, 0, 0); } while (0)
#define PG8_LDA(dst, b, h) do { _Pragma("unroll") for (int m = 0; m < 4; ++m) _Pragma("unroll") for (int k = 0; k < 2; ++k) dst[m][k] = *(const PG8_LAS bf16x8*)(lds + PG8_SA(b, h) + aoff + m * 2048 + k * 1024); } while (0)
#define PG8_LDB(dst, b, h) do { _Pragma("unroll") for (int n = 0; n < 2; ++n) _Pragma("unroll") for (int k = 0; k < 2; ++k) dst[n][k] = *(const PG8_LAS bf16x8*)(lds + PG8_SB(b, h) + boff + n * 2048 + k * 1024); } while (0)
#define PG8_MMA(ai, bj, At, Bt) do { __builtin_amdgcn_s_setprio(1); _Pragma("unroll") for (int m = 0; m < 4; ++m) _Pragma("unroll") for (int n = 0; n < 2; ++n) _Pragma("unroll") for (int k = 0; k < 2; ++k) \
        acc[ai][bj][m][n] = __builtin_amdgcn_mfma_f32_16x16x32_bf16(Bt[n][k], At[m][k], acc[ai][bj][m][n], 0, 0, 0); __builtin_amdgcn_s_setprio(0); } while (0)
#define PG8_WAIT_V(n) asm volatile("s_waitcnt vmcnt(" #n ")" ::: "memory")
#define PG8_WAIT_L(n) asm volatile("s_waitcnt lgkmcnt(" #n ")" ::: "memory")
#define PG8_BAR __builtin_amdgcn_s_barrier()
#define PG8_SCHED __builtin_amdgcn_sched_barrier(0)
    Unit cur, nxt; int ui = 0;
    if (!S.next(0, cur)) return;
    f32x4 acc[2][2][4][2];
#pragma unroll
    for (int a = 0; a < 2; ++a)
#pragma unroll
        for (int b = 0; b < 2; ++b)
#pragma unroll
            for (int m = 0; m < 4; ++m)
#pragma unroll
                for (int n = 0; n < 2; ++n) acc[a][b][m][n] = (f32x4){0.f, 0.f, 0.f, 0.f};
    bf16x8 At[4][2], B0[2][2], B1[2][2];
    const char* cA = (const char*)g.A + (size_t)cur.pm * tstep; const char* cB = (const char*)g.Bt + (size_t)cur.pn * tstep;
    S.a_ready(cur);
    PG8_STAGE(PG8_SB(0, 0), cB, voffB); PG8_STAGE(PG8_SA(0, 0), cA, voffA); PG8_STAGE(PG8_SB(0, 1), cB + hstep, voffB); PG8_STAGE(PG8_SA(0, 1), cA + hstep, voffA);
    if (wr == 1) PG8_BAR;
    PG8_WAIT_V(4); PG8_BAR;
    PG8_STAGE(PG8_SB(1, 0), cB + kstep, voffB); PG8_STAGE(PG8_SA(1, 0), cA + kstep, voffA); PG8_STAGE(PG8_SB(1, 1), cB + hstep + kstep, voffB);
    PG8_WAIT_V(6); PG8_BAR;
    PG8_STAMP();
    for (;;) {
        const bool has_next = S.next(ui + 1, nxt);
        const char* nA = has_next ? (const char*)g.A + (size_t)nxt.pm * tstep : cA; const char* nB = has_next ? (const char*)g.Bt + (size_t)nxt.pn * tstep : cB;
        for (int t = 0; t < nt; t += 2) {
            const bool last = (t == nt - 2);
            const char* a1 = cA + (size_t)(t + 1) * kstep;
            const char* a2 = last ? nA : cA + (size_t)(t + 2) * kstep; const char* b2 = last ? nB : cB + (size_t)(t + 2) * kstep;
            const char* a3 = a2 + kstep; const char* b3 = b2 + kstep;
            if (last && has_next) S.a_ready(nxt);
            PG8_LDB(B0, 0, 0); PG8_SCHED; PG8_LDA(At, 0, 0); PG8_STAGE(PG8_SA(1, 1), a1 + hstep, voffA);
            PG8_WAIT_L(8); PG8_BAR; PG8_WAIT_L(0); PG8_MMA(0, 0, At, B0); PG8_BAR; PG8_SCHED;
            PG8_LDB(B1, 0, 1); PG8_STAGE(PG8_SB(0, 0), b2, voffB);
            PG8_BAR; PG8_WAIT_L(0); PG8_MMA(0, 1, At, B1); PG8_BAR;
            PG8_LDA(At, 0, 1); PG8_STAGE(PG8_SA(0, 0), a2, voffA);
            PG8_BAR; PG8_WAIT_L(0); PG8_MMA(1, 0, At, B0); PG8_BAR; PG8_SCHED;
            PG8_STAGE(PG8_SB(0, 1), b2 + hstep, voffB);
            PG8_WAIT_V(6); PG8_BAR; PG8_MMA(1, 1, At, B1); PG8_BAR;
            PG8_LDB(B0, 1, 0); PG8_SCHED; PG8_LDA(At, 1, 0); PG8_STAGE(PG8_SA(0, 1), a2 + hstep, voffA);
            PG8_WAIT_L(8); PG8_BAR; PG8_WAIT_L(0); PG8_MMA(0, 0, At, B0); PG8_BAR; PG8_SCHED;
            PG8_LDB(B1, 1, 1); PG8_STAGE(PG8_SB(1, 0), b3, voffB);
            PG8_BAR; PG8_WAIT_L(0); PG8_MMA(0, 1, At, B1); PG8_BAR;
            PG8_LDA(At, 1, 1); PG8_STAGE(PG8_SA(1, 0), a3, voffA);
            PG8_BAR; PG8_WAIT_L(0); PG8_MMA(1, 0, At, B0); PG8_BAR; PG8_SCHED;
            PG8_STAGE(PG8_SB(1, 1), b3 + hstep, voffB);
            PG8_WAIT_V(6); PG8_BAR; PG8_MMA(1, 1, At, B1); PG8_BAR;
        }
        PG8_STAMP();
        if constexpr (!Epi::AFTER_DRAIN) { E(acc, cur, wr, wc, fr, fq); S.done(cur); }
        PG8_STAMP();
        if (!has_next) break;
#pragma unroll
        for (int a = 0; a < 2; ++a)
#pragma unroll
            for (int b = 0; b < 2; ++b)
#pragma unroll
                for (int m = 0; m < 4; ++m)
#pragma unroll
                    for (int n = 0; n < 2; ++n) acc[a][b][m][n] = (f32x4){0.f, 0.f, 0.f, 0.f};
        cur = nxt; cA = nA; cB = nB; ++ui;
    }
    PG8_WAIT_V(0);
    if (wr == 0) PG8_BAR;
    PG8_BAR;
    if constexpr (Epi::AFTER_DRAIN) { E.fused(acc, cur, wr, wc, fr, fq, lds, wid, lane); S.done(cur); }
    PG8_STAMP();
    if (STAMP && wid == 0) { stamps[lane] = lane < nts ? (((unsigned long long)(unsigned)ts_hi << 32) | (unsigned)ts_lo) : 0ull;
        if (lane == 62) stamps[62] = rt_entry; if (lane == 63) stamps[63] = (unsigned long long)wall_clock64(); }
#undef PG8_STAMP
#undef PG8_SA
#undef PG8_SB
#undef PG8_STAGE
#undef PG8_LDA
#undef PG8_LDB
#undef PG8_MMA
#undef PG8_WAIT_V
#undef PG8_WAIT_L
#undef PG8_BAR
#undef PG8_SCHED
}
}
#define XB_TMO      128
#define XB_XCNT(j)  (256  + 64 * (j))
#define XB_XSUB(j)  (1280 + 64 * (j))
#define XB_XGEN(j)  (2304 + 64 * (j))
#define XB_TOP      3328
#define XB_TOPGEN   3392
#define XCD_BAR_WORDS 3456
#define XB_SPIN_CAP (1u << 22)

__device__ __forceinline__ unsigned xb_ld(unsigned* p)              { return __hip_atomic_load(p, __ATOMIC_RELAXED, __HIP_MEMORY_SCOPE_AGENT); }
__device__ __forceinline__ unsigned xb_add(unsigned* p, unsigned v) { return __hip_atomic_fetch_add(p, v, __ATOMIC_RELAXED, __HIP_MEMORY_SCOPE_AGENT); }
__device__ __forceinline__ unsigned xb_xcc_id() { return (unsigned)__builtin_amdgcn_s_getreg((3 << 11) | 20) & 0xFu; }
#define XB_SPIN(cond, bar) do { unsigned _sp = 0; while (cond) { __builtin_amdgcn_s_sleep(1); \
    if ((++_sp & 255u) == 0u) { if (xb_ld(&(bar)[XB_TMO])) break; if (_sp > XB_SPIN_CAP) { atomicAdd(&(bar)[XB_TMO], 1u); break; } } } } while (0)

struct XcdBarrier {
    unsigned* bar; unsigned x;
    volatile PG8_LAS unsigned* st;
};

__device__ __forceinline__ XcdBarrier xcd_barrier_post(unsigned* bar, volatile PG8_LAS unsigned* st) {
    XcdBarrier b; b.bar = bar; b.x = xb_xcc_id(); b.st = st;
    if (threadIdx.x == 0) (void)xb_add(&bar[XB_XCNT(b.x)], 1u);
    return b;
}
__device__ __forceinline__ void xcd_barrier_complete(unsigned* bar, unsigned x, unsigned& nloc, unsigned& nx) {
    const unsigned G = gridDim.x * gridDim.y * gridDim.z;
    unsigned sum, cnt, mine, sp = 0u;
    for (;;) {
        sum = 0u; cnt = 0u; mine = 0u;
#pragma unroll
        for (unsigned j = 0; j < 16; ++j) { const unsigned c = xb_ld(&bar[XB_XCNT(j)]); sum += c; cnt += (c > 0u) ? 1u : 0u; mine = (j == x) ? c : mine; }
        if (sum == G) break;
        __builtin_amdgcn_s_sleep(1);
        if ((++sp & 255u) == 0u) { if (xb_ld(&bar[XB_TMO])) break; if (sp > XB_SPIN_CAP) { atomicAdd(&bar[XB_TMO], 1u); break; } }
    }
    nloc = mine > 0u ? mine : 1u; nx = cnt > 0u ? cnt : 1u;
}

__device__ __forceinline__ void xcd_barrier(const XcdBarrier& b) {
    asm volatile("s_waitcnt vmcnt(0)" ::: "memory");
    __syncthreads();
    if (threadIdx.x == 0) {
        unsigned* bar = b.bar;
        __builtin_amdgcn_s_waitcnt(0);
        unsigned nloc = b.st[0], nx = b.st[1];
        if (nloc == 0u) { xcd_barrier_complete(bar, b.x, nloc, nx); b.st[0] = nloc; b.st[1] = nx; }
        const unsigned old = xb_add(&bar[XB_XSUB(b.x)], 1u);
        const unsigned gen = old / nloc;
        if (old + 1u == (gen + 1u) * nloc) {
            __builtin_amdgcn_fence(__ATOMIC_RELEASE, "agent");
            asm volatile("s_waitcnt vmcnt(0)" ::: "memory");
            const unsigned og = xb_add(&bar[XB_TOP], 1u);
            const unsigned tg = og / nx;
            if (og + 1u == (tg + 1u) * nx) xb_add(&bar[XB_TOPGEN], 1u);
            else XB_SPIN(xb_ld(&bar[XB_TOPGEN]) == tg, bar);
            __builtin_amdgcn_fence(__ATOMIC_ACQUIRE, "agent");
            xb_add(&bar[XB_XGEN(b.x)], 1u);
            asm volatile("s_waitcnt vmcnt(0)" ::: "memory");
        } else {
            XB_SPIN(xb_ld(&bar[XB_XGEN(b.x)]) == gen, bar);
            __builtin_amdgcn_fence(__ATOMIC_ACQUIRE, "agent");
            asm volatile("s_waitcnt vmcnt(0)" ::: "memory");
        }
    }
    __syncthreads();
}

using namespace pg8;
typedef float f32x16 __attribute__((ext_vector_type(16)));
typedef unsigned u32x2 __attribute__((ext_vector_type(2)));
#define LAS PG8_LAS
#define DI __device__ __forceinline__

constexpr int NT = 512;
constexpr int MP = 32768, MS = 2048, MT = MP + MS;
constexpr int KEYS_S = 4352;
constexpr int KR_ROWS = MP + 32 * KEYS_S;
constexpr int ZLD = 2560;
constexpr float EPS = 1e-6f;
constexpr float QSCALE = 0.10206207261596577f * 1.4426950408889634f;
constexpr int LDS_BYTES = 160 * 1024;

constexpr size_t SZ_WIN = 2560ull * 1024 * 2, SZ_WUQ = 768ull * 256 * 2, SZ_WUK = 512ull * 256 * 2, SZ_WUV = 512ull * 256 * 2,
                 SZ_WO = 1024ull * 1024 * 2, SZ_WFI = 5632ull * 1024 * 2, SZ_WFO = 1024ull * 2816 * 2;
constexpr size_t WOFF_IN = 0, WOFF_UQ = WOFF_IN + SZ_WIN, WOFF_UK = WOFF_UQ + SZ_WUQ, WOFF_UV = WOFF_UK + SZ_WUK, WOFF_O = WOFF_UV + SZ_WUV,
                 WOFF_FI = WOFF_O + SZ_WO, WOFF_FO = WOFF_FI + SZ_WFI, WL = WOFF_FO + SZ_WFO;
constexpr size_t OFF_W = 0;
constexpr size_t OFF_MOD = OFF_W + 2 * WL;
constexpr size_t OFF_ROPE = OFF_MOD + 2ull * 36 * 6144 * 4;
constexpr size_t OFF_H = OFF_ROPE + 8192ull * 16 * 2 * 4;
constexpr size_t OFF_Z = OFF_H + (size_t)MT * 1024 * 2;
constexpr size_t OFF_CQN = OFF_Z + (size_t)MT * ZLD * 2;
constexpr size_t OFF_CKV = OFF_CQN + (size_t)MT * 256 * 2;
constexpr size_t OFF_KROPE = OFF_CKV + (size_t)KR_ROWS * 256 * 2;
constexpr size_t OFF_Q = OFF_KROPE + (size_t)KR_ROWS * 32 * 2;
constexpr size_t OFF_KN = OFF_Q + (size_t)MT * 768 * 2;
constexpr size_t OFF_VT = OFF_KN + (size_t)KR_ROWS * 512 * 2;
constexpr size_t OFF_O = OFF_VT + (size_t)KR_ROWS * 512 * 2;
constexpr size_t OFF_PART = OFF_O + (size_t)MP * 512 * 2;
constexpr size_t OFF_UHG = OFF_PART + 32ull * 8 * 4 * 64 * 66 * 4;
constexpr size_t OFF_DHG = OFF_UHG + 544ull * 4 * 64 * 64 * 4;
constexpr size_t OFF_UGL = OFF_DHG + 544ull * 4 * 64 * 4;
constexpr size_t OFF_DGL = OFF_UGL + 544ull * 4 * 32 * 64 * 4;
constexpr size_t OFF_BAR = OFF_DGL + 544ull * 4 * 32 * 4;
constexpr size_t OFF_XB = OFF_BAR + 16384;
constexpr size_t WS_END = OFF_XB + (size_t)MT * 1024 * 2;
constexpr size_t OFF_ACT = OFF_KN;
static_assert((size_t)MT * 2816 * 2 <= 2 * (size_t)KR_ROWS * 512 * 2, "act alias");

constexpr size_t OUT_Y = 0, OUT_CKVP = 35651584, OUT_KRP = 52428800, OUT_HGP = 54525952, OUT_GLP = 54657024,
                 OUT_CKVS = 54722560, OUT_KRS = 55771136, OUT_HGS = 55902208, OUT_GLS = 56950784;

DI int tid_() { int t = threadIdx.x; asm volatile("" : "+v"(t)); return t; }
DI int bid_() { int b = blockIdx.x; asm volatile("" : "+s"(b)); return b; }
DI float neg_big() { float v = -1e30f; asm volatile("" : "+v"(v)); return v; }
struct Params { const float* in[29]; float* out; unsigned char* ws; };

typedef __bf16 hbf2 __attribute__((ext_vector_type(2)));
typedef float f32x2_ __attribute__((ext_vector_type(2)));
DI unsigned pack2(float a, float b) { f32x2_ v = {a, b}; return __builtin_bit_cast(unsigned, __builtin_convertvector(v, hbf2)); }
DI bf16_t f2bf(float f) { return (bf16_t)(pack2(f, f) & 0xFFFFu); }
DI float bf2f(bf16_t b) { return __uint_as_float(((unsigned)b) << 16); }
DI float bflo(unsigned u) { return __uint_as_float(u << 16); }
DI float bfhi(unsigned u) { return __uint_as_float(u & 0xFFFF0000u); }
DI float wave_sum(float v) { v += __shfl_xor(v, 32); v += __shfl_xor(v, 16); v += __shfl_xor(v, 8); v += __shfl_xor(v, 4); v += __shfl_xor(v, 2); v += __shfl_xor(v, 1); return v; }
DI float sigmoidf_(float x) { return 1.f / (1.f + expf(-x)); }
DI int row_bi(int row) { return row < MP ? (row >> 13) : 4 + ((row - MP) >> 6); }

struct EpiZ {
    static constexpr bool PERM = true, AFTER_DRAIN = false;
    bf16_t* O; int ldc;
    DI void operator()(const f32x4 (&acc)[2][2][4][2], const Unit& u, int wr, int wc, int fr, int fq) const {
        const int row0 = u.pm * 256 + wr * 64 + fr, col0 = u.pn * 256 + wc * 32 + 8 * fq;
#pragma unroll
        for (int ai = 0; ai < 2; ++ai)
#pragma unroll
            for (int m = 0; m < 4; ++m) { bf16_t* rowp = O + (size_t)(row0 + ai * 128 + m * 16) * ldc + col0;
#pragma unroll
                for (int bj = 0; bj < 2; ++bj) { const f32x4 v0 = acc[ai][bj][m][0], v1 = acc[ai][bj][m][1]; uint4 w; w.x = pack2(v0[0], v0[1]); w.y = pack2(v0[2], v0[3]); w.z = pack2(v1[0], v1[1]); w.w = pack2(v1[2], v1[3]); *(uint4*)(rowp + bj * 128) = w; } }
    }
};
struct EpiQ {
    static constexpr bool PERM = false, AFTER_DRAIN = false;
    bf16_t* Q; const float* qn_; const float* rope_;
    DI void operator()(const f32x4 (&acc)[2][2][4][2], const Unit& u, int wr, int wc, int fr, int fq) const {
        const float* qn = qn_; const float* rope = rope_; asm volatile("" : "+s"(qn), "+s"(rope));
        float eps_ = EPS; asm volatile("" : "+v"(eps_));
        const int row0 = u.pm * 256 + wr * 64 + fr;
#pragma unroll
        for (int ai = 0; ai < 2; ++ai)
#pragma unroll
            for (int m = 0; m < 4; ++m) {
                const int row = row0 + ai * 128 + m * 16;
                int pos; size_t base, hs;
                if (row < MP) { const int b = row >> 13, t = row & 8191; pos = t; base = ((size_t)(b * 8) * 8192 + t) * 96; hs = 8192 * 96; }
                else { const int r = row - MP, b = r >> 6, t = r & 63; pos = 4096 + t; base = (size_t)MP * 768 + ((size_t)(b * 8) * 64 + t) * 96; hs = 64 * 96; }
                if (u.pn < 2) {
                    const int head = 4 * u.pn + wc;
                    float ss = 0.f;
#pragma unroll
                    for (int bj = 0; bj < 2; ++bj)
#pragma unroll
                        for (int n = 0; n < 2; ++n) { const f32x4 v = acc[ai][bj][m][n]; ss += v[0] * v[0] + v[1] * v[1] + v[2] * v[2] + v[3] * v[3]; }
                    ss += __shfl_xor(ss, 16); ss += __shfl_xor(ss, 32);
                    const float rs = rsqrtf(ss * (1.f / 64.f) + eps_) * QSCALE;
#pragma unroll
                    for (int bj = 0; bj < 2; ++bj)
#pragma unroll
                        for (int n = 0; n < 2; ++n) { const int d = 32 * bj + 16 * n + 4 * fq; const f32x4 v = acc[ai][bj][m][n]; const float4 g = *(const float4*)(qn + d);
                            uint2 w; w.x = pack2(v[0] * rs * g.x, v[1] * rs * g.y); w.y = pack2(v[2] * rs * g.z, v[3] * rs * g.w); *(uint2*)(Q + base + head * hs + d) = w; }
                } else {
#pragma unroll
                    for (int bj = 0; bj < 2; ++bj) {
                        const int head = 2 * wc + bj;
                        const f32x4 v1 = acc[ai][bj][m][0], v2 = acc[ai][bj][m][1];
                        float ss = v1[0] * v1[0] + v1[1] * v1[1] + v1[2] * v1[2] + v1[3] * v1[3] + v2[0] * v2[0] + v2[1] * v2[1] + v2[2] * v2[2] + v2[3] * v2[3];
                        ss += __shfl_xor(ss, 16); ss += __shfl_xor(ss, 32);
                        const float rs = rsqrtf(ss * (1.f / 32.f) + eps_);
                        const float4 g1 = *(const float4*)(qn + 64 + 4 * fq), g2 = *(const float4*)(qn + 80 + 4 * fq);
                        const float4 cs0 = *(const float4*)(rope + ((size_t)pos * 16 + 4 * fq) * 2), cs1 = *(const float4*)(rope + ((size_t)pos * 16 + 4 * fq) * 2 + 4);
                        const float x10 = v1[0] * rs * g1.x, x11 = v1[1] * rs * g1.y, x12 = v1[2] * rs * g1.z, x13 = v1[3] * rs * g1.w;
                        const float x20 = v2[0] * rs * g2.x, x21 = v2[1] * rs * g2.y, x22 = v2[2] * rs * g2.z, x23 = v2[3] * rs * g2.w;
                        uint2 w1, w2;
                        w1.x = pack2((x10 * cs0.x - x20 * cs0.y) * QSCALE, (x11 * cs0.z - x21 * cs0.w) * QSCALE);
                        w1.y = pack2((x12 * cs1.x - x22 * cs1.y) * QSCALE, (x13 * cs1.z - x23 * cs1.w) * QSCALE);
                        w2.x = pack2((x20 * cs0.x + x10 * cs0.y) * QSCALE, (x21 * cs0.z + x11 * cs0.w) * QSCALE);
                        w2.y = pack2((x22 * cs1.x + x12 * cs1.y) * QSCALE, (x23 * cs1.z + x13 * cs1.w) * QSCALE);
                        *(uint2*)(Q + base + head * hs + 64 + 4 * fq) = w1; *(uint2*)(Q + base + head * hs + 80 + 4 * fq) = w2;
                    }
                }
            }
    }
};
struct EpiKN {
    static constexpr bool PERM = true, AFTER_DRAIN = false;
    bf16_t* KN; const float* kn_;
    DI void operator()(const f32x4 (&acc)[2][2][4][2], const Unit& u, int wr, int wc, int fr, int fq) const {
        const float* kn = kn_; asm volatile("" : "+s"(kn));
        float eps_ = EPS; asm volatile("" : "+v"(eps_));
        float4 gk[2][2];
#pragma unroll
        for (int bj = 0; bj < 2; ++bj)
#pragma unroll
            for (int n = 0; n < 2; ++n) gk[bj][n] = *(const float4*)(kn + 32 * bj + 8 * fq + 4 * n);
        size_t base, hs;
        if (u.pm < 128) { const int b = u.pm >> 5, key0 = (u.pm & 31) * 256; base = ((size_t)(b * 8) * 8192 + key0) * 64; hs = (size_t)8192 * 64; }
        else { const int q = u.pm - 128, b = q / 17, key0 = (q % 17) * 256; base = (size_t)MP * 512 + ((size_t)(b * 8) * KEYS_S + key0) * 64; hs = (size_t)KEYS_S * 64; }
        const int head = 4 * u.pn + wc;
#pragma unroll
        for (int ai = 0; ai < 2; ++ai)
#pragma unroll
            for (int m = 0; m < 4; ++m) {
                const int key = 128 * ai + 64 * wr + 16 * m + fr;
                float ss = 0.f;
#pragma unroll
                for (int bj = 0; bj < 2; ++bj)
#pragma unroll
                    for (int n = 0; n < 2; ++n) { const f32x4 v = acc[ai][bj][m][n]; ss += v[0] * v[0] + v[1] * v[1] + v[2] * v[2] + v[3] * v[3]; }
                ss += __shfl_xor(ss, 16); ss += __shfl_xor(ss, 32);
                const float rs = rsqrtf(ss * (1.f / 64.f) + eps_);
#pragma unroll
                for (int bj = 0; bj < 2; ++bj) { const f32x4 v0 = acc[ai][bj][m][0], v1 = acc[ai][bj][m][1]; const float4 g0 = gk[bj][0], g1 = gk[bj][1];
                    uint4 w; w.x = pack2(v0[0] * rs * g0.x, v0[1] * rs * g0.y); w.y = pack2(v0[2] * rs * g0.z, v0[3] * rs * g0.w); w.z = pack2(v1[0] * rs * g1.x, v1[1] * rs * g1.y); w.w = pack2(v1[2] * rs * g1.z, v1[3] * rs * g1.w);
                    *(uint4*)(KN + base + head * hs + (size_t)key * 64 + 32 * bj + 8 * fq) = w; }
            }
    }
};
struct EpiVT {
    static constexpr bool PERM = true, AFTER_DRAIN = false;
    bf16_t* VT;
    DI void operator()(const f32x4 (&acc)[2][2][4][2], const Unit& u, int wr, int wc, int fr, int fq) const {
        size_t base; int KL;
        if (u.pn < 128) { const int b = u.pn >> 5, key0 = (u.pn & 31) * 256; base = (size_t)(b * 8) * 64 * 8192 + key0; KL = 8192; }
        else { const int q = u.pn - 128, b = q / 17, key0 = (q % 17) * 256; base = (size_t)MP * 512 + (size_t)(b * 8) * 64 * KEYS_S + key0; KL = KEYS_S; }
#pragma unroll
        for (int ai = 0; ai < 2; ++ai)
#pragma unroll
            for (int m = 0; m < 4; ++m) {
                const int r = 256 * u.pm + 128 * ai + 64 * wr + 16 * m + fr;
                bf16_t* rowp = VT + base + (size_t)r * KL + 32 * wc + 8 * fq;
#pragma unroll
                for (int bj = 0; bj < 2; ++bj) { const f32x4 v0 = acc[ai][bj][m][0], v1 = acc[ai][bj][m][1]; uint4 w; w.x = pack2(v0[0], v0[1]); w.y = pack2(v0[2], v0[3]); w.z = pack2(v1[0], v1[1]); w.w = pack2(v1[2], v1[3]); *(uint4*)(rowp + 128 * bj) = w; }
            }
    }
};
struct EpiRes {
    static constexpr bool PERM = false, AFTER_DRAIN = false;
    bf16_t* XB; float* out; const float* gate; int final;
    DI void operator()(const f32x4 (&acc)[2][2][4][2], const Unit& u, int wr, int wc, int fr, int fq) const {
        const int row0 = u.pm * 256 + wr * 64 + fr, col0 = u.pn * 256 + wc * 32 + 4 * fq;
#pragma unroll
        for (int ai = 0; ai < 2; ++ai) {
            const float* gr = gate + (size_t)row_bi(row0 + ai * 128) * 6144 + col0;
            f32x4 g[2][2]; uint2 x[4][2][2];
#pragma unroll
            for (int bj = 0; bj < 2; ++bj)
#pragma unroll
                for (int n = 0; n < 2; ++n) g[bj][n] = *(const f32x4*)(gr + bj * 128 + n * 16);
#pragma unroll
            for (int m = 0; m < 4; ++m) { const bf16_t* xr = XB + (size_t)(row0 + ai * 128 + m * 16) * 1024 + col0;
#pragma unroll
                for (int bj = 0; bj < 2; ++bj)
#pragma unroll
                    for (int n = 0; n < 2; ++n) x[m][bj][n] = *(const uint2*)(xr + bj * 128 + n * 16); }
#pragma unroll
            for (int m = 0; m < 4; ++m) { const size_t ro = (size_t)(row0 + ai * 128 + m * 16) * 1024 + col0;
#pragma unroll
                for (int bj = 0; bj < 2; ++bj)
#pragma unroll
                    for (int n = 0; n < 2; ++n) { const uint2 xv = x[m][bj][n]; const f32x4 xf = {bflo(xv.x), bfhi(xv.x), bflo(xv.y), bfhi(xv.y)}; const f32x4 r = xf + g[bj][n] * acc[ai][bj][m][n];
                        if (final) *(f32x4*)(out + ro + bj * 128 + n * 16) = r;
                        else { uint2 w; w.x = pack2(r[0], r[1]); w.y = pack2(r[2], r[3]); *(uint2*)(XB + ro + bj * 128 + n * 16) = w; } } }
        }
    }
};
struct EpiSwi {
    static constexpr bool PERM = true, AFTER_DRAIN = false;
    bf16_t* ACT;
    DI void operator()(const f32x4 (&acc)[2][2][4][2], const Unit& u, int wr, int wc, int fr, int fq) const {
        const int row0 = u.pm * 256 + wr * 64 + fr, col0 = u.pn * 128 + wc * 32 + 8 * fq;
#pragma unroll
        for (int ai = 0; ai < 2; ++ai)
#pragma unroll
            for (int m = 0; m < 4; ++m) { bf16_t* rowp = ACT + (size_t)(row0 + ai * 128 + m * 16) * 2816 + col0; float r[8];
#pragma unroll
                for (int n = 0; n < 2; ++n) { const f32x4 a = acc[ai][0][m][n], g = acc[ai][1][m][n];
#pragma unroll
                    for (int j = 0; j < 4; ++j) r[4 * n + j] = a[j] / (1.f + __expf(-a[j])) * g[j]; }
                uint4 w; w.x = pack2(r[0], r[1]); w.y = pack2(r[2], r[3]); w.z = pack2(r[4], r[5]); w.w = pack2(r[6], r[7]); *(uint4*)rowp = w; }
    }
};
template <class Epi> DI void run_gemm(LAS unsigned char* lds, const bf16_t* A, const bf16_t* Bt, int M, int N, int K, const Epi& E) {
    asm volatile("" : "+s"(M), "+s"(N), "+s"(K));
    Gemm g{A, Bt, M, N, K}; StaticOrder S; S.init(M, N, (int)gridDim.x, (int)bid_());
    gemm_phase<Epi, StaticOrder, false>(lds, g, S, E, nullptr);
}

DI int colmap(int w, int n) {
    if (w == 0) return n < 2352 ? n : -1;
    if (w == 1) { const int pn = n >> 8, c = n & 255, bj = c >> 7, wc = (c >> 5) & 3, cc = c & 31; return pn < 2 ? (4 * pn + wc) * 96 + 32 * bj + cc : (2 * wc + bj) * 96 + 64 + cc; }
    if (w == 2) { const int pn = n >> 8, c = n & 255, bj = c >> 7, wc = (c >> 5) & 3, cc = c & 31; return (4 * pn + wc) * 64 + 32 * bj + cc; }
    if (w == 5) { const int pn = n >> 8, c = n & 255; return c < 128 ? 128 * pn + c : 2816 + 128 * pn + (c - 128); }
    return n;
}
DI void phase_prep(const Params& p, LAS unsigned char* lds) {
    const int tid = tid_();
    LAS bf16_t* T = (LAS bf16_t*)lds;
    for (int ti = bid_(); ti < 2 * 1560; ti += gridDim.x) {
        const int l = ti / 1560, r = ti % 1560;
        int w, t0, K, ld; size_t doff; const float* src;
        if (r < 320) { w = 0; t0 = 0; K = 1024; ld = 2352; doff = WOFF_IN; src = p.in[12]; }
        else if (r < 344) { w = 1; t0 = 320; K = 256; ld = 768; doff = WOFF_UQ; src = p.in[15]; }
        else if (r < 360) { w = 2; t0 = 344; K = 256; ld = 512; doff = WOFF_UK; src = p.in[16]; }
        else if (r < 376) { w = 3; t0 = 360; K = 256; ld = 512; doff = WOFF_UV; src = p.in[17]; }
        else if (r < 504) { w = 4; t0 = 376; K = 1024; ld = 1024; doff = WOFF_O; src = p.in[26]; }
        else if (r < 1208) { w = 5; t0 = 504; K = 1024; ld = 5632; doff = WOFF_FI; src = p.in[27]; }
        else { w = 6; t0 = 1208; K = 2816; ld = 1024; doff = WOFF_FO; src = p.in[28]; }
        src += (size_t)l * K * ld;
        const int kt = K >> 7, tr = r - t0, n0 = (tr / kt) * 64, k0 = (tr % kt) * 128;
        bf16_t* dst = (bf16_t*)(p.ws + OFF_W + (size_t)l * WL + doff);
        const int nn = tid & 63, col = colmap(w, n0 + nn);
        float tv[16];
#pragma unroll
        for (int i = 0; i < 16; ++i) { const int kk = (tid >> 6) + 8 * i; tv[i] = col >= 0 ? src[(size_t)(k0 + kk) * ld + col] : 0.f; }
#pragma unroll
        for (int i = 0; i < 16; ++i) { const int kk = (tid >> 6) + 8 * i; T[nn * 130 + kk] = f2bf(tv[i]); }
        __syncthreads();
#pragma unroll
        for (int j = 0; j < 2; ++j) { const int q = tid + 512 * j, row = q >> 4, seg = q & 15; const LAS unsigned* tp = (const LAS unsigned*)(T + row * 130 + seg * 8);
          uint4 o; o.x = tp[0]; o.y = tp[1]; o.z = tp[2]; o.w = tp[3]; *(uint4*)(dst + (size_t)(n0 + row) * K + k0 + seg * 8) = o; }
        __syncthreads();
    }
    float* mod = (float*)(p.ws + OFF_MOD);
    for (int it = bid_(); it < 192; it += gridDim.x) {
        const int l = it / 96, cgp = it % 96;
        LAS float* sl = (LAS float*)lds;
        for (int i = tid; i < 36 * 1024; i += NT) { const int bi = i >> 10, k = i & 1023; const float c = bi < 4 ? p.in[2][bi * 1024 + k] : p.in[3][(bi - 4) * 1024 + k]; sl[i] = c / (1.f + expf(-c)); }
        __syncthreads();
        const int cl = tid & 63, kq = tid >> 6;
        float acc[36];
#pragma unroll
        for (int bi = 0; bi < 36; ++bi) acc[bi] = 0.f;
        const float* wm = p.in[8] + (size_t)l * 1024 * 6144 + cgp * 64 + cl;
#pragma unroll 4
        for (int k = kq * 128; k < kq * 128 + 128; k += 4) {
            const float w0 = wm[(size_t)k * 6144], w1 = wm[(size_t)(k + 1) * 6144], w2 = wm[(size_t)(k + 2) * 6144], w3 = wm[(size_t)(k + 3) * 6144];
#pragma unroll
            for (int bi = 0; bi < 36; ++bi) { const f32x4 s = *(const LAS f32x4*)(sl + bi * 1024 + k); acc[bi] += s[0] * w0 + s[1] * w1 + s[2] * w2 + s[3] * w3; }
        }
        __syncthreads();
        LAS float* red = (LAS float*)lds;
#pragma unroll
        for (int bi = 0; bi < 36; ++bi) red[(kq * 36 + bi) * 64 + cl] = acc[bi];
        __syncthreads();
        for (int o = tid; o < 36 * 64; o += NT) { const int bi = o >> 6, c = o & 63; float s = 0.f;
#pragma unroll
            for (int q = 0; q < 8; ++q) s += red[(q * 36 + bi) * 64 + c];
            const int colg = cgp * 64 + c; mod[((size_t)l * 36 + bi) * 6144 + colg] = s + p.in[9][l * 6144 + colg]; }
        __syncthreads();
    }
    float* rope = (float*)(p.ws + OFF_ROPE);
    for (int i = bid_() * NT + tid; i < 8192 * 16; i += gridDim.x * NT) { const int pos = i >> 4, j = i & 15;
        const float inv = exp2f(-(float)j * (13.287712379549449f / 16.f)); const float ang = (float)pos * inv; rope[2 * i] = cosf(ang); rope[2 * i + 1] = sinf(ang); }
}

template <bool FROM_INPUT>
DI void phase_hrows(const Params& p, int l, const float* xa, const float* xb, const float* g, int shoff, int scoff) {
    const int tid = tid_(), lane = tid & 63, wid = __builtin_amdgcn_readfirstlane(tid >> 6);
    const float* mod = (const float*)(p.ws + OFF_MOD) + (size_t)l * 36 * 6144;
    bf16_t* H = (bf16_t*)(p.ws + OFF_H); bf16_t* XB = (bf16_t*)(p.ws + OFF_XB);
    const int stride = gridDim.x * 8;
    int row = bid_() * 8 + wid;
    float4 v[4];
#define HR_LOAD(dst, rr) do { if (FROM_INPUT) { const float* xr_ = (rr) < MP ? xa + (size_t)(rr) * 1024 : xb + (size_t)((rr) - MP) * 1024; \
            _Pragma("unroll") for (int i = 0; i < 4; ++i) dst[i] = *(const float4*)(xr_ + i * 256 + lane * 4); } \
        else { const bf16_t* xr_ = XB + (size_t)(rr) * 1024; \
            _Pragma("unroll") for (int i = 0; i < 4; ++i) { const uint2 u_ = *(const uint2*)(xr_ + i * 256 + lane * 4); dst[i].x = bflo(u_.x); dst[i].y = bfhi(u_.x); dst[i].z = bflo(u_.y); dst[i].w = bfhi(u_.y); } } } while (0)
    if (row < MT) HR_LOAD(v, row);
    while (row < MT) {
        const int nrow = row + stride; float4 nv[4];
        if (nrow < MT) HR_LOAD(nv, nrow);
        float ss = 0.f;
#pragma unroll
        for (int i = 0; i < 4; ++i) ss += v[i].x * v[i].x + v[i].y * v[i].y + v[i].z * v[i].z + v[i].w * v[i].w;
        ss = wave_sum(ss);
        const float rs = rsqrtf(ss * (1.f / 1024.f) + EPS);
        const float* mp = mod + (size_t)row_bi(row) * 6144;
#pragma unroll
        for (int i = 0; i < 4; ++i) { const int col = i * 256 + lane * 4;
            const float4 gg = *(const float4*)(g + col), sc = *(const float4*)(mp + scoff + col), sh = *(const float4*)(mp + shoff + col);
            uint2 w; w.x = pack2(v[i].x * rs * gg.x * (1.f + sc.x) + sh.x, v[i].y * rs * gg.y * (1.f + sc.y) + sh.y);
            w.y = pack2(v[i].z * rs * gg.z * (1.f + sc.z) + sh.z, v[i].w * rs * gg.w * (1.f + sc.w) + sh.w);
            *(uint2*)(H + (size_t)row * 1024 + col) = w;
            if (FROM_INPUT) { uint2 xw; xw.x = pack2(v[i].x, v[i].y); xw.y = pack2(v[i].z, v[i].w); *(uint2*)(XB + (size_t)row * 1024 + col) = xw; } }
#pragma unroll
        for (int i = 0; i < 4; ++i) v[i] = nv[i];
        row = nrow;
    }
#undef HR_LOAD
}
DI void phase_cache(const Params& p, int l) {
    const size_t gt = (size_t)bid_() * NT + tid_(), gs = (size_t)gridDim.x * NT;
    bf16_t* ckv_s = (bf16_t*)(p.ws + OFF_CKV) + (size_t)MP * 256;
    bf16_t* kr_s = (bf16_t*)(p.ws + OFF_KROPE) + (size_t)MP * 32;
    const float4* s1 = (const float4*)(p.in[4] + (size_t)l * 32 * 4096 * 256);
    for (size_t i0 = gt; i0 < 8388608; i0 += gs * 8) { float4 v[8];
#pragma unroll
        for (int u = 0; u < 8; ++u) { const size_t i = i0 + u * gs; if (i < 8388608) v[u] = s1[i]; }
#pragma unroll
        for (int u = 0; u < 8; ++u) { const size_t i = i0 + u * gs; if (i < 8388608) { const size_t e = i * 4, b = e >> 20, rem = e & 1048575;
            uint2 w; w.x = pack2(v[u].x, v[u].y); w.y = pack2(v[u].z, v[u].w); *(uint2*)(ckv_s + b * KEYS_S * 256 + rem) = w; } } }
    unsigned zz = 0u; asm volatile("" : "+v"(zz));
    for (size_t i = gt; i < 393216; i += gs) { const size_t e = i * 4, b = e / 49152, rem = e % 49152; uint2 w; w.x = zz; w.y = zz; *(uint2*)(ckv_s + b * KEYS_S * 256 + 4160 * 256 + rem) = w; }
    const float4* s2 = (const float4*)(p.in[5] + (size_t)l * 32 * 4096 * 32);
    for (size_t i0 = gt; i0 < 1048576; i0 += gs * 8) { float4 v[8];
#pragma unroll
        for (int u = 0; u < 8; ++u) { const size_t i = i0 + u * gs; if (i < 1048576) v[u] = s2[i]; }
#pragma unroll
        for (int u = 0; u < 8; ++u) { const size_t i = i0 + u * gs; if (i < 1048576) { const size_t e = i * 4, b = e >> 17, rem = e & 131071;
            uint2 w; w.x = pack2(v[u].x, v[u].y); w.y = pack2(v[u].z, v[u].w); *(uint2*)(kr_s + b * KEYS_S * 32 + rem) = w; } } }
}
DI void phase_post(const Params& p, int l) {
    const int tid = tid_(), lane = tid & 63, wid = __builtin_amdgcn_readfirstlane(tid >> 6);
    const bf16_t* Z = (const bf16_t*)(p.ws + OFF_Z);
    bf16_t* CQN = (bf16_t*)(p.ws + OFF_CQN); bf16_t* CKV = (bf16_t*)(p.ws + OFF_CKV); bf16_t* KRO = (bf16_t*)(p.ws + OFF_KROPE);
    const float* rope = (const float*)(p.ws + OFF_ROPE);
    const float* gcq = p.in[13] + l * 256; const float* gckv = p.in[14] + l * 256; const float* gk = p.in[19] + l * 96 + 64;
    const int stride = gridDim.x * 8;
    int row = bid_() * 8 + wid;
    uint2 u1, u2; bf16_t u3;
    if (row < MT) { const bf16_t* zr = Z + (size_t)row * ZLD; u1 = *(const uint2*)(zr + 4 * lane); u2 = *(const uint2*)(zr + 256 + 4 * lane); u3 = zr[512 + (lane & 31)]; }
    while (row < MT) {
        const int nrow = row + stride; uint2 n1, n2; bf16_t n3;
        if (nrow < MT) { const bf16_t* zr = Z + (size_t)nrow * ZLD; n1 = *(const uint2*)(zr + 4 * lane); n2 = *(const uint2*)(zr + 256 + 4 * lane); n3 = zr[512 + (lane & 31)]; }
        int pos; size_t grow; float* o_ckv; float* o_kr;
        if (row < MP) { const int b = row >> 13, t = row & 8191; pos = t; grow = row; o_ckv = p.out + OUT_CKVP + ((size_t)(l * 4 + b) * 8192 + t) * 256; o_kr = p.out + OUT_KRP + ((size_t)(l * 4 + b) * 8192 + t) * 32; }
        else { const int r = row - MP, b = r >> 6, t = r & 63; pos = 4096 + t; grow = (size_t)MP + (size_t)b * KEYS_S + 4096 + t; o_ckv = p.out + OUT_CKVS + ((size_t)(l * 32 + b) * 64 + t) * 256; o_kr = p.out + OUT_KRS + ((size_t)(l * 32 + b) * 64 + t) * 32; }
        { const uint2 u = u1; const float a0 = bflo(u.x), a1 = bfhi(u.x), a2 = bflo(u.y), a3 = bfhi(u.y);
          const float ss = wave_sum(a0 * a0 + a1 * a1 + a2 * a2 + a3 * a3); const float rs = rsqrtf(ss * (1.f / 256.f) + EPS); const float4 g = *(const float4*)(gcq + 4 * lane);
          uint2 w; w.x = pack2(a0 * rs * g.x, a1 * rs * g.y); w.y = pack2(a2 * rs * g.z, a3 * rs * g.w); *(uint2*)(CQN + (size_t)row * 256 + 4 * lane) = w; }
        { const uint2 u = u2; const float a0 = bflo(u.x), a1 = bfhi(u.x), a2 = bflo(u.y), a3 = bfhi(u.y);
          const float ss = wave_sum(a0 * a0 + a1 * a1 + a2 * a2 + a3 * a3); const float rs = rsqrtf(ss * (1.f / 256.f) + EPS); const float4 g = *(const float4*)(gckv + 4 * lane);
          float4 o; o.x = a0 * rs * g.x; o.y = a1 * rs * g.y; o.z = a2 * rs * g.z; o.w = a3 * rs * g.w; *(float4*)(o_ckv + 4 * lane) = o;
          uint2 w; w.x = pack2(o.x, o.y); w.y = pack2(o.z, o.w); *(uint2*)(CKV + grow * 256 + 4 * lane) = w; }
        { const int i = lane & 31; const float a = bf2f(u3); float ss = a * a; ss += __shfl_xor(ss, 16); ss += __shfl_xor(ss, 8); ss += __shfl_xor(ss, 4); ss += __shfl_xor(ss, 2); ss += __shfl_xor(ss, 1);
          const float xn = a * rsqrtf(ss * (1.f / 32.f) + EPS) * gk[i]; const float other = __shfl_xor(xn, 16);
          const float2 cs = *(const float2*)(rope + ((size_t)pos * 16 + (i & 15)) * 2);
          const float o = i < 16 ? xn * cs.x - other * cs.y : xn * cs.x + other * cs.y;
          if (lane < 32) { o_kr[i] = o; KRO[grow * 32 + i] = f2bf(o); } }
        u1 = n1; u2 = n2; u3 = n3; row = nrow;
    }
}

DI f32x16 mfma32(bf16x8 a, bf16x8 b, f32x16 c) { return __builtin_amdgcn_mfma_f32_32x32x16_bf16(a, b, c, 0, 0, 0); }
DI f32x4 mfma16(bf16x8 a, bf16x8 b, f32x4 c) { return __builtin_amdgcn_mfma_f32_16x16x32_bf16(a, b, c, 0, 0, 0); }
DI bf16x8 pack8(const f32x16& s, int b) { u32x4 r; r[0] = pack2(s[b], s[b + 1]); r[1] = pack2(s[b + 2], s[b + 3]); r[2] = pack2(s[b + 4], s[b + 5]); r[3] = pack2(s[b + 6], s[b + 7]); return __builtin_bit_cast(bf16x8, r); }

template <int NH>
DI void attn_core(LAS unsigned char* lds, const bf16_t* qptr, const bf16_t* kn, size_t kn_hs, const bf16_t* kr, const bf16_t* vt, size_t vt_hs, int KL,
                  int kt0, int kstep, int nit, int nvalid, int tile_lim, int hh, f32x16 (&o)[2], float& m_run, float& l_run) {
    constexpr int BUFSZ = NH * 17920 + 5120;
    const int tid = tid_(), lane = tid & 63, r = lane & 31, h = lane >> 5;
    bf16x8 qf[6];
#pragma unroll
    for (int ks = 0; ks < 6; ++ks) qf[ks] = *(const bf16x8*)(qptr + ks * 16 + h * 8);
#pragma unroll
    for (int i = 0; i < 16; ++i) { o[0][i] = 0.f; o[1][i] = 0.f; }
    m_run = neg_big(); l_run = 0.f;
    u32x4 rkn[NH], rvt[NH], rkr = {0u, 0u, 0u, 0u};
    const int lrow = tid >> 3, lseg = tid & 7;
#define ATT_GLOAD(kt) do { const size_t key0_ = (size_t)(kt) * 64; \
        _Pragma("unroll") for (int hx = 0; hx < NH; ++hx) { rkn[hx] = *(const u32x4*)(kn + hx * kn_hs + (key0_ + lrow) * 64 + lseg * 8); rvt[hx] = *(const u32x4*)(vt + hx * vt_hs + (size_t)lrow * KL + key0_ + lseg * 8); } \
        if (tid < 256) rkr = *(const u32x4*)(kr + (key0_ + (tid >> 2)) * 32 + (tid & 3) * 8); } while (0)
#define ATT_LSTORE(buf) do { LAS unsigned char* B_ = lds + (buf) * BUFSZ; \
        _Pragma("unroll") for (int hx = 0; hx < NH; ++hx) { *(LAS u32x4*)(B_ + hx * 9216 + lrow * 144 + lseg * 16) = rkn[hx]; \
            LAS u32x2* pv_ = (LAS u32x2*)(B_ + NH * 9216 + 5120 + hx * 8704 + lrow * 136 + lseg * 16); u32x2 a_, b_; a_[0] = rvt[hx][0]; a_[1] = rvt[hx][1]; b_[0] = rvt[hx][2]; b_[1] = rvt[hx][3]; pv_[0] = a_; pv_[1] = b_; } \
        if (tid < 256) *(LAS u32x4*)(B_ + NH * 9216 + (tid >> 2) * 80 + (tid & 3) * 16) = rkr; } while (0)
    ATT_GLOAD(kt0); ATT_LSTORE(0);
    __syncthreads();
    for (int it = 0; it < nit; ++it) {
        const int ktn = kt0 + (it + 1) * kstep;
        const bool more = (it + 1 < nit) && (ktn < tile_lim);
        if (more) ATT_GLOAD(ktn);
        if (it < nvalid) {
            const LAS unsigned char* B = lds + (it & 1) * BUFSZ;
            const LAS unsigned char* knb = B + hh * 9216; const LAS unsigned char* krb = B + NH * 9216; const LAS unsigned char* vtb = B + NH * 9216 + 5120 + hh * 8704;
            f32x16 s0, s1;
#pragma unroll
            for (int i = 0; i < 16; ++i) { s0[i] = 0.f; s1[i] = 0.f; }
#pragma unroll
            for (int ks = 0; ks < 4; ++ks) { const bf16x8 a0 = *(const LAS bf16x8*)(knb + r * 144 + ks * 32 + h * 16), a1 = *(const LAS bf16x8*)(knb + (32 + r) * 144 + ks * 32 + h * 16);
                s0 = mfma32(a0, qf[ks], s0); s1 = mfma32(a1, qf[ks], s1); }
#pragma unroll
            for (int ks = 0; ks < 2; ++ks) { const bf16x8 a0 = *(const LAS bf16x8*)(krb + r * 80 + ks * 32 + h * 16), a1 = *(const LAS bf16x8*)(krb + (32 + r) * 80 + ks * 32 + h * 16);
                s0 = mfma32(a0, qf[4 + ks], s0); s1 = mfma32(a1, qf[4 + ks], s1); }
            float mx = s0[0];
#pragma unroll
            for (int i = 0; i < 16; ++i) { mx = fmaxf(mx, s0[i]); mx = fmaxf(mx, s1[i]); }
            mx = fmaxf(mx, __shfl_xor(mx, 32));
            const float mnew = fmaxf(m_run, mx), alpha = __builtin_amdgcn_exp2f(m_run - mnew);
            m_run = mnew;
            float ps = 0.f;
#pragma unroll
            for (int i = 0; i < 16; ++i) { s0[i] = __builtin_amdgcn_exp2f(s0[i] - mnew); s1[i] = __builtin_amdgcn_exp2f(s1[i] - mnew); ps += s0[i] + s1[i]; }
            l_run = l_run * alpha + ps;
#pragma unroll
            for (int i = 0; i < 16; ++i) { o[0][i] *= alpha; o[1][i] *= alpha; }
            bf16x8 pf[4];
            pf[0] = pack8(s0, 0); pf[1] = pack8(s0, 8); pf[2] = pack8(s1, 0); pf[3] = pack8(s1, 8);
#pragma unroll
            for (int dh = 0; dh < 2; ++dh)
#pragma unroll
                for (int s4 = 0; s4 < 4; ++s4) { const LAS u32x2* pa = (const LAS u32x2*)(vtb + (32 * dh + r) * 136 + (16 * s4 + 4 * h) * 2); const u32x2 lo = pa[0], hi = pa[2];
                    u32x4 av; av[0] = lo[0]; av[1] = lo[1]; av[2] = hi[0]; av[3] = hi[1]; o[dh] = mfma32(__builtin_bit_cast(bf16x8, av), pf[s4], o[dh]); }
        }
        if (more) ATT_LSTORE((it + 1) & 1);
        __syncthreads();
    }
#undef ATT_GLOAD
#undef ATT_LSTORE
}
DI void attn_core64(LAS unsigned char* lds, const bf16_t* qptr, const bf16_t* kn, const bf16_t* kr, const bf16_t* vt, int KL, int nit, int nvalid,
                    f32x16 (&o)[2][2], float (&m_run)[2], float (&l_run)[2]) {
    constexpr int BUFSZ = 17920 + 5120;
    const int tid = tid_(), lane = tid & 63, r = lane & 31, h = lane >> 5;
    bf16x8 qf[2][2];
    LAS bf16x8* qr = (LAS bf16x8*)(lds + 2 * BUFSZ + (tid >> 6) * 8192) + lane;
#pragma unroll
    for (int g = 0; g < 2; ++g) {
#pragma unroll
        for (int ks = 0; ks < 2; ++ks) qf[g][ks] = *(const bf16x8*)(qptr + g * 32 * 96 + ks * 16 + h * 8);
#pragma unroll
        for (int ks = 0; ks < 4; ++ks) qr[(g * 4 + ks) * 64] = *(const bf16x8*)(qptr + g * 32 * 96 + (2 + ks) * 16 + h * 8); }
#pragma unroll
    for (int g = 0; g < 2; ++g) { m_run[g] = neg_big(); l_run[g] = 0.f;
#pragma unroll
        for (int i = 0; i < 16; ++i) { o[g][0][i] = 0.f; o[g][1][i] = 0.f; } }
    u32x4 rkn, rvt, rkr = {0u, 0u, 0u, 0u};
    const int lrow = tid >> 3, lseg = tid & 7;
#define A64_GLOAD(kt) do { const size_t key0_ = (size_t)(kt) * 64; rkn = *(const u32x4*)(kn + (key0_ + lrow) * 64 + lseg * 8); rvt = *(const u32x4*)(vt + (size_t)lrow * KL + key0_ + lseg * 8); \
        if (tid < 256) rkr = *(const u32x4*)(kr + (key0_ + (tid >> 2)) * 32 + (tid & 3) * 8); } while (0)
#define A64_LSTORE(buf) do { LAS unsigned char* B_ = lds + (buf) * BUFSZ; *(LAS u32x4*)(B_ + lrow * 144 + lseg * 16) = rkn; \
        LAS u32x2* pv_ = (LAS u32x2*)(B_ + 9216 + 5120 + lrow * 136 + lseg * 16); u32x2 a_, b_; a_[0] = rvt[0]; a_[1] = rvt[1]; b_[0] = rvt[2]; b_[1] = rvt[3]; pv_[0] = a_; pv_[1] = b_; \
        if (tid < 256) *(LAS u32x4*)(B_ + 9216 + (tid >> 2) * 80 + (tid & 3) * 16) = rkr; } while (0)
    A64_GLOAD(0); A64_LSTORE(0);
    __syncthreads();
    for (int it = 0; it < nit; ++it) {
        const bool more = (it + 1 < nit);
        if (more) A64_GLOAD(it + 1);
        if (it < nvalid) {
            const LAS unsigned char* B = lds + (it & 1) * BUFSZ;
            const LAS unsigned char* knb = B; const LAS unsigned char* krb = B + 9216; const LAS unsigned char* vtb = B + 9216 + 5120;
            f32x16 s[2][2];
#pragma unroll
            for (int g = 0; g < 2; ++g)
#pragma unroll
                for (int i = 0; i < 16; ++i) { s[g][0][i] = 0.f; s[g][1][i] = 0.f; }
            __builtin_amdgcn_s_setprio(1);
#define A64_KA0(ks) ((ks) < 4 ? *(const LAS bf16x8*)(knb + r * 144 + (ks) * 32 + h * 16) : *(const LAS bf16x8*)(krb + r * 80 + ((ks) - 4) * 32 + h * 16))
#define A64_KA1(ks) ((ks) < 4 ? *(const LAS bf16x8*)(knb + (32 + r) * 144 + (ks) * 32 + h * 16) : *(const LAS bf16x8*)(krb + (32 + r) * 80 + ((ks) - 4) * 32 + h * 16))
#define A64_Q(g, ks) ((ks) < 2 ? qf[g][(ks) < 2 ? (ks) : 0] : qr[((g) * 4 + (ks) - 2) * 64])
            { bf16x8 a0 = A64_KA0(0), a1 = A64_KA1(0), q0 = A64_Q(0, 0), q1 = A64_Q(1, 0);
#pragma unroll
              for (int ks = 0; ks < 6; ++ks) {
                  bf16x8 na0 = a0, na1 = a1, nq0 = q0, nq1 = q1;
                  if (ks < 5) { na0 = A64_KA0(ks + 1); na1 = A64_KA1(ks + 1); nq0 = A64_Q(0, ks + 1); nq1 = A64_Q(1, ks + 1); }
                  __builtin_amdgcn_sched_barrier(0);
                  s[0][0] = mfma32(a0, q0, s[0][0]); s[1][0] = mfma32(a0, q1, s[1][0]); s[0][1] = mfma32(a1, q0, s[0][1]); s[1][1] = mfma32(a1, q1, s[1][1]);
                  __builtin_amdgcn_sched_barrier(0);
                  a0 = na0; a1 = na1; q0 = nq0; q1 = nq1; } }
#undef A64_KA0
#undef A64_KA1
#undef A64_Q
            __builtin_amdgcn_s_setprio(0);
            __builtin_amdgcn_sched_barrier(0);
            bf16x8 pf[2][4];
#pragma unroll
            for (int g = 0; g < 2; ++g) {
                float mx = s[g][0][0];
#pragma unroll
                for (int i = 0; i < 16; ++i) { mx = fmaxf(mx, s[g][0][i]); mx = fmaxf(mx, s[g][1][i]); }
                mx = fmaxf(mx, __shfl_xor(mx, 32));
                const float mnew = mx > m_run[g] + 8.f ? mx : m_run[g], alpha = __builtin_amdgcn_exp2f(m_run[g] - mnew);
                const bool resc = __builtin_amdgcn_ballot_w64(mnew != m_run[g]) != 0ull;
                m_run[g] = mnew;
                float ps = 0.f;
#pragma unroll
                for (int i = 0; i < 16; ++i) { s[g][0][i] = __builtin_amdgcn_exp2f(s[g][0][i] - mnew); s[g][1][i] = __builtin_amdgcn_exp2f(s[g][1][i] - mnew); ps += s[g][0][i] + s[g][1][i]; }
                l_run[g] = l_run[g] * alpha + ps;
                if (resc) {
#pragma unroll
                    for (int i = 0; i < 16; ++i) { o[g][0][i] *= alpha; o[g][1][i] *= alpha; } }
                pf[g][0] = pack8(s[g][0], 0); pf[g][1] = pack8(s[g][0], 8); pf[g][2] = pack8(s[g][1], 0); pf[g][3] = pack8(s[g][1], 8);
                __builtin_amdgcn_sched_barrier(0);
            }
            __builtin_amdgcn_s_setprio(1);
#define A64_VF(idx, lo_, hi_) const LAS u32x2* pa_##lo_ = (const LAS u32x2*)(vtb + (32 * ((idx) >> 2) + r) * 136 + (16 * ((idx) & 3) + 4 * h) * 2); u32x2 lo_ = pa_##lo_[0], hi_ = pa_##lo_[2]
            { A64_VF(0, lo, hi);
#pragma unroll
              for (int idx = 0; idx < 8; ++idx) {
                  u32x2 nlo = lo, nhi = hi;
                  if (idx < 7) { const LAS u32x2* pn = (const LAS u32x2*)(vtb + (32 * ((idx + 1) >> 2) + r) * 136 + (16 * ((idx + 1) & 3) + 4 * h) * 2); nlo = pn[0]; nhi = pn[2]; }
                  __builtin_amdgcn_sched_barrier(0);
                  u32x4 av; av[0] = lo[0]; av[1] = lo[1]; av[2] = hi[0]; av[3] = hi[1]; const bf16x8 avb = __builtin_bit_cast(bf16x8, av);
                  o[0][idx >> 2] = mfma32(avb, pf[0][idx & 3], o[0][idx >> 2]); o[1][idx >> 2] = mfma32(avb, pf[1][idx & 3], o[1][idx >> 2]);
                  __builtin_amdgcn_sched_barrier(0);
                  lo = nlo; hi = nhi; } }
#undef A64_VF
            __builtin_amdgcn_s_setprio(0);
        }
        if (more) A64_LSTORE((it + 1) & 1);
        __syncthreads();
    }
#undef A64_GLOAD
#undef A64_LSTORE
}
DI void phase_attn_p(const Params& p, LAS unsigned char* lds) {
    const int tid = tid_(), lane = tid & 63, wid = __builtin_amdgcn_readfirstlane(tid >> 6), r = lane & 31, h = lane >> 5;
    const bf16_t* Q = (const bf16_t*)(p.ws + OFF_Q); const bf16_t* KN = (const bf16_t*)(p.ws + OFF_KN); const bf16_t* VT = (const bf16_t*)(p.ws + OFF_VT);
    const bf16_t* KRO = (const bf16_t*)(p.ws + OFF_KROPE); bf16_t* O = (bf16_t*)(p.ws + OFF_O);
    for (int pair = bid_(); pair < 256; pair += gridDim.x) {
        const int bh = pair >> 3, qa = pair & 7, b = bh >> 3, hd = bh & 7;
        for (int sub = 0; sub < 2; ++sub) {
            const int qb = sub ? qa : 15 - qa;
            const int t0 = qb * 512 + wid * 64 + r;
            f32x16 o[2][2]; float m_run[2], l_run[2];
            attn_core64(lds, Q + ((size_t)bh * 8192 + t0) * 96, KN + (size_t)bh * 8192 * 64, KRO + (size_t)b * 8192 * 32, VT + (size_t)bh * 64 * 8192, 8192,
                        8 * qb + 8, 8 * qb + wid + 1, o, m_run, l_run);
#pragma unroll
            for (int g = 0; g < 2; ++g) {
                const float inv = 1.f / (l_run[g] + __shfl_xor(l_run[g], 32));
                bf16_t* orow = O + ((size_t)b * 8192 + t0 + g * 32) * 512 + hd * 64;
#pragma unroll
                for (int dh = 0; dh < 2; ++dh)
#pragma unroll
                    for (int q4 = 0; q4 < 4; ++q4) { uint2 w; w.x = pack2(o[g][dh][4 * q4] * inv, o[g][dh][4 * q4 + 1] * inv); w.y = pack2(o[g][dh][4 * q4 + 2] * inv, o[g][dh][4 * q4 + 3] * inv); *(uint2*)(orow + 32 * dh + 8 * q4 + 4 * h) = w; }
            }
        }
    }
}
DI void phase_attn_s(const Params& p, LAS unsigned char* lds) {
    const int tid = tid_(), lane = tid & 63, wid = __builtin_amdgcn_readfirstlane(tid >> 6), r = lane & 31, h = lane >> 5;
    const bf16_t* Q = (const bf16_t*)(p.ws + OFF_Q); const bf16_t* KN = (const bf16_t*)(p.ws + OFF_KN); const bf16_t* VT = (const bf16_t*)(p.ws + OFF_VT);
    const bf16_t* KRO = (const bf16_t*)(p.ws + OFF_KROPE); float* PART = (float*)(p.ws + OFF_PART);
    for (int c = bid_(); c < 256; c += gridDim.x) {
        const int b = c >> 3, hg = (c >> 2) & 1, split = c & 3, hh = wid >> 1, head = hg * 4 + hh, t = (wid & 1) * 32 + r;
        f32x16 o[2]; float m_run, l_run;
        attn_core<4>(lds, Q + (size_t)MP * 768 + ((size_t)(b * 8 + head) * 64 + t) * 96, KN + (size_t)MP * 512 + (size_t)(b * 8 + hg * 4) * KEYS_S * 64, (size_t)KEYS_S * 64,
                     KRO + (size_t)MP * 32 + (size_t)b * KEYS_S * 32, VT + (size_t)MP * 512 + (size_t)(b * 8 + hg * 4) * 64 * KEYS_S, (size_t)64 * KEYS_S, KEYS_S,
                     split, 4, 17, split == 0 ? 17 : 16, 65, hh, o, m_run, l_run);
        const float lt = l_run + __shfl_xor(l_run, 32);
        float* pr = PART + (((size_t)(b * 8 + head) * 4 + split) * 64 + t) * 66;
#pragma unroll
        for (int dh = 0; dh < 2; ++dh)
#pragma unroll
            for (int g = 0; g < 4; ++g) { float2 a, bb; a.x = o[dh][4 * g]; a.y = o[dh][4 * g + 1]; bb.x = o[dh][4 * g + 2]; bb.y = o[dh][4 * g + 3]; float* d = pr + 32 * dh + 8 * g + 4 * h; *(float2*)d = a; *(float2*)(d + 2) = bb; }
        if (h == 0) { float2 ml; ml.x = m_run; ml.y = lt; *(float2*)(pr + 64) = ml; }
    }
}

constexpr int R_QF = 0, R_KF = 16384, R_G = 32768, R_VTI = 49152, R_KTI = 58368, R_QTI = 67584, R_STI = 76800, R_PPI = 86016, R_QHI = 95232, R_KHI = 102144,
              R_GA = 115968, R_WA = 120064, R_SEG = 122240, R_OF = 0, R_WALL = 124288, R_BA = 132480, R_LB = 132992, R_QD = 134016, R_KD = 143232;
struct RecPre { u32x4 uv, ua, uq, ug, gz; f32x4 s0, s1; };
DI uint4 to_u4(u32x4 v) { uint4 r; r.x = v[0]; r.y = v[1]; r.z = v[2]; r.w = v[3]; return r; }
DI float4 to_f4(f32x4 v) { float4 r; r.x = v[0]; r.y = v[1]; r.z = v[2]; r.w = v[3]; return r; }
DI void rec_tables(const Params& p, int l, LAS unsigned char* lds) {
    const int tid = tid_();
    LAS float* WALL = (LAS float*)(lds + R_WALL); LAS float* BA = (LAS float*)(lds + R_BA); LAS float* LB = (LAS float*)(lds + R_LB);
#pragma unroll
    for (int i = 0; i < 4; ++i) WALL[tid + 512 * i] = p.in[23][l * 2048 + tid + 512 * i];
    if (tid < 128) BA[tid] = p.in[24][l * 128 + tid];
    if (tid < 256) { float lb = 0.f; if (l == 1) { const float l0 = p.in[21][tid], l1 = p.in[21][256 + tid]; lb = 1.f / (1.f + expf(l0 - l1)); } LB[tid] = lb; }
    __syncthreads();
}
template <int DK, bool HG>
DI void rec_issue(const Params& p, int cid, int hd, bool passC, RecPre& r) {
    const int tid = tid_();
    const bf16_t* Z = (const bf16_t*)(p.ws + OFF_Z);
    const size_t row0 = (size_t)cid * 64;
    const int lj = tid >> 3, ls8 = (tid & 7) * 8;
    const bf16_t* zr = Z + (row0 + lj) * ZLD;
    r.uv = *(const u32x4*)(zr + (HG ? 1056 : 1824) + hd * 64 + ls8);
    if (HG) { r.ua = *(const u32x4*)(zr + 800 + hd * 64 + ls8); if (passC) r.uq = *(const u32x4*)(zr + 544 + hd * 64 + ls8); }
    else { if (tid < 256) { const bf16_t* z2 = Z + (row0 + (tid >> 2)) * ZLD; r.ua = *(const u32x4*)(z2 + 1696 + hd * 32 + (tid & 3) * 8); if (passC) r.uq = *(const u32x4*)(z2 + 1568 + hd * 32 + (tid & 3) * 8); }
           if (tid < 128) r.ug = *(const u32x4*)(Z + (row0 + (tid >> 1)) * ZLD + 2336 + (tid & 1) * 8); }
    if (passC) {
        const float* S = (const float*)(p.ws + (HG ? OFF_UHG : OFF_UGL)) + ((size_t)cid * 4 + hd) * DK * 64;
            if (tid < DK * 8) { const int k = tid >> 3, v0 = (tid & 7) * 8; r.s0 = *(const f32x4*)(S + k * 64 + v0); r.s1 = *(const f32x4*)(S + k * 64 + v0 + 4); }
        r.gz = *(const u32x4*)(zr + (HG ? 1312 : 2080) + hd * 64 + ls8);
    }
}
template <int DK, bool HG>
DI void rec_load(const RecPre& pre, LAS unsigned char* lds, int hd, bool need_q) {
    const int tid = tid_();
    LAS float* QF = (LAS float*)(lds + R_QF); LAS float* KF = (LAS float*)(lds + R_KF); LAS float* G = (LAS float*)(lds + R_G);
    LAS bf16_t* VTI = (LAS bf16_t*)(lds + R_VTI); LAS float* GA = (LAS float*)(lds + R_GA); LAS float* SEG = (LAS float*)(lds + R_SEG);
    const LAS float* WA = (const LAS float*)(lds + (HG ? R_LB : R_WALL)) + (HG ? hd * 64 : hd * 32);
    const LAS float* BA = (const LAS float*)(lds + R_BA) + hd * 32;
    const int lj = tid >> 3, ls8 = (tid & 7) * 8;
    const uint4 uv = to_u4(pre.uv), ua = to_u4(pre.ua), uq = to_u4(pre.uq);
    if (!HG) {
        if (tid < 128) { const int j = tid >> 1, hf = tid & 1; const uint4 u = to_u4(pre.ug); LAS float* ga = GA + j * 16 + hf * 8;
            ga[0] = bflo(u.x); ga[1] = bfhi(u.x); ga[2] = bflo(u.y); ga[3] = bfhi(u.y); ga[4] = bflo(u.z); ga[5] = bfhi(u.z); ga[6] = bflo(u.w); ga[7] = bfhi(u.w); }
        __syncthreads();
    }
    { const float va[8] = {bflo(ua.x), bfhi(ua.x), bflo(ua.y), bfhi(ua.y), bflo(ua.z), bfhi(ua.z), bflo(ua.w), bfhi(ua.w)};
      const float vq[8] = {bflo(uq.x), bfhi(uq.x), bflo(uq.y), bfhi(uq.y), bflo(uq.z), bfhi(uq.z), bflo(uq.w), bfhi(uq.w)};
      if (HG) { float gg[8], kk[8];
#pragma unroll
          for (int x = 0; x < 8; ++x) { const float lb = WA[ls8 + x], e = __expf(fminf(-va[x], 80.f)), s = 1.f / (1.f + e); gg[x] = logf(lb + (1.f - lb) * s); kk[x] = (1.f - lb) * e * s; }
          LAS f32x4* gp = (LAS f32x4*)(G + lj * 64 + ls8); LAS f32x4* kp = (LAS f32x4*)(KF + lj * 64 + ls8);
          gp[0] = (f32x4){gg[0], gg[1], gg[2], gg[3]}; gp[1] = (f32x4){gg[4], gg[5], gg[6], gg[7]}; kp[0] = (f32x4){kk[0], kk[1], kk[2], kk[3]}; kp[1] = (f32x4){kk[4], kk[5], kk[6], kk[7]};
          if (need_q) { LAS f32x4* qp = (LAS f32x4*)(QF + lj * 64 + ls8); qp[0] = (f32x4){vq[0], vq[1], vq[2], vq[3]}; qp[1] = (f32x4){vq[4], vq[5], vq[6], vq[7]}; } }
      else {
          { const int kq = (tid & 7) * 4; f32x4 x = *(const LAS f32x4*)(BA + kq);
#pragma unroll
            for (int r = 0; r < 16; ++r) { const float ga = GA[lj * 16 + r]; const f32x4 wv = *(const LAS f32x4*)(WA + r * 128 + kq); x += ga * wv; }
            f32x4 o;
#pragma unroll
            for (int y = 0; y < 4; ++y) o[y] = (fminf(x[y], 0.f) - log1pf(__expf(-fabsf(x[y])))) * (1.f / 16.f);
            *(LAS f32x4*)(G + lj * 32 + kq) = o; }
          if (tid < 256) { const int j2 = tid >> 2, k2 = (tid & 3) * 8; LAS f32x4* kp = (LAS f32x4*)(KF + j2 * 32 + k2); kp[0] = (f32x4){va[0], va[1], va[2], va[3]}; kp[1] = (f32x4){va[4], va[5], va[6], va[7]};
              if (need_q) { const float qs = 0.17677669529663687f; LAS f32x4* qp = (LAS f32x4*)(QF + j2 * 32 + k2); qp[0] = (f32x4){vq[0] * qs, vq[1] * qs, vq[2] * qs, vq[3] * qs}; qp[1] = (f32x4){vq[4] * qs, vq[5] * qs, vq[6] * qs, vq[7] * qs}; } } }
      const unsigned vv[4] = {uv.x, uv.y, uv.z, uv.w};
#pragma unroll
      for (int x = 0; x < 4; ++x) { VTI[(ls8 + 2 * x) * 72 + lj] = (bf16_t)(vv[x] & 0xFFFFu); VTI[(ls8 + 2 * x + 1) * 72 + lj] = (bf16_t)(vv[x] >> 16); } }
    __syncthreads();
    constexpr int NSEG = NT / DK, JS = 64 / NSEG;
    const int seg = tid / DK, k = tid % DK;
    float loc[JS]; float s = 0.f;
#pragma unroll
    for (int jj = 0; jj < JS; ++jj) { s += G[(seg * JS + jj) * DK + k]; loc[jj] = s; }
    SEG[seg * DK + k] = s;
    __syncthreads();
    float off = 0.f;
#pragma unroll
    for (int s2 = 0; s2 < NSEG; ++s2) { const float t = SEG[s2 * DK + k]; off += s2 < seg ? t : 0.f; }
#pragma unroll
    for (int jj = 0; jj < JS; ++jj) G[(seg * JS + jj) * DK + k] = loc[jj] + off;
    __syncthreads();
}
template <int DK, bool HG>
DI void rec_passA_item(const Params& p, int l, LAS unsigned char* lds, int cid, int hd, const RecPre& pre) {
    const int tid = tid_(), lane = tid & 63, wid = __builtin_amdgcn_readfirstlane(tid >> 6), fr = lane & 15, fq = lane >> 4;
    rec_load<DK, HG>(pre, lds, hd, false);
    LAS float* KF = (LAS float*)(lds + R_KF); LAS float* G = (LAS float*)(lds + R_G);
    LAS bf16_t* VTI = (LAS bf16_t*)(lds + R_VTI); LAS bf16_t* KTI = (LAS bf16_t*)(lds + R_KTI);
    float* U = (float*)(p.ws + (HG ? OFF_UHG : OFF_UGL)); float* D = (float*)(p.ws + (HG ? OFF_DHG : OFF_DGL));
    for (int e = tid; e < 64 * DK; e += NT) { const int j = e / DK, k = e % DK; KTI[k * 72 + j] = f2bf(KF[e] * __expf(G[63 * DK + k] - G[e])); }
    if (tid < DK) D[((size_t)cid * 4 + hd) * DK + tid] = __expf(G[63 * DK + tid]);
    __syncthreads();
    for (int tile = wid; tile < (DK / 16) * 4; tile += 8) {
        const int tk = tile >> 2, tv = tile & 3; f32x4 acc = {0.f, 0.f, 0.f, 0.f};
#pragma unroll
        for (int s = 0; s < 2; ++s) { const bf16x8 a = *(const LAS bf16x8*)(KTI + (16 * tk + fr) * 72 + 32 * s + 8 * fq), b = *(const LAS bf16x8*)(VTI + (16 * tv + fr) * 72 + 32 * s + 8 * fq); acc = mfma16(a, b, acc); }
#pragma unroll
        for (int reg = 0; reg < 4; ++reg) U[(((size_t)cid * 4 + hd) * DK + 16 * tk + 4 * fq + reg) * 64 + 16 * tv + fr] = acc[reg];
    }
    __syncthreads();
}
template <int DK, bool HG>
DI void rec_passC_item(const Params& p, int l, LAS unsigned char* lds, int cid, int hd, const RecPre& pre) {
    const int tid = tid_(), lane = tid & 63, wid = __builtin_amdgcn_readfirstlane(tid >> 6), fr = lane & 15, fq = lane >> 4;
    rec_load<DK, HG>(pre, lds, hd, true);
    LAS float* QF = (LAS float*)(lds + R_QF); LAS float* KF = (LAS float*)(lds + R_KF); LAS float* G = (LAS float*)(lds + R_G); LAS float* OF = (LAS float*)(lds + R_OF);
    LAS bf16_t* VTI = (LAS bf16_t*)(lds + R_VTI); LAS bf16_t* QTI = (LAS bf16_t*)(lds + R_QTI); LAS bf16_t* STI = (LAS bf16_t*)(lds + R_STI);
    LAS bf16_t* PPI = (LAS bf16_t*)(lds + R_PPI); LAS bf16_t* QHI = (LAS bf16_t*)(lds + R_QHI); LAS bf16_t* KHI = (LAS bf16_t*)(lds + R_KHI);
    const bf16_t* Z = (const bf16_t*)(p.ws + OFF_Z); bf16_t* H = (bf16_t*)(p.ws + OFF_H);
    for (int e = tid; e < 64 * DK; e += NT) { const int i = e / DK, k = e % DK; QTI[i * 72 + k] = f2bf(QF[e] * __expf(G[e])); }
    if (tid < DK * 8) { const int k = tid >> 3, v0 = (tid & 7) * 8; const float4 s0 = to_f4(pre.s0), s1 = to_f4(pre.s1);
        STI[(v0 + 0) * 72 + k] = f2bf(s0.x); STI[(v0 + 1) * 72 + k] = f2bf(s0.y); STI[(v0 + 2) * 72 + k] = f2bf(s0.z); STI[(v0 + 3) * 72 + k] = f2bf(s0.w);
        STI[(v0 + 4) * 72 + k] = f2bf(s1.x); STI[(v0 + 5) * 72 + k] = f2bf(s1.y); STI[(v0 + 6) * 72 + k] = f2bf(s1.z); STI[(v0 + 7) * 72 + k] = f2bf(s1.w); }
    for (int e = tid; e < 48 * DK; e += NT) { const int ii = e / DK, k = e % DK, I = 1 + (ii >> 4), i = 16 + ii; const float ref = G[(16 * I - 1) * DK + k];
        QHI[ii * 72 + k] = f2bf(QF[i * DK + k] * __expf(G[i * DK + k] - ref)); }
    for (int e = tid; e < 96 * DK; e += NT) { const int rr = e / DK, k = e % DK, I = rr < 16 ? 1 : (rr < 48 ? 2 : 3), j = rr - 8 * I * (I - 1); const float ref = G[(16 * I - 1) * DK + k];
        KHI[rr * 72 + k] = f2bf(KF[j * DK + k] * __expf(ref - G[j * DK + k])); }
    { LAS bf16_t* QD = (LAS bf16_t*)(lds + R_QD); LAS bf16_t* KD = (LAS bf16_t*)(lds + R_KD);
      for (int e = tid; e < 64 * DK; e += NT) { const int i = e / DK, k = e % DK; const float ref = G[(16 * (i >> 4) + 7) * DK + k], gi = G[e];
          QD[i * 72 + k] = f2bf(QF[e] * __expf(fminf(fmaxf(gi - ref, -80.f), 80.f))); KD[i * 72 + k] = f2bf(KF[e] * __expf(fminf(fmaxf(ref - gi, -80.f), 80.f))); } }
    for (int e = tid; e < 1536; e += NT) { const int bidx = e >> 8, w = e & 255; const int I = bidx < 3 ? 0 : (bidx < 5 ? 1 : 2), J = bidx < 3 ? bidx + 1 : (bidx < 5 ? bidx - 1 : 3);
        PPI[(16 * I + (w >> 4)) * 72 + 16 * J + (w & 15)] = 0; }
    __syncthreads();
    if (wid >= 6) { const LAS bf16_t* QD = (const LAS bf16_t*)(lds + R_QD); const LAS bf16_t* KD = (const LAS bf16_t*)(lds + R_KD);
#pragma unroll
        for (int t2 = 0; t2 < 2; ++t2) { const int I = (wid - 6) * 2 + t2; f32x4 acc = {0.f, 0.f, 0.f, 0.f};
#pragma unroll
            for (int s = 0; s < DK / 32; ++s) { const bf16x8 a = *(const LAS bf16x8*)(QD + (16 * I + fr) * 72 + 32 * s + 8 * fq), b = *(const LAS bf16x8*)(KD + (16 * I + fr) * 72 + 32 * s + 8 * fq); acc = mfma16(a, b, acc); }
#pragma unroll
            for (int reg = 0; reg < 4; ++reg) PPI[(16 * I + 4 * fq + reg) * 72 + 16 * I + fr] = f2bf(fr <= 4 * fq + reg ? acc[reg] : 0.f); } }
    if (wid < 6) { const int I = wid < 1 ? 1 : (wid < 3 ? 2 : 3), J = wid < 1 ? 0 : (wid < 3 ? wid - 1 : wid - 3); f32x4 acc = {0.f, 0.f, 0.f, 0.f};
#pragma unroll
        for (int s = 0; s < DK / 32; ++s) { const bf16x8 a = *(const LAS bf16x8*)(QHI + ((I - 1) * 16 + fr) * 72 + 32 * s + 8 * fq), b = *(const LAS bf16x8*)(KHI + (8 * I * (I - 1) + 16 * J + fr) * 72 + 32 * s + 8 * fq); acc = mfma16(a, b, acc); }
#pragma unroll
        for (int reg = 0; reg < 4; ++reg) PPI[(16 * I + 4 * fq + reg) * 72 + 16 * J + fr] = f2bf(acc[reg]); }
    __syncthreads();
#pragma unroll
    for (int tt = 0; tt < 2; ++tt) { const int tile = wid * 2 + tt, ti = tile >> 2, tv = tile & 3; f32x4 acc = {0.f, 0.f, 0.f, 0.f};
#pragma unroll
        for (int s = 0; s < DK / 32; ++s) { const bf16x8 a = *(const LAS bf16x8*)(QTI + (16 * ti + fr) * 72 + 32 * s + 8 * fq), b = *(const LAS bf16x8*)(STI + (16 * tv + fr) * 72 + 32 * s + 8 * fq); acc = mfma16(a, b, acc); }
#pragma unroll
        for (int s = 0; s < 2; ++s) { const bf16x8 a = *(const LAS bf16x8*)(PPI + (16 * ti + fr) * 72 + 32 * s + 8 * fq), b = *(const LAS bf16x8*)(VTI + (16 * tv + fr) * 72 + 32 * s + 8 * fq); acc = mfma16(a, b, acc); }
#pragma unroll
        for (int reg = 0; reg < 4; ++reg) OF[(16 * ti + 4 * fq + reg) * 65 + 16 * tv + fr] = acc[reg]; }
    __syncthreads();
    { const int i = tid >> 3, part = tid & 7; float v[8]; float ss = 0.f;
#pragma unroll
      for (int x = 0; x < 8; ++x) { v[x] = OF[i * 65 + part * 8 + x]; ss += v[x] * v[x]; }
      ss += __shfl_xor(ss, 1); ss += __shfl_xor(ss, 2); ss += __shfl_xor(ss, 4);
      const float rs = rsqrtf(ss * (1.f / 64.f) + EPS);
      const size_t row = (size_t)cid * 64 + i;
      const uint4 gz = to_u4(pre.gz);
      const float* go = p.in[HG ? 22 : 25] + l * 64 + part * 8;
      const float gt[8] = {bflo(gz.x), bfhi(gz.x), bflo(gz.y), bfhi(gz.y), bflo(gz.z), bfhi(gz.z), bflo(gz.w), bfhi(gz.w)};
      float r[8];
#pragma unroll
      for (int x = 0; x < 8; ++x) r[x] = v[x] * rs * go[x] * (gt[x] / (1.f + __expf(-gt[x])));
      uint4 w; w.x = pack2(r[0], r[1]); w.y = pack2(r[2], r[3]); w.z = pack2(r[4], r[5]); w.w = pack2(r[6], r[7]);
      *(uint4*)(H + row * 1024 + 512 + (HG ? 0 : 256) + hd * 64 + part * 8) = w; }
    __syncthreads();
}
template <int DK>
DI void scan_prompt(float* U, const float* D, float* outp, int e) {
    const int v = e & 63, k = (e >> 6) % DK, hd = (e / (64 * DK)) & 3, b = e / (256 * DK);
    float S = 0.f;
    for (int n0 = 0; n0 < 128; n0 += 16) {
        float u[16], d[16];
#pragma unroll
        for (int i = 0; i < 16; ++i) { const size_t ch = ((size_t)(b * 128 + n0 + i) * 4 + hd); u[i] = U[(ch * DK + k) * 64 + v]; d[i] = D[ch * DK + k]; }
#pragma unroll
        for (int i = 0; i < 16; ++i) { const size_t ch = ((size_t)(b * 128 + n0 + i) * 4 + hd); U[(ch * DK + k) * 64 + v] = S; S = d[i] * S + u[i]; }
    }
    outp[e] = S;
}
template <int DK>
DI void scan_sample(float* U, const float* D, const float* s0p, float* outp, int e) {
    const int v = e & 63, k = (e >> 6) % DK, hd = (e / (64 * DK)) & 3, b = e / (256 * DK);
    const size_t ch = (size_t)(512 + b) * 4 + hd; const size_t idx = (ch * DK + k) * 64 + v;
    const float s0 = s0p[e], u = U[idx], d = D[ch * DK + k];
    U[idx] = s0; outp[e] = d * s0 + u;
}
DI void phase_scan(const Params& p, int l) {
    const int g = bid_() * NT + tid_(), gs = gridDim.x * NT;
    float* UH = (float*)(p.ws + OFF_UHG); const float* DH = (const float*)(p.ws + OFF_DHG); float* UG = (float*)(p.ws + OFF_UGL); const float* DG = (const float*)(p.ws + OFF_DGL);
    for (int e = g; e < 98304; e += gs) {
        if (e < 65536) scan_prompt<64>(UH, DH, p.out + OUT_HGP + (size_t)l * 65536, e);
        else scan_prompt<32>(UG, DG, p.out + OUT_GLP + (size_t)l * 32768, e - 65536);
    }
    for (int e = g; e < 786432; e += gs) {
        if (e < 524288) scan_sample<64>(UH, DH, p.in[6] + (size_t)l * 524288, p.out + OUT_HGS + (size_t)l * 524288, e);
        else scan_sample<32>(UG, DG, p.in[7] + (size_t)l * 262144, p.out + OUT_GLS + (size_t)l * 262144, e - 524288);
    }
}
DI void phase_mlaout(const Params& p, int l) {
    const int tid = tid_(), lane = tid & 63, wid = __builtin_amdgcn_readfirstlane(tid >> 6);
    const bf16_t* O = (const bf16_t*)(p.ws + OFF_O); const float* PART = (const float*)(p.ws + OFF_PART); bf16_t* H = (bf16_t*)(p.ws + OFF_H);
    const float* g = p.in[20] + l * 512 + 8 * lane;
    for (int row = bid_() * 8 + wid; row < MT; row += gridDim.x * 8) {
        float v[8];
        if (row < MP) { const uint4 u = *(const uint4*)(O + (size_t)row * 512 + 8 * lane);
            v[0] = bflo(u.x); v[1] = bfhi(u.x); v[2] = bflo(u.y); v[3] = bfhi(u.y); v[4] = bflo(u.z); v[5] = bfhi(u.z); v[6] = bflo(u.w); v[7] = bfhi(u.w); }
        else { const int r = row - MP, b = r >> 6, t = r & 63, head = lane >> 3, dv0 = (lane & 7) * 8;
            const float* pb = PART + (((size_t)(b * 8 + head) * 4) * 64 + t) * 66;
            float m[4], lsum[4]; float M = neg_big();
#pragma unroll
            for (int s = 0; s < 4; ++s) { m[s] = pb[(size_t)s * 64 * 66 + 64]; lsum[s] = pb[(size_t)s * 64 * 66 + 65]; M = fmaxf(M, m[s]); }
            float L = 0.f;
#pragma unroll
            for (int x = 0; x < 8; ++x) v[x] = 0.f;
#pragma unroll
            for (int s = 0; s < 4; ++s) { const float w = exp2f(m[s] - M); L += w * lsum[s];
#pragma unroll
                for (int x = 0; x < 8; ++x) v[x] += w * pb[(size_t)s * 64 * 66 + dv0 + x]; }
            const float inv = 1.f / L;
#pragma unroll
            for (int x = 0; x < 8; ++x) v[x] *= inv; }
        float ss = 0.f;
#pragma unroll
        for (int x = 0; x < 8; ++x) ss += v[x] * v[x];
        ss = wave_sum(ss);
        const float rs = rsqrtf(ss * (1.f / 512.f) + EPS);
        uint4 w; w.x = pack2(v[0] * rs * g[0], v[1] * rs * g[1]); w.y = pack2(v[2] * rs * g[2], v[3] * rs * g[3]); w.z = pack2(v[4] * rs * g[4], v[5] * rs * g[5]); w.w = pack2(v[6] * rs * g[6], v[7] * rs * g[7]);
        *(uint4*)(H + (size_t)row * 1024 + 8 * lane) = w;
    }
}

DI void gsync(const Params& p, LAS unsigned char* lds) { XcdBarrier b; b.bar = (unsigned*)(p.ws + OFF_BAR); b.x = xb_xcc_id(); b.st = (volatile LAS unsigned*)(lds + LDS_BYTES - 16); xcd_barrier(b); }
__global__ void __launch_bounds__(512, 2) mk_fwd(Params p) {
    extern __shared__ __attribute__((aligned(16))) unsigned char shm[];
    LAS unsigned char* lds = (LAS unsigned char*)shm;
    cg::grid_group grid = cg::this_grid();
    bf16_t* H = (bf16_t*)(p.ws + OFF_H); bf16_t* Z = (bf16_t*)(p.ws + OFF_Z); bf16_t* CQN = (bf16_t*)(p.ws + OFF_CQN); bf16_t* CKV = (bf16_t*)(p.ws + OFF_CKV);
    bf16_t* Q = (bf16_t*)(p.ws + OFF_Q); bf16_t* KN = (bf16_t*)(p.ws + OFF_KN); bf16_t* VT = (bf16_t*)(p.ws + OFF_VT); bf16_t* ACT = (bf16_t*)(p.ws + OFF_ACT);
    const float* rope = (const float*)(p.ws + OFF_ROPE); bf16_t* XB = (bf16_t*)(p.ws + OFF_XB);
    volatile LAS unsigned* xst = (volatile LAS unsigned*)(lds + LDS_BYTES - 16);
    if (threadIdx.x == 0) { xst[0] = 0u; xst[1] = 0u; }
    __syncthreads();
    (void)xcd_barrier_post((unsigned*)(p.ws + OFF_BAR), xst);
    phase_prep(p, lds);
    grid.sync();
#pragma unroll 1
    for (int l = 0; l < 2; ++l) {
        const unsigned char* W = p.ws + OFF_W + (size_t)l * WL;
        const float* modl = (const float*)(p.ws + OFF_MOD) + (size_t)l * 36 * 6144;
        if (l == 0) phase_hrows<true>(p, l, p.in[0], p.in[1], p.in[10] + l * 1024, 0, 1024); else phase_hrows<false>(p, l, nullptr, nullptr, p.in[10] + l * 1024, 0, 1024);
        phase_cache(p, l);
        gsync(p, lds);
        run_gemm(lds, H, (const bf16_t*)(W + WOFF_IN), MT, 2560, 1024, EpiZ{Z, ZLD});
        gsync(p, lds);
        phase_post(p, l);
        gsync(p, lds);
        run_gemm(lds, CQN, (const bf16_t*)(W + WOFF_UQ), MT, 768, 256, EpiQ{Q, p.in[18] + l * 96, rope});
        run_gemm(lds, CKV, (const bf16_t*)(W + WOFF_UK), KR_ROWS, 512, 256, EpiKN{KN, p.in[19] + l * 96});
        run_gemm(lds, (const bf16_t*)(W + WOFF_UV), CKV, 512, KR_ROWS, 256, EpiVT{VT});
        gsync(p, lds);
        phase_attn_p(p, lds);
        phase_attn_s(p, lds);
        rec_tables(p, l, lds);
        { RecPre pre = {}; int it = bid_(); if (it < 2176) rec_issue<64, true>(p, it >> 2, it & 3, false, pre);
          for (; it < 2176; it += gridDim.x) { const RecPre cur = pre; const int nx = it + gridDim.x; if (nx < 2176) rec_issue<64, true>(p, nx >> 2, nx & 3, false, pre); rec_passA_item<64, true>(p, l, lds, it >> 2, it & 3, cur); } }
        { RecPre pre = {}; int it = bid_(); if (it < 2176) rec_issue<32, false>(p, it >> 2, it & 3, false, pre);
          for (; it < 2176; it += gridDim.x) { const RecPre cur = pre; const int nx = it + gridDim.x; if (nx < 2176) rec_issue<32, false>(p, nx >> 2, nx & 3, false, pre); rec_passA_item<32, false>(p, l, lds, it >> 2, it & 3, cur); } }
        gsync(p, lds);
        phase_scan(p, l);
        gsync(p, lds);
        rec_tables(p, l, lds);
        { RecPre pre = {}; int it = bid_(); if (it < 2176) rec_issue<64, true>(p, it >> 2, it & 3, true, pre);
          for (; it < 2176; it += gridDim.x) { const RecPre cur = pre; const int nx = it + gridDim.x; if (nx < 2176) rec_issue<64, true>(p, nx >> 2, nx & 3, true, pre); rec_passC_item<64, true>(p, l, lds, it >> 2, it & 3, cur); } }
        { RecPre pre = {}; int it = bid_(); if (it < 2176) rec_issue<32, false>(p, it >> 2, it & 3, true, pre);
          for (; it < 2176; it += gridDim.x) { const RecPre cur = pre; const int nx = it + gridDim.x; if (nx < 2176) rec_issue<32, false>(p, nx >> 2, nx & 3, true, pre); rec_passC_item<32, false>(p, l, lds, it >> 2, it & 3, cur); } }
        phase_mlaout(p, l);
        gsync(p, lds);
        run_gemm(lds, H, (const bf16_t*)(W + WOFF_O), MT, 1024, 1024, EpiRes{XB, p.out, modl + 2048, 0});
        gsync(p, lds);
        phase_hrows<false>(p, l, nullptr, nullptr, p.in[11] + l * 1024, 3072, 4096);
        gsync(p, lds);
        run_gemm(lds, H, (const bf16_t*)(W + WOFF_FI), MT, 5632, 1024, EpiSwi{ACT});
        gsync(p, lds);
        run_gemm(lds, ACT, (const bf16_t*)(W + WOFF_FO), MT, 1024, 2816, EpiRes{XB, p.out, modl + 5120, l});
        if (l == 0) gsync(p, lds);
    }
}

extern "C" void kernel_launch(void* const* d_in, const int* in_sizes, int n_in, void* d_out, int out_size, void* d_ws, size_t ws_size, hipStream_t stream) {
    static int grid = 0;
    if (grid == 0) {
        int dev = 0, cus = 0, per_cu = 0;
        hipGetDevice(&dev);
        hipDeviceGetAttribute(&cus, hipDeviceAttributeMultiprocessorCount, dev);
        hipFuncSetAttribute((const void*)mk_fwd, hipFuncAttributeMaxDynamicSharedMemorySize, LDS_BYTES);
        hipOccupancyMaxActiveBlocksPerMultiprocessor(&per_cu, (const void*)mk_fwd, NT, LDS_BYTES);
        if (per_cu < 1) { fprintf(stderr, "kernel_launch: occupancy query says %d blocks per CU\n", per_cu); per_cu = 1; }
        (void)hipGetLastError();
        grid = cus;
        if (ws_size < WS_END) { fprintf(stderr, "kernel_launch: workspace too small: %zu < %zu\n", ws_size, (size_t)WS_END); grid = -1; }
    }
    if (grid < 0) return;
    if (hipMemsetAsync((char*)d_ws + OFF_BAR, 0, XCD_BAR_WORDS * 4, stream) != hipSuccess) { fprintf(stderr, "kernel_launch: memset failed\n"); return; }
    Params p{};
    for (int i = 0; i < 29; ++i) p.in[i] = (const float*)d_in[i];
    p.out = (float*)d_out; p.ws = (unsigned char*)d_ws;
    void* args[] = {&p};
    hipError_t e = hipLaunchCooperativeKernel((const void*)mk_fwd, dim3(grid), dim3(NT), args, LDS_BYTES, stream);
    if (e != hipSuccess) fprintf(stderr, "cooperative launch failed: %s (grid %d)\n", hipGetErrorString(e), grid);
}
```

```cpp
#include <hip/hip_runtime.h>
#include <hip/hip_cooperative_groups.h>
#include <cstdio>
namespace cg = cooperative_groups;
namespace pg8 {
#define PG8_LAS __attribute__((address_space(3)))
typedef unsigned short bf16_t;
typedef short bf16x8 __attribute__((ext_vector_type(8)));
typedef float f32x4 __attribute__((ext_vector_type(4)));
typedef unsigned u32x4 __attribute__((ext_vector_type(4)));
constexpr int BM = 256, BK = 64, HALF = 128, HTB = HALF * BK * 2  , STAGE_BYTES = 8 * HTB, NXCD = 8, WGM = 8;

__host__ __device__ __forceinline__ int lds_byte(int r, int c) { const int st = (r >> 4) * 2 + (c >> 5), rr = r & 15, cc = c & 31, ob = rr * 64 + cc * 2; return st * 1024 + (ob ^ (((ob >> 9) & 1) << 5)); }
__host__ __device__ __forceinline__ void stage_rc(int b, int& R, int& C) { const int st = b / 1024, sb = b % 1024, swz = sb ^ (((sb >> 9) & 1) << 5); R = (st >> 1) * 16 + swz / 64; C = (st & 1) * 32 + (swz % 64) / 2; }
__host__ __device__ __forceinline__ int perm32(int rho) { const int n = rho >> 4, i = rho & 15; return 8 * (i >> 2) + 4 * n + (i & 3); }

struct Unit { int pm, pn; };
struct Gemm { const bf16_t* A; const bf16_t* Bt; int M, N, K; };

struct StaticOrder {
    int nM, nN, nwg, G, c;
    __host__ __device__ void init(int M, int N, int G_, int c_) { nM = M / BM; nN = N / BM; nwg = nM * nN; G = G_; c = c_; }
    __host__ __device__ bool next(int i, Unit& u) const {
        const long L = (long)i * G + c; if (L >= nwg) return false;
        int wgid = (int)L; { const int q = nwg / NXCD, r = nwg % NXCD, xcd = wgid % NXCD, off = wgid / NXCD; wgid = (xcd < r ? xcd * (q + 1) : r * (q + 1) + (xcd - r) * q) + off; }
        const int nig = WGM * nN, gid = wgid / nig, fm = gid * WGM, gsz = (nM - fm) < WGM ? (nM - fm) : WGM;
        u.pm = fm + ((wgid % nig) % gsz); u.pn = (wgid % nig) / gsz; return true;
    }
    __device__ __forceinline__ void a_ready(const Unit&) const {}
    __device__ __forceinline__ void done(const Unit&) const {}
};
template <class Epi, class Sched, bool STAMP = false>
__device__ __forceinline__ void gemm_phase(PG8_LAS unsigned char* lds, const Gemm g, const Sched& S, const Epi& E, unsigned long long* stamps) {
    int tid = threadIdx.x; asm volatile("" : "+v"(tid)); const int wid = __builtin_amdgcn_readfirstlane(tid >> 6), lane = tid & 63, wr = wid >> 2, wc = wid & 3, fr = lane & 15, fq = lane >> 4;
    const int K = g.K, nt = K / BK;
    int ts_lo = 0, ts_hi = 0, nts = 0; const unsigned long long rt_entry = STAMP ? (unsigned long long)wall_clock64() : 0ull;
#define PG8_STAMP() do { if (STAMP && wid == 0 && nts < 64) { const unsigned long long _c = (unsigned long long)clock64(); \
        ts_lo = (lane == nts) ? (int)(unsigned)_c : ts_lo; ts_hi = (lane == nts) ? (int)(unsigned)(_c >> 32) : ts_hi; ++nts; } } while (0)
    PG8_STAMP();
    unsigned voffA[2], voffB[2];
#pragma unroll
    for (int i = 0; i < 2; ++i) { int R, C; stage_rc(tid * 16 + i * 8192, R, C); const int Rb = Epi::PERM ? ((R & ~31) + perm32(R & 31)) : R;
        voffA[i] = (unsigned)(R * K + C) * 2u; voffB[i] = (unsigned)(Rb * K + C) * 2u; }
    const size_t kstep = (size_t)(BK * 2);
    const size_t hstep = (size_t)HALF * K * 2;
    const size_t tstep = 2 * hstep;
    const unsigned ldsw = (unsigned)wid * 1024u;
    const int aoff = lds_byte(wr * 64 + fr, fq * 8), boff = lds_byte(wc * 32 + fr, fq * 8);
#define PG8_SA(b, h) (((b) * 2 + (h)) * HTB)
#define PG8_SB(b, h) ((4 + (b) * 2 + (h)) * HTB)
#define PG8_STAGE(bufoff, gbase, voff) do { _Pragma("unroll") for (int _i = 0; _i < 2; ++_i) \
        __builtin_amdgcn_global_load_lds((const unsigned*)((const char*)(gbase) + (voff)[_i]), (PG8_LAS unsigned*)(lds + (bufoff) + ldsw + _i * 8192), 16, 0, 0); } while (0)
#define PG8_LDA(dst, b, h) do { _Pragma("unroll") for (int m = 0; m < 4; ++m) _Pragma("unroll") for (int k = 0; k < 2; ++k) dst[m][k] = *(const PG8_LAS bf16x8*)(lds + PG8_SA(b, h) + aoff + m * 2048 + k * 1024); } while (0)
#define PG8_LDB(dst, b, h) do { _Pragma("unroll") for (int n = 0; n < 2; ++n) _Pragma("unroll") for (int k = 0; k < 2; ++k) dst[n][k] = *(const PG8_LAS bf16x8*)(lds + PG8_SB(b, h) + boff + n * 2048 + k * 1024); } while (0)
#define PG8_MMA(ai, bj, At, Bt) do { __builtin_amdgcn_s_setprio(1); _Pragma("unroll") for (int m = 0; m < 4; ++m) _Pragma("unroll") for (int n = 0; n < 2; ++n) _Pragma("unroll") for (int k = 0; k < 2; ++k) \
        acc[ai][bj][m][n] = __builtin_amdgcn_mfma_f32_16x16x32_bf16(Bt[n][k], At[m][k], acc[ai][bj][m][n], 0, 0, 0); __builtin_amdgcn_s_setprio(0); } while (0)
#define PG8_WAIT_V(n) asm volatile("s_waitcnt vmcnt(" #n ")" ::: "memory")
#define PG8_WAIT_L(n) asm volatile("s_waitcnt lgkmcnt(" #n ")" ::: "memory")
#define PG8_BAR __builtin_amdgcn_s_barrier()
#define PG8_SCHED __builtin_amdgcn_sched_barrier(0)
    Unit cur, nxt; int ui = 0;
    if (!S.next(0, cur)) return;
    f32x4 acc[2][2][4][2];
#pragma unroll
    for (int a = 0; a < 2; ++a)
#pragma unroll
        for (int b = 0; b < 2; ++b)
#pragma unroll
            for (int m = 0; m < 4; ++m)
#pragma unroll
                for (int n = 0; n < 2; ++n) acc[a][b][m][n] = (f32x4){0.f, 0.f, 0.f, 0.f};
    bf16x8 At[4][2], B0[2][2], B1[2][2];
    const char* cA = (const char*)g.A + (size_t)cur.pm * tstep; const char* cB = (const char*)g.Bt + (size_t)cur.pn * tstep;
    S.a_ready(cur);
    PG8_STAGE(PG8_SB(0, 0), cB, voffB); PG8_STAGE(PG8_SA(0, 0), cA, voffA); PG8_STAGE(PG8_SB(0, 1), cB + hstep, voffB); PG8_STAGE(PG8_SA(0, 1), cA + hstep, voffA);
    if (wr == 1) PG8_BAR;
    PG8_WAIT_V(4); PG8_BAR;
    PG8_STAGE(PG8_SB(1, 0), cB + kstep, voffB); PG8_STAGE(PG8_SA(1, 0), cA + kstep, voffA); PG8_STAGE(PG8_SB(1, 1), cB + hstep + kstep, voffB);
    PG8_WAIT_V(6); PG8_BAR;
    PG8_STAMP();
    for (;;) {
        const bool has_next = S.next(ui + 1, nxt);
        const char* nA = has_next ? (const char*)g.A + (size_t)nxt.pm * tstep : cA; const char* nB = has_next ? (const char*)g.Bt + (size_t)nxt.pn * tstep : cB;
        for (int t = 0; t < nt; t += 2) {
            const bool last = (t == nt - 2);
            const char* a1 = cA + (size_t)(t + 1) * kstep;
            const char* a2 = last ? nA : cA + (size_t)(t + 2) * kstep; const char* b2 = last ? nB : cB + (size_t)(t + 2) * kstep;
            const char* a3 = a2 + kstep; const char* b3 = b2 + kstep;
            if (last && has_next) S.a_ready(nxt);
            PG8_LDB(B0, 0, 0); PG8_SCHED; PG8_LDA(At, 0, 0); PG8_STAGE(PG8_SA(1, 1), a1 + hstep, voffA);
            PG8_WAIT_L(8); PG8_BAR; PG8_WAIT_L(0); PG8_MMA(0, 0, At, B0); PG8_BAR; PG8_SCHED;
            PG8_LDB(B1, 0, 1); PG8_STAGE(PG8_SB(0, 0), b2, voffB);
            PG8_BAR; PG8_WAIT_L(0); PG8_MMA(0, 1, At, B1); PG8_BAR;
            PG8_LDA(At, 0, 1); PG8_STAGE(PG8_SA(0, 0), a2, voffA);
            PG8_BAR; PG8_WAIT_L(0); PG8_MMA(1, 0, At, B0); PG8_BAR; PG8_SCHED;
            PG8_STAGE(PG8_SB(0, 1), b2 + hstep, voffB);
            PG8_WAIT_V(6); PG8_BAR; PG8_MMA(1, 1, At, B1); PG8_BAR;
            PG8_LDB(B0, 1, 0); PG8_SCHED; PG8_LDA(At, 1, 0); PG8_STAGE(PG8_SA(0, 1), a2 + hstep, voffA);
            PG8_WAIT_L(8); PG8_BAR; PG8_WAIT_L(0); PG8_MMA(0, 0, At, B0); PG8_BAR; PG8_SCHED;
            PG8_LDB(B1, 1, 1); PG8_STAGE(PG8_SB(1, 0), b3, voffB);
            PG8_BAR; PG8_WAIT_L(0); PG8_MMA(0, 1, At, B1); PG8_BAR;
            PG8_LDA(At, 1, 1); PG8_STAGE(PG8_SA(1, 0), a3, voffA);
            PG8_BAR; PG8_WAIT_L(0); PG8_MMA(1, 0, At, B0); PG8_BAR; PG8_SCHED;
            PG8_STAGE(PG8_SB(1, 1), b3 + hstep, voffB);
            PG8_WAIT_V(6); PG8_BAR; PG8_MMA(1, 1, At, B1); PG8_BAR;
        }
        PG8_STAMP();
        if constexpr (!Epi::AFTER_DRAIN) { E(acc, cur, wr, wc, fr, fq); S.done(cur); }
        PG8_STAMP();
        if (!has_next) break;
#pragma unroll
        for (int a = 0; a < 2; ++a)
#pragma unroll
            for (int b = 0; b < 2; ++b)
#pragma unroll
                for (int m = 0; m < 4; ++m)
#pragma unroll
                    for (int n = 0; n < 2; ++n) acc[a][b][m][n] = (f32x4){0.f, 0.f, 0.f, 0.f};
        cur = nxt; cA = nA; cB = nB; ++ui;
    }
    PG8_WAIT_V(0);
    if (wr == 0) PG8_BAR;
    PG8_BAR;
    if constexpr (Epi::AFTER_DRAIN) { E.fused(acc, cur, wr, wc, fr, fq, lds, wid, lane); S.done(cur); }
    PG8_STAMP();
    if (STAMP && wid == 0) { stamps[lane] = lane < nts ? (((unsigned long long)(unsigned)ts_hi << 32) | (unsigned)ts_lo) : 0ull;
        if (lane == 62) stamps[62] = rt_entry; if (lane == 63) stamps[63] = (unsigned long long)wall_clock64(); }
#undef PG8_STAMP
#undef PG8_SA
#undef PG8_SB
#undef PG8_STAGE
#undef PG8_LDA
#undef PG8_LDB
#undef PG8_MMA
#undef PG8_WAIT_V
#undef PG8_WAIT_L
#undef PG8_BAR
#undef PG8_SCHED
}
}
#define XB_TMO      128
#define XB_XCNT(j)  (256  + 64 * (j))
#define XB_XSUB(j)  (1280 + 64 * (j))
#define XB_XGEN(j)  (2304 + 64 * (j))
#define XB_TOP      3328
#define XB_TOPGEN   3392
#define XCD_BAR_WORDS 3456
#define XB_SPIN_CAP (1u << 22)

__device__ __forceinline__ unsigned xb_ld(unsigned* p)              { return __hip_atomic_load(p, __ATOMIC_RELAXED, __HIP_MEMORY_SCOPE_AGENT); }
__device__ __forceinline__ unsigned xb_add(unsigned* p, unsigned v) { return __hip_atomic_fetch_add(p, v, __ATOMIC_RELAXED, __HIP_MEMORY_SCOPE_AGENT); }
__device__ __forceinline__ unsigned xb_xcc_id() { return (unsigned)__builtin_amdgcn_s_getreg((3 << 11) | 20) & 0xFu; }
#define XB_SPIN(cond, bar) do { unsigned _sp = 0; while (cond) { __builtin_amdgcn_s_sleep(1); \
    if ((++_sp & 255u) == 0u) { if (xb_ld(&(bar)[XB_TMO])) break; if (_sp > XB_SPIN_CAP) { atomicAdd(&(bar)[XB_TMO], 1u); break; } } } } while (0)

struct XcdBarrier {
    unsigned* bar; unsigned x;
    volatile PG8_LAS unsigned* st;
};

__device__ __forceinline__ XcdBarrier xcd_barrier_post(unsigned* bar, volatile PG8_LAS unsigned* st) {
    XcdBarrier b; b.bar = bar; b.x = xb_xcc_id(); b.st = st;
    if (threadIdx.x == 0) (void)xb_add(&bar[XB_XCNT(b.x)], 1u);
    return b;
}
__device__ __forceinline__ void xcd_barrier_complete(unsigned* bar, unsigned x, unsigned& nloc, unsigned& nx) {
    const unsigned G = gridDim.x * gridDim.y * gridDim.z;
    unsigned sum, cnt, mine, sp = 0u;
    for (;;) {
        sum = 0u; cnt = 0u; mine = 0u;
#pragma unroll
        for (unsigned j = 0; j < 16; ++j) { const unsigned c = xb_ld(&bar[XB_XCNT(j)]); sum += c; cnt += (c > 0u) ? 1u : 0u; mine = (j == x) ? c : mine; }
        if (sum == G) break;
        __builtin_amdgcn_s_sleep(1);
        if ((++sp & 255u) == 0u) { if (xb_ld(&bar[XB_TMO])) break; if (sp > XB_SPIN_CAP) { atomicAdd(&bar[XB_TMO], 1u); break; } }
    }
    nloc = mine > 0u ? mine : 1u; nx = cnt > 0u ? cnt : 1u;
}

__device__ __forceinline__ void xcd_barrier(const XcdBarrier& b) {
    asm volatile("s_waitcnt vmcnt(0)" ::: "memory");
    __syncthreads();
    if (threadIdx.x == 0) {
        unsigned* bar = b.bar;
        __builtin_amdgcn_s_waitcnt(0);
        unsigned nloc = b.st[0], nx = b.st[1];
        if (nloc == 0u) { xcd_barrier_complete(bar, b.x, nloc, nx); b.st[0] = nloc; b.st[1] = nx; }
        const unsigned old = xb_add(&bar[XB_XSUB(b.x)], 1u);
        const unsigned gen = old / nloc;
        if (old + 1u == (gen + 1u) * nloc) {
            __builtin_amdgcn_fence(__ATOMIC_RELEASE, "agent");
            asm volatile("s_waitcnt vmcnt(0)" ::: "memory");
            const unsigned og = xb_add(&bar[XB_TOP], 1u);
            const unsigned tg = og / nx;
            if (og + 1u == (tg + 1u) * nx) xb_add(&bar[XB_TOPGEN], 1u);
            else XB_SPIN(xb_ld(&bar[XB_TOPGEN]) == tg, bar);
            __builtin_amdgcn_fence(__ATOMIC_ACQUIRE, "agent");
            xb_add(&bar[XB_XGEN(b.x)], 1u);
            asm volatile("s_waitcnt vmcnt(0)" ::: "memory");
        } else {
            XB_SPIN(xb_ld(&bar[XB_XGEN(b.x)]) == gen, bar);
            __builtin_amdgcn_fence(__ATOMIC_ACQUIRE, "agent");
            asm volatile("s_waitcnt vmcnt(0)" ::: "memory");
        }
    }
    __syncthreads();
}

using namespace pg8;
typedef float f32x16 __attribute__((ext_vector_type(16)));
typedef unsigned u32x2 __attribute__((ext_vector_type(2)));
#define LAS PG8_LAS
#define DI __device__ __forceinline__

constexpr int NT = 512;
constexpr int MP = 32768, MS = 2048, MT = MP + MS;
constexpr int KEYS_S = 4352;
constexpr int KR_ROWS = MP + 32 * KEYS_S;
constexpr int ZLD = 2560;
constexpr float EPS = 1e-6f;
constexpr float QSCALE = 0.10206207261596577f * 1.4426950408889634f;
constexpr int LDS_BYTES = 160 * 1024;

constexpr size_t SZ_WIN = 2560ull * 1024 * 2, SZ_WUQ = 768ull * 256 * 2, SZ_WUK = 512ull * 256 * 2, SZ_WUV = 512ull * 256 * 2,
                 SZ_WO = 1024ull * 1024 * 2, SZ_WFI = 5632ull * 1024 * 2, SZ_WFO = 1024ull * 2816 * 2;
constexpr size_t WOFF_IN = 0, WOFF_UQ = WOFF_IN + SZ_WIN, WOFF_UK = WOFF_UQ + SZ_WUQ, WOFF_UV = WOFF_UK + SZ_WUK, WOFF_O = WOFF_UV + SZ_WUV,
                 WOFF_FI = WOFF_O + SZ_WO, WOFF_FO = WOFF_FI + SZ_WFI, WL = WOFF_FO + SZ_WFO;
constexpr size_t OFF_W = 0;
constexpr size_t OFF_MOD = OFF_W + 2 * WL;
constexpr size_t OFF_ROPE = OFF_MOD + 2ull * 36 * 6144 * 4;
constexpr size_t OFF_H = OFF_ROPE + 8192ull * 16 * 2 * 4;
constexpr size_t OFF_Z = OFF_H + (size_t)MT * 1024 * 2;
constexpr size_t OFF_CQN = OFF_Z + (size_t)MT * ZLD * 2;
constexpr size_t OFF_CKV = OFF_CQN + (size_t)MT * 256 * 2;
constexpr size_t OFF_KROPE = OFF_CKV + (size_t)KR_ROWS * 256 * 2;
constexpr size_t OFF_Q = OFF_KROPE + (size_t)KR_ROWS * 32 * 2;
constexpr size_t OFF_KN = OFF_Q + (size_t)MT * 768 * 2;
constexpr size_t OFF_VT = OFF_KN + (size_t)KR_ROWS * 512 * 2;
constexpr size_t OFF_O = OFF_VT + (size_t)KR_ROWS * 512 * 2;
constexpr size_t OFF_PART = OFF_O + (size_t)MP * 512 * 2;
constexpr size_t OFF_UHG = OFF_PART + 32ull * 8 * 4 * 64 * 66 * 4;
constexpr size_t OFF_DHG = OFF_UHG + 544ull * 4 * 64 * 64 * 4;
constexpr size_t OFF_UGL = OFF_DHG + 544ull * 4 * 64 * 4;
constexpr size_t OFF_DGL = OFF_UGL + 544ull * 4 * 32 * 64 * 4;
constexpr size_t OFF_BAR = OFF_DGL + 544ull * 4 * 32 * 4;
constexpr size_t OFF_XB = OFF_BAR + 16384;
constexpr size_t WS_END = OFF_XB + (size_t)MT * 1024 * 2;
constexpr size_t OFF_ACT = OFF_KN;
static_assert((size_t)MT * 2816 * 2 <= 2 * (size_t)KR_ROWS * 512 * 2, "act alias");

constexpr size_t OUT_Y = 0, OUT_CKVP = 35651584, OUT_KRP = 52428800, OUT_HGP = 54525952, OUT_GLP = 54657024,
                 OUT_CKVS = 54722560, OUT_KRS = 55771136, OUT_HGS = 55902208, OUT_GLS = 56950784;

DI int tid_() { int t = threadIdx.x; asm volatile("" : "+v"(t)); return t; }
DI int bid_() { int b = blockIdx.x; asm volatile("" : "+s"(b)); return b; }
DI float neg_big() { float v = -1e30f; asm volatile("" : "+v"(v)); return v; }
struct Params { const float* in[29]; float* out; unsigned char* ws; };

typedef __bf16 hbf2 __attribute__((ext_vector_type(2)));
typedef float f32x2_ __attribute__((ext_vector_type(2)));
DI unsigned pack2(float a, float b) { f32x2_ v = {a, b}; return __builtin_bit_cast(unsigned, __builtin_convertvector(v, hbf2)); }
DI bf16_t f2bf(float f) { return (bf16_t)(pack2(f, f) & 0xFFFFu); }
DI float bf2f(bf16_t b) { return __uint_as_float(((unsigned)b) << 16); }
DI float bflo(unsigned u) { return __uint_as_float(u << 16); }
DI float bfhi(unsigned u) { return __uint_as_float(u & 0xFFFF0000u); }
DI float wave_sum(float v) { v += __shfl_xor(v, 32); v += __shfl_xor(v, 16); v += __shfl_xor(v, 8); v += __shfl_xor(v, 4); v += __shfl_xor(v, 2); v += __shfl_xor(v, 1); return v; }
DI float sigmoidf_(float x) { return 1.f / (1.f + expf(-x)); }
DI int row_bi(int row) { return row < MP ? (row >> 13) : 4 + ((row - MP) >> 6); }

struct EpiZ {
    static constexpr bool PERM = true, AFTER_DRAIN = false;
    bf16_t* O; int ldc;
    DI void operator()(const f32x4 (&acc)[2][2][4][2], const Unit& u, int wr, int wc, int fr, int fq) const {
        const int row0 = u.pm * 256 + wr * 64 + fr, col0 = u.pn * 256 + wc * 32 + 8 * fq;
#pragma unroll
        for (int ai = 0; ai < 2; ++ai)
#pragma unroll
            for (int m = 0; m < 4; ++m) { bf16_t* rowp = O + (size_t)(row0 + ai * 128 + m * 16) * ldc + col0;
#pragma unroll
                for (int bj = 0; bj < 2; ++bj) { const f32x4 v0 = acc[ai][bj][m][0], v1 = acc[ai][bj][m][1]; uint4 w; w.x = pack2(v0[0], v0[1]); w.y = pack2(v0[2], v0[3]); w.z = pack2(v1[0], v1[1]); w.w = pack2(v1[2], v1[3]); *(uint4*)(rowp + bj * 128) = w; } }
    }
};
struct EpiQ {
    static constexpr bool PERM = false, AFTER_DRAIN = false;
    bf16_t* Q; const float* qn_; const float* rope_;
    DI void operator()(const f32x4 (&acc)[2][2][4][2], const Unit& u, int wr, int wc, int fr, int fq) const {
        const float* qn = qn_; const float* rope = rope_; asm volatile("" : "+s"(qn), "+s"(rope));
        float eps_ = EPS; asm volatile("" : "+v"(eps_));
        const int row0 = u.pm * 256 + wr * 64 + fr;
#pragma unroll
        for (int ai = 0; ai < 2; ++ai)
#pragma unroll
            for (int m = 0; m < 4; ++m) {
                const int row = row0 + ai * 128 + m * 16;
                int pos; size_t base, hs;
                if (row < MP) { const int b = row >> 13, t = row & 8191; pos = t; base = ((size_t)(b * 8) * 8192 + t) * 96; hs = 8192 * 96; }
                else { const int r = row - MP, b = r >> 6, t = r & 63; pos = 4096 + t; base = (size_t)MP * 768 + ((size_t)(b * 8) * 64 + t) * 96; hs = 64 * 96; }
                if (u.pn < 2) {
                    const int head = 4 * u.pn + wc;
                    float ss = 0.f;
#pragma unroll
                    for (int bj = 0; bj < 2; ++bj)
#pragma unroll
                        for (int n = 0; n < 2; ++n) { const f32x4 v = acc[ai][bj][m][n]; ss += v[0] * v[0] + v[1] * v[1] + v[2] * v[2] + v[3] * v[3]; }
                    ss += __shfl_xor(ss, 16); ss += __shfl_xor(ss, 32);
                    const float rs = rsqrtf(ss * (1.f / 64.f) + eps_) * QSCALE;
#pragma unroll
                    for (int bj = 0; bj < 2; ++bj)
#pragma unroll
                        for (int n = 0; n < 2; ++n) { const int d = 32 * bj + 16 * n + 4 * fq; const f32x4 v = acc[ai][bj][m][n]; const float4 g = *(const float4*)(qn + d);
                            uint2 w; w.x = pack2(v[0] * rs * g.x, v[1] * rs * g.y); w.y = pack2(v[2] * rs * g.z, v[3] * rs * g.w); *(uint2*)(Q + base + head * hs + d) = w; }
                } else {
#pragma unroll
                    for (int bj = 0; bj < 2; ++bj) {
                        const int head = 2 * wc + bj;
                        const f32x4 v1 = acc[ai][bj][m][0], v2 = acc[ai][bj][m][1];
                        float ss = v1[0] * v1[0] + v1[1] * v1[1] + v1[2] * v1[2] + v1[3] * v1[3] + v2[0] * v2[0] + v2[1] * v2[1] + v2[2] * v2[2] + v2[3] * v2[3];
                        ss += __shfl_xor(ss, 16); ss += __shfl_xor(ss, 32);
                        const float rs = rsqrtf(ss * (1.f / 32.f) + eps_);
                        const float4 g1 = *(const float4*)(qn + 64 + 4 * fq), g2 = *(const float4*)(qn + 80 + 4 * fq);
                        const float4 cs0 = *(const float4*)(rope + ((size_t)pos * 16 + 4 * fq) * 2), cs1 = *(const float4*)(rope + ((size_t)pos * 16 + 4 * fq) * 2 + 4);
                        const float x10 = v1[0] * rs * g1.x, x11 = v1[1] * rs * g1.y, x12 = v1[2] * rs * g1.z, x13 = v1[3] * rs * g1.w;
                        const float x20 = v2[0] * rs * g2.x, x21 = v2[1] * rs * g2.y, x22 = v2[2] * rs * g2.z, x23 = v2[3] * rs * g2.w;
                        uint2 w1, w2;
                        w1.x = pack2((x10 * cs0.x - x20 * cs0.y) * QSCALE, (x11 * cs0.z - x21 * cs0.w) * QSCALE);
                        w1.y = pack2((x12 * cs1.x - x22 * cs1.y) * QSCALE, (x13 * cs1.z - x23 * cs1.w) * QSCALE);
                        w2.x = pack2((x20 * cs0.x + x10 * cs0.y) * QSCALE, (x21 * cs0.z + x11 * cs0.w) * QSCALE);
                        w2.y = pack2((x22 * cs1.x + x12 * cs1.y) * QSCALE, (x23 * cs1.z + x13 * cs1.w) * QSCALE);
                        *(uint2*)(Q + base + head * hs + 64 + 4 * fq) = w1; *(uint2*)(Q + base + head * hs + 80 + 4 * fq) = w2;
                    }
                }
            }
    }
};
struct EpiKN {
    static constexpr bool PERM = true, AFTER_DRAIN = false;
    bf16_t* KN; const float* kn_;
    DI void operator()(const f32x4 (&acc)[2][2][4][2], const Unit& u, int wr, int wc, int fr, int fq) const {
        const float* kn = kn_; asm volatile("" : "+s"(kn));
        float eps_ = EPS; asm volatile("" : "+v"(eps_));
        float4 gk[2][2];
#pragma unroll
        for (int bj = 0; bj < 2; ++bj)
#pragma unroll
            for (int n = 0; n < 2; ++n) gk[bj][n] = *(const float4*)(kn + 32 * bj + 8 * fq + 4 * n);
        size_t base, hs;
        if (u.pm < 128) { const int b = u.pm >> 5, key0 = (u.pm & 31) * 256; base = ((size_t)(b * 8) * 8192 + key0) * 64; hs = (size_t)8192 * 64; }
        else { const int q = u.pm - 128, b = q / 17, key0 = (q % 17) * 256; base = (size_t)MP * 512 + ((size_t)(b * 8) * KEYS_S + key0) * 64; hs = (size_t)KEYS_S * 64; }
        const int head = 4 * u.pn + wc;
#pragma unroll
        for (int ai = 0; ai < 2; ++ai)
#pragma unroll
            for (int m = 0; m < 4; ++m) {
                const int key = 128 * ai + 64 * wr + 16 * m + fr;
                float ss = 0.f;
#pragma unroll
                for (int bj = 0; bj < 2; ++bj)
#pragma unroll
                    for (int n = 0; n < 2; ++n) { const f32x4 v = acc[ai][bj][m][n]; ss += v[0] * v[0] + v[1] * v[1] + v[2] * v[2] + v[3] * v[3]; }
                ss += __shfl_xor(ss, 16); ss += __shfl_xor(ss, 32);
                const float rs = rsqrtf(ss * (1.f / 64.f) + eps_);
#pragma unroll
                for (int bj = 0; bj < 2; ++bj) { const f32x4 v0 = acc[ai][bj][m][0], v1 = acc[ai][bj][m][1]; const float4 g0 = gk[bj][0], g1 = gk[bj][1];
                    uint4 w; w.x = pack2(v0[0] * rs * g0.x, v0[1] * rs * g0.y); w.y = pack2(v0[2] * rs * g0.z, v0[3] * rs * g0.w); w.z = pack2(v1[0] * rs * g1.x, v1[1] * rs * g1.y); w.w = pack2(v1[2] * rs * g1.z, v1[3] * rs * g1.w);
                    *(uint4*)(KN + base + head * hs + (size_t)key * 64 + 32 * bj + 8 * fq) = w; }
            }
    }
};
struct EpiVT {
    static constexpr bool PERM = true, AFTER_DRAIN = false;
    bf16_t* VT;
    DI void operator()(const f32x4 (&acc)[2][2][4][2], const Unit& u, int wr, int wc, int fr, int fq) const {
        size_t base; int KL;
        if (u.pn < 128) { const int b = u.pn >> 5, key0 = (u.pn & 31) * 256; base = (size_t)(b * 8) * 64 * 8192 + key0; KL = 8192; }
        else { const int q = u.pn - 128, b = q / 17, key0 = (q % 17) * 256; base = (size_t)MP * 512 + (size_t)(b * 8) * 64 * KEYS_S + key0; KL = KEYS_S; }
#pragma unroll
        for (int ai = 0; ai < 2; ++ai)
#pragma unroll
            for (int m = 0; m < 4; ++m) {
                const int r = 256 * u.pm + 128 * ai + 64 * wr + 16 * m + fr;
                bf16_t* rowp = VT + base + (size_t)r * KL + 32 * wc + 8 * fq;
#pragma unroll
                for (int bj = 0; bj < 2; ++bj) { const f32x4 v0 = acc[ai][bj][m][0], v1 = acc[ai][bj][m][1]; uint4 w; w.x = pack2(v0[0], v0[1]); w.y = pack2(v0[2], v0[3]); w.z = pack2(v1[0], v1[1]); w.w = pack2(v1[2], v1[3]); *(uint4*)(rowp + 128 * bj) = w; }
            }
    }
};
struct EpiRes {
    static constexpr bool PERM = false, AFTER_DRAIN = false;
    bf16_t* XB; float* out; const float* gate; int final;
    DI void operator()(const f32x4 (&acc)[2][2][4][2], const Unit& u, int wr, int wc, int fr, int fq) const {
        const int row0 = u.pm * 256 + wr * 64 + fr, col0 = u.pn * 256 + wc * 32 + 4 * fq;
#pragma unroll
        for (int ai = 0; ai < 2; ++ai) {
            const float* gr = gate + (size_t)row_bi(row0 + ai * 128) * 6144 + col0;
            f32x4 g[2][2]; uint2 x[4][2][2];
#pragma unroll
            for (int bj = 0; bj < 2; ++bj)
#pragma unroll
                for (int n = 0; n < 2; ++n) g[bj][n] = *(const f32x4*)(gr + bj * 128 + n * 16);
#pragma unroll
            for (int m = 0; m < 4; ++m) { const bf16_t* xr = XB + (size_t)(row0 + ai * 128 + m * 16) * 1024 + col0;
#pragma unroll
                for (int bj = 0; bj < 2; ++bj)
#pragma unroll
                    for (int n = 0; n < 2; ++n) x[m][bj][n] = *(const uint2*)(xr + bj * 128 + n * 16); }
#pragma unroll
            for (int m = 0; m < 4; ++m) { const size_t ro = (size_t)(row0 + ai * 128 + m * 16) * 1024 + col0;
#pragma unroll
                for (int bj = 0; bj < 2; ++bj)
#pragma unroll
                    for (int n = 0; n < 2; ++n) { const uint2 xv = x[m][bj][n]; const f32x4 xf = {bflo(xv.x), bfhi(xv.x), bflo(xv.y), bfhi(xv.y)}; const f32x4 r = xf + g[bj][n] * acc[ai][bj][m][n];
                        if (final) *(f32x4*)(out + ro + bj * 128 + n * 16) = r;
                        else { uint2 w; w.x = pack2(r[0], r[1]); w.y = pack2(r[2], r[3]); *(uint2*)(XB + ro + bj * 128 + n * 16) = w; } } }
        }
    }
};
struct EpiSwi {
    static constexpr bool PERM = true, AFTER_DRAIN = false;
    bf16_t* ACT;
    DI void operator()(const f32x4 (&acc)[2][2][4][2], const Unit& u, int wr, int wc, int fr, int fq) const {
        const int row0 = u.pm * 256 + wr * 64 + fr, col0 = u.pn * 128 + wc * 32 + 8 * fq;
#pragma unroll
        for (int ai = 0; ai < 2; ++ai)
#pragma unroll
            for (int m = 0; m < 4; ++m) { bf16_t* rowp = ACT + (size_t)(row0 + ai * 128 + m * 16) * 2816 + col0; float r[8];
#pragma unroll
                for (int n = 0; n < 2; ++n) { const f32x4 a = acc[ai][0][m][n], g = acc[ai][1][m][n];
#pragma unroll
                    for (int j = 0; j < 4; ++j) r[4 * n + j] = a[j] / (1.f + __expf(-a[j])) * g[j]; }
                uint4 w; w.x = pack2(r[0], r[1]); w.y = pack2(r[2], r[3]); w.z = pack2(r[4], r[5]); w.w = pack2(r[6], r[7]); *(uint4*)rowp = w; }
    }
};
template <class Epi> DI void run_gemm(LAS unsigned char* lds, const bf16_t* A, const bf16_t* Bt, int M, int N, int K, const Epi& E) {
    asm volatile("" : "+s"(M), "+s"(N), "+s"(K));
    Gemm g{A, Bt, M, N, K}; StaticOrder S; S.init(M, N, (int)gridDim.x, (int)bid_());
    gemm_phase<Epi, StaticOrder, false>(lds, g, S, E, nullptr);
}

DI int colmap(int w, int n) {
    if (w == 0) return n < 2352 ? n : -1;
    if (w == 1) { const int pn = n >> 8, c = n & 255, bj = c >> 7, wc = (c >> 5) & 3, cc = c & 31; return pn < 2 ? (4 * pn + wc) * 96 + 32 * bj + cc : (2 * wc + bj) * 96 + 64 + cc; }
    if (w == 2) { const int pn = n >> 8, c = n & 255, bj = c >> 7, wc = (c >> 5) & 3, cc = c & 31; return (4 * pn + wc) * 64 + 32 * bj + cc; }
    if (w == 5) { const int pn = n >> 8, c = n & 255; return c < 128 ? 128 * pn + c : 2816 + 128 * pn + (c - 128); }
    return n;
}
DI void phase_prep(const Params& p, LAS unsigned char* lds) {
    const int tid = tid_();
    LAS bf16_t* T = (LAS bf16_t*)lds;
    for (int ti = bid_(); ti < 2 * 1560; ti += gridDim.x) {
        const int l = ti / 1560, r = ti % 1560;
        int w, t0, K, ld; size_t doff; const float* src;
        if (r < 320) { w = 0; t0 = 0; K = 1024; ld = 2352; doff = WOFF_IN; src = p.in[12]; }
        else if (r < 344) { w = 1; t0 = 320; K = 256; ld = 768; doff = WOFF_UQ; src = p.in[15]; }
        else if (r < 360) { w = 2; t0 = 344; K = 256; ld = 512; doff = WOFF_UK; src = p.in[16]; }
        else if (r < 376) { w = 3; t0 = 360; K = 256; ld = 512; doff = WOFF_UV; src = p.in[17]; }
        else if (r < 504) { w = 4; t0 = 376; K = 1024; ld = 1024; doff = WOFF_O; src = p.in[26]; }
        else if (r < 1208) { w = 5; t0 = 504; K = 1024; ld = 5632; doff = WOFF_FI; src = p.in[27]; }
        else { w = 6; t0 = 1208; K = 2816; ld = 1024; doff = WOFF_FO; src = p.in[28]; }
        src += (size_t)l * K * ld;
        const int kt = K >> 7, tr = r - t0, n0 = (tr / kt) * 64, k0 = (tr % kt) * 128;
        bf16_t* dst = (bf16_t*)(p.ws + OFF_W + (size_t)l * WL + doff);
        const int nn = tid & 63, col = colmap(w, n0 + nn);
        float tv[16];
#pragma unroll
        for (int i = 0; i < 16; ++i) { const int kk = (tid >> 6) + 8 * i; tv[i] = col >= 0 ? src[(size_t)(k0 + kk) * ld + col] : 0.f; }
#pragma unroll
        for (int i = 0; i < 16; ++i) { const int kk = (tid >> 6) + 8 * i; T[nn * 130 + kk] = f2bf(tv[i]); }
        __syncthreads();
#pragma unroll
        for (int j = 0; j < 2; ++j) { const int q = tid + 512 * j, row = q >> 4, seg = q & 15; const LAS unsigned* tp = (const LAS unsigned*)(T + row * 130 + seg * 8);
          uint4 o; o.x = tp[0]; o.y = tp[1]; o.z = tp[2]; o.w = tp[3]; *(uint4*)(dst + (size_t)(n0 + row) * K + k0 + seg * 8) = o; }
        __syncthreads();
    }
    float* mod = (float*)(p.ws + OFF_MOD);
    for (int it = bid_(); it < 192; it += gridDim.x) {
        const int l = it / 96, cgp = it % 96;
        LAS float* sl = (LAS float*)lds;
        for (int i = tid; i < 36 * 1024; i += NT) { const int bi = i >> 10, k = i & 1023; const float c = bi < 4 ? p.in[2][bi * 1024 + k] : p.in[3][(bi - 4) * 1024 + k]; sl[i] = c / (1.f + expf(-c)); }
        __syncthreads();
        const int cl = tid & 63, kq = tid >> 6;
        float acc[36];
#pragma unroll
        for (int bi = 0; bi < 36; ++bi) acc[bi] = 0.f;
        const float* wm = p.in[8] + (size_t)l * 1024 * 6144 + cgp * 64 + cl;
#pragma unroll 4
        for (int k = kq * 128; k < kq * 128 + 128; k += 4) {
            const float w0 = wm[(size_t)k * 6144], w1 = wm[(size_t)(k + 1) * 6144], w2 = wm[(size_t)(k + 2) * 6144], w3 = wm[(size_t)(k + 3) * 6144];
#pragma unroll
            for (int bi = 0; bi < 36; ++bi) { const f32x4 s = *(const LAS f32x4*)(sl + bi * 1024 + k); acc[bi] += s[0] * w0 + s[1] * w1 + s[2] * w2 + s[3] * w3; }
        }
        __syncthreads();
        LAS float* red = (LAS float*)lds;
#pragma unroll
        for (int bi = 0; bi < 36; ++bi) red[(kq * 36 + bi) * 64 + cl] = acc[bi];
        __syncthreads();
        for (int o = tid; o < 36 * 64; o += NT) { const int bi = o >> 6, c = o & 63; float s = 0.f;
#pragma unroll
            for (int q = 0; q < 8; ++q) s += red[(q * 36 + bi) * 64 + c];
            const int colg = cgp * 64 + c; mod[((size_t)l * 36 + bi) * 6144 + colg] = s + p.in[9][l * 6144 + colg]; }
        __syncthreads();
    }
    float* rope = (float*)(p.ws + OFF_ROPE);
    for (int i = bid_() * NT + tid; i < 8192 * 16; i += gridDim.x * NT) { const int pos = i >> 4, j = i & 15;
        const float inv = exp2f(-(float)j * (13.287712379549449f / 16.f)); const float ang = (float)pos * inv; rope[2 * i] = cosf(ang); rope[2 * i + 1] = sinf(ang); }
}

template <bool FROM_INPUT>
DI void phase_hrows(const Params& p, int l, const float* xa, const float* xb, const float* g, int shoff, int scoff) {
    const int tid = tid_(), lane = tid & 63, wid = __builtin_amdgcn_readfirstlane(tid >> 6);
    const float* mod = (const float*)(p.ws + OFF_MOD) + (size_t)l * 36 * 6144;
    bf16_t* H = (bf16_t*)(p.ws + OFF_H); bf16_t* XB = (bf16_t*)(p.ws + OFF_XB);
    const int stride = gridDim.x * 8;
    int row = bid_() * 8 + wid;
    float4 v[4];
#define HR_LOAD(dst, rr) do { if (FROM_INPUT) { const float* xr_ = (rr) < MP ? xa + (size_t)(rr) * 1024 : xb + (size_t)((rr) - MP) * 1024; \
            _Pragma("unroll") for (int i = 0; i < 4; ++i) dst[i] = *(const float4*)(xr_ + i * 256 + lane * 4); } \
        else { const bf16_t* xr_ = XB + (size_t)(rr) * 1024; \
            _Pragma("unroll") for (int i = 0; i < 4; ++i) { const uint2 u_ = *(const uint2*)(xr_ + i * 256 + lane * 4); dst[i].x = bflo(u_.x); dst[i].y = bfhi(u_.x); dst[i].z = bflo(u_.y); dst[i].w = bfhi(u_.y); } } } while (0)
    if (row < MT) HR_LOAD(v, row);
    while (row < MT) {
        const int nrow = row + stride; float4 nv[4];
        if (nrow < MT) HR_LOAD(nv, nrow);
        float ss = 0.f;
#pragma unroll
        for (int i = 0; i < 4; ++i) ss += v[i].x * v[i].x + v[i].y * v[i].y + v[i].z * v[i].z + v[i].w * v[i].w;
        ss = wave_sum(ss);
        const float rs = rsqrtf(ss * (1.f / 1024.f) + EPS);
        const float* mp = mod + (size_t)row_bi(row) * 6144;
#pragma unroll
        for (int i = 0; i < 4; ++i) { const int col = i * 256 + lane * 4;
            const float4 gg = *(const float4*)(g + col), sc = *(const float4*)(mp + scoff + col), sh = *(const float4*)(mp + shoff + col);
            uint2 w; w.x = pack2(v[i].x * rs * gg.x * (1.f + sc.x) + sh.x, v[i].y * rs * gg.y * (1.f + sc.y) + sh.y);
            w.y = pack2(v[i].z * rs * gg.z * (1.f + sc.z) + sh.z, v[i].w * rs * gg.w * (1.f + sc.w) + sh.w);
            *(uint2*)(H + (size_t)row * 1024 + col) = w;
            if (FROM_INPUT) { uint2 xw; xw.x = pack2(v[i].x, v[i].y); xw.y = pack2(v[i].z, v[i].w); *(uint2*)(XB + (size_t)row * 1024 + col) = xw; } }
#pragma unroll
        for (int i = 0; i < 4; ++i) v[i] = nv[i];
        row = nrow;
    }
#undef HR_LOAD
}
DI void phase_cache(const Params& p, int l) {
    const size_t gt = (size_t)bid_() * NT + tid_(), gs = (size_t)gridDim.x * NT;
    bf16_t* ckv_s = (bf16_t*)(p.ws + OFF_CKV) + (size_t)MP * 256;
    bf16_t* kr_s = (bf16_t*)(p.ws + OFF_KROPE) + (size_t)MP * 32;
    const float4* s1 = (const float4*)(p.in[4] + (size_t)l * 32 * 4096 * 256);
    for (size_t i0 = gt; i0 < 8388608; i0 += gs * 8) { float4 v[8];
#pragma unroll
        for (int u = 0; u < 8; ++u) { const size_t i = i0 + u * gs; if (i < 8388608) v[u] = s1[i]; }
#pragma unroll
        for (int u = 0; u < 8; ++u) { const size_t i = i0 + u * gs; if (i < 8388608) { const size_t e = i * 4, b = e >> 20, rem = e & 1048575;
            uint2 w; w.x = pack2(v[u].x, v[u].y); w.y = pack2(v[u].z, v[u].w); *(uint2*)(ckv_s + b * KEYS_S * 256 + rem) = w; } } }
    unsigned zz = 0u; asm volatile("" : "+v"(zz));
    for (size_t i = gt; i < 393216; i += gs) { const size_t e = i * 4, b = e / 49152, rem = e % 49152; uint2 w; w.x = zz; w.y = zz; *(uint2*)(ckv_s + b * KEYS_S * 256 + 4160 * 256 + rem) = w; }
    const float4* s2 = (const float4*)(p.in[5] + (size_t)l * 32 * 4096 * 32);
    for (size_t i0 = gt; i0 < 1048576; i0 += gs * 8) { float4 v[8];
#pragma unroll
        for (int u = 0; u < 8; ++u) { const size_t i = i0 + u * gs; if (i < 1048576) v[u] = s2[i]; }
#pragma unroll
        for (int u = 0; u < 8; ++u) { const size_t i = i0 + u * gs; if (i < 1048576) { const size_t e = i * 4, b = e >> 17, rem = e & 131071;
            uint2 w; w.x = pack2(v[u].x, v[u].y); w.y = pack2(v[u].z, v[u].w); *(uint2*)(kr_s + b * KEYS_S * 32 + rem) = w; } } }
}
DI void phase_post(const Params& p, int l) {
    const int tid = tid_(), lane = tid & 63, wid = __builtin_amdgcn_readfirstlane(tid >> 6);
    const bf16_t* Z = (const bf16_t*)(p.ws + OFF_Z);
    bf16_t* CQN = (bf16_t*)(p.ws + OFF_CQN); bf16_t* CKV = (bf16_t*)(p.ws + OFF_CKV); bf16_t* KRO = (bf16_t*)(p.ws + OFF_KROPE);
    const float* rope = (const float*)(p.ws + OFF_ROPE);
    const float* gcq = p.in[13] + l * 256; const float* gckv = p.in[14] + l * 256; const float* gk = p.in[19] + l * 96 + 64;
    const int stride = gridDim.x * 8;
    int row = bid_() * 8 + wid;
    uint2 u1, u2; bf16_t u3;
    if (row < MT) { const bf16_t* zr = Z + (size_t)row * ZLD; u1 = *(const uint2*)(zr + 4 * lane); u2 = *(const uint2*)(zr + 256 + 4 * lane); u3 = zr[512 + (lane & 31)]; }
    while (row < MT) {
        const int nrow = row + stride; uint2 n1, n2; bf16_t n3;
        if (nrow < MT) { const bf16_t* zr = Z + (size_t)nrow * ZLD; n1 = *(const uint2*)(zr + 4 * lane); n2 = *(const uint2*)(zr + 256 + 4 * lane); n3 = zr[512 + (lane & 31)]; }
        int pos; size_t grow; float* o_ckv; float* o_kr;
        if (row < MP) { const int b = row >> 13, t = row & 8191; pos = t; grow = row; o_ckv = p.out + OUT_CKVP + ((size_t)(l * 4 + b) * 8192 + t) * 256; o_kr = p.out + OUT_KRP + ((size_t)(l * 4 + b) * 8192 + t) * 32; }
        else { const int r = row - MP, b = r >> 6, t = r & 63; pos = 4096 + t; grow = (size_t)MP + (size_t)b * KEYS_S + 4096 + t; o_ckv = p.out + OUT_CKVS + ((size_t)(l * 32 + b) * 64 + t) * 256; o_kr = p.out + OUT_KRS + ((size_t)(l * 32 + b) * 64 + t) * 32; }
        { const uint2 u = u1; const float a0 = bflo(u.x), a1 = bfhi(u.x), a2 = bflo(u.y), a3 = bfhi(u.y);
          const float ss = wave_sum(a0 * a0 + a1 * a1 + a2 * a2 + a3 * a3); const float rs = rsqrtf(ss * (1.f / 256.f) + EPS); const float4 g = *(const float4*)(gcq + 4 * lane);
          uint2 w; w.x = pack2(a0 * rs * g.x, a1 * rs * g.y); w.y = pack2(a2 * rs * g.z, a3 * rs * g.w); *(uint2*)(CQN + (size_t)row * 256 + 4 * lane) = w; }
        { const uint2 u = u2; const float a0 = bflo(u.x), a1 = bfhi(u.x), a2 = bflo(u.y), a3 = bfhi(u.y);
          const float ss = wave_sum(a0 * a0 + a1 * a1 + a2 * a2 + a3 * a3); const float rs = rsqrtf(ss * (1.f / 256.f) + EPS); const float4 g = *(const float4*)(gckv + 4 * lane);
          float4 o; o.x = a0 * rs * g.x; o.y = a1 * rs * g.y; o.z = a2 * rs * g.z; o.w = a3 * rs * g.w; *(float4*)(o_ckv + 4 * lane) = o;
          uint2 w; w.x = pack2(o.x, o.y); w.y = pack2(o.z, o.w); *(uint2*)(CKV + grow * 256 + 4 * lane) = w; }
        { const int i = lane & 31; const float a = bf2f(u3); float ss = a * a; ss += __shfl_xor(ss, 16); ss += __shfl_xor(ss, 8); ss += __shfl_xor(ss, 4); ss += __shfl_xor(ss, 2); ss += __shfl_xor(ss, 1);
          const float xn = a * rsqrtf(ss * (1.f / 32.f) + EPS) * gk[i]; const float other = __shfl_xor(xn, 16);
          const float2 cs = *(const float2*)(rope + ((size_t)pos * 16 + (i & 15)) * 2);
          const float o = i < 16 ? xn * cs.x - other * cs.y : xn * cs.x + other * cs.y;
          if (lane < 32) { o_kr[i] = o; KRO[grow * 32 + i] = f2bf(o); } }
        u1 = n1; u2 = n2; u3 = n3; row = nrow;
    }
}

DI f32x16 mfma32(bf16x8 a, bf16x8 b, f32x16 c) { return __builtin_amdgcn_mfma_f32_32x32x16_bf16(a, b, c, 0, 0, 0); }
DI f32x4 mfma16(bf16x8 a, bf16x8 b, f32x4 c) { return __builtin_amdgcn_mfma_f32_16x16x32_bf16(a, b, c, 0, 0, 0); }
DI bf16x8 pack8(const f32x16& s, int b) { u32x4 r; r[0] = pack2(s[b], s[b + 1]); r[1] = pack2(s[b + 2], s[b + 3]); r[2] = pack2(s[b + 4], s[b + 5]); r[3] = pack2(s[b + 6], s[b + 7]); return __builtin_bit_cast(bf16x8, r); }

template <int NH>
DI void attn_core(LAS unsigned char* lds, const bf16_t* qptr, const bf16_t* kn, size_t kn_hs, const bf16_t* kr, const bf16_t* vt, size_t vt_hs, int KL,
                  int kt0, int kstep, int nit, int nvalid, int tile_lim, int hh, f32x16 (&o)[2], float& m_run, float& l_run) {
    constexpr int BUFSZ = NH * 17920 + 5120;
    const int tid = tid_(), lane = tid & 63, r = lane & 31, h = lane >> 5;
    bf16x8 qf[6];
#pragma unroll
    for (int ks = 0; ks < 6; ++ks) qf[ks] = *(const bf16x8*)(qptr + ks * 16 + h * 8);
#pragma unroll
    for (int i = 0; i < 16; ++i) { o[0][i] = 0.f; o[1][i] = 0.f; }
    m_run = neg_big(); l_run = 0.f;
    u32x4 rkn[NH], rvt[NH], rkr = {0u, 0u, 0u, 0u};
    const int lrow = tid >> 3, lseg = tid & 7;
#define ATT_GLOAD(kt) do { const size_t key0_ = (size_t)(kt) * 64; \
        _Pragma("unroll") for (int hx = 0; hx < NH; ++hx) { rkn[hx] = *(const u32x4*)(kn + hx * kn_hs + (key0_ + lrow) * 64 + lseg * 8); rvt[hx] = *(const u32x4*)(vt + hx * vt_hs + (size_t)lrow * KL + key0_ + lseg * 8); } \
        if (tid < 256) rkr = *(const u32x4*)(kr + (key0_ + (tid >> 2)) * 32 + (tid & 3) * 8); } while (0)
#define ATT_LSTORE(buf) do { LAS unsigned char* B_ = lds + (buf) * BUFSZ; \
        _Pragma("unroll") for (int hx = 0; hx < NH; ++hx) { *(LAS u32x4*)(B_ + hx * 9216 + lrow * 144 + lseg * 16) = rkn[hx]; \
            LAS u32x2* pv_ = (LAS u32x2*)(B_ + NH * 9216 + 5120 + hx * 8704 + lrow * 136 + lseg * 16); u32x2 a_, b_; a_[0] = rvt[hx][0]; a_[1] = rvt[hx][1]; b_[0] = rvt[hx][2]; b_[1] = rvt[hx][3]; pv_[0] = a_; pv_[1] = b_; } \
        if (tid < 256) *(LAS u32x4*)(B_ + NH * 9216 + (tid >> 2) * 80 + (tid & 3) * 16) = rkr; } while (0)
    ATT_GLOAD(kt0); ATT_LSTORE(0);
    __syncthreads();
    for (int it = 0; it < nit; ++it) {
        const int ktn = kt0 + (it + 1) * kstep;
        const bool more = (it + 1 < nit) && (ktn < tile_lim);
        if (more) ATT_GLOAD(ktn);
        if (it < nvalid) {
            const LAS unsigned char* B = lds + (it & 1) * BUFSZ;
            const LAS unsigned char* knb = B + hh * 9216; const LAS unsigned char* krb = B + NH * 9216; const LAS unsigned char* vtb = B + NH * 9216 + 5120 + hh * 8704;
            f32x16 s0, s1;
#pragma unroll
            for (int i = 0; i < 16; ++i) { s0[i] = 0.f; s1[i] = 0.f; }
#pragma unroll
            for (int ks = 0; ks < 4; ++ks) { const bf16x8 a0 = *(const LAS bf16x8*)(knb + r * 144 + ks * 32 + h * 16), a1 = *(const LAS bf16x8*)(knb + (32 + r) * 144 + ks * 32 + h * 16);
                s0 = mfma32(a0, qf[ks], s0); s1 = mfma32(a1, qf[ks], s1); }
#pragma unroll
            for (int ks = 0; ks < 2; ++ks) { const bf16x8 a0 = *(const LAS bf16x8*)(krb + r * 80 + ks * 32 + h * 16), a1 = *(const LAS bf16x8*)(krb + (32 + r) * 80 + ks * 32 + h * 16);
                s0 = mfma32(a0, qf[4 + ks], s0); s1 = mfma32(a1, qf[4 + ks], s1); }
            float mx = s0[0];
#pragma unroll
            for (int i = 0; i < 16; ++i) { mx = fmaxf(mx, s0[i]); mx = fmaxf(mx, s1[i]); }
            mx = fmaxf(mx, __shfl_xor(mx, 32));
            const float mnew = fmaxf(m_run, mx), alpha = __builtin_amdgcn_exp2f(m_run - mnew);
            m_run = mnew;
            float ps = 0.f;
#pragma unroll
            for (int i = 0; i < 16; ++i) { s0[i] = __builtin_amdgcn_exp2f(s0[i] - mnew); s1[i] = __builtin_amdgcn_exp2f(s1[i] - mnew); ps += s0[i] + s1[i]; }
            l_run = l_run * alpha + ps;
#pragma unroll
            for (int i = 0; i < 16; ++i) { o[0][i] *= alpha; o[1][i] *= alpha; }
            bf16x8 pf[4];
            pf[0] = pack8(s0, 0); pf[1] = pack8(s0, 8); pf[2] = pack8(s1, 0); pf[3] = pack8(s1, 8);
#pragma unroll
            for (int dh = 0; dh < 2; ++dh)
#pragma unroll
                for (int s4 = 0; s4 < 4; ++s4) { const LAS u32x2* pa = (const LAS u32x2*)(vtb + (32 * dh + r) * 136 + (16 * s4 + 4 * h) * 2); const u32x2 lo = pa[0], hi = pa[2];
                    u32x4 av; av[0] = lo[0]; av[1] = lo[1]; av[2] = hi[0]; av[3] = hi[1]; o[dh] = mfma32(__builtin_bit_cast(bf16x8, av), pf[s4], o[dh]); }
        }
        if (more) ATT_LSTORE((it + 1) & 1);
        __syncthreads();
    }
#undef ATT_GLOAD
#undef ATT_LSTORE
}
DI void attn_core64(LAS unsigned char* lds, const bf16_t* qptr, const bf16_t* kn, const bf16_t* kr, const bf16_t* vt, int KL, int nit, int nvalid,
                    f32x16 (&o)[2][2], float (&m_run)[2], float (&l_run)[2]) {
    constexpr int BUFSZ = 17920 + 5120;
    const int tid = tid_(), lane = tid & 63, r = lane & 31, h = lane >> 5;
    bf16x8 qf[2][2];
    LAS bf16x8* qr = (LAS bf16x8*)(lds + 2 * BUFSZ + (tid >> 6) * 8192) + lane;
#pragma unroll
    for (int g = 0; g < 2; ++g) {
#pragma unroll
        for (int ks = 0; ks < 2; ++ks) qf[g][ks] = *(const bf16x8*)(qptr + g * 32 * 96 + ks * 16 + h * 8);
#pragma unroll
        for (int ks = 0; ks < 4; ++ks) qr[(g * 4 + ks) * 64] = *(const bf16x8*)(qptr + g * 32 * 96 + (2 + ks) * 16 + h * 8); }
#pragma unroll
    for (int g = 0; g < 2; ++g) { m_run[g] = neg_big(); l_run[g] = 0.f;
#pragma unroll
        for (int i = 0; i < 16; ++i) { o[g][0][i] = 0.f; o[g][1][i] = 0.f; } }
    u32x4 rkn, rvt, rkr = {0u, 0u, 0u, 0u};
    const int lrow = tid >> 3, lseg = tid & 7;
#define A64_GLOAD(kt) do { const size_t key0_ = (size_t)(kt) * 64; rkn = *(const u32x4*)(kn + (key0_ + lrow) * 64 + lseg * 8); rvt = *(const u32x4*)(vt + (size_t)lrow * KL + key0_ + lseg * 8); \
        if (tid < 256) rkr = *(const u32x4*)(kr + (key0_ + (tid >> 2)) * 32 + (tid & 3) * 8); } while (0)
#define A64_LSTORE(buf) do { LAS unsigned char* B_ = lds + (buf) * BUFSZ; *(LAS u32x4*)(B_ + lrow * 144 + lseg * 16) = rkn; \
        LAS u32x2* pv_ = (LAS u32x2*)(B_ + 9216 + 5120 + lrow * 136 + lseg * 16); u32x2 a_, b_; a_[0] = rvt[0]; a_[1] = rvt[1]; b_[0] = rvt[2]; b_[1] = rvt[3]; pv_[0] = a_; pv_[1] = b_; \
        if (tid < 256) *(LAS u32x4*)(B_ + 9216 + (tid >> 2) * 80 + (tid & 3) * 16) = rkr; } while (0)
    A64_GLOAD(0); A64_LSTORE(0);
    __syncthreads();
    for (int it = 0; it < nit; ++it) {
        const bool more = (it + 1 < nit);
        if (more) A64_GLOAD(it + 1);
        if (it < nvalid) {
            const LAS unsigned char* B = lds + (it & 1) * BUFSZ;
            const LAS unsigned char* knb = B; const LAS unsigned char* krb = B + 9216; const LAS unsigned char* vtb = B + 9216 + 5120;
            f32x16 s[2][2];
#pragma unroll
            for (int g = 0; g < 2; ++g)
#pragma unroll
                for (int i = 0; i < 16; ++i) { s[g][0][i] = 0.f; s[g][1][i] = 0.f; }
            __builtin_amdgcn_s_setprio(1);
#define A64_KA0(ks) ((ks) < 4 ? *(const LAS bf16x8*)(knb + r * 144 + (ks) * 32 + h * 16) : *(const LAS bf16x8*)(krb + r * 80 + ((ks) - 4) * 32 + h * 16))
#define A64_KA1(ks) ((ks) < 4 ? *(const LAS bf16x8*)(knb + (32 + r) * 144 + (ks) * 32 + h * 16) : *(const LAS bf16x8*)(krb + (32 + r) * 80 + ((ks) - 4) * 32 + h * 16))
#define A64_Q(g, ks) ((ks) < 2 ? qf[g][(ks) < 2 ? (ks) : 0] : qr[((g) * 4 + (ks) - 2) * 64])
            { bf16x8 a0 = A64_KA0(0), a1 = A64_KA1(0), q0 = A64_Q(0, 0), q1 = A64_Q(1, 0);
#pragma unroll
              for (int ks = 0; ks < 6; ++ks) {
                  bf16x8 na0 = a0, na1 = a1, nq0 = q0, nq1 = q1;
                  if (ks < 5) { na0 = A64_KA0(ks + 1); na1 = A64_KA1(ks + 1); nq0 = A64_Q(0, ks + 1); nq1 = A64_Q(1, ks + 1); }
                  __builtin_amdgcn_sched_barrier(0);
                  s[0][0] = mfma32(a0, q0, s[0][0]); s[1][0] = mfma32(a0, q1, s[1][0]); s[0][1] = mfma32(a1, q0, s[0][1]); s[1][1] = mfma32(a1, q1, s[1][1]);
                  __builtin_amdgcn_sched_barrier(0);
                  a0 = na0; a1 = na1; q0 = nq0; q1 = nq1; } }
#undef A64_KA0
#undef A64_KA1
#undef A64_Q
            __builtin_amdgcn_s_setprio(0);
            __builtin_amdgcn_sched_barrier(0);
            bf16x8 pf[2][4];
#pragma unroll
            for (int g = 0; g < 2; ++g) {
                float mx = s[g][0][0];
#pragma unroll
                for (int i = 0; i < 16; ++i) { mx = fmaxf(mx, s[g][0][i]); mx = fmaxf(mx, s[g][1][i]); }
                mx = fmaxf(mx, __shfl_xor(mx, 32));
                const float mnew = mx > m_run[g] + 8.f ? mx : m_run[g], alpha = __builtin_amdgcn_exp2f(m_run[g] - mnew);
                const bool resc = __builtin_amdgcn_ballot_w64(mnew != m_run[g]) != 0ull;
                m_run[g] = mnew;
                float ps = 0.f;
#pragma unroll
                for (int i = 0; i < 16; ++i) { s[g][0][i] = __builtin_amdgcn_exp2f(s[g][0][i] - mnew); s[g][1][i] = __builtin_amdgcn_exp2f(s[g][1][i] - mnew); ps += s[g][0][i] + s[g][1][i]; }
                l_run[g] = l_run[g] * alpha + ps;
                if (resc) {
#pragma unroll
                    for (int i = 0; i < 16; ++i) { o[g][0][i] *= alpha; o[g][1][i] *= alpha; } }
                pf[g][0] = pack8(s[g][0], 0); pf[g][1] = pack8(s[g][0], 8); pf[g][2] = pack8(s[g][1], 0); pf[g][3] = pack8(s[g][1], 8);
                __builtin_amdgcn_sched_barrier(0);
            }
            __builtin_amdgcn_s_setprio(1);
#define A64_VF(idx, lo_, hi_) const LAS u32x2* pa_##lo_ = (const LAS u32x2*)(vtb + (32 * ((idx) >> 2) + r) * 136 + (16 * ((idx) & 3) + 4 * h) * 2); u32x2 lo_ = pa_##lo_[0], hi_ = pa_##lo_[2]
            { A64_VF(0, lo, hi);
#pragma unroll
              for (int idx = 0; idx < 8; ++idx) {
                  u32x2 nlo = lo, nhi = hi;
                  if (idx < 7) { const LAS u32x2* pn = (const LAS u32x2*)(vtb + (32 * ((idx + 1) >> 2) + r) * 136 + (16 * ((idx + 1) & 3) + 4 * h) * 2); nlo = pn[0]; nhi = pn[2]; }
                  __builtin_amdgcn_sched_barrier(0);
                  u32x4 av; av[0] = lo[0]; av[1] = lo[1]; av[2] = hi[0]; av[3] = hi[1]; const bf16x8 avb = __builtin_bit_cast(bf16x8, av);
                  o[0][idx >> 2] = mfma32(avb, pf[0][idx & 3], o[0][idx >> 2]); o[1][idx >> 2] = mfma32(avb, pf[1][idx & 3], o[1][idx >> 2]);
                  __builtin_amdgcn_sched_barrier(0);
                  lo = nlo; hi = nhi; } }
#undef A64_VF
            __builtin_amdgcn_s_setprio(0);
        }
        if (more) A64_LSTORE((it + 1) & 1);
        __syncthreads();
    }
#undef A64_GLOAD
#undef A64_LSTORE
}
DI void phase_attn_p(const Params& p, LAS unsigned char* lds) {
    const int tid = tid_(), lane = tid & 63, wid = __builtin_amdgcn_readfirstlane(tid >> 6), r = lane & 31, h = lane >> 5;
    const bf16_t* Q = (const bf16_t*)(p.ws + OFF_Q); const bf16_t* KN = (const bf16_t*)(p.ws + OFF_KN); const bf16_t* VT = (const bf16_t*)(p.ws + OFF_VT);
    const bf16_t* KRO = (const bf16_t*)(p.ws + OFF_KROPE); bf16_t* O = (bf16_t*)(p.ws + OFF_O);
    for (int pair = bid_(); pair < 256; pair += gridDim.x) {
        const int bh = pair >> 3, qa = pair & 7, b = bh >> 3, hd = bh & 7;
        for (int sub = 0; sub < 2; ++sub) {
            const int qb = sub ? qa : 15 - qa;
            const int t0 = qb * 512 + wid * 64 + r;
            f32x16 o[2][2]; float m_run[2], l_run[2];
            attn_core64(lds, Q + ((size_t)bh * 8192 + t0) * 96, KN + (size_t)bh * 8192 * 64, KRO + (size_t)b * 8192 * 32, VT + (size_t)bh * 64 * 8192, 8192,
                        8 * qb + 8, 8 * qb + wid + 1, o, m_run, l_run);
#pragma unroll
            for (int g = 0; g < 2; ++g) {
                const float inv = 1.f / (l_run[g] + __shfl_xor(l_run[g], 32));
                bf16_t* orow = O + ((size_t)b * 8192 + t0 + g * 32) * 512 + hd * 64;
#pragma unroll
                for (int dh = 0; dh < 2; ++dh)
#pragma unroll
                    for (int q4 = 0; q4 < 4; ++q4) { uint2 w; w.x = pack2(o[g][dh][4 * q4] * inv, o[g][dh][4 * q4 + 1] * inv); w.y = pack2(o[g][dh][4 * q4 + 2] * inv, o[g][dh][4 * q4 + 3] * inv); *(uint2*)(orow + 32 * dh + 8 * q4 + 4 * h) = w; }
            }
        }
    }
}
DI void phase_attn_s(const Params& p, LAS unsigned char* lds) {
    const int tid = tid_(), lane = tid & 63, wid = __builtin_amdgcn_readfirstlane(tid >> 6), r = lane & 31, h = lane >> 5;
    const bf16_t* Q = (const bf16_t*)(p.ws + OFF_Q); const bf16_t* KN = (const bf16_t*)(p.ws + OFF_KN); const bf16_t* VT = (const bf16_t*)(p.ws + OFF_VT);
    const bf16_t* KRO = (const bf16_t*)(p.ws + OFF_KROPE); float* PART = (float*)(p.ws + OFF_PART);
    for (int c = bid_(); c < 256; c += gridDim.x) {
        const int b = c >> 3, hg = (c >> 2) & 1, split = c & 3, hh = wid >> 1, head = hg * 4 + hh, t = (wid & 1) * 32 + r;
        f32x16 o[2]; float m_run, l_run;
        attn_core<4>(lds, Q + (size_t)MP * 768 + ((size_t)(b * 8 + head) * 64 + t) * 96, KN + (size_t)MP * 512 + (size_t)(b * 8 + hg * 4) * KEYS_S * 64, (size_t)KEYS_S * 64,
                     KRO + (size_t)MP * 32 + (size_t)b * KEYS_S * 32, VT + (size_t)MP * 512 + (size_t)(b * 8 + hg * 4) * 64 * KEYS_S, (size_t)64 * KEYS_S, KEYS_S,
                     split, 4, 17, split == 0 ? 17 : 16, 65, hh, o, m_run, l_run);
        const float lt = l_run + __shfl_xor(l_run, 32);
        float* pr = PART + (((size_t)(b * 8 + head) * 4 + split) * 64 + t) * 66;
#pragma unroll
        for (int dh = 0; dh < 2; ++dh)
#pragma unroll
            for (int g = 0; g < 4; ++g) { float2 a, bb; a.x = o[dh][4 * g]; a.y = o[dh][4 * g + 1]; bb.x = o[dh][4 * g + 2]; bb.y = o[dh][4 * g + 3]; float* d = pr + 32 * dh + 8 * g + 4 * h; *(float2*)d = a; *(float2*)(d + 2) = bb; }
        if (h == 0) { float2 ml; ml.x = m_run; ml.y = lt; *(float2*)(pr + 64) = ml; }
    }
}

constexpr int R_QF = 0, R_KF = 16384, R_G = 32768, R_VTI = 49152, R_KTI = 58368, R_QTI = 67584, R_STI = 76800, R_PPI = 86016, R_QHI = 95232, R_KHI = 102144,
              R_GA = 115968, R_WA = 120064, R_SEG = 122240, R_OF = 0, R_WALL = 124288, R_BA = 132480, R_LB = 132992, R_QD = 134016, R_KD = 143232;
struct RecPre { u32x4 uv, ua, uq, ug, gz; f32x4 s0, s1; };
DI uint4 to_u4(u32x4 v) { uint4 r; r.x = v[0]; r.y = v[1]; r.z = v[2]; r.w = v[3]; return r; }
DI float4 to_f4(f32x4 v) { float4 r; r.x = v[0]; r.y = v[1]; r.z = v[2]; r.w = v[3]; return r; }
DI void rec_tables(const Params& p, int l, LAS unsigned char* lds) {
    const int tid = tid_();
    LAS float* WALL = (LAS float*)(lds + R_WALL); LAS float* BA = (LAS float*)(lds + R_BA); LAS float* LB = (LAS float*)(lds + R_LB);
#pragma unroll
    for (int i = 0; i < 4; ++i) WALL[tid + 512 * i] = p.in[23][l * 2048 + tid + 512 * i];
    if (tid < 128) BA[tid] = p.in[24][l * 128 + tid];
    if (tid < 256) { float lb = 0.f; if (l == 1) { const float l0 = p.in[21][tid], l1 = p.in[21][256 + tid]; lb = 1.f / (1.f + expf(l0 - l1)); } LB[tid] = lb; }
    __syncthreads();
}
template <int DK, bool HG>
DI void rec_issue(const Params& p, int cid, int hd, bool passC, RecPre& r) {
    const int tid = tid_();
    const bf16_t* Z = (const bf16_t*)(p.ws + OFF_Z);
    const size_t row0 = (size_t)cid * 64;
    const int lj = tid >> 3, ls8 = (tid & 7) * 8;
    const bf16_t* zr = Z + (row0 + lj) * ZLD;
    r.uv = *(const u32x4*)(zr + (HG ? 1056 : 1824) + hd * 64 + ls8);
    if (HG) { r.ua = *(const u32x4*)(zr + 800 + hd * 64 + ls8); if (passC) r.uq = *(const u32x4*)(zr + 544 + hd * 64 + ls8); }
    else { if (tid < 256) { const bf16_t* z2 = Z + (row0 + (tid >> 2)) * ZLD; r.ua = *(const u32x4*)(z2 + 1696 + hd * 32 + (tid & 3) * 8); if (passC) r.uq = *(const u32x4*)(z2 + 1568 + hd * 32 + (tid & 3) * 8); }
           if (tid < 128) r.ug = *(const u32x4*)(Z + (row0 + (tid >> 1)) * ZLD + 2336 + (tid & 1) * 8); }
    if (passC) {
        const float* S = (const float*)(p.ws + (HG ? OFF_UHG : OFF_UGL)) + ((size_t)cid * 4 + hd) * DK * 64;
            if (tid < DK * 8) { const int k = tid >> 3, v0 = (tid & 7) * 8; r.s0 = *(const f32x4*)(S + k * 64 + v0); r.s1 = *(const f32x4*)(S + k * 64 + v0 + 4); }
        r.gz = *(const u32x4*)(zr + (HG ? 1312 : 2080) + hd * 64 + ls8);
    }
}
template <int DK, bool HG>
DI void rec_load(const RecPre& pre, LAS unsigned char* lds, int hd, bool need_q) {
    const int tid = tid_();
    LAS float* QF = (LAS float*)(lds + R_QF); LAS float* KF = (LAS float*)(lds + R_KF); LAS float* G = (LAS float*)(lds + R_G);
    LAS bf16_t* VTI = (LAS bf16_t*)(lds + R_VTI); LAS float* GA = (LAS float*)(lds + R_GA); LAS float* SEG = (LAS float*)(lds + R_SEG);
    const LAS float* WA = (const LAS float*)(lds + (HG ? R_LB : R_WALL)) + (HG ? hd * 64 : hd * 32);
    const LAS float* BA = (const LAS float*)(lds + R_BA) + hd * 32;
    const int lj = tid >> 3, ls8 = (tid & 7) * 8;
    const uint4 uv = to_u4(pre.uv), ua = to_u4(pre.ua), uq = to_u4(pre.uq);
    if (!HG) {
        if (tid < 128) { const int j = tid >> 1, hf = tid & 1; const uint4 u = to_u4(pre.ug); LAS float* ga = GA + j * 16 + hf * 8;
            ga[0] = bflo(u.x); ga[1] = bfhi(u.x); ga[2] = bflo(u.y); ga[3] = bfhi(u.y); ga[4] = bflo(u.z); ga[5] = bfhi(u.z); ga[6] = bflo(u.w); ga[7] = bfhi(u.w); }
        __syncthreads();
    }
    { const float va[8] = {bflo(ua.x), bfhi(ua.x), bflo(ua.y), bfhi(ua.y), bflo(ua.z), bfhi(ua.z), bflo(ua.w), bfhi(ua.w)};
      const float vq[8] = {bflo(uq.x), bfhi(uq.x), bflo(uq.y), bfhi(uq.y), bflo(uq.z), bfhi(uq.z), bflo(uq.w), bfhi(uq.w)};
      if (HG) { float gg[8], kk[8];
#pragma unroll
          for (int x = 0; x < 8; ++x) { const float lb = WA[ls8 + x], e = __expf(fminf(-va[x], 80.f)), s = 1.f / (1.f + e); gg[x] = logf(lb + (1.f - lb) * s); kk[x] = (1.f - lb) * e * s; }
          LAS f32x4* gp = (LAS f32x4*)(G + lj * 64 + ls8); LAS f32x4* kp = (LAS f32x4*)(KF + lj * 64 + ls8);
          gp[0] = (f32x4){gg[0], gg[1], gg[2], gg[3]}; gp[1] = (f32x4){gg[4], gg[5], gg[6], gg[7]}; kp[0] = (f32x4){kk[0], kk[1], kk[2], kk[3]}; kp[1] = (f32x4){kk[4], kk[5], kk[6], kk[7]};
          if (need_q) { LAS f32x4* qp = (LAS f32x4*)(QF + lj * 64 + ls8); qp[0] = (f32x4){vq[0], vq[1], vq[2], vq[3]}; qp[1] = (f32x4){vq[4], vq[5], vq[6], vq[7]}; } }
      else {
          { const int kq = (tid & 7) * 4; f32x4 x = *(const LAS f32x4*)(BA + kq);
#pragma unroll
            for (int r = 0; r < 16; ++r) { const float ga = GA[lj * 16 + r]; const f32x4 wv = *(const LAS f32x4*)(WA + r * 128 + kq); x += ga * wv; }
            f32x4 o;
#pragma unroll
            for (int y = 0; y < 4; ++y) o[y] = (fminf(x[y], 0.f) - log1pf(__expf(-fabsf(x[y])))) * (1.f / 16.f);
            *(LAS f32x4*)(G + lj * 32 + kq) = o; }
          if (tid < 256) { const int j2 = tid >> 2, k2 = (tid & 3) * 8; LAS f32x4* kp = (LAS f32x4*)(KF + j2 * 32 + k2); kp[0] = (f32x4){va[0], va[1], va[2], va[3]}; kp[1] = (f32x4){va[4], va[5], va[6], va[7]};
              if (need_q) { const float qs = 0.17677669529663687f; LAS f32x4* qp = (LAS f32x4*)(QF + j2 * 32 + k2); qp[0] = (f32x4){vq[0] * qs, vq[1] * qs, vq[2] * qs, vq[3] * qs}; qp[1] = (f32x4){vq[4] * qs, vq[5] * qs, vq[6] * qs, vq[7] * qs}; } } }
      const unsigned vv[4] = {uv.x, uv.y, uv.z, uv.w};
#pragma unroll
      for (int x = 0; x < 4; ++x) { VTI[(ls8 + 2 * x) * 72 + lj] = (bf16_t)(vv[x] & 0xFFFFu); VTI[(ls8 + 2 * x + 1) * 72 + lj] = (bf16_t)(vv[x] >> 16); } }
    __syncthreads();
    constexpr int NSEG = NT / DK, JS = 64 / NSEG;
    const int seg = tid / DK, k = tid % DK;
    float loc[JS]; float s = 0.f;
#pragma unroll
    for (int jj = 0; jj < JS; ++jj) { s += G[(seg * JS + jj) * DK + k]; loc[jj] = s; }
    SEG[seg * DK + k] = s;
    __syncthreads();
    float off = 0.f;
#pragma unroll
    for (int s2 = 0; s2 < NSEG; ++s2) { const float t = SEG[s2 * DK + k]; off += s2 < seg ? t : 0.f; }
#pragma unroll
    for (int jj = 0; jj < JS; ++jj) G[(seg * JS + jj) * DK + k] = loc[jj] + off;
    __syncthreads();
}
template <int DK, bool HG>
DI void rec_passA_item(const Params& p, int l, LAS unsigned char* lds, int cid, int hd, const RecPre& pre) {
    const int tid = tid_(), lane = tid & 63, wid = __builtin_amdgcn_readfirstlane(tid >> 6), fr = lane & 15, fq = lane >> 4;
    rec_load<DK, HG>(pre, lds, hd, false);
    LAS float* KF = (LAS float*)(lds + R_KF); LAS float* G = (LAS float*)(lds + R_G);
    LAS bf16_t* VTI = (LAS bf16_t*)(lds + R_VTI); LAS bf16_t* KTI = (LAS bf16_t*)(lds + R_KTI);
    float* U = (float*)(p.ws + (HG ? OFF_UHG : OFF_UGL)); float* D = (float*)(p.ws + (HG ? OFF_DHG : OFF_DGL));
    for (int e = tid; e < 64 * DK; e += NT) { const int j = e / DK, k = e % DK; KTI[k * 72 + j] = f2bf(KF[e] * __expf(G[63 * DK + k] - G[e])); }
    if (tid < DK) D[((size_t)cid * 4 + hd) * DK + tid] = __expf(G[63 * DK + tid]);
    __syncthreads();
    for (int tile = wid; tile < (DK / 16) * 4; tile += 8) {
        const int tk = tile >> 2, tv = tile & 3; f32x4 acc = {0.f, 0.f, 0.f, 0.f};
#pragma unroll
        for (int s = 0; s < 2; ++s) { const bf16x8 a = *(const LAS bf16x8*)(KTI + (16 * tk + fr) * 72 + 32 * s + 8 * fq), b = *(const LAS bf16x8*)(VTI + (16 * tv + fr) * 72 + 32 * s + 8 * fq); acc = mfma16(a, b, acc); }
#pragma unroll
        for (int reg = 0; reg < 4; ++reg) U[(((size_t)cid * 4 + hd) * DK + 16 * tk + 4 * fq + reg) * 64 + 16 * tv + fr] = acc[reg];
    }
    __syncthreads();
}
template <int DK, bool HG>
DI void rec_passC_item(const Params& p, int l, LAS unsigned char* lds, int cid, int hd, const RecPre& pre) {
    const int tid = tid_(), lane = tid & 63, wid = __builtin_amdgcn_readfirstlane(tid >> 6), fr = lane & 15, fq = lane >> 4;
    rec_load<DK, HG>(pre, lds, hd, true);
    LAS float* QF = (LAS float*)(lds + R_QF); LAS float* KF = (LAS float*)(lds + R_KF); LAS float* G = (LAS float*)(lds + R_G); LAS float* OF = (LAS float*)(lds + R_OF);
    LAS bf16_t* VTI = (LAS bf16_t*)(lds + R_VTI); LAS bf16_t* QTI = (LAS bf16_t*)(lds + R_QTI); LAS bf16_t* STI = (LAS bf16_t*)(lds + R_STI);
    LAS bf16_t* PPI = (LAS bf16_t*)(lds + R_PPI); LAS bf16_t* QHI = (LAS bf16_t*)(lds + R_QHI); LAS bf16_t* KHI = (LAS bf16_t*)(lds + R_KHI);
    const bf16_t* Z = (const bf16_t*)(p.ws + OFF_Z); bf16_t* H = (bf16_t*)(p.ws + OFF_H);
    for (int e = tid; e < 64 * DK; e += NT) { const int i = e / DK, k = e % DK; QTI[i * 72 + k] = f2bf(QF[e] * __expf(G[e])); }
    if (tid < DK * 8) { const int k = tid >> 3, v0 = (tid & 7) * 8; const float4 s0 = to_f4(pre.s0), s1 = to_f4(pre.s1);
        STI[(v0 + 0) * 72 + k] = f2bf(s0.x); STI[(v0 + 1) * 72 + k] = f2bf(s0.y); STI[(v0 + 2) * 72 + k] = f2bf(s0.z); STI[(v0 + 3) * 72 + k] = f2bf(s0.w);
        STI[(v0 + 4) * 72 + k] = f2bf(s1.x); STI[(v0 + 5) * 72 + k] = f2bf(s1.y); STI[(v0 + 6) * 72 + k] = f2bf(s1.z); STI[(v0 + 7) * 72 + k] = f2bf(s1.w); }
    for (int e = tid; e < 48 * DK; e += NT) { const int ii = e / DK, k = e % DK, I = 1 + (ii >> 4), i = 16 + ii; const float ref = G[(16 * I - 1) * DK + k];
        QHI[ii * 72 + k] = f2bf(QF[i * DK + k] * __expf(G[i * DK + k] - ref)); }
    for (int e = tid; e < 96 * DK; e += NT) { const int rr = e / DK, k = e % DK, I = rr < 16 ? 1 : (rr < 48 ? 2 : 3), j = rr - 8 * I * (I - 1); const float ref = G[(16 * I - 1) * DK + k];
        KHI[rr * 72 + k] = f2bf(KF[j * DK + k] * __expf(ref - G[j * DK + k])); }
    { LAS bf16_t* QD = (LAS bf16_t*)(lds + R_QD); LAS bf16_t* KD = (LAS bf16_t*)(lds + R_KD);
      for (int e = tid; e < 64 * DK; e += NT) { const int i = e / DK, k = e % DK; const float ref = G[(16 * (i >> 4) + 7) * DK + k], gi = G[e];
          QD[i * 72 + k] = f2bf(QF[e] * __expf(fminf(fmaxf(gi - ref, -80.f), 80.f))); KD[i * 72 + k] = f2bf(KF[e] * __expf(fminf(fmaxf(ref - gi, -80.f), 80.f))); } }
    for (int e = tid; e < 1536; e += NT) { const int bidx = e >> 8, w = e & 255; const int I = bidx < 3 ? 0 : (bidx < 5 ? 1 : 2), J = bidx < 3 ? bidx + 1 : (bidx < 5 ? bidx - 1 : 3);
        PPI[(16 * I + (w >> 4)) * 72 + 16 * J + (w & 15)] = 0; }
    __syncthreads();
    if (wid >= 6) { const LAS bf16_t* QD = (const LAS bf16_t*)(lds + R_QD); const LAS bf16_t* KD = (const LAS bf16_t*)(lds + R_KD);
#pragma unroll
        for (int t2 = 0; t2 < 2; ++t2) { const int I = (wid - 6) * 2 + t2; f32x4 acc = {0.f, 0.f, 0.f, 0.f};
#pragma unroll
            for (int s = 0; s < DK / 32; ++s) { const bf16x8 a = *(const LAS bf16x8*)(QD + (16 * I + fr) * 72 + 32 * s + 8 * fq), b = *(const LAS bf16x8*)(KD + (16 * I + fr) * 72 + 32 * s + 8 * fq); acc = mfma16(a, b, acc); }
#pragma unroll
            for (int reg = 0; reg < 4; ++reg) PPI[(16 * I + 4 * fq + reg) * 72 + 16 * I + fr] = f2bf(fr <= 4 * fq + reg ? acc[reg] : 0.f); } }
    if (wid < 6) { const int I = wid < 1 ? 1 : (wid < 3 ? 2 : 3), J = wid < 1 ? 0 : (wid < 3 ? wid - 1 : wid - 3); f32x4 acc = {0.f, 0.f, 0.f, 0.f};
#pragma unroll
        for (int s = 0; s < DK / 32; ++s) { const bf16x8 a = *(const LAS bf16x8*)(QHI + ((I - 1) * 16 + fr) * 72 + 32 * s + 8 * fq), b = *(const LAS bf16x8*)(KHI + (8 * I * (I - 1) + 16 * J + fr) * 72 + 32 * s + 8 * fq); acc = mfma16(a, b, acc); }
#pragma unroll
        for (int reg = 0; reg < 4; ++reg) PPI[(16 * I + 4 * fq + reg) * 72 + 16 * J + fr] = f2bf(acc[reg]); }
    __syncthreads();
#pragma unroll
    for (int tt = 0; tt < 2; ++tt) { const int tile = wid * 2 + tt, ti = tile >> 2, tv = tile & 3; f32x4 acc = {0.f, 0.f, 0.f, 0.f};
#pragma unroll
        for (int s = 0; s < DK / 32; ++s) { const bf16x8 a = *(const LAS bf16x8*)(QTI + (16 * ti + fr) * 72 + 32 * s + 8 * fq), b = *(const LAS bf16x8*)(STI + (16 * tv + fr) * 72 + 32 * s + 8 * fq); acc = mfma16(a, b, acc); }
#pragma unroll
        for (int s = 0; s < 2; ++s) { const bf16x8 a = *(const LAS bf16x8*)(PPI + (16 * ti + fr) * 72 + 32 * s + 8 * fq), b = *(const LAS bf16x8*)(VTI + (16 * tv + fr) * 72 + 32 * s + 8 * fq); acc = mfma16(a, b, acc); }
#pragma unroll
        for (int reg = 0; reg < 4; ++reg) OF[(16 * ti + 4 * fq + reg) * 65 + 16 * tv + fr] = acc[reg]; }
    __syncthreads();
    { const int i = tid >> 3, part = tid & 7; float v[8]; float ss = 0.f;
#pragma unroll
      for (int x = 0; x < 8; ++x) { v[x] = OF[i * 65 + part * 8 + x]; ss += v[x] * v[x]; }
      ss += __shfl_xor(ss, 1); ss += __shfl_xor(ss, 2); ss += __shfl_xor(ss, 4);
      const float rs = rsqrtf(ss * (1.f / 64.f) + EPS);
      const size_t row = (size_t)cid * 64 + i;
      const uint4 gz = to_u4(pre.gz);
      const float* go = p.in[HG ? 22 : 25] + l * 64 + part * 8;
      const float gt[8] = {bflo(gz.x), bfhi(gz.x), bflo(gz.y), bfhi(gz.y), bflo(gz.z), bfhi(gz.z), bflo(gz.w), bfhi(gz.w)};
      float r[8];
#pragma unroll
      for (int x = 0; x < 8; ++x) r[x] = v[x] * rs * go[x] * (gt[x] / (1.f + __expf(-gt[x])));
      uint4 w; w.x = pack2(r[0], r[1]); w.y = pack2(r[2], r[3]); w.z = pack2(r[4], r[5]); w.w = pack2(r[6], r[7]);
      *(uint4*)(H + row * 1024 + 512 + (HG ? 0 : 256) + hd * 64 + part * 8) = w; }
    __syncthreads();
}
template <int DK>
DI void scan_prompt(float* U, const float* D, float* outp, int e) {
    const int v = e & 63, k = (e >> 6) % DK, hd = (e / (64 * DK)) & 3, b = e / (256 * DK);
    float S = 0.f;
    for (int n0 = 0; n0 < 128; n0 += 16) {
        float u[16], d[16];
#pragma unroll
        for (int i = 0; i < 16; ++i) { const size_t ch = ((size_t)(b * 128 + n0 + i) * 4 + hd); u[i] = U[(ch * DK + k) * 64 + v]; d[i] = D[ch * DK + k]; }
#pragma unroll
        for (int i = 0; i < 16; ++i) { const size_t ch = ((size_t)(b * 128 + n0 + i) * 4 + hd); U[(ch * DK + k) * 64 + v] = S; S = d[i] * S + u[i]; }
    }
    outp[e] = S;
}
template <int DK>
DI void scan_sample(float* U, const float* D, const float* s0p, float* outp, int e) {
    const int v = e & 63, k = (e >> 6) % DK, hd = (e / (64 * DK)) & 3, b = e / (256 * DK);
    const size_t ch = (size_t)(512 + b) * 4 + hd; const size_t idx = (ch * DK + k) * 64 + v;
    const float s0 = s0p[e], u = U[idx], d = D[ch * DK + k];
    U[idx] = s0; outp[e] = d * s0 + u;
}
DI void phase_scan(const Params& p, int l) {
    const int g = bid_() * NT + tid_(), gs = gridDim.x * NT;
    float* UH = (float*)(p.ws + OFF_UHG); const float* DH = (const float*)(p.ws + OFF_DHG); float* UG = (float*)(p.ws + OFF_UGL); const float* DG = (const float*)(p.ws + OFF_DGL);
    for (int e = g; e < 98304; e += gs) {
        if (e < 65536) scan_prompt<64>(UH, DH, p.out + OUT_HGP + (size_t)l * 65536, e);
        else scan_prompt<32>(UG, DG, p.out + OUT_GLP + (size_t)l * 32768, e - 65536);
    }
    for (int e = g; e < 786432; e += gs) {
        if (e < 524288) scan_sample<64>(UH, DH, p.in[6] + (size_t)l * 524288, p.out + OUT_HGS + (size_t)l * 524288, e);
        else scan_sample<32>(UG, DG, p.in[7] + (size_t)l * 262144, p.out + OUT_GLS + (size_t)l * 262144, e - 524288);
    }
}
DI void phase_mlaout(const Params& p, int l) {
    const int tid = tid_(), lane = tid & 63, wid = __builtin_amdgcn_readfirstlane(tid >> 6);
    const bf16_t* O = (const bf16_t*)(p.ws + OFF_O); const float* PART = (const float*)(p.ws + OFF_PART); bf16_t* H = (bf16_t*)(p.ws + OFF_H);
    const float* g = p.in[20] + l * 512 + 8 * lane;
    for (int row = bid_() * 8 + wid; row < MT; row += gridDim.x * 8) {
        float v[8];
        if (row < MP) { const uint4 u = *(const uint4*)(O + (size_t)row * 512 + 8 * lane);
            v[0] = bflo(u.x); v[1] = bfhi(u.x); v[2] = bflo(u.y); v[3] = bfhi(u.y); v[4] = bflo(u.z); v[5] = bfhi(u.z); v[6] = bflo(u.w); v[7] = bfhi(u.w); }
        else { const int r = row - MP, b = r >> 6, t = r & 63, head = lane >> 3, dv0 = (lane & 7) * 8;
            const float* pb = PART + (((size_t)(b * 8 + head) * 4) * 64 + t) * 66;
            float m[4], lsum[4]; float M = neg_big();
#pragma unroll
            for (int s = 0; s < 4; ++s) { m[s] = pb[(size_t)s * 64 * 66 + 64]; lsum[s] = pb[(size_t)s * 64 * 66 + 65]; M = fmaxf(M, m[s]); }
            float L = 0.f;
#pragma unroll
            for (int x = 0; x < 8; ++x) v[x] = 0.f;
#pragma unroll
            for (int s = 0; s < 4; ++s) { const float w = exp2f(m[s] - M); L += w * lsum[s];
#pragma unroll
                for (int x = 0; x < 8; ++x) v[x] += w * pb[(size_t)s * 64 * 66 + dv0 + x]; }
            const float inv = 1.f / L;
#pragma unroll
            for (int x = 0; x < 8; ++x) v[x] *= inv; }
        float ss = 0.f;
#pragma unroll
        for (int x = 0; x < 8; ++x) ss += v[x] * v[x];
        ss = wave_sum(ss);
        const float rs = rsqrtf(ss * (1.f / 512.f) + EPS);
        uint4 w; w.x = pack2(v[0] * rs * g[0], v[1] * rs * g[1]); w.y = pack2(v[2] * rs * g[2], v[3] * rs * g[3]); w.z = pack2(v[4] * rs * g[4], v[5] * rs * g[5]); w.w = pack2(v[6] * rs * g[6], v[7] * rs * g[7]);
        *(uint4*)(H + (size_t)row * 1024 + 8 * lane) = w;
    }
}

DI void gsync(const Params& p, LAS unsigned char* lds) { XcdBarrier b; b.bar = (unsigned*)(p.ws + OFF_BAR); b.x = xb_xcc_id(); b.st = (volatile LAS unsigned*)(lds + LDS_BYTES - 16); xcd_barrier(b); }
__global__ void __launch_bounds__(512, 2) mk_fwd(Params p) {
    extern __shared__ __attribute__((aligned(16))) unsigned char shm[];
    LAS unsigned char* lds = (LAS unsigned char*)shm;
    cg::grid_group grid = cg::this_grid();
    bf16_t* H = (bf16_t*)(p.ws + OFF_H); bf16_t* Z = (bf16_t*)(p.ws + OFF_Z); bf16_t* CQN = (bf16_t*)(p.ws + OFF_CQN); bf16_t* CKV = (bf16_t*)(p.ws + OFF_CKV);
    bf16_t* Q = (bf16_t*)(p.ws + OFF_Q); bf16_t* KN = (bf16_t*)(p.ws + OFF_KN); bf16_t* VT = (bf16_t*)(p.ws + OFF_VT); bf16_t* ACT = (bf16_t*)(p.ws + OFF_ACT);
    const float* rope = (const float*)(p.ws + OFF_ROPE); bf16_t* XB = (bf16_t*)(p.ws + OFF_XB);
    volatile LAS unsigned* xst = (volatile LAS unsigned*)(lds + LDS_BYTES - 16);
    if (threadIdx.x == 0) { xst[0] = 0u; xst[1] = 0u; }
    __syncthreads();
    (void)xcd_barrier_post((unsigned*)(p.ws + OFF_BAR), xst);
    phase_prep(p, lds);
    grid.sync();
#pragma unroll 1
    for (int l = 0; l < 2; ++l) {
        const unsigned char* W = p.ws + OFF_W + (size_t)l * WL;
        const float* modl = (const float*)(p.ws + OFF_MOD) + (size_t)l * 36 * 6144;
        if (l == 0) phase_hrows<true>(p, l, p.in[0], p.in[1], p.in[10] + l * 1024, 0, 1024); else phase_hrows<false>(p, l, nullptr, nullptr, p.in[10] + l * 1024, 0, 1024);
        phase_cache(p, l);
        gsync(p, lds);
        run_gemm(lds, H, (const bf16_t*)(W + WOFF_IN), MT, 2560, 1024, EpiZ{Z, ZLD});
        gsync(p, lds);
        phase_post(p, l);
        rec_tables(p, l, lds);
        { RecPre pre = {}; int it = bid_(); if (it < 2176) rec_issue<64, true>(p, it >> 2, it & 3, false, pre);
          for (; it < 2176; it += gridDim.x) { const RecPre cur = pre; const int nx = it + gridDim.x; if (nx < 2176) rec_issue<64, true>(p, nx >> 2, nx & 3, false, pre); rec_passA_item<64, true>(p, l, lds, it >> 2, it & 3, cur); } }
        { RecPre pre = {}; int it = bid_(); if (it < 2176) rec_issue<32, false>(p, it >> 2, it & 3, false, pre);
          for (; it < 2176; it += gridDim.x) { const RecPre cur = pre; const int nx = it + gridDim.x; if (nx < 2176) rec_issue<32, false>(p, nx >> 2, nx & 3, false, pre); rec_passA_item<32, false>(p, l, lds, it >> 2, it & 3, cur); } }
        gsync(p, lds);
        run_gemm(lds, CQN, (const bf16_t*)(W + WOFF_UQ), MT, 768, 256, EpiQ{Q, p.in[18] + l * 96, rope});
        run_gemm(lds, CKV, (const bf16_t*)(W + WOFF_UK), KR_ROWS, 512, 256, EpiKN{KN, p.in[19] + l * 96});
        run_gemm(lds, (const bf16_t*)(W + WOFF_UV), CKV, 512, KR_ROWS, 256, EpiVT{VT});
        phase_scan(p, l);
        gsync(p, lds);
        phase_attn_p(p, lds);
        phase_attn_s(p, lds);
        rec_tables(p, l, lds);
        { RecPre pre = {}; int it = bid_(); if (it < 2176) rec_issue<64, true>(p, it >> 2, it & 3, true, pre);
          for (; it < 2176; it += gridDim.x) { const RecPre cur = pre; const int nx = it + gridDim.x; if (nx < 2176) rec_issue<64, true>(p, nx >> 2, nx & 3, true, pre); rec_passC_item<64, true>(p, l, lds, it >> 2, it & 3, cur); } }
        { RecPre pre = {}; int it = bid_(); if (it < 2176) rec_issue<32, false>(p, it >> 2, it & 3, true, pre);
          for (; it < 2176; it += gridDim.x) { const RecPre cur = pre; const int nx = it + gridDim.x; if (nx < 2176) rec_issue<32, false>(p, nx >> 2, nx & 3, true, pre); rec_passC_item<32, false>(p, l, lds, it >> 2, it & 3, cur); } }
        gsync(p, lds);
        phase_mlaout(p, l);
        gsync(p, lds);
        run_gemm(lds, H, (const bf16_t*)(W + WOFF_O), MT, 1024, 1024, EpiRes{XB, p.out, modl + 2048, 0});
        gsync(p, lds);
        phase_hrows<false>(p, l, nullptr, nullptr, p.in[11] + l * 1024, 3072, 4096);
        gsync(p, lds);
        run_gemm(lds, H, (const bf16_t*)(W + WOFF_FI), MT, 5632, 1024, EpiSwi{ACT});
        gsync(p, lds);
        run_gemm(lds, ACT, (const bf16_t*)(W + WOFF_FO), MT, 1024, 2816, EpiRes{XB, p.out, modl + 5120, l});
        if (l == 0) gsync(p, lds);
    }
}

extern "C" void kernel_launch(void* const* d_in, const int* in_sizes, int n_in, void* d_out, int out_size, void* d_ws, size_t ws_size, hipStream_t stream) {
    static int grid = 0;
    if (grid == 0) {
        int dev = 0, cus = 0, per_cu = 0;
        hipGetDevice(&dev);
        hipDeviceGetAttribute(&cus, hipDeviceAttributeMultiprocessorCount, dev);
        hipFuncSetAttribute((const void*)mk_fwd, hipFuncAttributeMaxDynamicSharedMemorySize, LDS_BYTES);
        hipOccupancyMaxActiveBlocksPerMultiprocessor(&per_cu, (const void*)mk_fwd, NT, LDS_BYTES);
        if (per_cu < 1) { fprintf(stderr, "kernel_launch: occupancy query says %d blocks per CU\n", per_cu); per_cu = 1; }
        (void)hipGetLastError();
        grid = cus;
        if (ws_size < WS_END) { fprintf(stderr, "kernel_launch: workspace too small: %zu < %zu\n", ws_size, (size_t)WS_END); grid = -1; }
    }
    if (grid < 0) return;
    if (hipMemsetAsync((char*)d_ws + OFF_BAR, 0, XCD_BAR_WORDS * 4, stream) != hipSuccess) { fprintf(stderr, "kernel_launch: memset failed\n"); return; }
    Params p{};
    for (int i = 0; i < 29; ++i) p.in[i] = (const float*)d_in[i];
    p.out = (float*)d_out; p.ws = (unsigned char*)d_ws;
    void* args[] = {&p};
    hipError_t e = hipLaunchCooperativeKernel((const void*)mk_fwd, dim3(grid), dim3(NT), args, LDS_BYTES, stream);
    if (e != hipSuccess) fprintf(stderr, "cooperative launch failed: %s (grid %d)\n", hipGetErrorString(e), grid);
}
```

```cpp
#include <hip/hip_runtime.h>
#include <hip/hip_cooperative_groups.h>
#include <cstdio>
namespace cg = cooperative_groups;
namespace pg8 {
#define PG8_LAS __attribute__((address_space(3)))
typedef unsigned short bf16_t;
typedef short bf16x8 __attribute__((ext_vector_type(8)));
typedef float f32x4 __attribute__((ext_vector_type(4)));
typedef unsigned u32x4 __attribute__((ext_vector_type(4)));
constexpr int BM = 256, BK = 64, HALF = 128, HTB = HALF * BK * 2  , STAGE_BYTES = 8 * HTB, NXCD = 8, WGM = 8;

__host__ __device__ __forceinline__ int lds_byte(int r, int c) { const int st = (r >> 4) * 2 + (c >> 5), rr = r & 15, cc = c & 31, ob = rr * 64 + cc * 2; return st * 1024 + (ob ^ (((ob >> 9) & 1) << 5)); }
__host__ __device__ __forceinline__ void stage_rc(int b, int& R, int& C) { const int st = b / 1024, sb = b % 1024, swz = sb ^ (((sb >> 9) & 1) << 5); R = (st >> 1) * 16 + swz / 64; C = (st & 1) * 32 + (swz % 64) / 2; }
__host__ __device__ __forceinline__ int perm32(int rho) { const int n = rho >> 4, i = rho & 15; return 8 * (i >> 2) + 4 * n + (i & 3); }

struct Unit { int pm, pn; };
struct Gemm { const bf16_t* A; const bf16_t* Bt; int M, N, K; };

struct StaticOrder {
    int nM, nN, nwg, G, c;
    __host__ __device__ void init(int M, int N, int G_, int c_) { nM = M / BM; nN = N / BM; nwg = nM * nN; G = G_; c = c_; }
    __host__ __device__ bool next(int i, Unit& u) const {
        const long L = (long)i * G + c; if (L >= nwg) return false;
        int wgid = (int)L; { const int q = nwg / NXCD, r = nwg % NXCD, xcd = wgid % NXCD, off = wgid / NXCD; wgid = (xcd < r ? xcd * (q + 1) : r * (q + 1) + (xcd - r) * q) + off; }
        const int nig = WGM * nN, gid = wgid / nig, fm = gid * WGM, gsz = (nM - fm) < WGM ? (nM - fm) : WGM;
        u.pm = fm + ((wgid % nig) % gsz); u.pn = (wgid % nig) / gsz; return true;
    }
    __device__ __forceinline__ void a_ready(const Unit&) const {}
    __device__ __forceinline__ void done(const Unit&) const {}
};
template <class Epi, class Sched, bool STAMP = false>
__device__ __forceinline__ void gemm_phase(PG8_LAS unsigned char* lds, const Gemm g, const Sched& S, const Epi& E, unsigned long long* stamps) {
    int tid = threadIdx.x; asm volatile("" : "+v"(tid)); const int wid = __builtin_amdgcn_readfirstlane(tid >> 6), lane = tid & 63, wr = wid >> 2, wc = wid & 3, fr = lane & 15, fq = lane >> 4;
    const int K = g.K, nt = K / BK;
    int ts_lo = 0, ts_hi = 0, nts = 0; const unsigned long long rt_entry = STAMP ? (unsigned long long)wall_clock64() : 0ull;
#define PG8_STAMP() do { if (STAMP && wid == 0 && nts < 64) { const unsigned long long _c = (unsigned long long)clock64(); \
        ts_lo = (lane == nts) ? (int)(unsigned)_c : ts_lo; ts_hi = (lane == nts) ? (int)(unsigned)(_c >> 32) : ts_hi; ++nts; } } while (0)
    PG8_STAMP();
    unsigned voffA[2], voffB[2];
#pragma unroll
    for (int i = 0; i < 2; ++i) { int R, C; stage_rc(tid * 16 + i * 8192, R, C); const int Rb = Epi::PERM ? ((R & ~31) + perm32(R & 31)) : R;
        voffA[i] = (unsigned)(R * K + C) * 2u; voffB[i] = (unsigned)(Rb * K + C) * 2u; }
    const size_t kstep = (size_t)(BK * 2);
    const size_t hstep = (size_t)HALF * K * 2;
    const size_t tstep = 2 * hstep;
    const unsigned ldsw = (unsigned)wid * 1024u;
    const int aoff = lds_byte(wr * 64 + fr, fq * 8), boff = lds_byte(wc * 32 + fr, fq * 8);
#define PG8_SA(b, h) (((b) * 2 + (h)) * HTB)
#define PG8_SB(b, h) ((4 + (b) * 2 + (h)) * HTB)
#define PG8_STAGE(bufoff, gbase, voff) do { _Pragma("unroll") for (int _i = 0; _i < 2; ++_i) \
        __builtin_amdgcn_global_load_lds((const unsigned*)((const char*)(gbase) + (voff)[_i]), (PG8_LAS unsigned*)(lds + (bufoff) + ldsw + _i * 8192), 16, 0, 0); } while (0)
#define PG8_LDA(dst, b, h) do { _Pragma("unroll") for (int m = 0; m < 4; ++m) _Pragma("unroll") for (int k = 0; k < 2; ++k) dst[m][k] = *(const PG8_LAS bf16x8*)(lds + PG8_SA(b, h) + aoff + m * 2048 + k * 1024); } while (0)
#define PG8_LDB(dst, b, h) do { _Pragma("unroll") for (int n = 0; n < 2; ++n) _Pragma("unroll") for (int k = 0; k < 2; ++k) dst[n][k] = *(const PG8_LAS bf16x8*)(lds + PG8_SB(b, h) + boff + n * 2048 + k * 1024); } while (0)
#define PG8_MMA(ai, bj, At, Bt) do { __builtin_amdgcn_s_setprio(1); _Pragma("unroll") for (int m = 0; m < 4; ++m) _Pragma("unroll") for (int n = 0; n < 2; ++n) _Pragma("unroll") for (int k = 0; k < 2; ++k) \
        acc[ai][bj][m][n] = __builtin_amdgcn_mfma_f32_16x16x32_bf16(Bt[n][k], At[m][k], acc[ai][bj][m][n], 0, 0, 0); __builtin_amdgcn_s_setprio(0); } while (0)
#define PG8_WAIT_V(n) asm volatile("s_waitcnt vmcnt(" #n ")" ::: "memory")
#define PG8_WAIT_L(n) asm volatile("s_waitcnt lgkmcnt(" #n ")" ::: "memory")
#define PG8_BAR __builtin_amdgcn_s_barrier()
#define PG8_SCHED __builtin_amdgcn_sched_barrier(0)
    Unit cur, nxt; int ui = 0;
    if (!S.next(0, cur)) return;
    f32x4 acc[2][2][4][2];
#pragma unroll
    for (int a = 0; a < 2; ++a)
#pragma unroll
        for (int b = 0; b < 2; ++b)
#pragma unroll
            for (int m = 0; m < 4; ++m)
#pragma unroll
                for (int n = 0; n < 2; ++n) acc[a][b][m][n] = (f32x4){0.f, 0.f, 0.f, 0.f};
    bf16x8 At[4][2], B0[2][2], B1[2][2];
    const char* cA = (const char*)g.A + (size_t)cur.pm * tstep; const char* cB = (const char*)g.Bt + (size_t)cur.pn * tstep;
    S.a_ready(cur);
    PG8_STAGE(PG8_SB(0, 0), cB, voffB); PG8_STAGE(PG8_SA(0, 0), cA, voffA); PG8_STAGE(PG8_SB(0, 1), cB + hstep, voffB); PG8_STAGE(PG8_SA(0, 1), cA + hstep, voffA);
    if (wr == 1) PG8_BAR;
    PG8_WAIT_V(4); PG8_BAR;
    PG8_STAGE(PG8_SB(1, 0), cB + kstep, voffB); PG8_STAGE(PG8_SA(1, 0), cA + kstep, voffA); PG8_STAGE(PG8_SB(1, 1), cB + hstep + kstep, voffB);
    PG8_WAIT_V(6); PG8_BAR;
    PG8_STAMP();
    for (;;) {
        const bool has_next = S.next(ui + 1, nxt);
        const char* nA = has_next ? (const char*)g.A + (size_t)nxt.pm * tstep : cA; const char* nB = has_next ? (const char*)g.Bt + (size_t)nxt.pn * tstep : cB;
        for (int t = 0; t < nt; t += 2) {
            const bool last = (t == nt - 2);
            const char* a1 = cA + (size_t)(t + 1) * kstep;
            const char* a2 = last ? nA : cA + (size_t)(t + 2) * kstep; const char* b2 = last ? nB : cB + (size_t)(t + 2) * kstep;
            const char* a3 = a2 + kstep; const char* b3 = b2 + kstep;
            if (last && has_next) S.a_ready(nxt);
            PG8_LDB(B0, 0, 0); PG8_SCHED; PG8_LDA(At, 0, 0); PG8_STAGE(PG8_SA(1, 1), a1 + hstep, voffA);
            PG8_WAIT_L(8); PG8_BAR; PG8_WAIT_L(0); PG8_MMA(0, 0, At, B0); PG8_BAR; PG8_SCHED;
            PG8_LDB(B1, 0, 1); PG8_STAGE(PG8_SB(0, 0), b2, voffB);
            PG8_BAR; PG8_WAIT_L(0); PG8_MMA(0, 1, At, B1); PG8_BAR;
            PG8_LDA(At, 0, 1); PG8_STAGE(PG8_SA(0, 0), a2, voffA);
            PG8_BAR; PG8_WAIT_L(0); PG8_MMA(1, 0, At, B0); PG8_BAR; PG8_SCHED;
            PG8_STAGE(PG8_SB(0, 1), b2 + hstep, voffB);
            PG8_WAIT_V(6); PG8_BAR; PG8_MMA(1, 1, At, B1); PG8_BAR;
            PG8_LDB(B0, 1, 0); PG8_SCHED; PG8_LDA(At, 1, 0); PG8_STAGE(PG8_SA(0, 1), a2 + hstep, voffA);
            PG8_WAIT_L(8); PG8_BAR; PG8_WAIT_L(0); PG8_MMA(0, 0, At, B0); PG8_BAR; PG8_SCHED;
            PG8_LDB(B1, 1, 1); PG8_STAGE(PG8_SB(1, 0), b3, voffB);
            PG8_BAR; PG8_WAIT_L(0); PG8_MMA(0, 1, At, B1); PG8_BAR;
            PG8_LDA(At, 1, 1); PG8_STAGE(PG8_SA(1, 0), a3, voffA);
            PG8_BAR; PG8_WAIT_L(0); PG8_MMA(1, 0, At, B0); PG8_BAR; PG8_SCHED;
            PG8_STAGE(PG8_SB(1, 1), b3 + hstep, voffB);
            PG8_WAIT_V(6); PG8_BAR; PG8_MMA(1, 1, At, B1); PG8_BAR;
        }
        PG8_STAMP();
        if constexpr (!Epi::AFTER_DRAIN) { E(acc, cur, wr, wc, fr, fq); S.done(cur); }
        PG8_STAMP();
        if (!has_next) break;
#pragma unroll
        for (int a = 0; a < 2; ++a)
#pragma unroll
            for (int b = 0; b < 2; ++b)
#pragma unroll
                for (int m = 0; m < 4; ++m)
#pragma unroll
                    for (int n = 0; n < 2; ++n) acc[a][b][m][n] = (f32x4){0.f, 0.f, 0.f, 0.f};
        cur = nxt; cA = nA; cB = nB; ++ui;
    }
    PG8_WAIT_V(0);
    if (wr == 0) PG8_BAR;
    PG8_BAR;
    if constexpr (Epi::AFTER_DRAIN) { E.fused(acc, cur, wr, wc, fr, fq, lds, wid, lane); S.done(cur); }
    PG8_STAMP();
    if (STAMP && wid == 0) { stamps[lane] = lane < nts ? (((unsigned long long)(unsigned)ts_hi << 32) | (unsigned)ts_lo) : 0ull;
        if (lane == 62) stamps[62] = rt_entry; if (lane == 63) stamps[63] = (unsigned long long)wall_clock64(); }
#undef PG8_STAMP
#undef PG8_SA
#undef PG8_SB
#undef PG8_STAGE
#undef PG8_LDA
#undef PG8_LDB
#undef PG8_MMA
#undef PG8_WAIT_V
#undef PG8_WAIT_L
#undef PG8_BAR
#undef PG8_SCHED
}
}
#define XB_TMO      128
#define XB_XCNT(j)  (256  + 64 * (j))
#define XB_XSUB(j)  (1280 + 64 * (j))
#define XB_XGEN(j)  (2304 + 64 * (j))
#define XB_TOP      3328
#define XB_TOPGEN   3392
#define XCD_BAR_WORDS 3456
#define XB_SPIN_CAP (1u << 22)

__device__ __forceinline__ unsigned xb_ld(unsigned* p)              { return __hip_atomic_load(p, __ATOMIC_RELAXED, __HIP_MEMORY_SCOPE_AGENT); }
__device__ __forceinline__ unsigned xb_add(unsigned* p, unsigned v) { return __hip_atomic_fetch_add(p, v, __ATOMIC_RELAXED, __HIP_MEMORY_SCOPE_AGENT); }
__device__ __forceinline__ unsigned xb_xcc_id() { return (unsigned)__builtin_amdgcn_s_getreg((3 << 11) | 20) & 0xFu; }
#define XB_SPIN(cond, bar) do { unsigned _sp = 0; while (cond) { __builtin_amdgcn_s_sleep(1); \
    if ((++_sp & 255u) == 0u) { if (xb_ld(&(bar)[XB_TMO])) break; if (_sp > XB_SPIN_CAP) { atomicAdd(&(bar)[XB_TMO], 1u); break; } } } } while (0)

struct XcdBarrier {
    unsigned* bar; unsigned x;
    volatile PG8_LAS unsigned* st;
};

__device__ __forceinline__ XcdBarrier xcd_barrier_post(unsigned* bar, volatile PG8_LAS unsigned* st) {
    XcdBarrier b; b.bar = bar; b.x = xb_xcc_id(); b.st = st;
    if (threadIdx.x == 0) (void)xb_add(&bar[XB_XCNT(b.x)], 1u);
    return b;
}
__device__ __forceinline__ void xcd_barrier_complete(unsigned* bar, unsigned x, unsigned& nloc, unsigned& nx) {
    const unsigned G = gridDim.x * gridDim.y * gridDim.z;
    unsigned sum, cnt, mine, sp = 0u;
    for (;;) {
        sum = 0u; cnt = 0u; mine = 0u;
#pragma unroll
        for (unsigned j = 0; j < 16; ++j) { const unsigned c = xb_ld(&bar[XB_XCNT(j)]); sum += c; cnt += (c > 0u) ? 1u : 0u; mine = (j == x) ? c : mine; }
        if (sum == G) break;
        __builtin_amdgcn_s_sleep(1);
        if ((++sp & 255u) == 0u) { if (xb_ld(&bar[XB_TMO])) break; if (sp > XB_SPIN_CAP) { atomicAdd(&bar[XB_TMO], 1u); break; } }
    }
    nloc = mine > 0u ? mine : 1u; nx = cnt > 0u ? cnt : 1u;
}

__device__ __forceinline__ void xcd_barrier(const XcdBarrier& b) {
    asm volatile("s_waitcnt vmcnt(0)" ::: "memory");
    __syncthreads();
    if (threadIdx.x == 0) {
        unsigned* bar = b.bar;
        __builtin_amdgcn_s_waitcnt(0);
        unsigned nloc = b.st[0], nx = b.st[1];
        if (nloc == 0u) { xcd_barrier_complete(bar, b.x, nloc, nx); b.st[0] = nloc; b.st[1] = nx; }
        const unsigned old = xb_add(&bar[XB_XSUB(b.x)], 1u);
        const unsigned gen = old / nloc;
        if (old + 1u == (gen + 1u) * nloc) {
            __builtin_amdgcn_fence(__ATOMIC_RELEASE, "agent");
            asm volatile("s_waitcnt vmcnt(0)" ::: "memory");
            const unsigned og = xb_add(&bar[XB_TOP], 1u);
            const unsigned tg = og / nx;
            if (og + 1u == (tg + 1u) * nx) xb_add(&bar[XB_TOPGEN], 1u);
            else XB_SPIN(xb_ld(&bar[XB_TOPGEN]) == tg, bar);
            __builtin_amdgcn_fence(__ATOMIC_ACQUIRE, "agent");
            xb_add(&bar[XB_XGEN(b.x)], 1u);
            asm volatile("s_waitcnt vmcnt(0)" ::: "memory");
        } else {
            XB_SPIN(xb_ld(&bar[XB_XGEN(b.x)]) == gen, bar);
            __builtin_amdgcn_fence(__ATOMIC_ACQUIRE, "agent");
            asm volatile("s_waitcnt vmcnt(0)" ::: "memory");
        }
    }
    __syncthreads();
}

using namespace pg8;
typedef float f32x16 __attribute__((ext_vector_type(16)));
typedef unsigned u32x2 __attribute__((ext_vector_type(2)));
#define LAS PG8_LAS
#define DI __device__ __forceinline__

constexpr int NT = 512;
constexpr int MP = 32768, MS = 2048, MT = MP + MS;
constexpr int KEYS_S = 4352;
constexpr int KR_ROWS = MP + 32 * KEYS_S;
constexpr int ZLD = 2560;
constexpr float EPS = 1e-6f;
constexpr float QSCALE = 0.10206207261596577f * 1.4426950408889634f;
constexpr int LDS_BYTES = 160 * 1024;

constexpr size_t SZ_WIN = 2560ull * 1024 * 2, SZ_WUQ = 768ull * 256 * 2, SZ_WUK = 512ull * 256 * 2, SZ_WUV = 512ull * 256 * 2,
                 SZ_WO = 1024ull * 1024 * 2, SZ_WFI = 5632ull * 1024 * 2, SZ_WFO = 1024ull * 2816 * 2;
constexpr size_t WOFF_IN = 0, WOFF_UQ = WOFF_IN + SZ_WIN, WOFF_UK = WOFF_UQ + SZ_WUQ, WOFF_UV = WOFF_UK + SZ_WUK, WOFF_O = WOFF_UV + SZ_WUV,
                 WOFF_FI = WOFF_O + SZ_WO, WOFF_FO = WOFF_FI + SZ_WFI, WL = WOFF_FO + SZ_WFO;
constexpr size_t OFF_W = 0;
constexpr size_t OFF_MOD = OFF_W + 2 * WL;
constexpr size_t OFF_ROPE = OFF_MOD + 2ull * 36 * 6144 * 4;
constexpr size_t OFF_H = OFF_ROPE + 8192ull * 16 * 2 * 4;
constexpr size_t OFF_Z = OFF_H + (size_t)MT * 1024 * 2;
constexpr size_t OFF_CQN = OFF_Z + (size_t)MT * ZLD * 2;
constexpr size_t OFF_CKV = OFF_CQN + (size_t)MT * 256 * 2;
constexpr size_t OFF_KROPE = OFF_CKV + (size_t)KR_ROWS * 256 * 2;
constexpr size_t OFF_Q = OFF_KROPE + (size_t)KR_ROWS * 32 * 2;
constexpr size_t OFF_KN = OFF_Q + (size_t)MT * 768 * 2;
constexpr size_t OFF_VT = OFF_KN + (size_t)KR_ROWS * 512 * 2;
constexpr size_t OFF_O = OFF_VT + (size_t)KR_ROWS * 512 * 2;
constexpr size_t OFF_PART = OFF_O + (size_t)MP * 512 * 2;
constexpr size_t OFF_UHG = OFF_PART + 32ull * 8 * 4 * 64 * 66 * 4;
constexpr size_t OFF_DHG = OFF_UHG + 544ull * 4 * 64 * 64 * 4;
constexpr size_t OFF_UGL = OFF_DHG + 544ull * 4 * 64 * 4;
constexpr size_t OFF_DGL = OFF_UGL + 544ull * 4 * 32 * 64 * 4;
constexpr size_t OFF_BAR = OFF_DGL + 544ull * 4 * 32 * 4;
constexpr size_t OFF_XB = OFF_BAR + 16384;
constexpr size_t WS_END = OFF_XB + (size_t)MT * 1024 * 2;
constexpr size_t OFF_ACT = OFF_KN;
static_assert((size_t)MT * 2816 * 2 <= 2 * (size_t)KR_ROWS * 512 * 2, "act alias");

constexpr size_t OUT_Y = 0, OUT_CKVP = 35651584, OUT_KRP = 52428800, OUT_HGP = 54525952, OUT_GLP = 54657024,
                 OUT_CKVS = 54722560, OUT_KRS = 55771136, OUT_HGS = 55902208, OUT_GLS = 56950784;

DI int tid_() { int t = threadIdx.x; asm volatile("" : "+v"(t)); return t; }
DI int bid_() { int b = blockIdx.x; asm volatile("" : "+s"(b)); return b; }
DI float neg_big() { float v = -1e30f; asm volatile("" : "+v"(v)); return v; }
struct Params { const float* in[29]; float* out; unsigned char* ws; };

typedef __bf16 hbf2 __attribute__((ext_vector_type(2)));
typedef float f32x2_ __attribute__((ext_vector_type(2)));
DI unsigned pack2(float a, float b) { f32x2_ v = {a, b}; return __builtin_bit_cast(unsigned, __builtin_convertvector(v, hbf2)); }
DI bf16_t f2bf(float f) { return (bf16_t)(pack2(f, f) & 0xFFFFu); }
DI float bf2f(bf16_t b) { return __uint_as_float(((unsigned)b) << 16); }
DI float bflo(unsigned u) { return __uint_as_float(u << 16); }
DI float bfhi(unsigned u) { return __uint_as_float(u & 0xFFFF0000u); }
DI float wave_sum(float v) { v += __shfl_xor(v, 32); v += __shfl_xor(v, 16); v += __shfl_xor(v, 8); v += __shfl_xor(v, 4); v += __shfl_xor(v, 2); v += __shfl_xor(v, 1); return v; }
DI float sigmoidf_(float x) { return 1.f / (1.f + expf(-x)); }
DI int row_bi(int row) { return row < MP ? (row >> 13) : 4 + ((row - MP) >> 6); }

struct EpiZ {
    static constexpr bool PERM = true, AFTER_DRAIN = false;
    bf16_t* O; int ldc;
    DI void operator()(const f32x4 (&acc)[2][2][4][2], const Unit& u, int wr, int wc, int fr, int fq) const {
        const int row0 = u.pm * 256 + wr * 64 + fr, col0 = u.pn * 256 + wc * 32 + 8 * fq;
#pragma unroll
        for (int ai = 0; ai < 2; ++ai)
#pragma unroll
            for (int m = 0; m < 4; ++m) { bf16_t* rowp = O + (size_t)(row0 + ai * 128 + m * 16) * ldc + col0;
#pragma unroll
                for (int bj = 0; bj < 2; ++bj) { const f32x4 v0 = acc[ai][bj][m][0], v1 = acc[ai][bj][m][1]; uint4 w; w.x = pack2(v0[0], v0[1]); w.y = pack2(v0[2], v0[3]); w.z = pack2(v1[0], v1[1]); w.w = pack2(v1[2], v1[3]); *(uint4*)(rowp + bj * 128) = w; } }
    }
};
struct EpiQ {
    static constexpr bool PERM = false, AFTER_DRAIN = false;
    bf16_t* Q; const float* qn_; const float* rope_;
    DI void operator()(const f32x4 (&acc)[2][2][4][2], const Unit& u, int wr, int wc, int fr, int fq) const {
        const float* qn = qn_; const float* rope = rope_; asm volatile("" : "+s"(qn), "+s"(rope));
        float eps_ = EPS; asm volatile("" : "+v"(eps_));
        const int row0 = u.pm * 256 + wr * 64 + fr;
#pragma unroll
        for (int ai = 0; ai < 2; ++ai)
#pragma unroll
            for (int m = 0; m < 4; ++m) {
                const int row = row0 + ai * 128 + m * 16;
                int pos; size_t base, hs;
                if (row < MP) { const int b = row >> 13, t = row & 8191; pos = t; base = ((size_t)(b * 8) * 8192 + t) * 96; hs = 8192 * 96; }
                else { const int r = row - MP, b = r >> 6, t = r & 63; pos = 4096 + t; base = (size_t)MP * 768 + ((size_t)(b * 8) * 64 + t) * 96; hs = 64 * 96; }
                if (u.pn < 2) {
                    const int head = 4 * u.pn + wc;
                    float ss = 0.f;
#pragma unroll
                    for (int bj = 0; bj < 2; ++bj)
#pragma unroll
                        for (int n = 0; n < 2; ++n) { const f32x4 v = acc[ai][bj][m][n]; ss += v[0] * v[0] + v[1] * v[1] + v[2] * v[2] + v[3] * v[3]; }
                    ss += __shfl_xor(ss, 16); ss += __shfl_xor(ss, 32);
                    const float rs = rsqrtf(ss * (1.f / 64.f) + eps_) * QSCALE;
#pragma unroll
                    for (int bj = 0; bj < 2; ++bj)
#pragma unroll
                        for (int n = 0; n < 2; ++n) { const int d = 32 * bj + 16 * n + 4 * fq; const f32x4 v = acc[ai][bj][m][n]; const float4 g = *(const float4*)(qn + d);
                            uint2 w; w.x = pack2(v[0] * rs * g.x, v[1] * rs * g.y); w.y = pack2(v[2] * rs * g.z, v[3] * rs * g.w); *(uint2*)(Q + base + head * hs + d) = w; }
                } else {
#pragma unroll
                    for (int bj = 0; bj < 2; ++bj) {
                        const int head = 2 * wc + bj;
                        const f32x4 v1 = acc[ai][bj][m][0], v2 = acc[ai][bj][m][1];
                        float ss = v1[0] * v1[0] + v1[1] * v1[1] + v1[2] * v1[2] + v1[3] * v1[3] + v2[0] * v2[0] + v2[1] * v2[1] + v2[2] * v2[2] + v2[3] * v2[3];
                        ss += __shfl_xor(ss, 16); ss += __shfl_xor(ss, 32);
                        const float rs = rsqrtf(ss * (1.f / 32.f) + eps_);
                        const float4 g1 = *(const float4*)(qn + 64 + 4 * fq), g2 = *(const float4*)(qn + 80 + 4 * fq);
                        const float4 cs0 = *(const float4*)(rope + ((size_t)pos * 16 + 4 * fq) * 2), cs1 = *(const float4*)(rope + ((size_t)pos * 16 + 4 * fq) * 2 + 4);
                        const float x10 = v1[0] * rs * g1.x, x11 = v1[1] * rs * g1.y, x12 = v1[2] * rs * g1.z, x13 = v1[3] * rs * g1.w;
                        const float x20 = v2[0] * rs * g2.x, x21 = v2[1] * rs * g2.y, x22 = v2[2] * rs * g2.z, x23 = v2[3] * rs * g2.w;
                        uint2 w1, w2;
                        w1.x = pack2((x10 * cs0.x - x20 * cs0.y) * QSCALE, (x11 * cs0.z - x21 * cs0.w) * QSCALE);
                        w1.y = pack2((x12 * cs1.x - x22 * cs1.y) * QSCALE, (x13 * cs1.z - x23 * cs1.w) * QSCALE);
                        w2.x = pack2((x20 * cs0.x + x10 * cs0.y) * QSCALE, (x21 * cs0.z + x11 * cs0.w) * QSCALE);
                        w2.y = pack2((x22 * cs1.x + x12 * cs1.y) * QSCALE, (x23 * cs1.z + x13 * cs1.w) * QSCALE);
                        *(uint2*)(Q + base + head * hs + 64 + 4 * fq) = w1; *(uint2*)(Q + base + head * hs + 80 + 4 * fq) = w2;
                    }
                }
            }
    }
};
struct EpiKN {
    static constexpr bool PERM = true, AFTER_DRAIN = false;
    bf16_t* KN; const float* kn_;
    DI void operator()(const f32x4 (&acc)[2][2][4][2], const Unit& u, int wr, int wc, int fr, int fq) const {
        const float* kn = kn_; asm volatile("" : "+s"(kn));
        float eps_ = EPS; asm volatile("" : "+v"(eps_));
        float4 gk[2][2];
#pragma unroll
        for (int bj = 0; bj < 2; ++bj)
#pragma unroll
            for (int n = 0; n < 2; ++n) gk[bj][n] = *(const float4*)(kn + 32 * bj + 8 * fq + 4 * n);
        size_t base, hs;
        if (u.pm < 128) { const int b = u.pm >> 5, key0 = (u.pm & 31) * 256; base = ((size_t)(b * 8) * 8192 + key0) * 64; hs = (size_t)8192 * 64; }
        else { const int q = u.pm - 128, b = q / 17, key0 = (q % 17) * 256; base = (size_t)MP * 512 + ((size_t)(b * 8) * KEYS_S + key0) * 64; hs = (size_t)KEYS_S * 64; }
        const int head = 4 * u.pn + wc;
#pragma unroll
        for (int ai = 0; ai < 2; ++ai)
#pragma unroll
            for (int m = 0; m < 4; ++m) {
                const int key = 128 * ai + 64 * wr + 16 * m + fr;
                float ss = 0.f;
#pragma unroll
                for (int bj = 0; bj < 2; ++bj)
#pragma unroll
                    for (int n = 0; n < 2; ++n) { const f32x4 v = acc[ai][bj][m][n]; ss += v[0] * v[0] + v[1] * v[1] + v[2] * v[2] + v[3] * v[3]; }
                ss += __shfl_xor(ss, 16); ss += __shfl_xor(ss, 32);
                const float rs = rsqrtf(ss * (1.f / 64.f) + eps_);
#pragma unroll
                for (int bj = 0; bj < 2; ++bj) { const f32x4 v0 = acc[ai][bj][m][0], v1 = acc[ai][bj][m][1]; const float4 g0 = gk[bj][0], g1 = gk[bj][1];
                    uint4 w; w.x = pack2(v0[0] * rs * g0.x, v0[1] * rs * g0.y); w.y = pack2(v0[2] * rs * g0.z, v0[3] * rs * g0.w); w.z = pack2(v1[0] * rs * g1.x, v1[1] * rs * g1.y); w.w = pack2(v1[2] * rs * g1.z, v1[3] * rs * g1.w);
                    *(uint4*)(KN + base + head * hs + (size_t)key * 64 + 32 * bj + 8 * fq) = w; }
            }
    }
};
struct EpiVT {
    static constexpr bool PERM = true, AFTER_DRAIN = false;
    bf16_t* VT;
    DI void operator()(const f32x4 (&acc)[2][2][4][2], const Unit& u, int wr, int wc, int fr, int fq) const {
        size_t base; int KL;
        if (u.pn < 128) { const int b = u.pn >> 5, key0 = (u.pn & 31) * 256; base = (size_t)(b * 8) * 64 * 8192 + key0; KL = 8192; }
        else { const int q = u.pn - 128, b = q / 17, key0 = (q % 17) * 256; base = (size_t)MP * 512 + (size_t)(b * 8) * 64 * KEYS_S + key0; KL = KEYS_S; }
#pragma unroll
        for (int ai = 0; ai < 2; ++ai)
#pragma unroll
            for (int m = 0; m < 4; ++m) {
                const int r = 256 * u.pm + 128 * ai + 64 * wr + 16 * m + fr;
                bf16_t* rowp = VT + base + (size_t)r * KL + 32 * wc + 8 * fq;
#pragma unroll
                for (int bj = 0; bj < 2; ++bj) { const f32x4 v0 = acc[ai][bj][m][0], v1 = acc[ai][bj][m][1]; uint4 w; w.x = pack2(v0[0], v0[1]); w.y = pack2(v0[2], v0[3]); w.z = pack2(v1[0], v1[1]); w.w = pack2(v1[2], v1[3]); *(uint4*)(rowp + 128 * bj) = w; }
            }
    }
};
struct EpiRes {
    static constexpr bool PERM = false, AFTER_DRAIN = false;
    bf16_t* XB; float* out; const float* gate; int final;
    DI void operator()(const f32x4 (&acc)[2][2][4][2], const Unit& u, int wr, int wc, int fr, int fq) const {
        const int row0 = u.pm * 256 + wr * 64 + fr, col0 = u.pn * 256 + wc * 32 + 4 * fq;
#pragma unroll
        for (int ai = 0; ai < 2; ++ai) {
            const float* gr = gate + (size_t)row_bi(row0 + ai * 128) * 6144 + col0;
            f32x4 g[2][2]; uint2 x[4][2][2];
#pragma unroll
            for (int bj = 0; bj < 2; ++bj)
#pragma unroll
                for (int n = 0; n < 2; ++n) g[bj][n] = *(const f32x4*)(gr + bj * 128 + n * 16);
#pragma unroll
            for (int m = 0; m < 4; ++m) { const bf16_t* xr = XB + (size_t)(row0 + ai * 128 + m * 16) * 1024 + col0;
#pragma unroll
                for (int bj = 0; bj < 2; ++bj)
#pragma unroll
                    for (int n = 0; n < 2; ++n) x[m][bj][n] = *(const uint2*)(xr + bj * 128 + n * 16); }
#pragma unroll
            for (int m = 0; m < 4; ++m) { const size_t ro = (size_t)(row0 + ai * 128 + m * 16) * 1024 + col0;
#pragma unroll
                for (int bj = 0; bj < 2; ++bj)
#pragma unroll
                    for (int n = 0; n < 2; ++n) { const uint2 xv = x[m][bj][n]; const f32x4 xf = {bflo(xv.x), bfhi(xv.x), bflo(xv.y), bfhi(xv.y)}; const f32x4 r = xf + g[bj][n] * acc[ai][bj][m][n];
                        if (final) *(f32x4*)(out + ro + bj * 128 + n * 16) = r;
                        else { uint2 w; w.x = pack2(r[0], r[1]); w.y = pack2(r[2], r[3]); *(uint2*)(XB + ro + bj * 128 + n * 16) = w; } } }
        }
    }
};
struct EpiSwi {
    static constexpr bool PERM = true, AFTER_DRAIN = false;
    bf16_t* ACT;
    DI void operator()(const f32x4 (&acc)[2][2][4][2], const Unit& u, int wr, int wc, int fr, int fq) const {
        const int row0 = u.pm * 256 + wr * 64 + fr, col0 = u.pn * 128 + wc * 32 + 8 * fq;
#pragma unroll
        for (int ai = 0; ai < 2; ++ai)
#pragma unroll
            for (int m = 0; m < 4; ++m) { bf16_t* rowp = ACT + (size_t)(row0 + ai * 128 + m * 16) * 2816 + col0; float r[8];
#pragma unroll
                for (int n = 0; n < 2; ++n) { const f32x4 a = acc[ai][0][m][n], g = acc[ai][1][m][n];
#pragma unroll
                    for (int j = 0; j < 4; ++j) r[4 * n + j] = a[j] / (1.f + __expf(-a[j])) * g[j]; }
                uint4 w; w.x = pack2(r[0], r[1]); w.y = pack2(r[2], r[3]); w.z = pack2(r[4], r[5]); w.w = pack2(r[6], r[7]); *(uint4*)rowp = w; }
    }
};
template <class Epi> DI void run_gemm(LAS unsigned char* lds, const bf16_t* A, const bf16_t* Bt, int M, int N, int K, const Epi& E) {
    asm volatile("" : "+s"(M), "+s"(N), "+s"(K));
    Gemm g{A, Bt, M, N, K}; StaticOrder S; S.init(M, N, (int)gridDim.x, (int)bid_());
    gemm_phase<Epi, StaticOrder, false>(lds, g, S, E, nullptr);
}

DI int colmap(int w, int n) {
    if (w == 0) return n < 2352 ? n : -1;
    if (w == 1) { const int pn = n >> 8, c = n & 255, bj = c >> 7, wc = (c >> 5) & 3, cc = c & 31; return pn < 2 ? (4 * pn + wc) * 96 + 32 * bj + cc : (2 * wc + bj) * 96 + 64 + cc; }
    if (w == 2) { const int pn = n >> 8, c = n & 255, bj = c >> 7, wc = (c >> 5) & 3, cc = c & 31; return (4 * pn + wc) * 64 + 32 * bj + cc; }
    if (w == 5) { const int pn = n >> 8, c = n & 255; return c < 128 ? 128 * pn + c : 2816 + 128 * pn + (c - 128); }
    return n;
}
DI void phase_prep(const Params& p, LAS unsigned char* lds) {
    const int tid = tid_();
    LAS bf16_t* T = (LAS bf16_t*)lds;
    for (int ti = bid_(); ti < 2 * 1560; ti += gridDim.x) {
        const int l = ti / 1560, r = ti % 1560;
        int w, t0, K, ld; size_t doff; const float* src;
        if (r < 320) { w = 0; t0 = 0; K = 1024; ld = 2352; doff = WOFF_IN; src = p.in[12]; }
        else if (r < 344) { w = 1; t0 = 320; K = 256; ld = 768; doff = WOFF_UQ; src = p.in[15]; }
        else if (r < 360) { w = 2; t0 = 344; K = 256; ld = 512; doff = WOFF_UK; src = p.in[16]; }
        else if (r < 376) { w = 3; t0 = 360; K = 256; ld = 512; doff = WOFF_UV; src = p.in[17]; }
        else if (r < 504) { w = 4; t0 = 376; K = 1024; ld = 1024; doff = WOFF_O; src = p.in[26]; }
        else if (r < 1208) { w = 5; t0 = 504; K = 1024; ld = 5632; doff = WOFF_FI; src = p.in[27]; }
        else { w = 6; t0 = 1208; K = 2816; ld = 1024; doff = WOFF_FO; src = p.in[28]; }
        src += (size_t)l * K * ld;
        const int kt = K >> 7, tr = r - t0, n0 = (tr / kt) * 64, k0 = (tr % kt) * 128;
        bf16_t* dst = (bf16_t*)(p.ws + OFF_W + (size_t)l * WL + doff);
        const int nn = tid & 63, col = colmap(w, n0 + nn);
        float tv[16];
#pragma unroll
        for (int i = 0; i < 16; ++i) { const int kk = (tid >> 6) + 8 * i; tv[i] = col >= 0 ? src[(size_t)(k0 + kk) * ld + col] : 0.f; }
#pragma unroll
        for (int i = 0; i < 16; ++i) { const int kk = (tid >> 6) + 8 * i; T[nn * 130 + kk] = f2bf(tv[i]); }
        __syncthreads();
#pragma unroll
        for (int j = 0; j < 2; ++j) { const int q = tid + 512 * j, row = q >> 4, seg = q & 15; const LAS unsigned* tp = (const LAS unsigned*)(T + row * 130 + seg * 8);
          uint4 o; o.x = tp[0]; o.y = tp[1]; o.z = tp[2]; o.w = tp[3]; *(uint4*)(dst + (size_t)(n0 + row) * K + k0 + seg * 8) = o; }
        __syncthreads();
    }
    float* mod = (float*)(p.ws + OFF_MOD);
    for (int it = bid_(); it < 192; it += gridDim.x) {
        const int l = it / 96, cgp = it % 96;
        LAS float* sl = (LAS float*)lds;
        for (int i = tid; i < 36 * 1024; i += NT) { const int bi = i >> 10, k = i & 1023; const float c = bi < 4 ? p.in[2][bi * 1024 + k] : p.in[3][(bi - 4) * 1024 + k]; sl[i] = c / (1.f + expf(-c)); }
        __syncthreads();
        const int cl = tid & 63, kq = tid >> 6;
        float acc[36];
#pragma unroll
        for (int bi = 0; bi < 36; ++bi) acc[bi] = 0.f;
        const float* wm = p.in[8] + (size_t)l * 1024 * 6144 + cgp * 64 + cl;
#pragma unroll 4
        for (int k = kq * 128; k < kq * 128 + 128; k += 4) {
            const float w0 = wm[(size_t)k * 6144], w1 = wm[(size_t)(k + 1) * 6144], w2 = wm[(size_t)(k + 2) * 6144], w3 = wm[(size_t)(k + 3) * 6144];
#pragma unroll
            for (int bi = 0; bi < 36; ++bi) { const f32x4 s = *(const LAS f32x4*)(sl + bi * 1024 + k); acc[bi] += s[0] * w0 + s[1] * w1 + s[2] * w2 + s[3] * w3; }
        }
        __syncthreads();
        LAS float* red = (LAS float*)lds;
#pragma unroll
        for (int bi = 0; bi < 36; ++bi) red[(kq * 36 + bi) * 64 + cl] = acc[bi];
        __syncthreads();
        for (int o = tid; o < 36 * 64; o += NT) { const int bi = o >> 6, c = o & 63; float s = 0.f;
#pragma unroll
            for (int q = 0; q < 8; ++q) s += red[(q * 36 + bi) * 64 + c];
            const int colg = cgp * 64 + c; mod[((size_t)l * 36 + bi) * 6144 + colg] = s + p.in[9][l * 6144 + colg]; }
        __syncthreads();
    }
    float* rope = (float*)(p.ws + OFF_ROPE);
    for (int i = bid_() * NT + tid; i < 8192 * 16; i += gridDim.x * NT) { const int pos = i >> 4, j = i & 15;
        const float inv = exp2f(-(float)j * (13.287712379549449f / 16.f)); const float ang = (float)pos * inv; rope[2 * i] = cosf(ang); rope[2 * i + 1] = sinf(ang); }
}

template <bool FROM_INPUT>
DI void phase_hrows(const Params& p, int l, const float* xa, const float* xb, const float* g, int shoff, int scoff) {
    const int tid = tid_(), lane = tid & 63, wid = __builtin_amdgcn_readfirstlane(tid >> 6);
    const float* mod = (const float*)(p.ws + OFF_MOD) + (size_t)l * 36 * 6144;
    bf16_t* H = (bf16_t*)(p.ws + OFF_H); bf16_t* XB = (bf16_t*)(p.ws + OFF_XB);
    const int stride = gridDim.x * 8;
    int row = bid_() * 8 + wid;
    float4 v[4];
#define HR_LOAD(dst, rr) do { if (FROM_INPUT) { const float* xr_ = (rr) < MP ? xa + (size_t)(rr) * 1024 : xb + (size_t)((rr) - MP) * 1024; \
            _Pragma("unroll") for (int i = 0; i < 4; ++i) dst[i] = *(const float4*)(xr_ + i * 256 + lane * 4); } \
        else { const bf16_t* xr_ = XB + (size_t)(rr) * 1024; \
            _Pragma("unroll") for (int i = 0; i < 4; ++i) { const uint2 u_ = *(const uint2*)(xr_ + i * 256 + lane * 4); dst[i].x = bflo(u_.x); dst[i].y = bfhi(u_.x); dst[i].z = bflo(u_.y); dst[i].w = bfhi(u_.y); } } } while (0)
    if (row < MT) HR_LOAD(v, row);
    while (row < MT) {
        const int nrow = row + stride; float4 nv[4];
        if (nrow < MT) HR_LOAD(nv, nrow);
        float ss = 0.f;
#pragma unroll
        for (int i = 0; i < 4; ++i) ss += v[i].x * v[i].x + v[i].y * v[i].y + v[i].z * v[i].z + v[i].w * v[i].w;
        ss = wave_sum(ss);
        const float rs = rsqrtf(ss * (1.f / 1024.f) + EPS);
        const float* mp = mod + (size_t)row_bi(row) * 6144;
#pragma unroll
        for (int i = 0; i < 4; ++i) { const int col = i * 256 + lane * 4;
            const float4 gg = *(const float4*)(g + col), sc = *(const float4*)(mp + scoff + col), sh = *(const float4*)(mp + shoff + col);
            uint2 w; w.x = pack2(v[i].x * rs * gg.x * (1.f + sc.x) + sh.x, v[i].y * rs * gg.y * (1.f + sc.y) + sh.y);
            w.y = pack2(v[i].z * rs * gg.z * (1.f + sc.z) + sh.z, v[i].w * rs * gg.w * (1.f + sc.w) + sh.w);
            *(uint2*)(H + (size_t)row * 1024 + col) = w;
            if (FROM_INPUT) { uint2 xw; xw.x = pack2(v[i].x, v[i].y); xw.y = pack2(v[i].z, v[i].w); *(uint2*)(XB + (size_t)row * 1024 + col) = xw; } }
#pragma unroll
        for (int i = 0; i < 4; ++i) v[i] = nv[i];
        row = nrow;
    }
#undef HR_LOAD
}
DI void phase_cache(const Params& p, int l, int b0, int nb) {
    const size_t gt = (size_t)(bid_() - b0) * NT + tid_(), gs = (size_t)nb * NT;
    bf16_t* ckv_s = (bf16_t*)(p.ws + OFF_CKV) + (size_t)MP * 256;
    bf16_t* kr_s = (bf16_t*)(p.ws + OFF_KROPE) + (size_t)MP * 32;
    const float4* s1 = (const float4*)(p.in[4] + (size_t)l * 32 * 4096 * 256);
    for (size_t i0 = gt; i0 < 8388608; i0 += gs * 8) { float4 v[8];
#pragma unroll
        for (int u = 0; u < 8; ++u) { const size_t i = i0 + u * gs; if (i < 8388608) v[u] = s1[i]; }
#pragma unroll
        for (int u = 0; u < 8; ++u) { const size_t i = i0 + u * gs; if (i < 8388608) { const size_t e = i * 4, b = e >> 20, rem = e & 1048575;
            uint2 w; w.x = pack2(v[u].x, v[u].y); w.y = pack2(v[u].z, v[u].w); *(uint2*)(ckv_s + b * KEYS_S * 256 + rem) = w; } } }
    unsigned zz = 0u; asm volatile("" : "+v"(zz));
    for (size_t i = gt; i < 393216; i += gs) { const size_t e = i * 4, b = e / 49152, rem = e % 49152; uint2 w; w.x = zz; w.y = zz; *(uint2*)(ckv_s + b * KEYS_S * 256 + 4160 * 256 + rem) = w; }
    const float4* s2 = (const float4*)(p.in[5] + (size_t)l * 32 * 4096 * 32);
    for (size_t i0 = gt; i0 < 1048576; i0 += gs * 8) { float4 v[8];
#pragma unroll
        for (int u = 0; u < 8; ++u) { const size_t i = i0 + u * gs; if (i < 1048576) v[u] = s2[i]; }
#pragma unroll
        for (int u = 0; u < 8; ++u) { const size_t i = i0 + u * gs; if (i < 1048576) { const size_t e = i * 4, b = e >> 17, rem = e & 131071;
            uint2 w; w.x = pack2(v[u].x, v[u].y); w.y = pack2(v[u].z, v[u].w); *(uint2*)(kr_s + b * KEYS_S * 32 + rem) = w; } } }
}
DI void phase_post(const Params& p, int l) {
    const int tid = tid_(), lane = tid & 63, wid = __builtin_amdgcn_readfirstlane(tid >> 6);
    const bf16_t* Z = (const bf16_t*)(p.ws + OFF_Z);
    bf16_t* CQN = (bf16_t*)(p.ws + OFF_CQN); bf16_t* CKV = (bf16_t*)(p.ws + OFF_CKV); bf16_t* KRO = (bf16_t*)(p.ws + OFF_KROPE);
    const float* rope = (const float*)(p.ws + OFF_ROPE);
    const float* gcq = p.in[13] + l * 256; const float* gckv = p.in[14] + l * 256; const float* gk = p.in[19] + l * 96 + 64;
    const int stride = gridDim.x * 8;
    int row = bid_() * 8 + wid;
    uint2 u1, u2; bf16_t u3;
    if (row < MT) { const bf16_t* zr = Z + (size_t)row * ZLD; u1 = *(const uint2*)(zr + 4 * lane); u2 = *(const uint2*)(zr + 256 + 4 * lane); u3 = zr[512 + (lane & 31)]; }
    while (row < MT) {
        const int nrow = row + stride; uint2 n1, n2; bf16_t n3;
        if (nrow < MT) { const bf16_t* zr = Z + (size_t)nrow * ZLD; n1 = *(const uint2*)(zr + 4 * lane); n2 = *(const uint2*)(zr + 256 + 4 * lane); n3 = zr[512 + (lane & 31)]; }
        int pos; size_t grow; float* o_ckv; float* o_kr;
        if (row < MP) { const int b = row >> 13, t = row & 8191; pos = t; grow = row; o_ckv = p.out + OUT_CKVP + ((size_t)(l * 4 + b) * 8192 + t) * 256; o_kr = p.out + OUT_KRP + ((size_t)(l * 4 + b) * 8192 + t) * 32; }
        else { const int r = row - MP, b = r >> 6, t = r & 63; pos = 4096 + t; grow = (size_t)MP + (size_t)b * KEYS_S + 4096 + t; o_ckv = p.out + OUT_CKVS + ((size_t)(l * 32 + b) * 64 + t) * 256; o_kr = p.out + OUT_KRS + ((size_t)(l * 32 + b) * 64 + t) * 32; }
        { const uint2 u = u1; const float a0 = bflo(u.x), a1 = bfhi(u.x), a2 = bflo(u.y), a3 = bfhi(u.y);
          const float ss = wave_sum(a0 * a0 + a1 * a1 + a2 * a2 + a3 * a3); const float rs = rsqrtf(ss * (1.f / 256.f) + EPS); const float4 g = *(const float4*)(gcq + 4 * lane);
          uint2 w; w.x = pack2(a0 * rs * g.x, a1 * rs * g.y); w.y = pack2(a2 * rs * g.z, a3 * rs * g.w); *(uint2*)(CQN + (size_t)row * 256 + 4 * lane) = w; }
        { const uint2 u = u2; const float a0 = bflo(u.x), a1 = bfhi(u.x), a2 = bflo(u.y), a3 = bfhi(u.y);
          const float ss = wave_sum(a0 * a0 + a1 * a1 + a2 * a2 + a3 * a3); const float rs = rsqrtf(ss * (1.f / 256.f) + EPS); const float4 g = *(const float4*)(gckv + 4 * lane);
          float4 o; o.x = a0 * rs * g.x; o.y = a1 * rs * g.y; o.z = a2 * rs * g.z; o.w = a3 * rs * g.w; *(float4*)(o_ckv + 4 * lane) = o;
          uint2 w; w.x = pack2(o.x, o.y); w.y = pack2(o.z, o.w); *(uint2*)(CKV + grow * 256 + 4 * lane) = w; }
        { const int i = lane & 31; const float a = bf2f(u3); float ss = a * a; ss += __shfl_xor(ss, 16); ss += __shfl_xor(ss, 8); ss += __shfl_xor(ss, 4); ss += __shfl_xor(ss, 2); ss += __shfl_xor(ss, 1);
          const float xn = a * rsqrtf(ss * (1.f / 32.f) + EPS) * gk[i]; const float other = __shfl_xor(xn, 16);
          const float2 cs = *(const float2*)(rope + ((size_t)pos * 16 + (i & 15)) * 2);
          const float o = i < 16 ? xn * cs.x - other * cs.y : xn * cs.x + other * cs.y;
          if (lane < 32) { o_kr[i] = o; KRO[grow * 32 + i] = f2bf(o); } }
        u1 = n1; u2 = n2; u3 = n3; row = nrow;
    }
}

DI f32x16 mfma32(bf16x8 a, bf16x8 b, f32x16 c) { return __builtin_amdgcn_mfma_f32_32x32x16_bf16(a, b, c, 0, 0, 0); }
DI f32x4 mfma16(bf16x8 a, bf16x8 b, f32x4 c) { return __builtin_amdgcn_mfma_f32_16x16x32_bf16(a, b, c, 0, 0, 0); }
DI bf16x8 pack8(const f32x16& s, int b) { u32x4 r; r[0] = pack2(s[b], s[b + 1]); r[1] = pack2(s[b + 2], s[b + 3]); r[2] = pack2(s[b + 4], s[b + 5]); r[3] = pack2(s[b + 6], s[b + 7]); return __builtin_bit_cast(bf16x8, r); }

template <int NH>
DI void attn_core(LAS unsigned char* lds, const bf16_t* qptr, const bf16_t* kn, size_t kn_hs, const bf16_t* kr, const bf16_t* vt, size_t vt_hs, int KL,
                  int kt0, int kstep, int nit, int nvalid, int tile_lim, int hh, f32x16 (&o)[2], float& m_run, float& l_run) {
    constexpr int BUFSZ = NH * 17920 + 5120;
    const int tid = tid_(), lane = tid & 63, r = lane & 31, h = lane >> 5;
    bf16x8 qf[6];
#pragma unroll
    for (int ks = 0; ks < 6; ++ks) qf[ks] = *(const bf16x8*)(qptr + ks * 16 + h * 8);
#pragma unroll
    for (int i = 0; i < 16; ++i) { o[0][i] = 0.f; o[1][i] = 0.f; }
    m_run = neg_big(); l_run = 0.f;
    u32x4 rkn[NH], rvt[NH], rkr = {0u, 0u, 0u, 0u};
    const int lrow = tid >> 3, lseg = tid & 7;
#define ATT_GLOAD(kt) do { const size_t key0_ = (size_t)(kt) * 64; \
        _Pragma("unroll") for (int hx = 0; hx < NH; ++hx) { rkn[hx] = *(const u32x4*)(kn + hx * kn_hs + (key0_ + lrow) * 64 + lseg * 8); rvt[hx] = *(const u32x4*)(vt + hx * vt_hs + (size_t)lrow * KL + key0_ + lseg * 8); } \
        if (tid < 256) rkr = *(const u32x4*)(kr + (key0_ + (tid >> 2)) * 32 + (tid & 3) * 8); } while (0)
#define ATT_LSTORE(buf) do { LAS unsigned char* B_ = lds + (buf) * BUFSZ; \
        _Pragma("unroll") for (int hx = 0; hx < NH; ++hx) { *(LAS u32x4*)(B_ + hx * 9216 + lrow * 144 + lseg * 16) = rkn[hx]; \
            LAS u32x2* pv_ = (LAS u32x2*)(B_ + NH * 9216 + 5120 + hx * 8704 + lrow * 136 + lseg * 16); u32x2 a_, b_; a_[0] = rvt[hx][0]; a_[1] = rvt[hx][1]; b_[0] = rvt[hx][2]; b_[1] = rvt[hx][3]; pv_[0] = a_; pv_[1] = b_; } \
        if (tid < 256) *(LAS u32x4*)(B_ + NH * 9216 + (tid >> 2) * 80 + (tid & 3) * 16) = rkr; } while (0)
    ATT_GLOAD(kt0); ATT_LSTORE(0);
    __syncthreads();
    for (int it = 0; it < nit; ++it) {
        const int ktn = kt0 + (it + 1) * kstep;
        const bool more = (it + 1 < nit) && (ktn < tile_lim);
        if (more) ATT_GLOAD(ktn);
        if (it < nvalid) {
            const LAS unsigned char* B = lds + (it & 1) * BUFSZ;
            const LAS unsigned char* knb = B + hh * 9216; const LAS unsigned char* krb = B + NH * 9216; const LAS unsigned char* vtb = B + NH * 9216 + 5120 + hh * 8704;
            f32x16 s0, s1;
#pragma unroll
            for (int i = 0; i < 16; ++i) { s0[i] = 0.f; s1[i] = 0.f; }
#pragma unroll
            for (int ks = 0; ks < 4; ++ks) { const bf16x8 a0 = *(const LAS bf16x8*)(knb + r * 144 + ks * 32 + h * 16), a1 = *(const LAS bf16x8*)(knb + (32 + r) * 144 + ks * 32 + h * 16);
                s0 = mfma32(a0, qf[ks], s0); s1 = mfma32(a1, qf[ks], s1); }
#pragma unroll
            for (int ks = 0; ks < 2; ++ks) { const bf16x8 a0 = *(const LAS bf16x8*)(krb + r * 80 + ks * 32 + h * 16), a1 = *(const LAS bf16x8*)(krb + (32 + r) * 80 + ks * 32 + h * 16);
                s0 = mfma32(a0, qf[4 + ks], s0); s1 = mfma32(a1, qf[4 + ks], s1); }
            float mx = s0[0];
#pragma unroll
            for (int i = 0; i < 16; ++i) { mx = fmaxf(mx, s0[i]); mx = fmaxf(mx, s1[i]); }
            mx = fmaxf(mx, __shfl_xor(mx, 32));
            const float mnew = fmaxf(m_run, mx), alpha = __builtin_amdgcn_exp2f(m_run - mnew);
            m_run = mnew;
            float ps = 0.f;
#pragma unroll
            for (int i = 0; i < 16; ++i) { s0[i] = __builtin_amdgcn_exp2f(s0[i] - mnew); s1[i] = __builtin_amdgcn_exp2f(s1[i] - mnew); ps += s0[i] + s1[i]; }
            l_run = l_run * alpha + ps;
#pragma unroll
            for (int i = 0; i < 16; ++i) { o[0][i] *= alpha; o[1][i] *= alpha; }
            bf16x8 pf[4];
            pf[0] = pack8(s0, 0); pf[1] = pack8(s0, 8); pf[2] = pack8(s1, 0); pf[3] = pack8(s1, 8);
#pragma unroll
            for (int dh = 0; dh < 2; ++dh)
#pragma unroll
                for (int s4 = 0; s4 < 4; ++s4) { const LAS u32x2* pa = (const LAS u32x2*)(vtb + (32 * dh + r) * 136 + (16 * s4 + 4 * h) * 2); const u32x2 lo = pa[0], hi = pa[2];
                    u32x4 av; av[0] = lo[0]; av[1] = lo[1]; av[2] = hi[0]; av[3] = hi[1]; o[dh] = mfma32(__builtin_bit_cast(bf16x8, av), pf[s4], o[dh]); }
        }
        if (more) ATT_LSTORE((it + 1) & 1);
        __syncthreads();
    }
#undef ATT_GLOAD
#undef ATT_LSTORE
}
DI void attn_core64(LAS unsigned char* lds, const bf16_t* qptr, const bf16_t* kn, const bf16_t* kr, const bf16_t* vt, int KL, int nit, int nvalid,
                    f32x16 (&o)[2][2], float (&m_run)[2], float (&l_run)[2]) {
    constexpr int BUFSZ = 17920 + 5120;
    const int tid = tid_(), lane = tid & 63, r = lane & 31, h = lane >> 5;
    bf16x8 qf[2][2];
    LAS bf16x8* qr = (LAS bf16x8*)(lds + 2 * BUFSZ + (tid >> 6) * 8192) + lane;
#pragma unroll
    for (int g = 0; g < 2; ++g) {
#pragma unroll
        for (int ks = 0; ks < 2; ++ks) qf[g][ks] = *(const bf16x8*)(qptr + g * 32 * 96 + ks * 16 + h * 8);
#pragma unroll
        for (int ks = 0; ks < 4; ++ks) qr[(g * 4 + ks) * 64] = *(const bf16x8*)(qptr + g * 32 * 96 + (2 + ks) * 16 + h * 8); }
#pragma unroll
    for (int g = 0; g < 2; ++g) { m_run[g] = neg_big(); l_run[g] = 0.f;
#pragma unroll
        for (int i = 0; i < 16; ++i) { o[g][0][i] = 0.f; o[g][1][i] = 0.f; } }
    u32x4 rkn, rvt, rkr = {0u, 0u, 0u, 0u};
    const int lrow = tid >> 3, lseg = tid & 7;
#define A64_GLOAD(kt) do { const size_t key0_ = (size_t)(kt) * 64; rkn = *(const u32x4*)(kn + (key0_ + lrow) * 64 + lseg * 8); rvt = *(const u32x4*)(vt + (size_t)lrow * KL + key0_ + lseg * 8); \
        if (tid < 256) rkr = *(const u32x4*)(kr + (key0_ + (tid >> 2)) * 32 + (tid & 3) * 8); } while (0)
#define A64_LSTORE(buf) do { LAS unsigned char* B_ = lds + (buf) * BUFSZ; *(LAS u32x4*)(B_ + lrow * 144 + lseg * 16) = rkn; \
        LAS u32x2* pv_ = (LAS u32x2*)(B_ + 9216 + 5120 + lrow * 136 + lseg * 16); u32x2 a_, b_; a_[0] = rvt[0]; a_[1] = rvt[1]; b_[0] = rvt[2]; b_[1] = rvt[3]; pv_[0] = a_; pv_[1] = b_; \
        if (tid < 256) *(LAS u32x4*)(B_ + 9216 + (tid >> 2) * 80 + (tid & 3) * 16) = rkr; } while (0)
    A64_GLOAD(0); A64_LSTORE(0);
    __syncthreads();
    for (int it = 0; it < nit; ++it) {
        const bool more = (it + 1 < nit);
        if (more) A64_GLOAD(it + 1);
        if (it < nvalid) {
            const LAS unsigned char* B = lds + (it & 1) * BUFSZ;
            const LAS unsigned char* knb = B; const LAS unsigned char* krb = B + 9216; const LAS unsigned char* vtb = B + 9216 + 5120;
            f32x16 s[2][2];
#pragma unroll
            for (int g = 0; g < 2; ++g)
#pragma unroll
                for (int i = 0; i < 16; ++i) { s[g][0][i] = 0.f; s[g][1][i] = 0.f; }
            __builtin_amdgcn_s_setprio(1);
#define A64_KA0(ks) ((ks) < 4 ? *(const LAS bf16x8*)(knb + r * 144 + (ks) * 32 + h * 16) : *(const LAS bf16x8*)(krb + r * 80 + ((ks) - 4) * 32 + h * 16))
#define A64_KA1(ks) ((ks) < 4 ? *(const LAS bf16x8*)(knb + (32 + r) * 144 + (ks) * 32 + h * 16) : *(const LAS bf16x8*)(krb + (32 + r) * 80 + ((ks) - 4) * 32 + h * 16))
#define A64_Q(g, ks) ((ks) < 2 ? qf[g][(ks) < 2 ? (ks) : 0] : qr[((g) * 4 + (ks) - 2) * 64])
            { bf16x8 a0 = A64_KA0(0), a1 = A64_KA1(0), q0 = A64_Q(0, 0), q1 = A64_Q(1, 0);
#pragma unroll
              for (int ks = 0; ks < 6; ++ks) {
                  bf16x8 na0 = a0, na1 = a1, nq0 = q0, nq1 = q1;
                  if (ks < 5) { na0 = A64_KA0(ks + 1); na1 = A64_KA1(ks + 1); nq0 = A64_Q(0, ks + 1); nq1 = A64_Q(1, ks + 1); }
                  __builtin_amdgcn_sched_barrier(0);
                  s[0][0] = mfma32(a0, q0, s[0][0]); s[1][0] = mfma32(a0, q1, s[1][0]); s[0][1] = mfma32(a1, q0, s[0][1]); s[1][1] = mfma32(a1, q1, s[1][1]);
                  __builtin_amdgcn_sched_barrier(0);
                  a0 = na0; a1 = na1; q0 = nq0; q1 = nq1; } }
#undef A64_KA0
#undef A64_KA1
#undef A64_Q
            __builtin_amdgcn_s_setprio(0);
            __builtin_amdgcn_sched_barrier(0);
            bf16x8 pf[2][4];
#pragma unroll
            for (int g = 0; g < 2; ++g) {
                float mx = s[g][0][0];
#pragma unroll
                for (int i = 0; i < 16; ++i) { mx = fmaxf(mx, s[g][0][i]); mx = fmaxf(mx, s[g][1][i]); }
                mx = fmaxf(mx, __shfl_xor(mx, 32));
                const float mnew = mx > m_run[g] + 8.f ? mx : m_run[g], alpha = __builtin_amdgcn_exp2f(m_run[g] - mnew);
                const bool resc = __builtin_amdgcn_ballot_w64(mnew != m_run[g]) != 0ull;
                m_run[g] = mnew;
                float ps = 0.f;
#pragma unroll
                for (int i = 0; i < 16; ++i) { s[g][0][i] = __builtin_amdgcn_exp2f(s[g][0][i] - mnew); s[g][1][i] = __builtin_amdgcn_exp2f(s[g][1][i] - mnew); ps += s[g][0][i] + s[g][1][i]; }
                l_run[g] = l_run[g] * alpha + ps;
                if (resc) {
#pragma unroll
                    for (int i = 0; i < 16; ++i) { o[g][0][i] *= alpha; o[g][1][i] *= alpha; } }
                pf[g][0] = pack8(s[g][0], 0); pf[g][1] = pack8(s[g][0], 8); pf[g][2] = pack8(s[g][1], 0); pf[g][3] = pack8(s[g][1], 8);
                __builtin_amdgcn_sched_barrier(0);
            }
            __builtin_amdgcn_s_setprio(1);
#define A64_VF(idx, lo_, hi_) const LAS u32x2* pa_##lo_ = (const LAS u32x2*)(vtb + (32 * ((idx) >> 2) + r) * 136 + (16 * ((idx) & 3) + 4 * h) * 2); u32x2 lo_ = pa_##lo_[0], hi_ = pa_##lo_[2]
            { A64_VF(0, lo, hi);
#pragma unroll
              for (int idx = 0; idx < 8; ++idx) {
                  u32x2 nlo = lo, nhi = hi;
                  if (idx < 7) { const LAS u32x2* pn = (const LAS u32x2*)(vtb + (32 * ((idx + 1) >> 2) + r) * 136 + (16 * ((idx + 1) & 3) + 4 * h) * 2); nlo = pn[0]; nhi = pn[2]; }
                  __builtin_amdgcn_sched_barrier(0);
                  u32x4 av; av[0] = lo[0]; av[1] = lo[1]; av[2] = hi[0]; av[3] = hi[1]; const bf16x8 avb = __builtin_bit_cast(bf16x8, av);
                  o[0][idx >> 2] = mfma32(avb, pf[0][idx & 3], o[0][idx >> 2]); o[1][idx >> 2] = mfma32(avb, pf[1][idx & 3], o[1][idx >> 2]);
                  __builtin_amdgcn_sched_barrier(0);
                  lo = nlo; hi = nhi; } }
#undef A64_VF
            __builtin_amdgcn_s_setprio(0);
        }
        if (more) A64_LSTORE((it + 1) & 1);
        __syncthreads();
    }
#undef A64_GLOAD
#undef A64_LSTORE
}
DI void phase_attn_p(const Params& p, LAS unsigned char* lds) {
    const int tid = tid_(), lane = tid & 63, wid = __builtin_amdgcn_readfirstlane(tid >> 6), r = lane & 31, h = lane >> 5;
    const bf16_t* Q = (const bf16_t*)(p.ws + OFF_Q); const bf16_t* KN = (const bf16_t*)(p.ws + OFF_KN); const bf16_t* VT = (const bf16_t*)(p.ws + OFF_VT);
    const bf16_t* KRO = (const bf16_t*)(p.ws + OFF_KROPE); bf16_t* O = (bf16_t*)(p.ws + OFF_O);
    for (int pair = bid_(); pair < 256; pair += gridDim.x) {
        const int bh = (pair & 7) * 4 + (pair >> 6), qa = (pair >> 3) & 7, b = bh >> 3, hd = bh & 7;
        for (int sub = 0; sub < 2; ++sub) {
            const int qb = sub ? qa : 15 - qa;
            const int t0 = qb * 512 + wid * 64 + r;
            f32x16 o[2][2]; float m_run[2], l_run[2];
            attn_core64(lds, Q + ((size_t)bh * 8192 + t0) * 96, KN + (size_t)bh * 8192 * 64, KRO + (size_t)b * 8192 * 32, VT + (size_t)bh * 64 * 8192, 8192,
                        8 * qb + 8, 8 * qb + wid + 1, o, m_run, l_run);
#pragma unroll
            for (int g = 0; g < 2; ++g) {
                const float inv = 1.f / (l_run[g] + __shfl_xor(l_run[g], 32));
                bf16_t* orow = O + ((size_t)b * 8192 + t0 + g * 32) * 512 + hd * 64;
#pragma unroll
                for (int dh = 0; dh < 2; ++dh)
#pragma unroll
                    for (int q4 = 0; q4 < 4; ++q4) { uint2 w; w.x = pack2(o[g][dh][4 * q4] * inv, o[g][dh][4 * q4 + 1] * inv); w.y = pack2(o[g][dh][4 * q4 + 2] * inv, o[g][dh][4 * q4 + 3] * inv); *(uint2*)(orow + 32 * dh + 8 * q4 + 4 * h) = w; }
            }
        }
    }
}
DI void phase_attn_s(const Params& p, LAS unsigned char* lds) {
    const int tid = tid_(), lane = tid & 63, wid = __builtin_amdgcn_readfirstlane(tid >> 6), r = lane & 31, h = lane >> 5;
    const bf16_t* Q = (const bf16_t*)(p.ws + OFF_Q); const bf16_t* KN = (const bf16_t*)(p.ws + OFF_KN); const bf16_t* VT = (const bf16_t*)(p.ws + OFF_VT);
    const bf16_t* KRO = (const bf16_t*)(p.ws + OFF_KROPE); float* PART = (float*)(p.ws + OFF_PART);
    for (int c = bid_(); c < 256; c += gridDim.x) {
        const int b = c >> 3, hg = (c >> 2) & 1, split = c & 3, hh = wid >> 1, head = hg * 4 + hh, t = (wid & 1) * 32 + r;
        f32x16 o[2]; float m_run, l_run;
        attn_core<4>(lds, Q + (size_t)MP * 768 + ((size_t)(b * 8 + head) * 64 + t) * 96, KN + (size_t)MP * 512 + (size_t)(b * 8 + hg * 4) * KEYS_S * 64, (size_t)KEYS_S * 64,
                     KRO + (size_t)MP * 32 + (size_t)b * KEYS_S * 32, VT + (size_t)MP * 512 + (size_t)(b * 8 + hg * 4) * 64 * KEYS_S, (size_t)64 * KEYS_S, KEYS_S,
                     split, 4, 17, split == 0 ? 17 : 16, 65, hh, o, m_run, l_run);
        const float lt = l_run + __shfl_xor(l_run, 32);
        float* pr = PART + (((size_t)(b * 8 + head) * 4 + split) * 64 + t) * 66;
#pragma unroll
        for (int dh = 0; dh < 2; ++dh)
#pragma unroll
            for (int g = 0; g < 4; ++g) { float2 a, bb; a.x = o[dh][4 * g]; a.y = o[dh][4 * g + 1]; bb.x = o[dh][4 * g + 2]; bb.y = o[dh][4 * g + 3]; float* d = pr + 32 * dh + 8 * g + 4 * h; *(float2*)d = a; *(float2*)(d + 2) = bb; }
        if (h == 0) { float2 ml; ml.x = m_run; ml.y = lt; *(float2*)(pr + 64) = ml; }
    }
}

constexpr int R_QF = 0, R_KF = 16384, R_G = 32768, R_VTI = 49152, R_KTI = 58368, R_QTI = 67584, R_STI = 76800, R_PPI = 86016, R_QHI = 95232, R_KHI = 102144,
              R_GA = 115968, R_WA = 120064, R_SEG = 122240, R_OF = 0, R_WALL = 124288, R_BA = 132480, R_LB = 132992, R_QD = 134016, R_KD = 143232;
struct RecPre { u32x4 uv, ua, uq, ug, gz; f32x4 s0, s1; };
DI uint4 to_u4(u32x4 v) { uint4 r; r.x = v[0]; r.y = v[1]; r.z = v[2]; r.w = v[3]; return r; }
DI float4 to_f4(f32x4 v) { float4 r; r.x = v[0]; r.y = v[1]; r.z = v[2]; r.w = v[3]; return r; }
DI void rec_tables(const Params& p, int l, LAS unsigned char* lds) {
    const int tid = tid_();
    LAS float* WALL = (LAS float*)(lds + R_WALL); LAS float* BA = (LAS float*)(lds + R_BA); LAS float* LB = (LAS float*)(lds + R_LB);
#pragma unroll
    for (int i = 0; i < 4; ++i) WALL[tid + 512 * i] = p.in[23][l * 2048 + tid + 512 * i];
    if (tid < 128) BA[tid] = p.in[24][l * 128 + tid];
    if (tid < 256) { float lb = 0.f; if (l == 1) { const float l0 = p.in[21][tid], l1 = p.in[21][256 + tid]; lb = 1.f / (1.f + expf(l0 - l1)); } LB[tid] = lb; }
    __syncthreads();
}
template <int DK, bool HG>
DI void rec_issue(const Params& p, int cid, int hd, bool passC, RecPre& r) {
    const int tid = tid_();
    const bf16_t* Z = (const bf16_t*)(p.ws + OFF_Z);
    const size_t row0 = (size_t)cid * 64;
    const int lj = tid >> 3, ls8 = (tid & 7) * 8;
    const bf16_t* zr = Z + (row0 + lj) * ZLD;
    r.uv = *(const u32x4*)(zr + (HG ? 1056 : 1824) + hd * 64 + ls8);
    if (HG) { r.ua = *(const u32x4*)(zr + 800 + hd * 64 + ls8); if (passC) r.uq = *(const u32x4*)(zr + 544 + hd * 64 + ls8); }
    else { if (tid < 256) { const bf16_t* z2 = Z + (row0 + (tid >> 2)) * ZLD; r.ua = *(const u32x4*)(z2 + 1696 + hd * 32 + (tid & 3) * 8); if (passC) r.uq = *(const u32x4*)(z2 + 1568 + hd * 32 + (tid & 3) * 8); }
           if (tid < 128) r.ug = *(const u32x4*)(Z + (row0 + (tid >> 1)) * ZLD + 2336 + (tid & 1) * 8); }
    if (passC) {
        const float* S = (const float*)(p.ws + (HG ? OFF_UHG : OFF_UGL)) + ((size_t)cid * 4 + hd) * DK * 64;
            if (tid < DK * 8) { const int k = tid >> 3, v0 = (tid & 7) * 8; r.s0 = *(const f32x4*)(S + k * 64 + v0); r.s1 = *(const f32x4*)(S + k * 64 + v0 + 4); }
        r.gz = *(const u32x4*)(zr + (HG ? 1312 : 2080) + hd * 64 + ls8);
    }
}
template <int DK, bool HG>
DI void rec_load(const RecPre& pre, LAS unsigned char* lds, int hd, bool need_q) {
    const int tid = tid_();
    LAS float* QF = (LAS float*)(lds + R_QF); LAS float* KF = (LAS float*)(lds + R_KF); LAS float* G = (LAS float*)(lds + R_G);
    LAS bf16_t* VTI = (LAS bf16_t*)(lds + R_VTI); LAS float* GA = (LAS float*)(lds + R_GA); LAS float* SEG = (LAS float*)(lds + R_SEG);
    const LAS float* WA = (const LAS float*)(lds + (HG ? R_LB : R_WALL)) + (HG ? hd * 64 : hd * 32);
    const LAS float* BA = (const LAS float*)(lds + R_BA) + hd * 32;
    const int lj = tid >> 3, ls8 = (tid & 7) * 8;
    const uint4 uv = to_u4(pre.uv), ua = to_u4(pre.ua), uq = to_u4(pre.uq);
    if (!HG) {
        if (tid < 128) { const int j = tid >> 1, hf = tid & 1; const uint4 u = to_u4(pre.ug); LAS float* ga = GA + j * 16 + hf * 8;
            ga[0] = bflo(u.x); ga[1] = bfhi(u.x); ga[2] = bflo(u.y); ga[3] = bfhi(u.y); ga[4] = bflo(u.z); ga[5] = bfhi(u.z); ga[6] = bflo(u.w); ga[7] = bfhi(u.w); }
        __syncthreads();
    }
    { const float va[8] = {bflo(ua.x), bfhi(ua.x), bflo(ua.y), bfhi(ua.y), bflo(ua.z), bfhi(ua.z), bflo(ua.w), bfhi(ua.w)};
      const float vq[8] = {bflo(uq.x), bfhi(uq.x), bflo(uq.y), bfhi(uq.y), bflo(uq.z), bfhi(uq.z), bflo(uq.w), bfhi(uq.w)};
      if (HG) { float gg[8], kk[8];
#pragma unroll
          for (int x = 0; x < 8; ++x) { const float lb = WA[ls8 + x], e = __expf(fminf(-va[x], 80.f)), s = 1.f / (1.f + e); gg[x] = logf(lb + (1.f - lb) * s); kk[x] = (1.f - lb) * e * s; }
          LAS f32x4* gp = (LAS f32x4*)(G + lj * 64 + ls8); LAS f32x4* kp = (LAS f32x4*)(KF + lj * 64 + ls8);
          gp[0] = (f32x4){gg[0], gg[1], gg[2], gg[3]}; gp[1] = (f32x4){gg[4], gg[5], gg[6], gg[7]}; kp[0] = (f32x4){kk[0], kk[1], kk[2], kk[3]}; kp[1] = (f32x4){kk[4], kk[5], kk[6], kk[7]};
          if (need_q) { LAS f32x4* qp = (LAS f32x4*)(QF + lj * 64 + ls8); qp[0] = (f32x4){vq[0], vq[1], vq[2], vq[3]}; qp[1] = (f32x4){vq[4], vq[5], vq[6], vq[7]}; } }
      else {
          { const int kq = (tid & 7) * 4; f32x4 x = *(const LAS f32x4*)(BA + kq);
#pragma unroll
            for (int r = 0; r < 16; ++r) { const float ga = GA[lj * 16 + r]; const f32x4 wv = *(const LAS f32x4*)(WA + r * 128 + kq); x += ga * wv; }
            f32x4 o;
#pragma unroll
            for (int y = 0; y < 4; ++y) o[y] = (fminf(x[y], 0.f) - log1pf(__expf(-fabsf(x[y])))) * (1.f / 16.f);
            *(LAS f32x4*)(G + lj * 32 + kq) = o; }
          if (tid < 256) { const int j2 = tid >> 2, k2 = (tid & 3) * 8; LAS f32x4* kp = (LAS f32x4*)(KF + j2 * 32 + k2); kp[0] = (f32x4){va[0], va[1], va[2], va[3]}; kp[1] = (f32x4){va[4], va[5], va[6], va[7]};
              if (need_q) { const float qs = 0.17677669529663687f; LAS f32x4* qp = (LAS f32x4*)(QF + j2 * 32 + k2); qp[0] = (f32x4){vq[0] * qs, vq[1] * qs, vq[2] * qs, vq[3] * qs}; qp[1] = (f32x4){vq[4] * qs, vq[5] * qs, vq[6] * qs, vq[7] * qs}; } } }
      const unsigned vv[4] = {uv.x, uv.y, uv.z, uv.w};
#pragma unroll
      for (int x = 0; x < 4; ++x) { VTI[(ls8 + 2 * x) * 72 + lj] = (bf16_t)(vv[x] & 0xFFFFu); VTI[(ls8 + 2 * x + 1) * 72 + lj] = (bf16_t)(vv[x] >> 16); } }
    __syncthreads();
    constexpr int NSEG = NT / DK, JS = 64 / NSEG;
    const int seg = tid / DK, k = tid % DK;
    float loc[JS]; float s = 0.f;
#pragma unroll
    for (int jj = 0; jj < JS; ++jj) { s += G[(seg * JS + jj) * DK + k]; loc[jj] = s; }
    SEG[seg * DK + k] = s;
    __syncthreads();
    float off = 0.f;
#pragma unroll
    for (int s2 = 0; s2 < NSEG; ++s2) { const float t = SEG[s2 * DK + k]; off += s2 < seg ? t : 0.f; }
#pragma unroll
    for (int jj = 0; jj < JS; ++jj) G[(seg * JS + jj) * DK + k] = loc[jj] + off;
    __syncthreads();
}
template <int DK, bool HG>
DI void rec_passA_item(const Params& p, int l, LAS unsigned char* lds, int cid, int hd, const RecPre& pre) {
    const int tid = tid_(), lane = tid & 63, wid = __builtin_amdgcn_readfirstlane(tid >> 6), fr = lane & 15, fq = lane >> 4;
    rec_load<DK, HG>(pre, lds, hd, false);
    LAS float* KF = (LAS float*)(lds + R_KF); LAS float* G = (LAS float*)(lds + R_G);
    LAS bf16_t* VTI = (LAS bf16_t*)(lds + R_VTI); LAS bf16_t* KTI = (LAS bf16_t*)(lds + R_KTI);
    float* U = (float*)(p.ws + (HG ? OFF_UHG : OFF_UGL)); float* D = (float*)(p.ws + (HG ? OFF_DHG : OFF_DGL));
    for (int e = tid; e < 64 * DK; e += NT) { const int j = e / DK, k = e % DK; KTI[k * 72 + j] = f2bf(KF[e] * __expf(G[63 * DK + k] - G[e])); }
    if (tid < DK) D[((size_t)cid * 4 + hd) * DK + tid] = __expf(G[63 * DK + tid]);
    __syncthreads();
    for (int tile = wid; tile < (DK / 16) * 4; tile += 8) {
        const int tk = tile >> 2, tv = tile & 3; f32x4 acc = {0.f, 0.f, 0.f, 0.f};
#pragma unroll
        for (int s = 0; s < 2; ++s) { const bf16x8 a = *(const LAS bf16x8*)(KTI + (16 * tk + fr) * 72 + 32 * s + 8 * fq), b = *(const LAS bf16x8*)(VTI + (16 * tv + fr) * 72 + 32 * s + 8 * fq); acc = mfma16(a, b, acc); }
#pragma unroll
        for (int reg = 0; reg < 4; ++reg) U[(((size_t)cid * 4 + hd) * DK + 16 * tk + 4 * fq + reg) * 64 + 16 * tv + fr] = acc[reg];
    }
    __syncthreads();
}
template <int DK, bool HG>
DI void rec_passC_item(const Params& p, int l, LAS unsigned char* lds, int cid, int hd, const RecPre& pre) {
    const int tid = tid_(), lane = tid & 63, wid = __builtin_amdgcn_readfirstlane(tid >> 6), fr = lane & 15, fq = lane >> 4;
    rec_load<DK, HG>(pre, lds, hd, true);
    LAS float* QF = (LAS float*)(lds + R_QF); LAS float* KF = (LAS float*)(lds + R_KF); LAS float* G = (LAS float*)(lds + R_G); LAS float* OF = (LAS float*)(lds + R_OF);
    LAS bf16_t* VTI = (LAS bf16_t*)(lds + R_VTI); LAS bf16_t* QTI = (LAS bf16_t*)(lds + R_QTI); LAS bf16_t* STI = (LAS bf16_t*)(lds + R_STI);
    LAS bf16_t* PPI = (LAS bf16_t*)(lds + R_PPI); LAS bf16_t* QHI = (LAS bf16_t*)(lds + R_QHI); LAS bf16_t* KHI = (LAS bf16_t*)(lds + R_KHI);
    const bf16_t* Z = (const bf16_t*)(p.ws + OFF_Z); bf16_t* H = (bf16_t*)(p.ws + OFF_H);
    for (int e = tid; e < 64 * DK; e += NT) { const int i = e / DK, k = e % DK; QTI[i * 72 + k] = f2bf(QF[e] * __expf(G[e])); }
    if (tid < DK * 8) { const int k = tid >> 3, v0 = (tid & 7) * 8; const float4 s0 = to_f4(pre.s0), s1 = to_f4(pre.s1);
        STI[(v0 + 0) * 72 + k] = f2bf(s0.x); STI[(v0 + 1) * 72 + k] = f2bf(s0.y); STI[(v0 + 2) * 72 + k] = f2bf(s0.z); STI[(v0 + 3) * 72 + k] = f2bf(s0.w);
        STI[(v0 + 4) * 72 + k] = f2bf(s1.x); STI[(v0 + 5) * 72 + k] = f2bf(s1.y); STI[(v0 + 6) * 72 + k] = f2bf(s1.z); STI[(v0 + 7) * 72 + k] = f2bf(s1.w); }
    for (int e = tid; e < 48 * DK; e += NT) { const int ii = e / DK, k = e % DK, I = 1 + (ii >> 4), i = 16 + ii; const float ref = G[(16 * I - 1) * DK + k];
        QHI[ii * 72 + k] = f2bf(QF[i * DK + k] * __expf(G[i * DK + k] - ref)); }
    for (int e = tid; e < 96 * DK; e += NT) { const int rr = e / DK, k = e % DK, I = rr < 16 ? 1 : (rr < 48 ? 2 : 3), j = rr - 8 * I * (I - 1); const float ref = G[(16 * I - 1) * DK + k];
        KHI[rr * 72 + k] = f2bf(KF[j * DK + k] * __expf(ref - G[j * DK + k])); }
    { LAS bf16_t* QD = (LAS bf16_t*)(lds + R_QD); LAS bf16_t* KD = (LAS bf16_t*)(lds + R_KD);
      for (int e = tid; e < 64 * DK; e += NT) { const int i = e / DK, k = e % DK; const float ref = G[(16 * (i >> 4) + 7) * DK + k], gi = G[e];
          QD[i * 72 + k] = f2bf(QF[e] * __expf(fminf(fmaxf(gi - ref, -80.f), 80.f))); KD[i * 72 + k] = f2bf(KF[e] * __expf(fminf(fmaxf(ref - gi, -80.f), 80.f))); } }
    for (int e = tid; e < 1536; e += NT) { const int bidx = e >> 8, w = e & 255; const int I = bidx < 3 ? 0 : (bidx < 5 ? 1 : 2), J = bidx < 3 ? bidx + 1 : (bidx < 5 ? bidx - 1 : 3);
        PPI[(16 * I + (w >> 4)) * 72 + 16 * J + (w & 15)] = 0; }
    __syncthreads();
    if (wid >= 6) { const LAS bf16_t* QD = (const LAS bf16_t*)(lds + R_QD); const LAS bf16_t* KD = (const LAS bf16_t*)(lds + R_KD);
#pragma unroll
        for (int t2 = 0; t2 < 2; ++t2) { const int I = (wid - 6) * 2 + t2; f32x4 acc = {0.f, 0.f, 0.f, 0.f};
#pragma unroll
            for (int s = 0; s < DK / 32; ++s) { const bf16x8 a = *(const LAS bf16x8*)(QD + (16 * I + fr) * 72 + 32 * s + 8 * fq), b = *(const LAS bf16x8*)(KD + (16 * I + fr) * 72 + 32 * s + 8 * fq); acc = mfma16(a, b, acc); }
#pragma unroll
            for (int reg = 0; reg < 4; ++reg) PPI[(16 * I + 4 * fq + reg) * 72 + 16 * I + fr] = f2bf(fr <= 4 * fq + reg ? acc[reg] : 0.f); } }
    if (wid < 6) { const int I = wid < 1 ? 1 : (wid < 3 ? 2 : 3), J = wid < 1 ? 0 : (wid < 3 ? wid - 1 : wid - 3); f32x4 acc = {0.f, 0.f, 0.f, 0.f};
#pragma unroll
        for (int s = 0; s < DK / 32; ++s) { const bf16x8 a = *(const LAS bf16x8*)(QHI + ((I - 1) * 16 + fr) * 72 + 32 * s + 8 * fq), b = *(const LAS bf16x8*)(KHI + (8 * I * (I - 1) + 16 * J + fr) * 72 + 32 * s + 8 * fq); acc = mfma16(a, b, acc); }
#pragma unroll
        for (int reg = 0; reg < 4; ++reg) PPI[(16 * I + 4 * fq + reg) * 72 + 16 * J + fr] = f2bf(acc[reg]); }
    __syncthreads();
#pragma unroll
    for (int tt = 0; tt < 2; ++tt) { const int tile = wid * 2 + tt, ti = tile >> 2, tv = tile & 3; f32x4 acc = {0.f, 0.f, 0.f, 0.f};
#pragma unroll
        for (int s = 0; s < DK / 32; ++s) { const bf16x8 a = *(const LAS bf16x8*)(QTI + (16 * ti + fr) * 72 + 32 * s + 8 * fq), b = *(const LAS bf16x8*)(STI + (16 * tv + fr) * 72 + 32 * s + 8 * fq); acc = mfma16(a, b, acc); }
#pragma unroll
        for (int s = 0; s < 2; ++s) { const bf16x8 a = *(const LAS bf16x8*)(PPI + (16 * ti + fr) * 72 + 32 * s + 8 * fq), b = *(const LAS bf16x8*)(VTI + (16 * tv + fr) * 72 + 32 * s + 8 * fq); acc = mfma16(a, b, acc); }
#pragma unroll
        for (int reg = 0; reg < 4; ++reg) OF[(16 * ti + 4 * fq + reg) * 65 + 16 * tv + fr] = acc[reg]; }
    __syncthreads();
    { const int i = tid >> 3, part = tid & 7; float v[8]; float ss = 0.f;
#pragma unroll
      for (int x = 0; x < 8; ++x) { v[x] = OF[i * 65 + part * 8 + x]; ss += v[x] * v[x]; }
      ss += __shfl_xor(ss, 1); ss += __shfl_xor(ss, 2); ss += __shfl_xor(ss, 4);
      const float rs = rsqrtf(ss * (1.f / 64.f) + EPS);
      const size_t row = (size_t)cid * 64 + i;
      const uint4 gz = to_u4(pre.gz);
      const float* go = p.in[HG ? 22 : 25] + l * 64 + part * 8;
      const float gt[8] = {bflo(gz.x), bfhi(gz.x), bflo(gz.y), bfhi(gz.y), bflo(gz.z), bfhi(gz.z), bflo(gz.w), bfhi(gz.w)};
      float r[8];
#pragma unroll
      for (int x = 0; x < 8; ++x) r[x] = v[x] * rs * go[x] * (gt[x] / (1.f + __expf(-gt[x])));
      uint4 w; w.x = pack2(r[0], r[1]); w.y = pack2(r[2], r[3]); w.z = pack2(r[4], r[5]); w.w = pack2(r[6], r[7]);
      *(uint4*)(H + row * 1024 + 512 + (HG ? 0 : 256) + hd * 64 + part * 8) = w; }
    __syncthreads();
}
template <int DK>
DI void scan_prompt(float* U, const float* D, float* outp, int e) {
    const int v = e & 63, k = (e >> 6) % DK, hd = (e / (64 * DK)) & 3, b = e / (256 * DK);
    float S = 0.f;
    for (int n0 = 0; n0 < 128; n0 += 16) {
        float u[16], d[16];
#pragma unroll
        for (int i = 0; i < 16; ++i) { const size_t ch = ((size_t)(b * 128 + n0 + i) * 4 + hd); u[i] = U[(ch * DK + k) * 64 + v]; d[i] = D[ch * DK + k]; }
#pragma unroll
        for (int i = 0; i < 16; ++i) { const size_t ch = ((size_t)(b * 128 + n0 + i) * 4 + hd); U[(ch * DK + k) * 64 + v] = S; S = d[i] * S + u[i]; }
    }
    outp[e] = S;
}
template <int DK>
DI void scan_sample(float* U, const float* D, const float* s0p, float* outp, int e) {
    const int v = e & 63, k = (e >> 6) % DK, hd = (e / (64 * DK)) & 3, b = e / (256 * DK);
    const size_t ch = (size_t)(512 + b) * 4 + hd; const size_t idx = (ch * DK + k) * 64 + v;
    const float s0 = s0p[e], u = U[idx], d = D[ch * DK + k];
    U[idx] = s0; outp[e] = d * s0 + u;
}
DI void phase_scan(const Params& p, int l) {
    const int g = bid_() * NT + tid_(), gs = gridDim.x * NT;
    float* UH = (float*)(p.ws + OFF_UHG); const float* DH = (const float*)(p.ws + OFF_DHG); float* UG = (float*)(p.ws + OFF_UGL); const float* DG = (const float*)(p.ws + OFF_DGL);
    for (int e = g; e < 98304; e += gs) {
        if (e < 65536) scan_prompt<64>(UH, DH, p.out + OUT_HGP + (size_t)l * 65536, e);
        else scan_prompt<32>(UG, DG, p.out + OUT_GLP + (size_t)l * 32768, e - 65536);
    }
    for (int e = g; e < 786432; e += gs) {
        if (e < 524288) scan_sample<64>(UH, DH, p.in[6] + (size_t)l * 524288, p.out + OUT_HGS + (size_t)l * 524288, e);
        else scan_sample<32>(UG, DG, p.in[7] + (size_t)l * 262144, p.out + OUT_GLS + (size_t)l * 262144, e - 524288);
    }
}
DI void phase_mlaout(const Params& p, int l) {
    const int tid = tid_(), lane = tid & 63, wid = __builtin_amdgcn_readfirstlane(tid >> 6);
    const bf16_t* O = (const bf16_t*)(p.ws + OFF_O); const float* PART = (const float*)(p.ws + OFF_PART); bf16_t* H = (bf16_t*)(p.ws + OFF_H);
    const float* g = p.in[20] + l * 512 + 8 * lane;
    for (int row = bid_() * 8 + wid; row < MT; row += gridDim.x * 8) {
        float v[8];
        if (row < MP) { const uint4 u = *(const uint4*)(O + (size_t)row * 512 + 8 * lane);
            v[0] = bflo(u.x); v[1] = bfhi(u.x); v[2] = bflo(u.y); v[3] = bfhi(u.y); v[4] = bflo(u.z); v[5] = bfhi(u.z); v[6] = bflo(u.w); v[7] = bfhi(u.w); }
        else { const int r = row - MP, b = r >> 6, t = r & 63, head = lane >> 3, dv0 = (lane & 7) * 8;
            const float* pb = PART + (((size_t)(b * 8 + head) * 4) * 64 + t) * 66;
            float m[4], lsum[4]; float M = neg_big();
#pragma unroll
            for (int s = 0; s < 4; ++s) { m[s] = pb[(size_t)s * 64 * 66 + 64]; lsum[s] = pb[(size_t)s * 64 * 66 + 65]; M = fmaxf(M, m[s]); }
            float L = 0.f;
#pragma unroll
            for (int x = 0; x < 8; ++x) v[x] = 0.f;
#pragma unroll
            for (int s = 0; s < 4; ++s) { const float w = exp2f(m[s] - M); L += w * lsum[s];
#pragma unroll
                for (int x = 0; x < 8; ++x) v[x] += w * pb[(size_t)s * 64 * 66 + dv0 + x]; }
            const float inv = 1.f / L;
#pragma unroll
            for (int x = 0; x < 8; ++x) v[x] *= inv; }
        float ss = 0.f;
#pragma unroll
        for (int x = 0; x < 8; ++x) ss += v[x] * v[x];
        ss = wave_sum(ss);
        const float rs = rsqrtf(ss * (1.f / 512.f) + EPS);
        uint4 w; w.x = pack2(v[0] * rs * g[0], v[1] * rs * g[1]); w.y = pack2(v[2] * rs * g[2], v[3] * rs * g[3]); w.z = pack2(v[4] * rs * g[4], v[5] * rs * g[5]); w.w = pack2(v[6] * rs * g[6], v[7] * rs * g[7]);
        *(uint4*)(H + (size_t)row * 1024 + 8 * lane) = w;
    }
}

DI void gsync(const Params& p, LAS unsigned char* lds) { XcdBarrier b; b.bar = (unsigned*)(p.ws + OFF_BAR); b.x = xb_xcc_id(); b.st = (volatile LAS unsigned*)(lds + LDS_BYTES - 16); xcd_barrier(b); }
__global__ void __launch_bounds__(512, 2) mk_fwd(Params p) {
    extern __shared__ __attribute__((aligned(16))) unsigned char shm[];
    LAS unsigned char* lds = (LAS unsigned char*)shm;
    cg::grid_group grid = cg::this_grid();
    bf16_t* H = (bf16_t*)(p.ws + OFF_H); bf16_t* Z = (bf16_t*)(p.ws + OFF_Z); bf16_t* CQN = (bf16_t*)(p.ws + OFF_CQN); bf16_t* CKV = (bf16_t*)(p.ws + OFF_CKV);
    bf16_t* Q = (bf16_t*)(p.ws + OFF_Q); bf16_t* KN = (bf16_t*)(p.ws + OFF_KN); bf16_t* VT = (bf16_t*)(p.ws + OFF_VT); bf16_t* ACT = (bf16_t*)(p.ws + OFF_ACT);
    const float* rope = (const float*)(p.ws + OFF_ROPE); bf16_t* XB = (bf16_t*)(p.ws + OFF_XB);
    volatile LAS unsigned* xst = (volatile LAS unsigned*)(lds + LDS_BYTES - 16);
    if (threadIdx.x == 0) { xst[0] = 0u; xst[1] = 0u; }
    __syncthreads();
    (void)xcd_barrier_post((unsigned*)(p.ws + OFF_BAR), xst);
    phase_prep(p, lds);
    grid.sync();
#pragma unroll 1
    for (int l = 0; l < 2; ++l) {
        const unsigned char* W = p.ws + OFF_W + (size_t)l * WL;
        const float* modl = (const float*)(p.ws + OFF_MOD) + (size_t)l * 36 * 6144;
        if (l == 0) phase_hrows<true>(p, l, p.in[0], p.in[1], p.in[10] + l * 1024, 0, 1024); else phase_hrows<false>(p, l, nullptr, nullptr, p.in[10] + l * 1024, 0, 1024);
        gsync(p, lds);
        run_gemm(lds, H, (const bf16_t*)(W + WOFF_IN), MT, 2560, 1024, EpiZ{Z, ZLD});
        {
          const int G = (int)gridDim.x, rem = ((MT / 256) * (2560 / 256)) % G;
          if (rem > 0 && G - rem >= G / 2) { if ((int)bid_() >= rem) phase_cache(p, l, rem, G - rem); } else phase_cache(p, l, 0, G); }
        gsync(p, lds);
        phase_post(p, l);
        rec_tables(p, l, lds);
        { RecPre pre = {}; int it = bid_(); if (it < 2176) rec_issue<64, true>(p, it >> 2, it & 3, false, pre);
          for (; it < 2176; it += gridDim.x) { const RecPre cur = pre; const int nx = it + gridDim.x; if (nx < 2176) rec_issue<64, true>(p, nx >> 2, nx & 3, false, pre); rec_passA_item<64, true>(p, l, lds, it >> 2, it & 3, cur); } }
        { RecPre pre = {}; int it = bid_(); if (it < 2176) rec_issue<32, false>(p, it >> 2, it & 3, false, pre);
          for (; it < 2176; it += gridDim.x) { const RecPre cur = pre; const int nx = it + gridDim.x; if (nx < 2176) rec_issue<32, false>(p, nx >> 2, nx & 3, false, pre); rec_passA_item<32, false>(p, l, lds, it >> 2, it & 3, cur); } }
        gsync(p, lds);
        run_gemm(lds, CQN, (const bf16_t*)(W + WOFF_UQ), MT, 768, 256, EpiQ{Q, p.in[18] + l * 96, rope});
        run_gemm(lds, CKV, (const bf16_t*)(W + WOFF_UK), KR_ROWS, 512, 256, EpiKN{KN, p.in[19] + l * 96});
        run_gemm(lds, (const bf16_t*)(W + WOFF_UV), CKV, 512, KR_ROWS, 256, EpiVT{VT});
        phase_scan(p, l);
        gsync(p, lds);
        phase_attn_p(p, lds);
        phase_attn_s(p, lds);
        rec_tables(p, l, lds);
        { RecPre pre = {}; int it = bid_(); if (it < 2176) rec_issue<64, true>(p, it >> 2, it & 3, true, pre);
          for (; it < 2176; it += gridDim.x) { const RecPre cur = pre; const int nx = it + gridDim.x; if (nx < 2176) rec_issue<64, true>(p, nx >> 2, nx & 3, true, pre); rec_passC_item<64, true>(p, l, lds, it >> 2, it & 3, cur); } }
        { RecPre pre = {}; int it = bid_(); if (it < 2176) rec_issue<32, false>(p, it >> 2, it & 3, true, pre);
          for (; it < 2176; it += gridDim.x) { const RecPre cur = pre; const int nx = it + gridDim.x; if (nx < 2176) rec_issue<32, false>(p, nx >> 2, nx & 3, true, pre); rec_passC_item<32, false>(p, l, lds, it >> 2, it & 3, cur); } }
        gsync(p, lds);
        phase_mlaout(p, l);
        gsync(p, lds);
        run_gemm(lds, H, (const bf16_t*)(W + WOFF_O), MT, 1024, 1024, EpiRes{XB, p.out, modl + 2048, 0});
        gsync(p, lds);
        phase_hrows<false>(p, l, nullptr, nullptr, p.in[11] + l * 1024, 3072, 4096);
        gsync(p, lds);
        run_gemm(lds, H, (const bf16_t*)(W + WOFF_FI), MT, 5632, 1024, EpiSwi{ACT});
        gsync(p, lds);
        run_gemm(lds, ACT, (const bf16_t*)(W + WOFF_FO), MT, 1024, 2816, EpiRes{XB, p.out, modl + 5120, l});
        if (l == 0) gsync(p, lds);
    }
}

extern "C" void kernel_launch(void* const* d_in, const int* in_sizes, int n_in, void* d_out, int out_size, void* d_ws, size_t ws_size, hipStream_t stream) {
    static int grid = 0;
    if (grid == 0) {
        int dev = 0, cus = 0, per_cu = 0;
        hipGetDevice(&dev);
        hipDeviceGetAttribute(&cus, hipDeviceAttributeMultiprocessorCount, dev);
        hipFuncSetAttribute((const void*)mk_fwd, hipFuncAttributeMaxDynamicSharedMemorySize, LDS_BYTES);
        hipOccupancyMaxActiveBlocksPerMultiprocessor(&per_cu, (const void*)mk_fwd, NT, LDS_BYTES);
        if (per_cu < 1) { fprintf(stderr, "kernel_launch: occupancy query says %d blocks per CU\n", per_cu); per_cu = 1; }
        (void)hipGetLastError();
        grid = cus;
        if (ws_size < WS_END) { fprintf(stderr, "kernel_launch: workspace too small: %zu < %zu\n", ws_size, (size_t)WS_END); grid = -1; }
    }
    if (grid < 0) return;
    if (hipMemsetAsync((char*)d_ws + OFF_BAR, 0, XCD_BAR_WORDS * 4, stream) != hipSuccess) { fprintf(stderr, "kernel_launch: memset failed\n"); return; }
    Params p{};
    for (int i = 0; i < 29; ++i) p.in[i] = (const float*)d_in[i];
    p.out = (float*)d_out; p.ws = (unsigned char*)d_ws;
    void* args[] = {&p};
    hipError_t e = hipLaunchCooperativeKernel((const void*)mk_fwd, dim3(grid), dim3(NT), args, LDS_BYTES, stream);
    if (e != hipSuccess) fprintf(stderr, "cooperative launch failed: %s (grid %d)\n", hipGetErrorString(e), grid);
}
```

```cpp
#include <hip/hip_runtime.h>
#include <hip/hip_cooperative_groups.h>
#include <cstdio>
namespace cg = cooperative_groups;
namespace pg8 {
#define PG8_LAS __attribute__((address_space(3)))
typedef unsigned short bf16_t;
typedef short bf16x8 __attribute__((ext_vector_type(8)));
typedef float f32x4 __attribute__((ext_vector_type(4)));
typedef unsigned u32x4 __attribute__((ext_vector_type(4)));
constexpr int BM = 256, BK = 64, HALF = 128, HTB = HALF * BK * 2  , STAGE_BYTES = 8 * HTB, NXCD = 8, WGM = 8;

__host__ __device__ __forceinline__ int lds_byte(int r, int c) { const int st = (r >> 4) * 2 + (c >> 5), rr = r & 15, cc = c & 31, ob = rr * 64 + cc * 2; return st * 1024 + (ob ^ (((ob >> 9) & 1) << 5)); }
__host__ __device__ __forceinline__ void stage_rc(int b, int& R, int& C) { const int st = b / 1024, sb = b % 1024, swz = sb ^ (((sb >> 9) & 1) << 5); R = (st >> 1) * 16 + swz / 64; C = (st & 1) * 32 + (swz % 64) / 2; }
__host__ __device__ __forceinline__ int perm32(int rho) { const int n = rho >> 4, i = rho & 15; return 8 * (i >> 2) + 4 * n + (i & 3); }

struct Unit { int pm, pn; };
struct Gemm { const bf16_t* A; const bf16_t* Bt; int M, N, K; };

struct StaticOrder {
    int nM, nN, nwg, G, c;
    __host__ __device__ void init(int M, int N, int G_, int c_) { nM = M / BM; nN = N / BM; nwg = nM * nN; G = G_; c = c_; }
    __host__ __device__ bool next(int i, Unit& u) const {
        const long L = (long)i * G + c; if (L >= nwg) return false;
        int wgid = (int)L; { const int q = nwg / NXCD, r = nwg % NXCD, xcd = wgid % NXCD, off = wgid / NXCD; wgid = (xcd < r ? xcd * (q + 1) : r * (q + 1) + (xcd - r) * q) + off; }
        const int nig = WGM * nN, gid = wgid / nig, fm = gid * WGM, gsz = (nM - fm) < WGM ? (nM - fm) : WGM;
        u.pm = fm + ((wgid % nig) % gsz); u.pn = (wgid % nig) / gsz; return true;
    }
    __device__ __forceinline__ void a_ready(const Unit&) const {}
    __device__ __forceinline__ void done(const Unit&) const {}
};
template <class Epi, class Sched, bool STAMP = false>
__device__ __forceinline__ void gemm_phase(PG8_LAS unsigned char* lds, const Gemm g, const Sched& S, const Epi& E, unsigned long long* stamps) {
    int tid = threadIdx.x; asm volatile("" : "+v"(tid)); const int wid = __builtin_amdgcn_readfirstlane(tid >> 6), lane = tid & 63, wr = wid >> 2, wc = wid & 3, fr = lane & 15, fq = lane >> 4;
    const int K = g.K, nt = K / BK;
    int ts_lo = 0, ts_hi = 0, nts = 0; const unsigned long long rt_entry = STAMP ? (unsigned long long)wall_clock64() : 0ull;
#define PG8_STAMP() do { if (STAMP && wid == 0 && nts < 64) { const unsigned long long _c = (unsigned long long)clock64(); \
        ts_lo = (lane == nts) ? (int)(unsigned)_c : ts_lo; ts_hi = (lane == nts) ? (int)(unsigned)(_c >> 32) : ts_hi; ++nts; } } while (0)
    PG8_STAMP();
    unsigned voffA[2], voffB[2];
#pragma unroll
    for (int i = 0; i < 2; ++i) { int R, C; stage_rc(tid * 16 + i * 8192, R, C); const int Rb = Epi::PERM ? ((R & ~31) + perm32(R & 31)) : R;
        voffA[i] = (unsigned)(R * K + C) * 2u; voffB[i] = (unsigned)(Rb * K + C) * 2u; }
    const size_t kstep = (size_t)(BK * 2);
    const size_t hstep = (size_t)HALF * K * 2;
    const size_t tstep = 2 * hstep;
    const unsigned ldsw = (unsigned)wid * 1024u;
    const int aoff = lds_byte(wr * 64 + fr, fq * 8), boff = lds_byte(wc * 32 + fr, fq * 8);
#define PG8_SA(b, h) (((b) * 2 + (h)) * HTB)
#define PG8_SB(b, h) ((4 + (b) * 2 + (h)) * HTB)
#define PG8_STAGE(bufoff, gbase, voff) do { _Pragma("unroll") for (int _i = 0; _i < 2; ++_i) \
        __builtin_amdgcn_global_load_lds((const unsigned*)((const char*)(gbase) + (voff)[_i]), (PG8_LAS unsigned*)(lds + (bufoff) + ldsw + _i * 8192), 16, 0, 0); } while (0)
#define PG8_LDA(dst, b, h) do { _Pragma("unroll") for (int m = 0; m < 4; ++m) _Pragma("unroll") for (int k = 0; k < 2; ++k) dst[m][k] = *(const PG8_LAS bf16x8*)(lds + PG8_SA(b, h) + aoff + m * 2048 + k * 1024); } while (0)
#define PG8_LDB(dst, b, h) do { _Pragma("unroll") for (int n = 0; n < 2; ++n) _Pragma("unroll") for (int k = 0; k < 2; ++k) dst[n][k] = *(const PG8_LAS bf16x8*)(lds + PG8_SB(b, h) + boff + n * 2048 + k * 1024); } while (0)
#define PG8_MMA(ai, bj, At, Bt) do { __builtin_amdgcn_s_setprio(1); _Pragma("unroll") for (int m = 0; m < 4; ++m) _Pragma("unroll") for (int n = 0; n < 2; ++n) _Pragma("unroll") for (int k = 0; k < 2; ++k) \
        acc[ai][bj][m][n] = __builtin_amdgcn_mfma_f32_16x16x32_bf16(Bt[n][k], At[m][k], acc[ai][bj][m][n], 0, 0, 0); __builtin_amdgcn_s_setprio(0); } while (0)
#define PG8_WAIT_V(n) asm volatile("s_waitcnt vmcnt(" #n ")" ::: "memory")
#define PG8_WAIT_L(n) asm volatile("s_waitcnt lgkmcnt(" #n ")" ::: "memory")
#define PG8_BAR __builtin_amdgcn_s_barrier()
#define PG8_SCHED __builtin_amdgcn_sched_barrier(0)
    Unit cur, nxt; int ui = 0;
    if (!S.next(0, cur)) return;
    f32x4 acc[2][2][4][2];
#pragma unroll
    for (int a = 0; a < 2; ++a)
#pragma unroll
        for (int b = 0; b < 2; ++b)
#pragma unroll
            for (int m = 0; m < 4; ++m)
#pragma unroll
                for (int n = 0; n < 2; ++n) acc[a][b][m][n] = (f32x4){0.f, 0.f, 0.f, 0.f};
    bf16x8 At[4][2], B0[2][2], B1[2][2];
    const char* cA = (const char*)g.A + (size_t)cur.pm * tstep; const char* cB = (const char*)g.Bt + (size_t)cur.pn * tstep;
    S.a_ready(cur);
    PG8_STAGE(PG8_SB(0, 0), cB, voffB); PG8_STAGE(PG8_SA(0, 0), cA, voffA); PG8_STAGE(PG8_SB(0, 1), cB + hstep, voffB); PG8_STAGE(PG8_SA(0, 1), cA + hstep, voffA);
    if (wr == 1) PG8_BAR;
    PG8_WAIT_V(4); PG8_BAR;
    PG8_STAGE(PG8_SB(1, 0), cB + kstep, voffB); PG8_STAGE(PG8_SA(1, 0), cA + kstep, voffA); PG8_STAGE(PG8_SB(1, 1), cB + hstep + kstep, voffB);
    PG8_WAIT_V(6); PG8_BAR;
    PG8_STAMP();
    for (;;) {
        const bool has_next = S.next(ui + 1, nxt);
        const char* nA = has_next ? (const char*)g.A + (size_t)nxt.pm * tstep : cA; const char* nB = has_next ? (const char*)g.Bt + (size_t)nxt.pn * tstep : cB;
        for (int t = 0; t < nt; t += 2) {
            const bool last = (t == nt - 2);
            const char* a1 = cA + (size_t)(t + 1) * kstep;
            const char* a2 = last ? nA : cA + (size_t)(t + 2) * kstep; const char* b2 = last ? nB : cB + (size_t)(t + 2) * kstep;
            const char* a3 = a2 + kstep; const char* b3 = b2 + kstep;
            if (last && has_next) S.a_ready(nxt);
            PG8_LDB(B0, 0, 0); PG8_SCHED; PG8_LDA(At, 0, 0); PG8_STAGE(PG8_SA(1, 1), a1 + hstep, voffA);
            PG8_WAIT_L(8); PG8_BAR; PG8_WAIT_L(0); PG8_MMA(0, 0, At, B0); PG8_BAR; PG8_SCHED;
            PG8_LDB(B1, 0, 1); PG8_STAGE(PG8_SB(0, 0), b2, voffB);
            PG8_BAR; PG8_WAIT_L(0); PG8_MMA(0, 1, At, B1); PG8_BAR;
            PG8_LDA(At, 0, 1); PG8_STAGE(PG8_SA(0, 0), a2, voffA);
            PG8_BAR; PG8_WAIT_L(0); PG8_MMA(1, 0, At, B0); PG8_BAR; PG8_SCHED;
            PG8_STAGE(PG8_SB(0, 1), b2 + hstep, voffB);
            PG8_WAIT_V(6); PG8_BAR; PG8_MMA(1, 1, At, B1); PG8_BAR;
            PG8_LDB(B0, 1, 0); PG8_SCHED; PG8_LDA(At, 1, 0); PG8_STAGE(PG8_SA(0, 1), a2 + hstep, voffA);
            PG8_WAIT_L(8); PG8_BAR; PG8_WAIT_L(0); PG8_MMA(0, 0, At, B0); PG8_BAR; PG8_SCHED;
            PG8_LDB(B1, 1, 1); PG8_STAGE(PG8_SB(1, 0), b3, voffB);
            PG8_BAR; PG8_WAIT_L(0); PG8_MMA(0, 1, At, B1); PG8_BAR;
            PG8_LDA(At, 1, 1); PG8_STAGE(PG8_SA(1, 0), a3, voffA);
            PG8_BAR; PG8_WAIT_L(0); PG8_MMA(1, 0, At, B0); PG8_BAR; PG8_SCHED;
            PG8_STAGE(PG8_SB(1, 1), b3 + hstep, voffB);
            PG8_WAIT_V(6); PG8_BAR; PG8_MMA(1, 1, At, B1); PG8_BAR;
        }
        PG8_STAMP();
        if constexpr (!Epi::AFTER_DRAIN) { E(acc, cur, wr, wc, fr, fq); S.done(cur); }
        PG8_STAMP();
        if (!has_next) break;
#pragma unroll
        for (int a = 0; a < 2; ++a)
#pragma unroll
            for (int b = 0; b < 2; ++b)
#pragma unroll
                for (int m = 0; m < 4; ++m)
#pragma unroll
                    for (int n = 0; n < 2; ++n) acc[a][b][m][n] = (f32x4){0.f, 0.f, 0.f, 0.f};
        cur = nxt; cA = nA; cB = nB; ++ui;
    }
    PG8_WAIT_V(0);
    if (wr == 0) PG8_BAR;
    PG8_BAR;
    if constexpr (Epi::AFTER_DRAIN) { E.fused(acc, cur, wr, wc, fr, fq, lds, wid, lane); S.done(cur); }
    PG8_STAMP();
    if (STAMP && wid == 0) { stamps[lane] = lane < nts ? (((unsigned long long)(unsigned)ts_hi << 32) | (unsigned)ts_lo) : 0ull;
        if (lane == 62) stamps[62] = rt_entry; if (lane == 63) stamps[63] = (unsigned long long)wall_clock64(); }
#undef PG8_STAMP
#undef PG8_SA
#undef PG8_SB
#undef PG8_STAGE
#undef PG8_LDA
#undef PG8_LDB
#undef PG8_MMA
#undef PG8_WAIT_V
#undef PG8_WAIT_L
#undef PG8_BAR
#undef PG8_SCHED
}
}
#define XB_TMO      128
#define XB_XCNT(j)  (256  + 64 * (j))
#define XB_XSUB(j)  (1280 + 64 * (j))
#define XB_XGEN(j)  (2304 + 64 * (j))
#define XB_TOP      3328
#define XB_TOPGEN   3392
#define XCD_BAR_WORDS 3456
#define XB_SPIN_CAP (1u << 22)

__device__ __forceinline__ unsigned xb_ld(unsigned* p)              { return __hip_atomic_load(p, __ATOMIC_RELAXED, __HIP_MEMORY_SCOPE_AGENT); }
__device__ __forceinline__ unsigned xb_add(unsigned* p, unsigned v) { return __hip_atomic_fetch_add(p, v, __ATOMIC_RELAXED, __HIP_MEMORY_SCOPE_AGENT); }
__device__ __forceinline__ unsigned xb_xcc_id() { return (unsigned)__builtin_amdgcn_s_getreg((3 << 11) | 20) & 0xFu; }
#define XB_SPIN(cond, bar) do { unsigned _sp = 0; while (cond) { __builtin_amdgcn_s_sleep(1); \
    if ((++_sp & 255u) == 0u) { if (xb_ld(&(bar)[XB_TMO])) break; if (_sp > XB_SPIN_CAP) { atomicAdd(&(bar)[XB_TMO], 1u); break; } } } } while (0)

struct XcdBarrier {
    unsigned* bar; unsigned x;
    volatile PG8_LAS unsigned* st;
};

__device__ __forceinline__ XcdBarrier xcd_barrier_post(unsigned* bar, volatile PG8_LAS unsigned* st) {
    XcdBarrier b; b.bar = bar; b.x = xb_xcc_id(); b.st = st;
    if (threadIdx.x == 0) (void)xb_add(&bar[XB_XCNT(b.x)], 1u);
    return b;
}
__device__ __forceinline__ void xcd_barrier_complete(unsigned* bar, unsigned x, unsigned& nloc, unsigned& nx) {
    const unsigned G = gridDim.x * gridDim.y * gridDim.z;
    unsigned sum, cnt, mine, sp = 0u;
    for (;;) {
        sum = 0u; cnt = 0u; mine = 0u;
#pragma unroll
        for (unsigned j = 0; j < 16; ++j) { const unsigned c = xb_ld(&bar[XB_XCNT(j)]); sum += c; cnt += (c > 0u) ? 1u : 0u; mine = (j == x) ? c : mine; }
        if (sum == G) break;
        __builtin_amdgcn_s_sleep(1);
        if ((++sp & 255u) == 0u) { if (xb_ld(&bar[XB_TMO])) break; if (sp > XB_SPIN_CAP) { atomicAdd(&bar[XB_TMO], 1u); break; } }
    }
    nloc = mine > 0u ? mine : 1u; nx = cnt > 0u ? cnt : 1u;
}

__device__ __forceinline__ void xcd_barrier(const XcdBarrier& b) {
    asm volatile("s_waitcnt vmcnt(0)" ::: "memory");
    __syncthreads();
    if (threadIdx.x == 0) {
        unsigned* bar = b.bar;
        __builtin_amdgcn_s_waitcnt(0);
        unsigned nloc = b.st[0], nx = b.st[1];
        if (nloc == 0u) { xcd_barrier_complete(bar, b.x, nloc, nx); b.st[0] = nloc; b.st[1] = nx; }
        const unsigned old = xb_add(&bar[XB_XSUB(b.x)], 1u);
        const unsigned gen = old / nloc;
        if (old + 1u == (gen + 1u) * nloc) {
            __builtin_amdgcn_fence(__ATOMIC_RELEASE, "agent");
            asm volatile("s_waitcnt vmcnt(0)" ::: "memory");
            const unsigned og = xb_add(&bar[XB_TOP], 1u);
            const unsigned tg = og / nx;
            if (og + 1u == (tg + 1u) * nx) xb_add(&bar[XB_TOPGEN], 1u);
            else XB_SPIN(xb_ld(&bar[XB_TOPGEN]) == tg, bar);
            __builtin_amdgcn_fence(__ATOMIC_ACQUIRE, "agent");
            xb_add(&bar[XB_XGEN(b.x)], 1u);
            asm volatile("s_waitcnt vmcnt(0)" ::: "memory");
        } else {
            XB_SPIN(xb_ld(&bar[XB_XGEN(b.x)]) == gen, bar);
            __builtin_amdgcn_fence(__ATOMIC_ACQUIRE, "agent");
            asm volatile("s_waitcnt vmcnt(0)" ::: "memory");
        }
    }
    __syncthreads();
}

using namespace pg8;
typedef float f32x16 __attribute__((ext_vector_type(16)));
typedef unsigned u32x2 __attribute__((ext_vector_type(2)));
#define LAS PG8_LAS
#define DI __device__ __forceinline__

constexpr int NT = 512;
constexpr int MP = 32768, MS = 2048, MT = MP + MS;
constexpr int KEYS_S = 4352;
constexpr int KR_ROWS = MP + 32 * KEYS_S;
constexpr int ZLD = 2560;
constexpr float EPS = 1e-6f;
constexpr float QSCALE = 0.10206207261596577f * 1.4426950408889634f;
constexpr int LDS_BYTES = 160 * 1024;

constexpr size_t SZ_WIN = 2560ull * 1024 * 2, SZ_WUQ = 768ull * 256 * 2, SZ_WUK = 512ull * 256 * 2, SZ_WUV = 512ull * 256 * 2,
                 SZ_WO = 1024ull * 1024 * 2, SZ_WFI = 5632ull * 1024 * 2, SZ_WFO = 1024ull * 2816 * 2;
constexpr size_t WOFF_IN = 0, WOFF_UQ = WOFF_IN + SZ_WIN, WOFF_UK = WOFF_UQ + SZ_WUQ, WOFF_UV = WOFF_UK + SZ_WUK, WOFF_O = WOFF_UV + SZ_WUV,
                 WOFF_FI = WOFF_O + SZ_WO, WOFF_FO = WOFF_FI + SZ_WFI, WL = WOFF_FO + SZ_WFO;
constexpr size_t OFF_W = 0;
constexpr size_t OFF_MOD = OFF_W + 2 * WL;
constexpr size_t OFF_ROPE = OFF_MOD + 2ull * 36 * 6144 * 4;
constexpr size_t OFF_H = OFF_ROPE + 8192ull * 16 * 2 * 4;
constexpr size_t OFF_Z = OFF_H + (size_t)MT * 1024 * 2;
constexpr size_t OFF_CQN = OFF_Z + (size_t)MT * ZLD * 2;
constexpr size_t OFF_CKV = OFF_CQN + (size_t)MT * 256 * 2;
constexpr size_t OFF_KROPE = OFF_CKV + (size_t)KR_ROWS * 256 * 2;
constexpr size_t OFF_Q = OFF_KROPE + (size_t)KR_ROWS * 32 * 2;
constexpr size_t OFF_KN = OFF_Q + (size_t)MT * 768 * 2;
constexpr size_t OFF_VT = OFF_KN + (size_t)KR_ROWS * 512 * 2;
constexpr size_t OFF_O = OFF_VT + (size_t)KR_ROWS * 512 * 2;
constexpr size_t OFF_PART = OFF_O + (size_t)MP * 512 * 2;
constexpr size_t OFF_UHG = OFF_PART + 32ull * 8 * 4 * 64 * 66 * 4;
constexpr size_t OFF_DHG = OFF_UHG + 544ull * 4 * 64 * 64 * 4;
constexpr size_t OFF_UGL = OFF_DHG + 544ull * 4 * 64 * 4;
constexpr size_t OFF_DGL = OFF_UGL + 544ull * 4 * 32 * 64 * 4;
constexpr size_t OFF_BAR = OFF_DGL + 544ull * 4 * 32 * 4;
constexpr size_t OFF_XB = OFF_BAR + 16384;
constexpr size_t WS_END = OFF_XB + (size_t)MT * 1024 * 2;
constexpr size_t OFF_ACT = OFF_KN;
static_assert((size_t)MT * 2816 * 2 <= 2 * (size_t)KR_ROWS * 512 * 2, "act alias");

constexpr size_t OUT_Y = 0, OUT_CKVP = 35651584, OUT_KRP = 52428800, OUT_HGP = 54525952, OUT_GLP = 54657024,
                 OUT_CKVS = 54722560, OUT_KRS = 55771136, OUT_HGS = 55902208, OUT_GLS = 56950784;

DI int tid_() { int t = threadIdx.x; asm volatile("" : "+v"(t)); return t; }
DI int bid_() { int b = blockIdx.x; asm volatile("" : "+s"(b)); return b; }
DI float neg_big() { float v = -1e30f; asm volatile("" : "+v"(v)); return v; }
struct Params { const float* in[29]; float* out; unsigned char* ws; };

typedef __bf16 hbf2 __attribute__((ext_vector_type(2)));
typedef float f32x2_ __attribute__((ext_vector_type(2)));
DI unsigned pack2(float a, float b) { f32x2_ v = {a, b}; return __builtin_bit_cast(unsigned, __builtin_convertvector(v, hbf2)); }
DI bf16_t f2bf(float f) { return (bf16_t)(pack2(f, f) & 0xFFFFu); }
DI float bf2f(bf16_t b) { return __uint_as_float(((unsigned)b) << 16); }
DI float bflo(unsigned u) { return __uint_as_float(u << 16); }
DI float bfhi(unsigned u) { return __uint_as_float(u & 0xFFFF0000u); }
DI float wave_sum(float v) { v += __shfl_xor(v, 32); v += __shfl_xor(v, 16); v += __shfl_xor(v, 8); v += __shfl_xor(v, 4); v += __shfl_xor(v, 2); v += __shfl_xor(v, 1); return v; }
DI float sigmoidf_(float x) { return 1.f / (1.f + expf(-x)); }
DI int row_bi(int row) { return row < MP ? (row >> 13) : 4 + ((row - MP) >> 6); }

struct EpiZ {
    static constexpr bool PERM = true, AFTER_DRAIN = false;
    bf16_t* O; int ldc;
    DI void operator()(const f32x4 (&acc)[2][2][4][2], const Unit& u, int wr, int wc, int fr, int fq) const {
        const int row0 = u.pm * 256 + wr * 64 + fr, col0 = u.pn * 256 + wc * 32 + 8 * fq;
#pragma unroll
        for (int ai = 0; ai < 2; ++ai)
#pragma unroll
            for (int m = 0; m < 4; ++m) { bf16_t* rowp = O + (size_t)(row0 + ai * 128 + m * 16) * ldc + col0;
#pragma unroll
                for (int bj = 0; bj < 2; ++bj) { const f32x4 v0 = acc[ai][bj][m][0], v1 = acc[ai][bj][m][1]; uint4 w; w.x = pack2(v0[0], v0[1]); w.y = pack2(v0[2], v0[3]); w.z = pack2(v1[0], v1[1]); w.w = pack2(v1[2], v1[3]); *(uint4*)(rowp + bj * 128) = w; } }
    }
};
struct EpiQ {
    static constexpr bool PERM = false, AFTER_DRAIN = false;
    bf16_t* Q; const float* qn_; const float* rope_;
    DI void operator()(const f32x4 (&acc)[2][2][4][2], const Unit& u, int wr, int wc, int fr, int fq) const {
        const float* qn = qn_; const float* rope = rope_; asm volatile("" : "+s"(qn), "+s"(rope));
        float eps_ = EPS; asm volatile("" : "+v"(eps_));
        const int row0 = u.pm * 256 + wr * 64 + fr;
#pragma unroll
        for (int ai = 0; ai < 2; ++ai)
#pragma unroll
            for (int m = 0; m < 4; ++m) {
                const int row = row0 + ai * 128 + m * 16;
                int pos; size_t base, hs;
                if (row < MP) { const int b = row >> 13, t = row & 8191; pos = t; base = ((size_t)(b * 8) * 8192 + t) * 96; hs = 8192 * 96; }
                else { const int r = row - MP, b = r >> 6, t = r & 63; pos = 4096 + t; base = (size_t)MP * 768 + ((size_t)(b * 8) * 64 + t) * 96; hs = 64 * 96; }
                if (u.pn < 2) {
                    const int head = 4 * u.pn + wc;
                    float ss = 0.f;
#pragma unroll
                    for (int bj = 0; bj < 2; ++bj)
#pragma unroll
                        for (int n = 0; n < 2; ++n) { const f32x4 v = acc[ai][bj][m][n]; ss += v[0] * v[0] + v[1] * v[1] + v[2] * v[2] + v[3] * v[3]; }
                    ss += __shfl_xor(ss, 16); ss += __shfl_xor(ss, 32);
                    const float rs = rsqrtf(ss * (1.f / 64.f) + eps_) * QSCALE;
#pragma unroll
                    for (int bj = 0; bj < 2; ++bj)
#pragma unroll
                        for (int n = 0; n < 2; ++n) { const int d = 32 * bj + 16 * n + 4 * fq; const f32x4 v = acc[ai][bj][m][n]; const float4 g = *(const float4*)(qn + d);
                            uint2 w; w.x = pack2(v[0] * rs * g.x, v[1] * rs * g.y); w.y = pack2(v[2] * rs * g.z, v[3] * rs * g.w); *(uint2*)(Q + base + head * hs + d) = w; }
                } else {
#pragma unroll
                    for (int bj = 0; bj < 2; ++bj) {
                        const int head = 2 * wc + bj;
                        const f32x4 v1 = acc[ai][bj][m][0], v2 = acc[ai][bj][m][1];
                        float ss = v1[0] * v1[0] + v1[1] * v1[1] + v1[2] * v1[2] + v1[3] * v1[3] + v2[0] * v2[0] + v2[1] * v2[1] + v2[2] * v2[2] + v2[3] * v2[3];
                        ss += __shfl_xor(ss, 16); ss += __shfl_xor(ss, 32);
                        const float rs = rsqrtf(ss * (1.f / 32.f) + eps_);
                        const float4 g1 = *(const float4*)(qn + 64 + 4 * fq), g2 = *(const float4*)(qn + 80 + 4 * fq);
                        const float4 cs0 = *(const float4*)(rope + ((size_t)pos * 16 + 4 * fq) * 2), cs1 = *(const float4*)(rope + ((size_t)pos * 16 + 4 * fq) * 2 + 4);
                        const float x10 = v1[0] * rs * g1.x, x11 = v1[1] * rs * g1.y, x12 = v1[2] * rs * g1.z, x13 = v1[3] * rs * g1.w;
                        const float x20 = v2[0] * rs * g2.x, x21 = v2[1] * rs * g2.y, x22 = v2[2] * rs * g2.z, x23 = v2[3] * rs * g2.w;
                        uint2 w1, w2;
                        w1.x = pack2((x10 * cs0.x - x20 * cs0.y) * QSCALE, (x11 * cs0.z - x21 * cs0.w) * QSCALE);
                        w1.y = pack2((x12 * cs1.x - x22 * cs1.y) * QSCALE, (x13 * cs1.z - x23 * cs1.w) * QSCALE);
                        w2.x = pack2((x20 * cs0.x + x10 * cs0.y) * QSCALE, (x21 * cs0.z + x11 * cs0.w) * QSCALE);
                        w2.y = pack2((x22 * cs1.x + x12 * cs1.y) * QSCALE, (x23 * cs1.z + x13 * cs1.w) * QSCALE);
                        *(uint2*)(Q + base + head * hs + 64 + 4 * fq) = w1; *(uint2*)(Q + base + head * hs + 80 + 4 * fq) = w2;
                    }
                }
            }
    }
};
struct EpiKN {
    static constexpr bool PERM = true, AFTER_DRAIN = false;
    bf16_t* KN; const float* kn_;
    DI void operator()(const f32x4 (&acc)[2][2][4][2], const Unit& u, int wr, int wc, int fr, int fq) const {
        const float* kn = kn_; asm volatile("" : "+s"(kn));
        float eps_ = EPS; asm volatile("" : "+v"(eps_));
        float4 gk[2][2];
#pragma unroll
        for (int bj = 0; bj < 2; ++bj)
#pragma unroll
            for (int n = 0; n < 2; ++n) gk[bj][n] = *(const float4*)(kn + 32 * bj + 8 * fq + 4 * n);
        size_t base, hs;
        if (u.pm < 128) { const int b = u.pm >> 5, key0 = (u.pm & 31) * 256; base = ((size_t)(b * 8) * 8192 + key0) * 64; hs = (size_t)8192 * 64; }
        else { const int q = u.pm - 128, b = q / 17, key0 = (q % 17) * 256; base = (size_t)MP * 512 + ((size_t)(b * 8) * KEYS_S + key0) * 64; hs = (size_t)KEYS_S * 64; }
        const int head = 4 * u.pn + wc;
#pragma unroll
        for (int ai = 0; ai < 2; ++ai)
#pragma unroll
            for (int m = 0; m < 4; ++m) {
                const int key = 128 * ai + 64 * wr + 16 * m + fr;
                float ss = 0.f;
#pragma unroll
                for (int bj = 0; bj < 2; ++bj)
#pragma unroll
                    for (int n = 0; n < 2; ++n) { const f32x4 v = acc[ai][bj][m][n]; ss += v[0] * v[0] + v[1] * v[1] + v[2] * v[2] + v[3] * v[3]; }
                ss += __shfl_xor(ss, 16); ss += __shfl_xor(ss, 32);
                const float rs = rsqrtf(ss * (1.f / 64.f) + eps_);
#pragma unroll
                for (int bj = 0; bj < 2; ++bj) { const f32x4 v0 = acc[ai][bj][m][0], v1 = acc[ai][bj][m][1]; const float4 g0 = gk[bj][0], g1 = gk[bj][1];
                    uint4 w; w.x = pack2(v0[0] * rs * g0.x, v0[1] * rs * g0.y); w.y = pack2(v0[2] * rs * g0.z, v0[3] * rs * g0.w); w.z = pack2(v1[0] * rs * g1.x, v1[1] * rs * g1.y); w.w = pack2(v1[2] * rs * g1.z, v1[3] * rs * g1.w);
                    *(uint4*)(KN + base + head * hs + (size_t)key * 64 + 32 * bj + 8 * fq) = w; }
            }
    }
};
struct EpiVT {
    static constexpr bool PERM = true, AFTER_DRAIN = false;
    bf16_t* VT;
    DI void operator()(const f32x4 (&acc)[2][2][4][2], const Unit& u, int wr, int wc, int fr, int fq) const {
        size_t base; int KL;
        if (u.pn < 128) { const int b = u.pn >> 5, key0 = (u.pn & 31) * 256; base = (size_t)(b * 8) * 64 * 8192 + key0; KL = 8192; }
        else { const int q = u.pn - 128, b = q / 17, key0 = (q % 17) * 256; base = (size_t)MP * 512 + (size_t)(b * 8) * 64 * KEYS_S + key0; KL = KEYS_S; }
#pragma unroll
        for (int ai = 0; ai < 2; ++ai)
#pragma unroll
            for (int m = 0; m < 4; ++m) {
                const int r = 256 * u.pm + 128 * ai + 64 * wr + 16 * m + fr;
                bf16_t* rowp = VT + base + (size_t)r * KL + 32 * wc + 8 * fq;
#pragma unroll
                for (int bj = 0; bj < 2; ++bj) { const f32x4 v0 = acc[ai][bj][m][0], v1 = acc[ai][bj][m][1]; uint4 w; w.x = pack2(v0[0], v0[1]); w.y = pack2(v0[2], v0[3]); w.z = pack2(v1[0], v1[1]); w.w = pack2(v1[2], v1[3]); *(uint4*)(rowp + 128 * bj) = w; }
            }
    }
};
struct EpiRes {
    static constexpr bool PERM = false, AFTER_DRAIN = false;
    bf16_t* XB; float* out; const float* gate; int final;
    DI void operator()(const f32x4 (&acc)[2][2][4][2], const Unit& u, int wr, int wc, int fr, int fq) const {
        const int row0 = u.pm * 256 + wr * 64 + fr, col0 = u.pn * 256 + wc * 32 + 4 * fq;
#pragma unroll
        for (int ai = 0; ai < 2; ++ai) {
            const float* gr = gate + (size_t)row_bi(row0 + ai * 128) * 6144 + col0;
            f32x4 g[2][2]; uint2 x[4][2][2];
#pragma unroll
            for (int bj = 0; bj < 2; ++bj)
#pragma unroll
                for (int n = 0; n < 2; ++n) g[bj][n] = *(const f32x4*)(gr + bj * 128 + n * 16);
#pragma unroll
            for (int m = 0; m < 4; ++m) { const bf16_t* xr = XB + (size_t)(row0 + ai * 128 + m * 16) * 1024 + col0;
#pragma unroll
                for (int bj = 0; bj < 2; ++bj)
#pragma unroll
                    for (int n = 0; n < 2; ++n) x[m][bj][n] = *(const uint2*)(xr + bj * 128 + n * 16); }
#pragma unroll
            for (int m = 0; m < 4; ++m) { const size_t ro = (size_t)(row0 + ai * 128 + m * 16) * 1024 + col0;
#pragma unroll
                for (int bj = 0; bj < 2; ++bj)
#pragma unroll
                    for (int n = 0; n < 2; ++n) { const uint2 xv = x[m][bj][n]; const f32x4 xf = {bflo(xv.x), bfhi(xv.x), bflo(xv.y), bfhi(xv.y)}; const f32x4 r = xf + g[bj][n] * acc[ai][bj][m][n];
                        if (final) *(f32x4*)(out + ro + bj * 128 + n * 16) = r;
                        else { uint2 w; w.x = pack2(r[0], r[1]); w.y = pack2(r[2], r[3]); *(uint2*)(XB + ro + bj * 128 + n * 16) = w; } } }
        }
    }
};
struct EpiSwi {
    static constexpr bool PERM = true, AFTER_DRAIN = false;
    bf16_t* ACT;
    DI void operator()(const f32x4 (&acc)[2][2][4][2], const Unit& u, int wr, int wc, int fr, int fq) const {
        const int row0 = u.pm * 256 + wr * 64 + fr, col0 = u.pn * 128 + wc * 32 + 8 * fq;
#pragma unroll
        for (int ai = 0; ai < 2; ++ai)
#pragma unroll
            for (int m = 0; m < 4; ++m) { bf16_t* rowp = ACT + (size_t)(row0 + ai * 128 + m * 16) * 2816 + col0; float r[8];
#pragma unroll
                for (int n = 0; n < 2; ++n) { const f32x4 a = acc[ai][0][m][n], g = acc[ai][1][m][n];
#pragma unroll
                    for (int j = 0; j < 4; ++j) r[4 * n + j] = a[j] / (1.f + __expf(-a[j])) * g[j]; }
                uint4 w; w.x = pack2(r[0], r[1]); w.y = pack2(r[2], r[3]); w.z = pack2(r[4], r[5]); w.w = pack2(r[6], r[7]); *(uint4*)rowp = w; }
    }
};
template <class Epi> DI void run_gemm(LAS unsigned char* lds, const bf16_t* A, const bf16_t* Bt, int M, int N, int K, const Epi& E, int rot = 0) {
    asm volatile("" : "+s"(M), "+s"(N), "+s"(K));
    Gemm g{A, Bt, M, N, K}; StaticOrder S; S.init(M, N, (int)gridDim.x, (int)((bid_() + rot) % gridDim.x));
    gemm_phase<Epi, StaticOrder, false>(lds, g, S, E, nullptr);
}

DI int colmap(int w, int n) {
    if (w == 0) return n < 2352 ? n : -1;
    if (w == 1) { const int pn = n >> 8, c = n & 255, bj = c >> 7, wc = (c >> 5) & 3, cc = c & 31; return pn < 2 ? (4 * pn + wc) * 96 + 32 * bj + cc : (2 * wc + bj) * 96 + 64 + cc; }
    if (w == 2) { const int pn = n >> 8, c = n & 255, bj = c >> 7, wc = (c >> 5) & 3, cc = c & 31; return (4 * pn + wc) * 64 + 32 * bj + cc; }
    if (w == 5) { const int pn = n >> 8, c = n & 255; return c < 128 ? 128 * pn + c : 2816 + 128 * pn + (c - 128); }
    return n;
}
DI void phase_prep(const Params& p, LAS unsigned char* lds) {
    const int tid = tid_();
    LAS bf16_t* T = (LAS bf16_t*)lds;
    for (int ti = bid_(); ti < 2 * 1560; ti += gridDim.x) {
        const int l = ti / 1560, r = ti % 1560;
        int w, t0, K, ld; size_t doff; const float* src;
        if (r < 320) { w = 0; t0 = 0; K = 1024; ld = 2352; doff = WOFF_IN; src = p.in[12]; }
        else if (r < 344) { w = 1; t0 = 320; K = 256; ld = 768; doff = WOFF_UQ; src = p.in[15]; }
        else if (r < 360) { w = 2; t0 = 344; K = 256; ld = 512; doff = WOFF_UK; src = p.in[16]; }
        else if (r < 376) { w = 3; t0 = 360; K = 256; ld = 512; doff = WOFF_UV; src = p.in[17]; }
        else if (r < 504) { w = 4; t0 = 376; K = 1024; ld = 1024; doff = WOFF_O; src = p.in[26]; }
        else if (r < 1208) { w = 5; t0 = 504; K = 1024; ld = 5632; doff = WOFF_FI; src = p.in[27]; }
        else { w = 6; t0 = 1208; K = 2816; ld = 1024; doff = WOFF_FO; src = p.in[28]; }
        src += (size_t)l * K * ld;
        const int kt = K >> 7, tr = r - t0, n0 = (tr / kt) * 64, k0 = (tr % kt) * 128;
        bf16_t* dst = (bf16_t*)(p.ws + OFF_W + (size_t)l * WL + doff);
        const int nn = tid & 63, col = colmap(w, n0 + nn);
        float tv[16];
#pragma unroll
        for (int i = 0; i < 16; ++i) { const int kk = (tid >> 6) + 8 * i; tv[i] = col >= 0 ? src[(size_t)(k0 + kk) * ld + col] : 0.f; }
#pragma unroll
        for (int i = 0; i < 16; ++i) { const int kk = (tid >> 6) + 8 * i; T[nn * 130 + kk] = f2bf(tv[i]); }
        __syncthreads();
#pragma unroll
        for (int j = 0; j < 2; ++j) { const int q = tid + 512 * j, row = q >> 4, seg = q & 15; const LAS unsigned* tp = (const LAS unsigned*)(T + row * 130 + seg * 8);
          uint4 o; o.x = tp[0]; o.y = tp[1]; o.z = tp[2]; o.w = tp[3]; *(uint4*)(dst + (size_t)(n0 + row) * K + k0 + seg * 8) = o; }
        __syncthreads();
    }
    float* mod = (float*)(p.ws + OFF_MOD);
    for (int it = bid_(); it < 192; it += gridDim.x) {
        const int l = it / 96, cgp = it % 96;
        LAS float* sl = (LAS float*)lds;
        for (int i = tid; i < 36 * 1024; i += NT) { const int bi = i >> 10, k = i & 1023; const float c = bi < 4 ? p.in[2][bi * 1024 + k] : p.in[3][(bi - 4) * 1024 + k]; sl[i] = c / (1.f + expf(-c)); }
        __syncthreads();
        const int cl = tid & 63, kq = tid >> 6;
        float acc[36];
#pragma unroll
        for (int bi = 0; bi < 36; ++bi) acc[bi] = 0.f;
        const float* wm = p.in[8] + (size_t)l * 1024 * 6144 + cgp * 64 + cl;
#pragma unroll 4
        for (int k = kq * 128; k < kq * 128 + 128; k += 4) {
            const float w0 = wm[(size_t)k * 6144], w1 = wm[(size_t)(k + 1) * 6144], w2 = wm[(size_t)(k + 2) * 6144], w3 = wm[(size_t)(k + 3) * 6144];
#pragma unroll
            for (int bi = 0; bi < 36; ++bi) { const f32x4 s = *(const LAS f32x4*)(sl + bi * 1024 + k); acc[bi] += s[0] * w0 + s[1] * w1 + s[2] * w2 + s[3] * w3; }
        }
        __syncthreads();
        LAS float* red = (LAS float*)lds;
#pragma unroll
        for (int bi = 0; bi < 36; ++bi) red[(kq * 36 + bi) * 64 + cl] = acc[bi];
        __syncthreads();
        for (int o = tid; o < 36 * 64; o += NT) { const int bi = o >> 6, c = o & 63; float s = 0.f;
#pragma unroll
            for (int q = 0; q < 8; ++q) s += red[(q * 36 + bi) * 64 + c];
            const int colg = cgp * 64 + c; mod[((size_t)l * 36 + bi) * 6144 + colg] = s + p.in[9][l * 6144 + colg]; }
        __syncthreads();
    }
    float* rope = (float*)(p.ws + OFF_ROPE);
    for (int i = bid_() * NT + tid; i < 8192 * 16; i += gridDim.x * NT) { const int pos = i >> 4, j = i & 15;
        const float inv = exp2f(-(float)j * (13.287712379549449f / 16.f)); const float ang = (float)pos * inv; rope[2 * i] = cosf(ang); rope[2 * i + 1] = sinf(ang); }
}

template <bool FROM_INPUT>
DI void phase_hrows(const Params& p, int l, const float* xa, const float* xb, const float* g, int shoff, int scoff) {
    const int tid = tid_(), lane = tid & 63, wid = __builtin_amdgcn_readfirstlane(tid >> 6);
    const float* mod = (const float*)(p.ws + OFF_MOD) + (size_t)l * 36 * 6144;
    bf16_t* H = (bf16_t*)(p.ws + OFF_H); bf16_t* XB = (bf16_t*)(p.ws + OFF_XB);
    const int stride = gridDim.x * 8;
    int row = bid_() * 8 + wid;
    float4 v[4];
#define HR_LOAD(dst, rr) do { if (FROM_INPUT) { const float* xr_ = (rr) < MP ? xa + (size_t)(rr) * 1024 : xb + (size_t)((rr) - MP) * 1024; \
            _Pragma("unroll") for (int i = 0; i < 4; ++i) dst[i] = *(const float4*)(xr_ + i * 256 + lane * 4); } \
        else { const bf16_t* xr_ = XB + (size_t)(rr) * 1024; \
            _Pragma("unroll") for (int i = 0; i < 4; ++i) { const uint2 u_ = *(const uint2*)(xr_ + i * 256 + lane * 4); dst[i].x = bflo(u_.x); dst[i].y = bfhi(u_.x); dst[i].z = bflo(u_.y); dst[i].w = bfhi(u_.y); } } } while (0)
    if (row < MT) HR_LOAD(v, row);
    while (row < MT) {
        const int nrow = row + stride; float4 nv[4];
        if (nrow < MT) HR_LOAD(nv, nrow);
        float ss = 0.f;
#pragma unroll
        for (int i = 0; i < 4; ++i) ss += v[i].x * v[i].x + v[i].y * v[i].y + v[i].z * v[i].z + v[i].w * v[i].w;
        ss = wave_sum(ss);
        const float rs = rsqrtf(ss * (1.f / 1024.f) + EPS);
        const float* mp = mod + (size_t)row_bi(row) * 6144;
#pragma unroll
        for (int i = 0; i < 4; ++i) { const int col = i * 256 + lane * 4;
            const float4 gg = *(const float4*)(g + col), sc = *(const float4*)(mp + scoff + col), sh = *(const float4*)(mp + shoff + col);
            uint2 w; w.x = pack2(v[i].x * rs * gg.x * (1.f + sc.x) + sh.x, v[i].y * rs * gg.y * (1.f + sc.y) + sh.y);
            w.y = pack2(v[i].z * rs * gg.z * (1.f + sc.z) + sh.z, v[i].w * rs * gg.w * (1.f + sc.w) + sh.w);
            *(uint2*)(H + (size_t)row * 1024 + col) = w;
            if (FROM_INPUT) { uint2 xw; xw.x = pack2(v[i].x, v[i].y); xw.y = pack2(v[i].z, v[i].w); *(uint2*)(XB + (size_t)row * 1024 + col) = xw; } }
#pragma unroll
        for (int i = 0; i < 4; ++i) v[i] = nv[i];
        row = nrow;
    }
#undef HR_LOAD
}
DI void phase_cache(const Params& p, int l, int b0, int nb) {
    const size_t gt = (size_t)(bid_() - b0) * NT + tid_(), gs = (size_t)nb * NT;
    bf16_t* ckv_s = (bf16_t*)(p.ws + OFF_CKV) + (size_t)MP * 256;
    bf16_t* kr_s = (bf16_t*)(p.ws + OFF_KROPE) + (size_t)MP * 32;
    const float4* s1 = (const float4*)(p.in[4] + (size_t)l * 32 * 4096 * 256);
    for (size_t i0 = gt; i0 < 8388608; i0 += gs * 8) { float4 v[8];
#pragma unroll
        for (int u = 0; u < 8; ++u) { const size_t i = i0 + u * gs; if (i < 8388608) v[u] = s1[i]; }
#pragma unroll
        for (int u = 0; u < 8; ++u) { const size_t i = i0 + u * gs; if (i < 8388608) { const size_t e = i * 4, b = e >> 20, rem = e & 1048575;
            uint2 w; w.x = pack2(v[u].x, v[u].y); w.y = pack2(v[u].z, v[u].w); *(uint2*)(ckv_s + b * KEYS_S * 256 + rem) = w; } } }
    unsigned zz = 0u; asm volatile("" : "+v"(zz));
    for (size_t i = gt; i < 393216; i += gs) { const size_t e = i * 4, b = e / 49152, rem = e % 49152; uint2 w; w.x = zz; w.y = zz; *(uint2*)(ckv_s + b * KEYS_S * 256 + 4160 * 256 + rem) = w; }
    const float4* s2 = (const float4*)(p.in[5] + (size_t)l * 32 * 4096 * 32);
    for (size_t i0 = gt; i0 < 1048576; i0 += gs * 8) { float4 v[8];
#pragma unroll
        for (int u = 0; u < 8; ++u) { const size_t i = i0 + u * gs; if (i < 1048576) v[u] = s2[i]; }
#pragma unroll
        for (int u = 0; u < 8; ++u) { const size_t i = i0 + u * gs; if (i < 1048576) { const size_t e = i * 4, b = e >> 17, rem = e & 131071;
            uint2 w; w.x = pack2(v[u].x, v[u].y); w.y = pack2(v[u].z, v[u].w); *(uint2*)(kr_s + b * KEYS_S * 32 + rem) = w; } } }
}
DI void phase_post(const Params& p, int l) {
    const int tid = tid_(), lane = tid & 63, wid = __builtin_amdgcn_readfirstlane(tid >> 6);
    const bf16_t* Z = (const bf16_t*)(p.ws + OFF_Z);
    bf16_t* CQN = (bf16_t*)(p.ws + OFF_CQN); bf16_t* CKV = (bf16_t*)(p.ws + OFF_CKV); bf16_t* KRO = (bf16_t*)(p.ws + OFF_KROPE);
    const float* rope = (const float*)(p.ws + OFF_ROPE);
    const float* gcq = p.in[13] + l * 256; const float* gckv = p.in[14] + l * 256; const float* gk = p.in[19] + l * 96 + 64;
    const int stride = gridDim.x * 8;
    int row = bid_() * 8 + wid;
    uint2 u1, u2; bf16_t u3;
    if (row < MT) { const bf16_t* zr = Z + (size_t)row * ZLD; u1 = *(const uint2*)(zr + 4 * lane); u2 = *(const uint2*)(zr + 256 + 4 * lane); u3 = zr[512 + (lane & 31)]; }
    while (row < MT) {
        const int nrow = row + stride; uint2 n1, n2; bf16_t n3;
        if (nrow < MT) { const bf16_t* zr = Z + (size_t)nrow * ZLD; n1 = *(const uint2*)(zr + 4 * lane); n2 = *(const uint2*)(zr + 256 + 4 * lane); n3 = zr[512 + (lane & 31)]; }
        int pos; size_t grow; float* o_ckv; float* o_kr;
        if (row < MP) { const int b = row >> 13, t = row & 8191; pos = t; grow = row; o_ckv = p.out + OUT_CKVP + ((size_t)(l * 4 + b) * 8192 + t) * 256; o_kr = p.out + OUT_KRP + ((size_t)(l * 4 + b) * 8192 + t) * 32; }
        else { const int r = row - MP, b = r >> 6, t = r & 63; pos = 4096 + t; grow = (size_t)MP + (size_t)b * KEYS_S + 4096 + t; o_ckv = p.out + OUT_CKVS + ((size_t)(l * 32 + b) * 64 + t) * 256; o_kr = p.out + OUT_KRS + ((size_t)(l * 32 + b) * 64 + t) * 32; }
        { const uint2 u = u1; const float a0 = bflo(u.x), a1 = bfhi(u.x), a2 = bflo(u.y), a3 = bfhi(u.y);
          const float ss = wave_sum(a0 * a0 + a1 * a1 + a2 * a2 + a3 * a3); const float rs = rsqrtf(ss * (1.f / 256.f) + EPS); const float4 g = *(const float4*)(gcq + 4 * lane);
          uint2 w; w.x = pack2(a0 * rs * g.x, a1 * rs * g.y); w.y = pack2(a2 * rs * g.z, a3 * rs * g.w); *(uint2*)(CQN + (size_t)row * 256 + 4 * lane) = w; }
        { const uint2 u = u2; const float a0 = bflo(u.x), a1 = bfhi(u.x), a2 = bflo(u.y), a3 = bfhi(u.y);
          const float ss = wave_sum(a0 * a0 + a1 * a1 + a2 * a2 + a3 * a3); const float rs = rsqrtf(ss * (1.f / 256.f) + EPS); const float4 g = *(const float4*)(gckv + 4 * lane);
          float4 o; o.x = a0 * rs * g.x; o.y = a1 * rs * g.y; o.z = a2 * rs * g.z; o.w = a3 * rs * g.w; *(float4*)(o_ckv + 4 * lane) = o;
          uint2 w; w.x = pack2(o.x, o.y); w.y = pack2(o.z, o.w); *(uint2*)(CKV + grow * 256 + 4 * lane) = w; }
        { const int i = lane & 31; const float a = bf2f(u3); float ss = a * a; ss += __shfl_xor(ss, 16); ss += __shfl_xor(ss, 8); ss += __shfl_xor(ss, 4); ss += __shfl_xor(ss, 2); ss += __shfl_xor(ss, 1);
          const float xn = a * rsqrtf(ss * (1.f / 32.f) + EPS) * gk[i]; const float other = __shfl_xor(xn, 16);
          const float2 cs = *(const float2*)(rope + ((size_t)pos * 16 + (i & 15)) * 2);
          const float o = i < 16 ? xn * cs.x - other * cs.y : xn * cs.x + other * cs.y;
          if (lane < 32) { o_kr[i] = o; KRO[grow * 32 + i] = f2bf(o); } }
        u1 = n1; u2 = n2; u3 = n3; row = nrow;
    }
}

DI f32x16 mfma32(bf16x8 a, bf16x8 b, f32x16 c) { return __builtin_amdgcn_mfma_f32_32x32x16_bf16(a, b, c, 0, 0, 0); }
DI f32x4 mfma16(bf16x8 a, bf16x8 b, f32x4 c) { return __builtin_amdgcn_mfma_f32_16x16x32_bf16(a, b, c, 0, 0, 0); }
DI bf16x8 pack8(const f32x16& s, int b) { u32x4 r; r[0] = pack2(s[b], s[b + 1]); r[1] = pack2(s[b + 2], s[b + 3]); r[2] = pack2(s[b + 4], s[b + 5]); r[3] = pack2(s[b + 6], s[b + 7]); return __builtin_bit_cast(bf16x8, r); }

template <int NH>
DI void attn_core(LAS unsigned char* lds, const bf16_t* qptr, const bf16_t* kn, size_t kn_hs, const bf16_t* kr, const bf16_t* vt, size_t vt_hs, int KL,
                  int kt0, int kstep, int nit, int nvalid, int tile_lim, int hh, f32x16 (&o)[2], float& m_run, float& l_run) {
    constexpr int BUFSZ = NH * 17920 + 5120;
    const int tid = tid_(), lane = tid & 63, r = lane & 31, h = lane >> 5;
    bf16x8 qf[6];
#pragma unroll
    for (int ks = 0; ks < 6; ++ks) qf[ks] = *(const bf16x8*)(qptr + ks * 16 + h * 8);
#pragma unroll
    for (int i = 0; i < 16; ++i) { o[0][i] = 0.f; o[1][i] = 0.f; }
    m_run = neg_big(); l_run = 0.f;
    u32x4 rkn[NH], rvt[NH], rkr = {0u, 0u, 0u, 0u};
    const int lrow = tid >> 3, lseg = tid & 7;
#define ATT_GLOAD(kt) do { const size_t key0_ = (size_t)(kt) * 64; \
        _Pragma("unroll") for (int hx = 0; hx < NH; ++hx) { rkn[hx] = *(const u32x4*)(kn + hx * kn_hs + (key0_ + lrow) * 64 + lseg * 8); rvt[hx] = *(const u32x4*)(vt + hx * vt_hs + (size_t)lrow * KL + key0_ + lseg * 8); } \
        if (tid < 256) rkr = *(const u32x4*)(kr + (key0_ + (tid >> 2)) * 32 + (tid & 3) * 8); } while (0)
#define ATT_LSTORE(buf) do { LAS unsigned char* B_ = lds + (buf) * BUFSZ; \
        _Pragma("unroll") for (int hx = 0; hx < NH; ++hx) { *(LAS u32x4*)(B_ + hx * 9216 + lrow * 144 + lseg * 16) = rkn[hx]; \
            LAS u32x2* pv_ = (LAS u32x2*)(B_ + NH * 9216 + 5120 + hx * 8704 + lrow * 136 + lseg * 16); u32x2 a_, b_; a_[0] = rvt[hx][0]; a_[1] = rvt[hx][1]; b_[0] = rvt[hx][2]; b_[1] = rvt[hx][3]; pv_[0] = a_; pv_[1] = b_; } \
        if (tid < 256) *(LAS u32x4*)(B_ + NH * 9216 + (tid >> 2) * 80 + (tid & 3) * 16) = rkr; } while (0)
    ATT_GLOAD(kt0); ATT_LSTORE(0);
    __syncthreads();
    for (int it = 0; it < nit; ++it) {
        const int ktn = kt0 + (it + 1) * kstep;
        const bool more = (it + 1 < nit) && (ktn < tile_lim);
        if (more) ATT_GLOAD(ktn);
        if (it < nvalid) {
            const LAS unsigned char* B = lds + (it & 1) * BUFSZ;
            const LAS unsigned char* knb = B + hh * 9216; const LAS unsigned char* krb = B + NH * 9216; const LAS unsigned char* vtb = B + NH * 9216 + 5120 + hh * 8704;
            f32x16 s0, s1;
#pragma unroll
            for (int i = 0; i < 16; ++i) { s0[i] = 0.f; s1[i] = 0.f; }
#pragma unroll
            for (int ks = 0; ks < 4; ++ks) { const bf16x8 a0 = *(const LAS bf16x8*)(knb + r * 144 + ks * 32 + h * 16), a1 = *(const LAS bf16x8*)(knb + (32 + r) * 144 + ks * 32 + h * 16);
                s0 = mfma32(a0, qf[ks], s0); s1 = mfma32(a1, qf[ks], s1); }
#pragma unroll
            for (int ks = 0; ks < 2; ++ks) { const bf16x8 a0 = *(const LAS bf16x8*)(krb + r * 80 + ks * 32 + h * 16), a1 = *(const LAS bf16x8*)(krb + (32 + r) * 80 + ks * 32 + h * 16);
                s0 = mfma32(a0, qf[4 + ks], s0); s1 = mfma32(a1, qf[4 + ks], s1); }
            float mx = s0[0];
#pragma unroll
            for (int i = 0; i < 16; ++i) { mx = fmaxf(mx, s0[i]); mx = fmaxf(mx, s1[i]); }
            mx = fmaxf(mx, __shfl_xor(mx, 32));
            const float mnew = fmaxf(m_run, mx), alpha = __builtin_amdgcn_exp2f(m_run - mnew);
            m_run = mnew;
            float ps = 0.f;
#pragma unroll
            for (int i = 0; i < 16; ++i) { s0[i] = __builtin_amdgcn_exp2f(s0[i] - mnew); s1[i] = __builtin_amdgcn_exp2f(s1[i] - mnew); ps += s0[i] + s1[i]; }
            l_run = l_run * alpha + ps;
#pragma unroll
            for (int i = 0; i < 16; ++i) { o[0][i] *= alpha; o[1][i] *= alpha; }
            bf16x8 pf[4];
            pf[0] = pack8(s0, 0); pf[1] = pack8(s0, 8); pf[2] = pack8(s1, 0); pf[3] = pack8(s1, 8);
#pragma unroll
            for (int dh = 0; dh < 2; ++dh)
#pragma unroll
                for (int s4 = 0; s4 < 4; ++s4) { const LAS u32x2* pa = (const LAS u32x2*)(vtb + (32 * dh + r) * 136 + (16 * s4 + 4 * h) * 2); const u32x2 lo = pa[0], hi = pa[2];
                    u32x4 av; av[0] = lo[0]; av[1] = lo[1]; av[2] = hi[0]; av[3] = hi[1]; o[dh] = mfma32(__builtin_bit_cast(bf16x8, av), pf[s4], o[dh]); }
        }
        if (more) ATT_LSTORE((it + 1) & 1);
        __syncthreads();
    }
#undef ATT_GLOAD
#undef ATT_LSTORE
}
DI void attn_core64(LAS unsigned char* lds, const bf16_t* qptr, const bf16_t* kn, const bf16_t* kr, const bf16_t* vt, int KL, int nit, int nvalid,
                    f32x16 (&o)[2][2], float (&m_run)[2], float (&l_run)[2]) {
    constexpr int BUFSZ = 17920 + 5120;
    const int tid = tid_(), lane = tid & 63, r = lane & 31, h = lane >> 5;
    bf16x8 qf[2][2];
    LAS bf16x8* qr = (LAS bf16x8*)(lds + 2 * BUFSZ + (tid >> 6) * 8192) + lane;
#pragma unroll
    for (int g = 0; g < 2; ++g) {
#pragma unroll
        for (int ks = 0; ks < 2; ++ks) qf[g][ks] = *(const bf16x8*)(qptr + g * 32 * 96 + ks * 16 + h * 8);
#pragma unroll
        for (int ks = 0; ks < 4; ++ks) qr[(g * 4 + ks) * 64] = *(const bf16x8*)(qptr + g * 32 * 96 + (2 + ks) * 16 + h * 8); }
#pragma unroll
    for (int g = 0; g < 2; ++g) { m_run[g] = neg_big(); l_run[g] = 0.f;
#pragma unroll
        for (int i = 0; i < 16; ++i) { o[g][0][i] = 0.f; o[g][1][i] = 0.f; } }
    u32x4 rkn, rvt, rkr = {0u, 0u, 0u, 0u};
    const int lrow = tid >> 3, lseg = tid & 7;
#define A64_GLOAD(kt) do { const size_t key0_ = (size_t)(kt) * 64; rkn = *(const u32x4*)(kn + (key0_ + lrow) * 64 + lseg * 8); rvt = *(const u32x4*)(vt + (size_t)lrow * KL + key0_ + lseg * 8); \
        if (tid < 256) rkr = *(const u32x4*)(kr + (key0_ + (tid >> 2)) * 32 + (tid & 3) * 8); } while (0)
#define A64_LSTORE(buf) do { LAS unsigned char* B_ = lds + (buf) * BUFSZ; *(LAS u32x4*)(B_ + lrow * 144 + lseg * 16) = rkn; \
        LAS u32x2* pv_ = (LAS u32x2*)(B_ + 9216 + 5120 + lrow * 136 + lseg * 16); u32x2 a_, b_; a_[0] = rvt[0]; a_[1] = rvt[1]; b_[0] = rvt[2]; b_[1] = rvt[3]; pv_[0] = a_; pv_[1] = b_; \
        if (tid < 256) *(LAS u32x4*)(B_ + 9216 + (tid >> 2) * 80 + (tid & 3) * 16) = rkr; } while (0)
    A64_GLOAD(0); A64_LSTORE(0);
    __syncthreads();
    for (int it = 0; it < nit; ++it) {
        const bool more = (it + 1 < nit);
        if (more) A64_GLOAD(it + 1);
        if (it < nvalid) {
            const LAS unsigned char* B = lds + (it & 1) * BUFSZ;
            const LAS unsigned char* knb = B; const LAS unsigned char* krb = B + 9216; const LAS unsigned char* vtb = B + 9216 + 5120;
            f32x16 s[2][2];
#pragma unroll
            for (int g = 0; g < 2; ++g)
#pragma unroll
                for (int i = 0; i < 16; ++i) { s[g][0][i] = 0.f; s[g][1][i] = 0.f; }
            __builtin_amdgcn_s_setprio(1);
#define A64_KA0(ks) ((ks) < 4 ? *(const LAS bf16x8*)(knb + r * 144 + (ks) * 32 + h * 16) : *(const LAS bf16x8*)(krb + r * 80 + ((ks) - 4) * 32 + h * 16))
#define A64_KA1(ks) ((ks) < 4 ? *(const LAS bf16x8*)(knb + (32 + r) * 144 + (ks) * 32 + h * 16) : *(const LAS bf16x8*)(krb + (32 + r) * 80 + ((ks) - 4) * 32 + h * 16))
#define A64_Q(g, ks) ((ks) < 2 ? qf[g][(ks) < 2 ? (ks) : 0] : qr[((g) * 4 + (ks) - 2) * 64])
            { bf16x8 a0 = A64_KA0(0), a1 = A64_KA1(0), q0 = A64_Q(0, 0), q1 = A64_Q(1, 0);
#pragma unroll
              for (int ks = 0; ks < 6; ++ks) {
                  bf16x8 na0 = a0, na1 = a1, nq0 = q0, nq1 = q1;
                  if (ks < 5) { na0 = A64_KA0(ks + 1); na1 = A64_KA1(ks + 1); nq0 = A64_Q(0, ks + 1); nq1 = A64_Q(1, ks + 1); }
                  __builtin_amdgcn_sched_barrier(0);
                  s[0][0] = mfma32(a0, q0, s[0][0]); s[1][0] = mfma32(a0, q1, s[1][0]); s[0][1] = mfma32(a1, q0, s[0][1]); s[1][1] = mfma32(a1, q1, s[1][1]);
                  __builtin_amdgcn_sched_barrier(0);
                  a0 = na0; a1 = na1; q0 = nq0; q1 = nq1; } }
#undef A64_KA0
#undef A64_KA1
#undef A64_Q
            __builtin_amdgcn_s_setprio(0);
            __builtin_amdgcn_sched_barrier(0);
            bf16x8 pf[2][4];
#pragma unroll
            for (int g = 0; g < 2; ++g) {
                float mx = s[g][0][0];
#pragma unroll
                for (int i = 0; i < 16; ++i) { mx = fmaxf(mx, s[g][0][i]); mx = fmaxf(mx, s[g][1][i]); }
                mx = fmaxf(mx, __shfl_xor(mx, 32));
                const float mnew = mx > m_run[g] + 8.f ? mx : m_run[g], alpha = __builtin_amdgcn_exp2f(m_run[g] - mnew);
                const bool resc = __builtin_amdgcn_ballot_w64(mnew != m_run[g]) != 0ull;
                m_run[g] = mnew;
                float ps = 0.f;
#pragma unroll
                for (int i = 0; i < 16; ++i) { s[g][0][i] = __builtin_amdgcn_exp2f(s[g][0][i] - mnew); s[g][1][i] = __builtin_amdgcn_exp2f(s[g][1][i] - mnew); ps += s[g][0][i] + s[g][1][i]; }
                l_run[g] = l_run[g] * alpha + ps;
                if (resc) {
#pragma unroll
                    for (int i = 0; i < 16; ++i) { o[g][0][i] *= alpha; o[g][1][i] *= alpha; } }
                pf[g][0] = pack8(s[g][0], 0); pf[g][1] = pack8(s[g][0], 8); pf[g][2] = pack8(s[g][1], 0); pf[g][3] = pack8(s[g][1], 8);
                __builtin_amdgcn_sched_barrier(0);
            }
            __builtin_amdgcn_s_setprio(1);
#define A64_VF(idx, lo_, hi_) const LAS u32x2* pa_##lo_ = (const LAS u32x2*)(vtb + (32 * ((idx) >> 2) + r) * 136 + (16 * ((idx) & 3) + 4 * h) * 2); u32x2 lo_ = pa_##lo_[0], hi_ = pa_##lo_[2]
            { A64_VF(0, lo, hi);
#pragma unroll
              for (int idx = 0; idx < 8; ++idx) {
                  u32x2 nlo = lo, nhi = hi;
                  if (idx < 7) { const LAS u32x2* pn = (const LAS u32x2*)(vtb + (32 * ((idx + 1) >> 2) + r) * 136 + (16 * ((idx + 1) & 3) + 4 * h) * 2); nlo = pn[0]; nhi = pn[2]; }
                  __builtin_amdgcn_sched_barrier(0);
                  u32x4 av; av[0] = lo[0]; av[1] = lo[1]; av[2] = hi[0]; av[3] = hi[1]; const bf16x8 avb = __builtin_bit_cast(bf16x8, av);
                  o[0][idx >> 2] = mfma32(avb, pf[0][idx & 3], o[0][idx >> 2]); o[1][idx >> 2] = mfma32(avb, pf[1][idx & 3], o[1][idx >> 2]);
                  __builtin_amdgcn_sched_barrier(0);
                  lo = nlo; hi = nhi; } }
#undef A64_VF
            __builtin_amdgcn_s_setprio(0);
        }
        if (more) A64_LSTORE((it + 1) & 1);
        __syncthreads();
    }
#undef A64_GLOAD
#undef A64_LSTORE
}
DI void phase_attn_p(const Params& p, LAS unsigned char* lds) {
    const int tid = tid_(), lane = tid & 63, wid = __builtin_amdgcn_readfirstlane(tid >> 6), r = lane & 31, h = lane >> 5;
    const bf16_t* Q = (const bf16_t*)(p.ws + OFF_Q); const bf16_t* KN = (const bf16_t*)(p.ws + OFF_KN); const bf16_t* VT = (const bf16_t*)(p.ws + OFF_VT);
    const bf16_t* KRO = (const bf16_t*)(p.ws + OFF_KROPE); bf16_t* O = (bf16_t*)(p.ws + OFF_O);
    for (int pair = bid_(); pair < 256; pair += gridDim.x) {
        const int bh = (pair & 7) * 4 + (pair >> 6), qa = (pair >> 3) & 7, b = bh >> 3, hd = bh & 7;
        for (int sub = 0; sub < 2; ++sub) {
            const int qb = sub ? qa : 15 - qa;
            const int t0 = qb * 512 + wid * 64 + r;
            f32x16 o[2][2]; float m_run[2], l_run[2];
            attn_core64(lds, Q + ((size_t)bh * 8192 + t0) * 96, KN + (size_t)bh * 8192 * 64, KRO + (size_t)b * 8192 * 32, VT + (size_t)bh * 64 * 8192, 8192,
                        8 * qb + 8, 8 * qb + wid + 1, o, m_run, l_run);
#pragma unroll
            for (int g = 0; g < 2; ++g) {
                const float inv = 1.f / (l_run[g] + __shfl_xor(l_run[g], 32));
                bf16_t* orow = O + ((size_t)b * 8192 + t0 + g * 32) * 512 + hd * 64;
#pragma unroll
                for (int dh = 0; dh < 2; ++dh)
#pragma unroll
                    for (int q4 = 0; q4 < 4; ++q4) { uint2 w; w.x = pack2(o[g][dh][4 * q4] * inv, o[g][dh][4 * q4 + 1] * inv); w.y = pack2(o[g][dh][4 * q4 + 2] * inv, o[g][dh][4 * q4 + 3] * inv); *(uint2*)(orow + 32 * dh + 8 * q4 + 4 * h) = w; }
            }
        }
    }
}
DI void phase_attn_s(const Params& p, LAS unsigned char* lds) {
    const int tid = tid_(), lane = tid & 63, wid = __builtin_amdgcn_readfirstlane(tid >> 6), r = lane & 31, h = lane >> 5;
    const bf16_t* Q = (const bf16_t*)(p.ws + OFF_Q); const bf16_t* KN = (const bf16_t*)(p.ws + OFF_KN); const bf16_t* VT = (const bf16_t*)(p.ws + OFF_VT);
    const bf16_t* KRO = (const bf16_t*)(p.ws + OFF_KROPE); float* PART = (float*)(p.ws + OFF_PART);
    for (int c = bid_(); c < 256; c += gridDim.x) {
        const int b = c >> 3, hg = (c >> 2) & 1, split = c & 3, hh = wid >> 1, head = hg * 4 + hh, t = (wid & 1) * 32 + r;
        f32x16 o[2]; float m_run, l_run;
        attn_core<4>(lds, Q + (size_t)MP * 768 + ((size_t)(b * 8 + head) * 64 + t) * 96, KN + (size_t)MP * 512 + (size_t)(b * 8 + hg * 4) * KEYS_S * 64, (size_t)KEYS_S * 64,
                     KRO + (size_t)MP * 32 + (size_t)b * KEYS_S * 32, VT + (size_t)MP * 512 + (size_t)(b * 8 + hg * 4) * 64 * KEYS_S, (size_t)64 * KEYS_S, KEYS_S,
                     split, 4, 17, split == 0 ? 17 : 16, 65, hh, o, m_run, l_run);
        const float lt = l_run + __shfl_xor(l_run, 32);
        float* pr = PART + (((size_t)(b * 8 + head) * 4 + split) * 64 + t) * 66;
#pragma unroll
        for (int dh = 0; dh < 2; ++dh)
#pragma unroll
            for (int g = 0; g < 4; ++g) { float2 a, bb; a.x = o[dh][4 * g]; a.y = o[dh][4 * g + 1]; bb.x = o[dh][4 * g + 2]; bb.y = o[dh][4 * g + 3]; float* d = pr + 32 * dh + 8 * g + 4 * h; *(float2*)d = a; *(float2*)(d + 2) = bb; }
        if (h == 0) { float2 ml; ml.x = m_run; ml.y = lt; *(float2*)(pr + 64) = ml; }
    }
}

constexpr int R_QF = 0, R_KF = 16384, R_G = 32768, R_VTI = 49152, R_KTI = 58368, R_QTI = 67584, R_STI = 76800, R_PPI = 86016, R_QHI = 95232, R_KHI = 102144,
              R_GA = 115968, R_WA = 120064, R_SEG = 122240, R_OF = 0, R_WALL = 124288, R_BA = 132480, R_LB = 132992, R_QD = 134016, R_KD = 143232;
struct RecPre { u32x4 uv, ua, uq, ug, gz; f32x4 s0, s1; };
DI uint4 to_u4(u32x4 v) { uint4 r; r.x = v[0]; r.y = v[1]; r.z = v[2]; r.w = v[3]; return r; }
DI float4 to_f4(f32x4 v) { float4 r; r.x = v[0]; r.y = v[1]; r.z = v[2]; r.w = v[3]; return r; }
DI void rec_tables(const Params& p, int l, LAS unsigned char* lds) {
    const int tid = tid_();
    LAS float* WALL = (LAS float*)(lds + R_WALL); LAS float* BA = (LAS float*)(lds + R_BA); LAS float* LB = (LAS float*)(lds + R_LB);
#pragma unroll
    for (int i = 0; i < 4; ++i) WALL[tid + 512 * i] = p.in[23][l * 2048 + tid + 512 * i];
    if (tid < 128) BA[tid] = p.in[24][l * 128 + tid];
    if (tid < 256) { float lb = 0.f; if (l == 1) { const float l0 = p.in[21][tid], l1 = p.in[21][256 + tid]; lb = 1.f / (1.f + expf(l0 - l1)); } LB[tid] = lb; }
    __syncthreads();
}
template <int DK, bool HG>
DI void rec_issue(const Params& p, int cid, int hd, bool passC, RecPre& r) {
    const int tid = tid_();
    const bf16_t* Z = (const bf16_t*)(p.ws + OFF_Z);
    const size_t row0 = (size_t)cid * 64;
    const int lj = tid >> 3, ls8 = (tid & 7) * 8;
    const bf16_t* zr = Z + (row0 + lj) * ZLD;
    r.uv = *(const u32x4*)(zr + (HG ? 1056 : 1824) + hd * 64 + ls8);
    if (HG) { r.ua = *(const u32x4*)(zr + 800 + hd * 64 + ls8); if (passC) r.uq = *(const u32x4*)(zr + 544 + hd * 64 + ls8); }
    else { if (tid < 256) { const bf16_t* z2 = Z + (row0 + (tid >> 2)) * ZLD; r.ua = *(const u32x4*)(z2 + 1696 + hd * 32 + (tid & 3) * 8); if (passC) r.uq = *(const u32x4*)(z2 + 1568 + hd * 32 + (tid & 3) * 8); }
           if (tid < 128) r.ug = *(const u32x4*)(Z + (row0 + (tid >> 1)) * ZLD + 2336 + (tid & 1) * 8); }
    if (passC) {
        const float* S = (const float*)(p.ws + (HG ? OFF_UHG : OFF_UGL)) + ((size_t)cid * 4 + hd) * DK * 64;
            if (tid < DK * 8) { const int k = tid >> 3, v0 = (tid & 7) * 8; r.s0 = *(const f32x4*)(S + k * 64 + v0); r.s1 = *(const f32x4*)(S + k * 64 + v0 + 4); }
        r.gz = *(const u32x4*)(zr + (HG ? 1312 : 2080) + hd * 64 + ls8);
    }
}
template <int DK, bool HG>
DI void rec_load(const RecPre& pre, LAS unsigned char* lds, int hd, bool need_q) {
    const int tid = tid_();
    LAS float* QF = (LAS float*)(lds + R_QF); LAS float* KF = (LAS float*)(lds + R_KF); LAS float* G = (LAS float*)(lds + R_G);
    LAS bf16_t* VTI = (LAS bf16_t*)(lds + R_VTI); LAS float* GA = (LAS float*)(lds + R_GA); LAS float* SEG = (LAS float*)(lds + R_SEG);
    const LAS float* WA = (const LAS float*)(lds + (HG ? R_LB : R_WALL)) + (HG ? hd * 64 : hd * 32);
    const LAS float* BA = (const LAS float*)(lds + R_BA) + hd * 32;
    const int lj = tid >> 3, ls8 = (tid & 7) * 8;
    const uint4 uv = to_u4(pre.uv), ua = to_u4(pre.ua), uq = to_u4(pre.uq);
    if (!HG) {
        if (tid < 128) { const int j = tid >> 1, hf = tid & 1; const uint4 u = to_u4(pre.ug); LAS float* ga = GA + j * 16 + hf * 8;
            ga[0] = bflo(u.x); ga[1] = bfhi(u.x); ga[2] = bflo(u.y); ga[3] = bfhi(u.y); ga[4] = bflo(u.z); ga[5] = bfhi(u.z); ga[6] = bflo(u.w); ga[7] = bfhi(u.w); }
        __syncthreads();
    }
    { const float va[8] = {bflo(ua.x), bfhi(ua.x), bflo(ua.y), bfhi(ua.y), bflo(ua.z), bfhi(ua.z), bflo(ua.w), bfhi(ua.w)};
      const float vq[8] = {bflo(uq.x), bfhi(uq.x), bflo(uq.y), bfhi(uq.y), bflo(uq.z), bfhi(uq.z), bflo(uq.w), bfhi(uq.w)};
      if (HG) { float gg[8], kk[8];
#pragma unroll
          for (int x = 0; x < 8; ++x) { const float lb = WA[ls8 + x], e = __expf(fminf(-va[x], 80.f)), s = 1.f / (1.f + e); gg[x] = logf(lb + (1.f - lb) * s); kk[x] = (1.f - lb) * e * s; }
          LAS f32x4* gp = (LAS f32x4*)(G + lj * 64 + ls8); LAS f32x4* kp = (LAS f32x4*)(KF + lj * 64 + ls8);
          gp[0] = (f32x4){gg[0], gg[1], gg[2], gg[3]}; gp[1] = (f32x4){gg[4], gg[5], gg[6], gg[7]}; kp[0] = (f32x4){kk[0], kk[1], kk[2], kk[3]}; kp[1] = (f32x4){kk[4], kk[5], kk[6], kk[7]};
          if (need_q) { LAS f32x4* qp = (LAS f32x4*)(QF + lj * 64 + ls8); qp[0] = (f32x4){vq[0], vq[1], vq[2], vq[3]}; qp[1] = (f32x4){vq[4], vq[5], vq[6], vq[7]}; } }
      else {
          { const int kq = (tid & 7) * 4; f32x4 x = *(const LAS f32x4*)(BA + kq);
#pragma unroll
            for (int r = 0; r < 16; ++r) { const float ga = GA[lj * 16 + r]; const f32x4 wv = *(const LAS f32x4*)(WA + r * 128 + kq); x += ga * wv; }
            f32x4 o;
#pragma unroll
            for (int y = 0; y < 4; ++y) o[y] = (fminf(x[y], 0.f) - log1pf(__expf(-fabsf(x[y])))) * (1.f / 16.f);
            *(LAS f32x4*)(G + lj * 32 + kq) = o; }
          if (tid < 256) { const int j2 = tid >> 2, k2 = (tid & 3) * 8; LAS f32x4* kp = (LAS f32x4*)(KF + j2 * 32 + k2); kp[0] = (f32x4){va[0], va[1], va[2], va[3]}; kp[1] = (f32x4){va[4], va[5], va[6], va[7]};
              if (need_q) { const float qs = 0.17677669529663687f; LAS f32x4* qp = (LAS f32x4*)(QF + j2 * 32 + k2); qp[0] = (f32x4){vq[0] * qs, vq[1] * qs, vq[2] * qs, vq[3] * qs}; qp[1] = (f32x4){vq[4] * qs, vq[5] * qs, vq[6] * qs, vq[7] * qs}; } } }
      const unsigned vv[4] = {uv.x, uv.y, uv.z, uv.w};
#pragma unroll
      for (int x = 0; x < 4; ++x) { VTI[(ls8 + 2 * x) * 72 + lj] = (bf16_t)(vv[x] & 0xFFFFu); VTI[(ls8 + 2 * x + 1) * 72 + lj] = (bf16_t)(vv[x] >> 16); } }
    __syncthreads();
    constexpr int NSEG = NT / DK, JS = 64 / NSEG;
    const int seg = tid / DK, k = tid % DK;
    float loc[JS]; float s = 0.f;
#pragma unroll
    for (int jj = 0; jj < JS; ++jj) { s += G[(seg * JS + jj) * DK + k]; loc[jj] = s; }
    SEG[seg * DK + k] = s;
    __syncthreads();
    float off = 0.f;
#pragma unroll
    for (int s2 = 0; s2 < NSEG; ++s2) { const float t = SEG[s2 * DK + k]; off += s2 < seg ? t : 0.f; }
#pragma unroll
    for (int jj = 0; jj < JS; ++jj) G[(seg * JS + jj) * DK + k] = loc[jj] + off;
    __syncthreads();
}
template <int DK, bool HG>
DI void rec_passA_item(const Params& p, int l, LAS unsigned char* lds, int cid, int hd, const RecPre& pre) {
    const int tid = tid_(), lane = tid & 63, wid = __builtin_amdgcn_readfirstlane(tid >> 6), fr = lane & 15, fq = lane >> 4;
    rec_load<DK, HG>(pre, lds, hd, false);
    LAS float* KF = (LAS float*)(lds + R_KF); LAS float* G = (LAS float*)(lds + R_G);
    LAS bf16_t* VTI = (LAS bf16_t*)(lds + R_VTI); LAS bf16_t* KTI = (LAS bf16_t*)(lds + R_KTI);
    float* U = (float*)(p.ws + (HG ? OFF_UHG : OFF_UGL)); float* D = (float*)(p.ws + (HG ? OFF_DHG : OFF_DGL));
    for (int e = tid; e < 64 * DK; e += NT) { const int j = e / DK, k = e % DK; KTI[k * 72 + j] = f2bf(KF[e] * __expf(G[63 * DK + k] - G[e])); }
    if (tid < DK) D[((size_t)cid * 4 + hd) * DK + tid] = __expf(G[63 * DK + tid]);
    __syncthreads();
    for (int tile = wid; tile < (DK / 16) * 4; tile += 8) {
        const int tk = tile >> 2, tv = tile & 3; f32x4 acc = {0.f, 0.f, 0.f, 0.f};
#pragma unroll
        for (int s = 0; s < 2; ++s) { const bf16x8 a = *(const LAS bf16x8*)(KTI + (16 * tk + fr) * 72 + 32 * s + 8 * fq), b = *(const LAS bf16x8*)(VTI + (16 * tv + fr) * 72 + 32 * s + 8 * fq); acc = mfma16(a, b, acc); }
#pragma unroll
        for (int reg = 0; reg < 4; ++reg) U[(((size_t)cid * 4 + hd) * DK + 16 * tk + 4 * fq + reg) * 64 + 16 * tv + fr] = acc[reg];
    }
    __syncthreads();
}
template <int DK, bool HG>
DI void rec_passC_item(const Params& p, int l, LAS unsigned char* lds, int cid, int hd, const RecPre& pre) {
    const int tid = tid_(), lane = tid & 63, wid = __builtin_amdgcn_readfirstlane(tid >> 6), fr = lane & 15, fq = lane >> 4;
    rec_load<DK, HG>(pre, lds, hd, true);
    LAS float* QF = (LAS float*)(lds + R_QF); LAS float* KF = (LAS float*)(lds + R_KF); LAS float* G = (LAS float*)(lds + R_G); LAS float* OF = (LAS float*)(lds + R_OF);
    LAS bf16_t* VTI = (LAS bf16_t*)(lds + R_VTI); LAS bf16_t* QTI = (LAS bf16_t*)(lds + R_QTI); LAS bf16_t* STI = (LAS bf16_t*)(lds + R_STI);
    LAS bf16_t* PPI = (LAS bf16_t*)(lds + R_PPI); LAS bf16_t* QHI = (LAS bf16_t*)(lds + R_QHI); LAS bf16_t* KHI = (LAS bf16_t*)(lds + R_KHI);
    const bf16_t* Z = (const bf16_t*)(p.ws + OFF_Z); bf16_t* H = (bf16_t*)(p.ws + OFF_H);
    for (int e = tid; e < 64 * DK; e += NT) { const int i = e / DK, k = e % DK; QTI[i * 72 + k] = f2bf(QF[e] * __expf(G[e])); }
    if (tid < DK * 8) { const int k = tid >> 3, v0 = (tid & 7) * 8; const float4 s0 = to_f4(pre.s0), s1 = to_f4(pre.s1);
        STI[(v0 + 0) * 72 + k] = f2bf(s0.x); STI[(v0 + 1) * 72 + k] = f2bf(s0.y); STI[(v0 + 2) * 72 + k] = f2bf(s0.z); STI[(v0 + 3) * 72 + k] = f2bf(s0.w);
        STI[(v0 + 4) * 72 + k] = f2bf(s1.x); STI[(v0 + 5) * 72 + k] = f2bf(s1.y); STI[(v0 + 6) * 72 + k] = f2bf(s1.z); STI[(v0 + 7) * 72 + k] = f2bf(s1.w); }
    for (int e = tid; e < 48 * DK; e += NT) { const int ii = e / DK, k = e % DK, I = 1 + (ii >> 4), i = 16 + ii; const float ref = G[(16 * I - 1) * DK + k];
        QHI[ii * 72 + k] = f2bf(QF[i * DK + k] * __expf(G[i * DK + k] - ref)); }
    for (int e = tid; e < 96 * DK; e += NT) { const int rr = e / DK, k = e % DK, I = rr < 16 ? 1 : (rr < 48 ? 2 : 3), j = rr - 8 * I * (I - 1); const float ref = G[(16 * I - 1) * DK + k];
        KHI[rr * 72 + k] = f2bf(KF[j * DK + k] * __expf(ref - G[j * DK + k])); }
    { LAS bf16_t* QD = (LAS bf16_t*)(lds + R_QD); LAS bf16_t* KD = (LAS bf16_t*)(lds + R_KD);
      for (int e = tid; e < 64 * DK; e += NT) { const int i = e / DK, k = e % DK; const float ref = G[(16 * (i >> 4) + 7) * DK + k], gi = G[e];
          QD[i * 72 + k] = f2bf(QF[e] * __expf(fminf(fmaxf(gi - ref, -80.f), 80.f))); KD[i * 72 + k] = f2bf(KF[e] * __expf(fminf(fmaxf(ref - gi, -80.f), 80.f))); } }
    for (int e = tid; e < 1536; e += NT) { const int bidx = e >> 8, w = e & 255; const int I = bidx < 3 ? 0 : (bidx < 5 ? 1 : 2), J = bidx < 3 ? bidx + 1 : (bidx < 5 ? bidx - 1 : 3);
        PPI[(16 * I + (w >> 4)) * 72 + 16 * J + (w & 15)] = 0; }
    __syncthreads();
    if (wid >= 6) { const LAS bf16_t* QD = (const LAS bf16_t*)(lds + R_QD); const LAS bf16_t* KD = (const LAS bf16_t*)(lds + R_KD);
#pragma unroll
        for (int t2 = 0; t2 < 2; ++t2) { const int I = (wid - 6) * 2 + t2; f32x4 acc = {0.f, 0.f, 0.f, 0.f};
#pragma unroll
            for (int s = 0; s < DK / 32; ++s) { const bf16x8 a = *(const LAS bf16x8*)(QD + (16 * I + fr) * 72 + 32 * s + 8 * fq), b = *(const LAS bf16x8*)(KD + (16 * I + fr) * 72 + 32 * s + 8 * fq); acc = mfma16(a, b, acc); }
#pragma unroll
            for (int reg = 0; reg < 4; ++reg) PPI[(16 * I + 4 * fq + reg) * 72 + 16 * I + fr] = f2bf(fr <= 4 * fq + reg ? acc[reg] : 0.f); } }
    if (wid < 6) { const int I = wid < 1 ? 1 : (wid < 3 ? 2 : 3), J = wid < 1 ? 0 : (wid < 3 ? wid - 1 : wid - 3); f32x4 acc = {0.f, 0.f, 0.f, 0.f};
#pragma unroll
        for (int s = 0; s < DK / 32; ++s) { const bf16x8 a = *(const LAS bf16x8*)(QHI + ((I - 1) * 16 + fr) * 72 + 32 * s + 8 * fq), b = *(const LAS bf16x8*)(KHI + (8 * I * (I - 1) + 16 * J + fr) * 72 + 32 * s + 8 * fq); acc = mfma16(a, b, acc); }
#pragma unroll
        for (int reg = 0; reg < 4; ++reg) PPI[(16 * I + 4 * fq + reg) * 72 + 16 * J + fr] = f2bf(acc[reg]); }
    __syncthreads();
#pragma unroll
    for (int tt = 0; tt < 2; ++tt) { const int tile = wid * 2 + tt, ti = tile >> 2, tv = tile & 3; f32x4 acc = {0.f, 0.f, 0.f, 0.f};
#pragma unroll
        for (int s = 0; s < DK / 32; ++s) { const bf16x8 a = *(const LAS bf16x8*)(QTI + (16 * ti + fr) * 72 + 32 * s + 8 * fq), b = *(const LAS bf16x8*)(STI + (16 * tv + fr) * 72 + 32 * s + 8 * fq); acc = mfma16(a, b, acc); }
#pragma unroll
        for (int s = 0; s < 2; ++s) { const bf16x8 a = *(const LAS bf16x8*)(PPI + (16 * ti + fr) * 72 + 32 * s + 8 * fq), b = *(const LAS bf16x8*)(VTI + (16 * tv + fr) * 72 + 32 * s + 8 * fq); acc = mfma16(a, b, acc); }
#pragma unroll
        for (int reg = 0; reg < 4; ++reg) OF[(16 * ti + 4 * fq + reg) * 65 + 16 * tv + fr] = acc[reg]; }
    __syncthreads();
    { const int i = tid >> 3, part = tid & 7; float v[8]; float ss = 0.f;
#pragma unroll
      for (int x = 0; x < 8; ++x) { v[x] = OF[i * 65 + part * 8 + x]; ss += v[x] * v[x]; }
      ss += __shfl_xor(ss, 1); ss += __shfl_xor(ss, 2); ss += __shfl_xor(ss, 4);
      const float rs = rsqrtf(ss * (1.f / 64.f) + EPS);
      const size_t row = (size_t)cid * 64 + i;
      const uint4 gz = to_u4(pre.gz);
      const float* go = p.in[HG ? 22 : 25] + l * 64 + part * 8;
      const float gt[8] = {bflo(gz.x), bfhi(gz.x), bflo(gz.y), bfhi(gz.y), bflo(gz.z), bfhi(gz.z), bflo(gz.w), bfhi(gz.w)};
      float r[8];
#pragma unroll
      for (int x = 0; x < 8; ++x) r[x] = v[x] * rs * go[x] * (gt[x] / (1.f + __expf(-gt[x])));
      uint4 w; w.x = pack2(r[0], r[1]); w.y = pack2(r[2], r[3]); w.z = pack2(r[4], r[5]); w.w = pack2(r[6], r[7]);
      *(uint4*)(H + row * 1024 + 512 + (HG ? 0 : 256) + hd * 64 + part * 8) = w; }
    __syncthreads();
}
template <int DK>
DI void scan_prompt(float* U, const float* D, float* outp, int e) {
    const int v = e & 63, k = (e >> 6) % DK, hd = (e / (64 * DK)) & 3, b = e / (256 * DK);
    float S = 0.f;
    for (int n0 = 0; n0 < 128; n0 += 16) {
        float u[16], d[16];
#pragma unroll
        for (int i = 0; i < 16; ++i) { const size_t ch = ((size_t)(b * 128 + n0 + i) * 4 + hd); u[i] = U[(ch * DK + k) * 64 + v]; d[i] = D[ch * DK + k]; }
#pragma unroll
        for (int i = 0; i < 16; ++i) { const size_t ch = ((size_t)(b * 128 + n0 + i) * 4 + hd); U[(ch * DK + k) * 64 + v] = S; S = d[i] * S + u[i]; }
    }
    outp[e] = S;
}
template <int DK>
DI void scan_sample(float* U, const float* D, const float* s0p, float* outp, int e) {
    const int v = e & 63, k = (e >> 6) % DK, hd = (e / (64 * DK)) & 3, b = e / (256 * DK);
    const size_t ch = (size_t)(512 + b) * 4 + hd; const size_t idx = (ch * DK + k) * 64 + v;
    const float s0 = s0p[e], u = U[idx], d = D[ch * DK + k];
    U[idx] = s0; outp[e] = d * s0 + u;
}
DI void phase_scan(const Params& p, int l) {
    const int g = bid_() * NT + tid_(), gs = gridDim.x * NT;
    float* UH = (float*)(p.ws + OFF_UHG); const float* DH = (const float*)(p.ws + OFF_DHG); float* UG = (float*)(p.ws + OFF_UGL); const float* DG = (const float*)(p.ws + OFF_DGL);
    for (int e = g; e < 98304; e += gs) {
        if (e < 65536) scan_prompt<64>(UH, DH, p.out + OUT_HGP + (size_t)l * 65536, e);
        else scan_prompt<32>(UG, DG, p.out + OUT_GLP + (size_t)l * 32768, e - 65536);
    }
    for (int e = g; e < 786432; e += gs) {
        if (e < 524288) scan_sample<64>(UH, DH, p.in[6] + (size_t)l * 524288, p.out + OUT_HGS + (size_t)l * 524288, e);
        else scan_sample<32>(UG, DG, p.in[7] + (size_t)l * 262144, p.out + OUT_GLS + (size_t)l * 262144, e - 524288);
    }
}
DI void phase_mlaout(const Params& p, int l) {
    const int tid = tid_(), lane = tid & 63, wid = __builtin_amdgcn_readfirstlane(tid >> 6);
    const bf16_t* O = (const bf16_t*)(p.ws + OFF_O); const float* PART = (const float*)(p.ws + OFF_PART); bf16_t* H = (bf16_t*)(p.ws + OFF_H);
    const float* g = p.in[20] + l * 512 + 8 * lane;
    for (int row = bid_() * 8 + wid; row < MT; row += gridDim.x * 8) {
        float v[8];
        if (row < MP) { const uint4 u = *(const uint4*)(O + (size_t)row * 512 + 8 * lane);
            v[0] = bflo(u.x); v[1] = bfhi(u.x); v[2] = bflo(u.y); v[3] = bfhi(u.y); v[4] = bflo(u.z); v[5] = bfhi(u.z); v[6] = bflo(u.w); v[7] = bfhi(u.w); }
        else { const int r = row - MP, b = r >> 6, t = r & 63, head = lane >> 3, dv0 = (lane & 7) * 8;
            const float* pb = PART + (((size_t)(b * 8 + head) * 4) * 64 + t) * 66;
            float m[4], lsum[4]; float M = neg_big();
#pragma unroll
            for (int s = 0; s < 4; ++s) { m[s] = pb[(size_t)s * 64 * 66 + 64]; lsum[s] = pb[(size_t)s * 64 * 66 + 65]; M = fmaxf(M, m[s]); }
            float L = 0.f;
#pragma unroll
            for (int x = 0; x < 8; ++x) v[x] = 0.f;
#pragma unroll
            for (int s = 0; s < 4; ++s) { const float w = exp2f(m[s] - M); L += w * lsum[s];
#pragma unroll
                for (int x = 0; x < 8; ++x) v[x] += w * pb[(size_t)s * 64 * 66 + dv0 + x]; }
            const float inv = 1.f / L;
#pragma unroll
            for (int x = 0; x < 8; ++x) v[x] *= inv; }
        float ss = 0.f;
#pragma unroll
        for (int x = 0; x < 8; ++x) ss += v[x] * v[x];
        ss = wave_sum(ss);
        const float rs = rsqrtf(ss * (1.f / 512.f) + EPS);
        uint4 w; w.x = pack2(v[0] * rs * g[0], v[1] * rs * g[1]); w.y = pack2(v[2] * rs * g[2], v[3] * rs * g[3]); w.z = pack2(v[4] * rs * g[4], v[5] * rs * g[5]); w.w = pack2(v[6] * rs * g[6], v[7] * rs * g[7]);
        *(uint4*)(H + (size_t)row * 1024 + 8 * lane) = w;
    }
}

DI void gsync(const Params& p, LAS unsigned char* lds) { XcdBarrier b; b.bar = (unsigned*)(p.ws + OFF_BAR); b.x = xb_xcc_id(); b.st = (volatile LAS unsigned*)(lds + LDS_BYTES - 16); xcd_barrier(b); }
__global__ void __launch_bounds__(512, 2) mk_fwd(Params p) {
    extern __shared__ __attribute__((aligned(16))) unsigned char shm[];
    LAS unsigned char* lds = (LAS unsigned char*)shm;
    cg::grid_group grid = cg::this_grid();
    bf16_t* H = (bf16_t*)(p.ws + OFF_H); bf16_t* Z = (bf16_t*)(p.ws + OFF_Z); bf16_t* CQN = (bf16_t*)(p.ws + OFF_CQN); bf16_t* CKV = (bf16_t*)(p.ws + OFF_CKV);
    bf16_t* Q = (bf16_t*)(p.ws + OFF_Q); bf16_t* KN = (bf16_t*)(p.ws + OFF_KN); bf16_t* VT = (bf16_t*)(p.ws + OFF_VT); bf16_t* ACT = (bf16_t*)(p.ws + OFF_ACT);
    const float* rope = (const float*)(p.ws + OFF_ROPE); bf16_t* XB = (bf16_t*)(p.ws + OFF_XB);
    volatile LAS unsigned* xst = (volatile LAS unsigned*)(lds + LDS_BYTES - 16);
    if (threadIdx.x == 0) { xst[0] = 0u; xst[1] = 0u; }
    __syncthreads();
    (void)xcd_barrier_post((unsigned*)(p.ws + OFF_BAR), xst);
    phase_prep(p, lds);
    grid.sync();
#pragma unroll 1
    for (int l = 0; l < 2; ++l) {
        const unsigned char* W = p.ws + OFF_W + (size_t)l * WL;
        const float* modl = (const float*)(p.ws + OFF_MOD) + (size_t)l * 36 * 6144;
        if (l == 0) phase_hrows<true>(p, l, p.in[0], p.in[1], p.in[10] + l * 1024, 0, 1024); else phase_hrows<false>(p, l, nullptr, nullptr, p.in[10] + l * 1024, 0, 1024);
        gsync(p, lds);
        run_gemm(lds, H, (const bf16_t*)(W + WOFF_IN), MT, 2560, 1024, EpiZ{Z, ZLD});
        {
          const int G = (int)gridDim.x, rem = ((MT / 256) * (2560 / 256)) % G;
          if (rem > 0 && G - rem >= G / 2) { if ((int)bid_() >= rem) phase_cache(p, l, rem, G - rem); } else phase_cache(p, l, 0, G); }
        gsync(p, lds);
        phase_post(p, l);
        rec_tables(p, l, lds);
        { RecPre pre = {}; int it = bid_(); if (it < 2176) rec_issue<64, true>(p, it >> 2, it & 3, false, pre);
          for (; it < 2176; it += gridDim.x) { const RecPre cur = pre; const int nx = it + gridDim.x; if (nx < 2176) rec_issue<64, true>(p, nx >> 2, nx & 3, false, pre); rec_passA_item<64, true>(p, l, lds, it >> 2, it & 3, cur); } }
        { RecPre pre = {}; int it = (int)((bid_() + gridDim.x / 2) % gridDim.x); if (it < 2176) rec_issue<32, false>(p, it >> 2, it & 3, false, pre);
          for (; it < 2176; it += gridDim.x) { const RecPre cur = pre; const int nx = it + gridDim.x; if (nx < 2176) rec_issue<32, false>(p, nx >> 2, nx & 3, false, pre); rec_passA_item<32, false>(p, l, lds, it >> 2, it & 3, cur); } }
        gsync(p, lds);
        run_gemm(lds, CQN, (const bf16_t*)(W + WOFF_UQ), MT, 768, 256, EpiQ{Q, p.in[18] + l * 96, rope});
        run_gemm(lds, CKV, (const bf16_t*)(W + WOFF_UK), KR_ROWS, 512, 256, EpiKN{KN, p.in[19] + l * 96}, 104);
        run_gemm(lds, (const bf16_t*)(W + WOFF_UV), CKV, 512, KR_ROWS, 256, EpiVT{VT}, 40);
        phase_scan(p, l);
        gsync(p, lds);
        phase_attn_p(p, lds);
        phase_attn_s(p, lds);
        rec_tables(p, l, lds);
        { RecPre pre = {}; int it = bid_(); if (it < 2176) rec_issue<64, true>(p, it >> 2, it & 3, true, pre);
          for (; it < 2176; it += gridDim.x) { const RecPre cur = pre; const int nx = it + gridDim.x; if (nx < 2176) rec_issue<64, true>(p, nx >> 2, nx & 3, true, pre); rec_passC_item<64, true>(p, l, lds, it >> 2, it & 3, cur); } }
        { RecPre pre = {}; int it = (int)((bid_() + gridDim.x / 2) % gridDim.x); if (it < 2176) rec_issue<32, false>(p, it >> 2, it & 3, true, pre);
          for (; it < 2176; it += gridDim.x) { const RecPre cur = pre; const int nx = it + gridDim.x; if (nx < 2176) rec_issue<32, false>(p, nx >> 2, nx & 3, true, pre); rec_passC_item<32, false>(p, l, lds, it >> 2, it & 3, cur); } }
        gsync(p, lds);
        phase_mlaout(p, l);
        gsync(p, lds);
        run_gemm(lds, H, (const bf16_t*)(W + WOFF_O), MT, 1024, 1024, EpiRes{XB, p.out, modl + 2048, 0});
        gsync(p, lds);
        phase_hrows<false>(p, l, nullptr, nullptr, p.in[11] + l * 1024, 3072, 4096);
        gsync(p, lds);
        run_gemm(lds, H, (const bf16_t*)(W + WOFF_FI), MT, 5632, 1024, EpiSwi{ACT});
        gsync(p, lds);
        run_gemm(lds, ACT, (const bf16_t*)(W + WOFF_FO), MT, 1024, 2816, EpiRes{XB, p.out, modl + 5120, l});
        if (l == 0) gsync(p, lds);
    }
}

extern "C" void kernel_launch(void* const* d_in, const int* in_sizes, int n_in, void* d_out, int out_size, void* d_ws, size_t ws_size, hipStream_t stream) {
    static int grid = 0;
    if (grid == 0) {
        int dev = 0, cus = 0, per_cu = 0;
        hipGetDevice(&dev);
        hipDeviceGetAttribute(&cus, hipDeviceAttributeMultiprocessorCount, dev);
        hipFuncSetAttribute((const void*)mk_fwd, hipFuncAttributeMaxDynamicSharedMemorySize, LDS_BYTES);
        hipOccupancyMaxActiveBlocksPerMultiprocessor(&per_cu, (const void*)mk_fwd, NT, LDS_BYTES);
        if (per_cu < 1) { fprintf(stderr, "kernel_launch: occupancy query says %d blocks per CU\n", per_cu); per_cu = 1; }
        (void)hipGetLastError();
        grid = cus;
        if (ws_size < WS_END) { fprintf(stderr, "kernel_launch: workspace too small: %zu < %zu\n", ws_size, (size_t)WS_END); grid = -1; }
    }
    if (grid < 0) return;
    if (hipMemsetAsync((char*)d_ws + OFF_BAR, 0, XCD_BAR_WORDS * 4, stream) != hipSuccess) { fprintf(stderr, "kernel_launch: memset failed\n"); return; }
    Params p{};
    for (int i = 0; i < 29; ++i) p.in[i] = (const float*)d_in[i];
    p.out = (float*)d_out; p.ws = (unsigned char*)d_ws;
    void* args[] = {&p};
    hipError_t e = hipLaunchCooperativeKernel((const void*)mk_fwd, dim3(grid), dim3(NT), args, LDS_BYTES, stream);
    if (e != hipSuccess) fprintf(stderr, "cooperative launch failed: %s (grid %d)\n", hipGetErrorString(e), grid);
}
```

```cpp
#include <hip/hip_runtime.h>
#include <hip/hip_cooperative_groups.h>
#include <cstdio>
namespace cg = cooperative_groups;
namespace pg8 {
#define PG8_LAS __attribute__((address_space(3)))
typedef unsigned short bf16_t;
typedef short bf16x8 __attribute__((ext_vector_type(8)));
typedef float f32x4 __attribute__((ext_vector_type(4)));
typedef unsigned u32x4 __attribute__((ext_vector_type(4)));
constexpr int BM = 256, BK = 64, HALF = 128, HTB = HALF * BK * 2  , STAGE_BYTES = 8 * HTB, NXCD = 8, WGM = 8;

__host__ __device__ __forceinline__ int lds_byte(int r, int c) { const int st = (r >> 4) * 2 + (c >> 5), rr = r & 15, cc = c & 31, ob = rr * 64 + cc * 2; return st * 1024 + (ob ^ (((ob >> 9) & 1) << 5)); }
__host__ __device__ __forceinline__ void stage_rc(int b, int& R, int& C) { const int st = b / 1024, sb = b % 1024, swz = sb ^ (((sb >> 9) & 1) << 5); R = (st >> 1) * 16 + swz / 64; C = (st & 1) * 32 + (swz % 64) / 2; }
__host__ __device__ __forceinline__ int perm32(int rho) { const int n = rho >> 4, i = rho & 15; return 8 * (i >> 2) + 4 * n + (i & 3); }

struct Unit { int pm, pn; };
struct Gemm { const bf16_t* A; const bf16_t* Bt; int M, N, K; };

struct StaticOrder {
    int nM, nN, nwg, G, c;
    __host__ __device__ void init(int M, int N, int G_, int c_) { nM = M / BM; nN = N / BM; nwg = nM * nN; G = G_; c = c_; }
    __host__ __device__ bool next(int i, Unit& u) const {
        const long L = (long)i * G + c; if (L >= nwg) return false;
        int wgid = (int)L; { const int q = nwg / NXCD, r = nwg % NXCD, xcd = wgid % NXCD, off = wgid / NXCD; wgid = (xcd < r ? xcd * (q + 1) : r * (q + 1) + (xcd - r) * q) + off; }
        const int nig = WGM * nN, gid = wgid / nig, fm = gid * WGM, gsz = (nM - fm) < WGM ? (nM - fm) : WGM;
        u.pm = fm + ((wgid % nig) % gsz); u.pn = (wgid % nig) / gsz; return true;
    }
    __device__ __forceinline__ void a_ready(const Unit&) const {}
    __device__ __forceinline__ void done(const Unit&) const {}
};
template <class Epi, class Sched, bool STAMP = false>
__device__ __forceinline__ void gemm_phase(PG8_LAS unsigned char* lds, const Gemm g, const Sched& S, const Epi& E, unsigned long long* stamps) {
    int tid = threadIdx.x; asm volatile("" : "+v"(tid)); const int wid = __builtin_amdgcn_readfirstlane(tid >> 6), lane = tid & 63, wr = wid >> 2, wc = wid & 3, fr = lane & 15, fq = lane >> 4;
    const int K = g.K, nt = K / BK;
    int ts_lo = 0, ts_hi = 0, nts = 0; const unsigned long long rt_entry = STAMP ? (unsigned long long)wall_clock64() : 0ull;
#define PG8_STAMP() do { if (STAMP && wid == 0 && nts < 64) { const unsigned long long _c = (unsigned long long)clock64(); \
        ts_lo = (lane == nts) ? (int)(unsigned)_c : ts_lo; ts_hi = (lane == nts) ? (int)(unsigned)(_c >> 32) : ts_hi; ++nts; } } while (0)
    PG8_STAMP();
    unsigned voffA[2], voffB[2];
#pragma unroll
    for (int i = 0; i < 2; ++i) { int R, C; stage_rc(tid * 16 + i * 8192, R, C); const int Rb = Epi::PERM ? ((R & ~31) + perm32(R & 31)) : R;
        voffA[i] = (unsigned)(R * K + C) * 2u; voffB[i] = (unsigned)(Rb * K + C) * 2u; }
    const size_t kstep = (size_t)(BK * 2);
    const size_t hstep = (size_t)HALF * K * 2;
    const size_t tstep = 2 * hstep;
    const unsigned ldsw = (unsigned)wid * 1024u;
    const int aoff = lds_byte(wr * 64 + fr, fq * 8), boff = lds_byte(wc * 32 + fr, fq * 8);
#define PG8_SA(b, h) (((b) * 2 + (h)) * HTB)
#define PG8_SB(b, h) ((4 + (b) * 2 + (h)) * HTB)
#define PG8_STAGE(bufoff, gbase, voff) do { _Pragma("unroll") for (int _i = 0; _i < 2; ++_i) \
        __builtin_amdgcn_global_load_lds((const unsigned*)((const char*)(gbase) + (voff)[_i]), (PG8_LAS unsigned*)(lds + (bufoff) + ldsw + _i * 8192), 16, 0, 0); } while (0)
#define PG8_LDA(dst, b, h) do { _Pragma("unroll") for (int m = 0; m < 4; ++m) _Pragma("unroll") for (int k = 0; k < 2; ++k) dst[m][k] = *(const PG8_LAS bf16x8*)(lds + PG8_SA(b, h) + aoff + m * 2048 + k * 1024); } while (0)
#define PG8_LDB(dst, b, h) do { _Pragma("unroll") for (int n = 0; n < 2; ++n) _Pragma("unroll") for (int k = 0; k < 2; ++k) dst[n][k] = *(const PG8_LAS bf16x8*)(lds + PG8_SB(b, h) + boff + n * 2048 + k * 1024); } while (0)
#define PG8_MMA(ai, bj, At, Bt) do { __builtin_amdgcn_s_setprio(1); _Pragma("unroll") for (int m = 0; m < 4; ++m) _Pragma("unroll") for (int n = 0; n < 2; ++n) _Pragma("unroll") for (int k = 0; k < 2; ++k) \
        acc[ai][bj][m][n] = __builtin_amdgcn_mfma_f32_16x16x32_bf16(Bt[n][k], At[m][k], acc[ai][bj][m][n], 0, 0, 0); __builtin_amdgcn_s_setprio(0); } while (0)
#define PG8_WAIT_V(n) asm volatile("s_waitcnt vmcnt(" #n ")" ::: "memory")
#define PG8_WAIT_L(n) asm volatile("s_waitcnt lgkmcnt(" #n ")" ::: "memory")
#define PG8_BAR __builtin_amdgcn_s_barrier()
#define PG8_SCHED __builtin_amdgcn_sched_barrier(0)
    Unit cur, nxt; int ui = 0;
    if (!S.next(0, cur)) return;
    f32x4 acc[2][2][4][2];
#pragma unroll
    for (int a = 0; a < 2; ++a)
#pragma unroll
        for (int b = 0; b < 2; ++b)
#pragma unroll
            for (int m = 0; m < 4; ++m)
#pragma unroll
                for (int n = 0; n < 2; ++n) acc[a][b][m][n] = (f32x4){0.f, 0.f, 0.f, 0.f};
    bf16x8 At[4][2], B0[2][2], B1[2][2];
    const char* cA = (const char*)g.A + (size_t)cur.pm * tstep; const char* cB = (const char*)g.Bt + (size_t)cur.pn * tstep;
    S.a_ready(cur);
    PG8_STAGE(PG8_SB(0, 0), cB, voffB); PG8_STAGE(PG8_SA(0, 0), cA, voffA); PG8_STAGE(PG8_SB(0, 1), cB + hstep, voffB); PG8_STAGE(PG8_SA(0, 1), cA + hstep, voffA);
    if (wr == 1) PG8_BAR;
    PG8_WAIT_V(4); PG8_BAR;
    PG8_STAGE(PG8_SB(1, 0), cB + kstep, voffB); PG8_STAGE(PG8_SA(1, 0), cA + kstep, voffA); PG8_STAGE(PG8_SB(1, 1), cB + hstep + kstep, voffB);
    PG8_WAIT_V(6); PG8_BAR;
    PG8_STAMP();
    for (;;) {
        const bool has_next = S.next(ui + 1, nxt);
        const char* nA = has_next ? (const char*)g.A + (size_t)nxt.pm * tstep : cA; const char* nB = has_next ? (const char*)g.Bt + (size_t)nxt.pn * tstep : cB;
        for (int t = 0; t < nt; t += 2) {
            const bool last = (t == nt - 2);
            const char* a1 = cA + (size_t)(t + 1) * kstep;
            const char* a2 = last ? nA : cA + (size_t)(t + 2) * kstep; const char* b2 = last ? nB : cB + (size_t)(t + 2) * kstep;
            const char* a3 = a2 + kstep; const char* b3 = b2 + kstep;
            if (last && has_next) S.a_ready(nxt);
            PG8_LDB(B0, 0, 0); PG8_SCHED; PG8_LDA(At, 0, 0); PG8_STAGE(PG8_SA(1, 1), a1 + hstep, voffA);
            PG8_WAIT_L(8); PG8_BAR; PG8_WAIT_L(0); PG8_MMA(0, 0, At, B0); PG8_BAR; PG8_SCHED;
            PG8_LDB(B1, 0, 1); PG8_STAGE(PG8_SB(0, 0), b2, voffB);
            PG8_BAR; PG8_WAIT_L(0); PG8_MMA(0, 1, At, B1); PG8_BAR;
            PG8_LDA(At, 0, 1); PG8_STAGE(PG8_SA(0, 0), a2, voffA);
            PG8_BAR; PG8_WAIT_L(0); PG8_MMA(1, 0, At, B0); PG8_BAR; PG8_SCHED;
            PG8_STAGE(PG8_SB(0, 1), b2 + hstep, voffB);
            PG8_WAIT_V(6); PG8_BAR; PG8_MMA(1, 1, At, B1); PG8_BAR;
            PG8_LDB(B0, 1, 0); PG8_SCHED; PG8_LDA(At, 1, 0); PG8_STAGE(PG8_SA(0, 1), a2 + hstep, voffA);
            PG8_WAIT_L(8); PG8_BAR; PG8_WAIT_L(0); PG8_MMA(0, 0, At, B0); PG8_BAR; PG8_SCHED;
            PG8_LDB(B1, 1, 1); PG8_STAGE(PG8_SB(1, 0), b3, voffB);
            PG8_BAR; PG8_WAIT_L(0); PG8_MMA(0, 1, At, B1); PG8_BAR;
            PG8_LDA(At, 1, 1); PG8_STAGE(PG8_SA(1, 0), a3, voffA);
            PG8_BAR; PG8_WAIT_L(0); PG8_MMA(1, 0, At, B0); PG8_BAR; PG8_SCHED;
            PG8_STAGE(PG8_SB(1, 1), b3 + hstep, voffB);
            PG8_WAIT_V(6); PG8_BAR; PG8_MMA(1, 1, At, B1); PG8_BAR;
        }
        PG8_STAMP();
        if constexpr (!Epi::AFTER_DRAIN) { E(acc, cur, wr, wc, fr, fq); S.done(cur); }
        PG8_STAMP();
        if (!has_next) break;
#pragma unroll
        for (int a = 0; a < 2; ++a)
#pragma unroll
            for (int b = 0; b < 2; ++b)
#pragma unroll
                for (int m = 0; m < 4; ++m)
#pragma unroll
                    for (int n = 0; n < 2; ++n) acc[a][b][m][n] = (f32x4){0.f, 0.f, 0.f, 0.f};
        cur = nxt; cA = nA; cB = nB; ++ui;
    }
    PG8_WAIT_V(0);
    if (wr == 0) PG8_BAR;
    PG8_BAR;
    if constexpr (Epi::AFTER_DRAIN) { E.fused(acc, cur, wr, wc, fr, fq, lds, wid, lane); S.done(cur); }
    PG8_STAMP();
    if (STAMP && wid == 0) { stamps[lane] = lane < nts ? (((unsigned long long)(unsigned)ts_hi << 32) | (unsigned)ts_lo) : 0ull;
        if (lane == 62) stamps[62] = rt_entry; if (lane == 63) stamps[63] = (unsigned long long)wall_clock64(); }
#undef PG8_STAMP
#undef PG8_SA
#undef PG8_SB
#undef PG8_STAGE
#undef PG8_LDA
#undef PG8_LDB
#undef PG8_MMA
#undef PG8_WAIT_V
#undef PG8_WAIT_L
#undef PG8_BAR
#undef PG8_SCHED
}
}
#define XB_TMO      128
#define XB_XCNT(j)  (256  + 64 * (j))
#define XB_XSUB(j)  (1280 + 64 * (j))
#define XB_XGEN(j)  (2304 + 64 * (j))
#define XB_TOP      3328
#define XB_TOPGEN   3392
#define XCD_BAR_WORDS 3456
#define XB_SPIN_CAP (1u << 22)

__device__ __forceinline__ unsigned xb_ld(unsigned* p)              { return __hip_atomic_load(p, __ATOMIC_RELAXED, __HIP_MEMORY_SCOPE_AGENT); }
__device__ __forceinline__ unsigned xb_add(unsigned* p, unsigned v) { return __hip_atomic_fetch_add(p, v, __ATOMIC_RELAXED, __HIP_MEMORY_SCOPE_AGENT); }
__device__ __forceinline__ unsigned xb_xcc_id() { return (unsigned)__builtin_amdgcn_s_getreg((3 << 11) | 20) & 0xFu; }
#define XB_SPIN(cond, bar) do { unsigned _sp = 0; while (cond) { __builtin_amdgcn_s_sleep(1); \
    if ((++_sp & 255u) == 0u) { if (xb_ld(&(bar)[XB_TMO])) break; if (_sp > XB_SPIN_CAP) { atomicAdd(&(bar)[XB_TMO], 1u); break; } } } } while (0)

struct XcdBarrier {
    unsigned* bar; unsigned x;
    volatile PG8_LAS unsigned* st;
};

__device__ __forceinline__ XcdBarrier xcd_barrier_post(unsigned* bar, volatile PG8_LAS unsigned* st) {
    XcdBarrier b; b.bar = bar; b.x = xb_xcc_id(); b.st = st;
    if (threadIdx.x == 0) (void)xb_add(&bar[XB_XCNT(b.x)], 1u);
    return b;
}
__device__ __forceinline__ void xcd_barrier_complete(unsigned* bar, unsigned x, unsigned& nloc, unsigned& nx) {
    const unsigned G = gridDim.x * gridDim.y * gridDim.z;
    unsigned sum, cnt, mine, sp = 0u;
    for (;;) {
        sum = 0u; cnt = 0u; mine = 0u;
#pragma unroll
        for (unsigned j = 0; j < 16; ++j) { const unsigned c = xb_ld(&bar[XB_XCNT(j)]); sum += c; cnt += (c > 0u) ? 1u : 0u; mine = (j == x) ? c : mine; }
        if (sum == G) break;
        __builtin_amdgcn_s_sleep(1);
        if ((++sp & 255u) == 0u) { if (xb_ld(&bar[XB_TMO])) break; if (sp > XB_SPIN_CAP) { atomicAdd(&bar[XB_TMO], 1u); break; } }
    }
    nloc = mine > 0u ? mine : 1u; nx = cnt > 0u ? cnt : 1u;
}

__device__ __forceinline__ void xcd_barrier(const XcdBarrier& b) {
    asm volatile("s_waitcnt vmcnt(0)" ::: "memory");
    __syncthreads();
    if (threadIdx.x == 0) {
        unsigned* bar = b.bar;
        __builtin_amdgcn_s_waitcnt(0);
        unsigned nloc = b.st[0], nx = b.st[1];
        if (nloc == 0u) { xcd_barrier_complete(bar, b.x, nloc, nx); b.st[0] = nloc; b.st[1] = nx; }
        const unsigned old = xb_add(&bar[XB_XSUB(b.x)], 1u);
        const unsigned gen = old / nloc;
        if (old + 1u == (gen + 1u) * nloc) {
            __builtin_amdgcn_fence(__ATOMIC_RELEASE, "agent");
            asm volatile("s_waitcnt vmcnt(0)" ::: "memory");
            const unsigned og = xb_add(&bar[XB_TOP], 1u);
            const unsigned tg = og / nx;
            if (og + 1u == (tg + 1u) * nx) xb_add(&bar[XB_TOPGEN], 1u);
            else XB_SPIN(xb_ld(&bar[XB_TOPGEN]) == tg, bar);
            __builtin_amdgcn_fence(__ATOMIC_ACQUIRE, "agent");
            xb_add(&bar[XB_XGEN(b.x)], 1u);
            asm volatile("s_waitcnt vmcnt(0)" ::: "memory");
        } else {
            XB_SPIN(xb_ld(&bar[XB_XGEN(b.x)]) == gen, bar);
            __builtin_amdgcn_fence(__ATOMIC_ACQUIRE, "agent");
            asm volatile("s_waitcnt vmcnt(0)" ::: "memory");
        }
    }
    __syncthreads();
}

using namespace pg8;
typedef float f32x16 __attribute__((ext_vector_type(16)));
typedef unsigned u32x2 __attribute__((ext_vector_type(2)));
#define LAS PG8_LAS
#define DI __device__ __forceinline__

constexpr int NT = 512;
constexpr int MP = 32768, MS = 2048, MT = MP + MS;
constexpr int KEYS_S = 4352;
constexpr int KR_ROWS = MP + 32 * KEYS_S;
constexpr int ZLD = 2560;
constexpr float EPS = 1e-6f;
constexpr float QSCALE = 0.10206207261596577f * 1.4426950408889634f;
constexpr int LDS_BYTES = 160 * 1024;

constexpr size_t SZ_WIN = 2560ull * 1024 * 2, SZ_WUQ = 768ull * 256 * 2, SZ_WUK = 512ull * 256 * 2, SZ_WUV = 512ull * 256 * 2,
                 SZ_WO = 1024ull * 1024 * 2, SZ_WFI = 5632ull * 1024 * 2, SZ_WFO = 1024ull * 2816 * 2;
constexpr size_t WOFF_IN = 0, WOFF_UQ = WOFF_IN + SZ_WIN, WOFF_UK = WOFF_UQ + SZ_WUQ, WOFF_UV = WOFF_UK + SZ_WUK, WOFF_O = WOFF_UV + SZ_WUV,
                 WOFF_FI = WOFF_O + SZ_WO, WOFF_FO = WOFF_FI + SZ_WFI, WL = WOFF_FO + SZ_WFO;
constexpr size_t OFF_W = 0;
constexpr size_t OFF_MOD = OFF_W + 2 * WL;
constexpr size_t OFF_ROPE = OFF_MOD + 2ull * 36 * 6144 * 4;
constexpr size_t OFF_H = OFF_ROPE + 8192ull * 16 * 2 * 4;
constexpr size_t OFF_Z = OFF_H + (size_t)MT * 1024 * 2;
constexpr size_t OFF_CQN = OFF_Z + (size_t)MT * ZLD * 2;
constexpr size_t OFF_CKV = OFF_CQN + (size_t)MT * 256 * 2;
constexpr size_t OFF_KROPE = OFF_CKV + (size_t)KR_ROWS * 256 * 2;
constexpr size_t OFF_Q = OFF_KROPE + (size_t)KR_ROWS * 32 * 2;
constexpr size_t OFF_KN = OFF_Q + (size_t)MT * 768 * 2;
constexpr size_t OFF_VT = OFF_KN + (size_t)KR_ROWS * 512 * 2;
constexpr size_t OFF_O = OFF_VT + (size_t)KR_ROWS * 512 * 2;
constexpr size_t OFF_PART = OFF_O + (size_t)MP * 512 * 2;
constexpr size_t OFF_UHG = OFF_PART + 32ull * 8 * 4 * 64 * 66 * 4;
constexpr size_t OFF_DHG = OFF_UHG + 544ull * 4 * 64 * 64 * 4;
constexpr size_t OFF_UGL = OFF_DHG + 544ull * 4 * 64 * 4;
constexpr size_t OFF_DGL = OFF_UGL + 544ull * 4 * 32 * 64 * 4;
constexpr size_t OFF_BAR = OFF_DGL + 544ull * 4 * 32 * 4;
constexpr size_t OFF_XB = OFF_BAR + 16384;
constexpr size_t WS_END = OFF_XB + (size_t)MT * 1024 * 2;
constexpr size_t OFF_ACT = OFF_KN;
static_assert((size_t)MT * 2816 * 2 <= 2 * (size_t)KR_ROWS * 512 * 2, "act alias");

constexpr size_t OUT_Y = 0, OUT_CKVP = 35651584, OUT_KRP = 52428800, OUT_HGP = 54525952, OUT_GLP = 54657024,
                 OUT_CKVS = 54722560, OUT_KRS = 55771136, OUT_HGS = 55902208, OUT_GLS = 56950784;

DI int tid_() { int t = threadIdx.x; asm volatile("" : "+v"(t)); return t; }
DI int bid_() { int b = blockIdx.x; asm volatile("" : "+s"(b)); return b; }
DI float neg_big() { float v = -1e30f; asm volatile("" : "+v"(v)); return v; }
struct Params { const float* in[29]; float* out; unsigned char* ws; };

typedef __bf16 hbf2 __attribute__((ext_vector_type(2)));
typedef float f32x2_ __attribute__((ext_vector_type(2)));
DI unsigned pack2(float a, float b) { f32x2_ v = {a, b}; return __builtin_bit_cast(unsigned, __builtin_convertvector(v, hbf2)); }
DI bf16_t f2bf(float f) { return (bf16_t)(pack2(f, f) & 0xFFFFu); }
DI float bf2f(bf16_t b) { return __uint_as_float(((unsigned)b) << 16); }
DI float bflo(unsigned u) { return __uint_as_float(u << 16); }
DI float bfhi(unsigned u) { return __uint_as_float(u & 0xFFFF0000u); }
DI float wave_sum(float v) { v += __shfl_xor(v, 32); v += __shfl_xor(v, 16); v += __shfl_xor(v, 8); v += __shfl_xor(v, 4); v += __shfl_xor(v, 2); v += __shfl_xor(v, 1); return v; }
DI float sigmoidf_(float x) { return 1.f / (1.f + expf(-x)); }
DI int row_bi(int row) { return row < MP ? (row >> 13) : 4 + ((row - MP) >> 6); }

struct EpiZ {
    static constexpr bool PERM = true, AFTER_DRAIN = false;
    bf16_t* O; int ldc;
    DI void operator()(const f32x4 (&acc)[2][2][4][2], const Unit& u, int wr, int wc, int fr, int fq) const {
        const int row0 = u.pm * 256 + wr * 64 + fr, col0 = u.pn * 256 + wc * 32 + 8 * fq;
#pragma unroll
        for (int ai = 0; ai < 2; ++ai)
#pragma unroll
            for (int m = 0; m < 4; ++m) { bf16_t* rowp = O + (size_t)(row0 + ai * 128 + m * 16) * ldc + col0;
#pragma unroll
                for (int bj = 0; bj < 2; ++bj) { const f32x4 v0 = acc[ai][bj][m][0], v1 = acc[ai][bj][m][1]; uint4 w; w.x = pack2(v0[0], v0[1]); w.y = pack2(v0[2], v0[3]); w.z = pack2(v1[0], v1[1]); w.w = pack2(v1[2], v1[3]); *(uint4*)(rowp + bj * 128) = w; } }
    }
};
struct EpiQ {
    static constexpr bool PERM = false, AFTER_DRAIN = false;
    bf16_t* Q; const float* qn_; const float* rope_;
    DI void operator()(const f32x4 (&acc)[2][2][4][2], const Unit& u, int wr, int wc, int fr, int fq) const {
        const float* qn = qn_; const float* rope = rope_; asm volatile("" : "+s"(qn), "+s"(rope));
        float eps_ = EPS; asm volatile("" : "+v"(eps_));
        const int row0 = u.pm * 256 + wr * 64 + fr;
#pragma unroll
        for (int ai = 0; ai < 2; ++ai)
#pragma unroll
            for (int m = 0; m < 4; ++m) {
                const int row = row0 + ai * 128 + m * 16;
                int pos; size_t base, hs;
                if (row < MP) { const int b = row >> 13, t = row & 8191; pos = t; base = ((size_t)(b * 8) * 8192 + t) * 96; hs = 8192 * 96; }
                else { const int r = row - MP, b = r >> 6, t = r & 63; pos = 4096 + t; base = (size_t)MP * 768 + ((size_t)(b * 8) * 64 + t) * 96; hs = 64 * 96; }
                if (u.pn < 2) {
                    const int head = 4 * u.pn + wc;
                    float ss = 0.f;
#pragma unroll
                    for (int bj = 0; bj < 2; ++bj)
#pragma unroll
                        for (int n = 0; n < 2; ++n) { const f32x4 v = acc[ai][bj][m][n]; ss += v[0] * v[0] + v[1] * v[1] + v[2] * v[2] + v[3] * v[3]; }
                    ss += __shfl_xor(ss, 16); ss += __shfl_xor(ss, 32);
                    const float rs = rsqrtf(ss * (1.f / 64.f) + eps_) * QSCALE;
#pragma unroll
                    for (int bj = 0; bj < 2; ++bj)
#pragma unroll
                        for (int n = 0; n < 2; ++n) { const int d = 32 * bj + 16 * n + 4 * fq; const f32x4 v = acc[ai][bj][m][n]; const float4 g = *(const float4*)(qn + d);
                            uint2 w; w.x = pack2(v[0] * rs * g.x, v[1] * rs * g.y); w.y = pack2(v[2] * rs * g.z, v[3] * rs * g.w); *(uint2*)(Q + base + head * hs + d) = w; }
                } else {
#pragma unroll
                    for (int bj = 0; bj < 2; ++bj) {
                        const int head = 2 * wc + bj;
                        const f32x4 v1 = acc[ai][bj][m][0], v2 = acc[ai][bj][m][1];
                        float ss = v1[0] * v1[0] + v1[1] * v1[1] + v1[2] * v1[2] + v1[3] * v1[3] + v2[0] * v2[0] + v2[1] * v2[1] + v2[2] * v2[2] + v2[3] * v2[3];
                        ss += __shfl_xor(ss, 16); ss += __shfl_xor(ss, 32);
                        const float rs = rsqrtf(ss * (1.f / 32.f) + eps_);
                        const float4 g1 = *(const float4*)(qn + 64 + 4 * fq), g2 = *(const float4*)(qn + 80 + 4 * fq);
                        const float4 cs0 = *(const float4*)(rope + ((size_t)pos * 16 + 4 * fq) * 2), cs1 = *(const float4*)(rope + ((size_t)pos * 16 + 4 * fq) * 2 + 4);
                        const float x10 = v1[0] * rs * g1.x, x11 = v1[1] * rs * g1.y, x12 = v1[2] * rs * g1.z, x13 = v1[3] * rs * g1.w;
                        const float x20 = v2[0] * rs * g2.x, x21 = v2[1] * rs * g2.y, x22 = v2[2] * rs * g2.z, x23 = v2[3] * rs * g2.w;
                        uint2 w1, w2;
                        w1.x = pack2((x10 * cs0.x - x20 * cs0.y) * QSCALE, (x11 * cs0.z - x21 * cs0.w) * QSCALE);
                        w1.y = pack2((x12 * cs1.x - x22 * cs1.y) * QSCALE, (x13 * cs1.z - x23 * cs1.w) * QSCALE);
                        w2.x = pack2((x20 * cs0.x + x10 * cs0.y) * QSCALE, (x21 * cs0.z + x11 * cs0.w) * QSCALE);
                        w2.y = pack2((x22 * cs1.x + x12 * cs1.y) * QSCALE, (x23 * cs1.z + x13 * cs1.w) * QSCALE);
                        *(uint2*)(Q + base + head * hs + 64 + 4 * fq) = w1; *(uint2*)(Q + base + head * hs + 80 + 4 * fq) = w2;
                    }
                }
            }
    }
};
struct EpiKN {
    static constexpr bool PERM = true, AFTER_DRAIN = false;
    bf16_t* KN; const float* kn_;
    DI void operator()(const f32x4 (&acc)[2][2][4][2], const Unit& u, int wr, int wc, int fr, int fq) const {
        const float* kn = kn_; asm volatile("" : "+s"(kn));
        float eps_ = EPS; asm volatile("" : "+v"(eps_));
        float4 gk[2][2];
#pragma unroll
        for (int bj = 0; bj < 2; ++bj)
#pragma unroll
            for (int n = 0; n < 2; ++n) gk[bj][n] = *(const float4*)(kn + 32 * bj + 8 * fq + 4 * n);
        size_t base, hs;
        if (u.pm < 128) { const int b = u.pm >> 5, key0 = (u.pm & 31) * 256; base = ((size_t)(b * 8) * 8192 + key0) * 64; hs = (size_t)8192 * 64; }
        else { const int q = u.pm - 128, b = q / 17, key0 = (q % 17) * 256; base = (size_t)MP * 512 + ((size_t)(b * 8) * KEYS_S + key0) * 64; hs = (size_t)KEYS_S * 64; }
        const int head = 4 * u.pn + wc;
#pragma unroll
        for (int ai = 0; ai < 2; ++ai)
#pragma unroll
            for (int m = 0; m < 4; ++m) {
                const int key = 128 * ai + 64 * wr + 16 * m + fr;
                float ss = 0.f;
#pragma unroll
                for (int bj = 0; bj < 2; ++bj)
#pragma unroll
                    for (int n = 0; n < 2; ++n) { const f32x4 v = acc[ai][bj][m][n]; ss += v[0] * v[0] + v[1] * v[1] + v[2] * v[2] + v[3] * v[3]; }
                ss += __shfl_xor(ss, 16); ss += __shfl_xor(ss, 32);
                const float rs = rsqrtf(ss * (1.f / 64.f) + eps_);
#pragma unroll
                for (int bj = 0; bj < 2; ++bj) { const f32x4 v0 = acc[ai][bj][m][0], v1 = acc[ai][bj][m][1]; const float4 g0 = gk[bj][0], g1 = gk[bj][1];
                    uint4 w; w.x = pack2(v0[0] * rs * g0.x, v0[1] * rs * g0.y); w.y = pack2(v0[2] * rs * g0.z, v0[3] * rs * g0.w); w.z = pack2(v1[0] * rs * g1.x, v1[1] * rs * g1.y); w.w = pack2(v1[2] * rs * g1.z, v1[3] * rs * g1.w);
                    *(uint4*)(KN + base + head * hs + (size_t)key * 64 + 32 * bj + 8 * fq) = w; }
            }
    }
};
struct EpiVT {
    static constexpr bool PERM = true, AFTER_DRAIN = false;
    bf16_t* VT;
    DI void operator()(const f32x4 (&acc)[2][2][4][2], const Unit& u, int wr, int wc, int fr, int fq) const {
        size_t base; int KL;
        if (u.pn < 128) { const int b = u.pn >> 5, key0 = (u.pn & 31) * 256; base = (size_t)(b * 8) * 64 * 8192 + key0; KL = 8192; }
        else { const int q = u.pn - 128, b = q / 17, key0 = (q % 17) * 256; base = (size_t)MP * 512 + (size_t)(b * 8) * 64 * KEYS_S + key0; KL = KEYS_S; }
#pragma unroll
        for (int ai = 0; ai < 2; ++ai)
#pragma unroll
            for (int m = 0; m < 4; ++m) {
                const int r = 256 * u.pm + 128 * ai + 64 * wr + 16 * m + fr;
                bf16_t* rowp = VT + base + (size_t)r * KL + 32 * wc + 8 * fq;
#pragma unroll
                for (int bj = 0; bj < 2; ++bj) { const f32x4 v0 = acc[ai][bj][m][0], v1 = acc[ai][bj][m][1]; uint4 w; w.x = pack2(v0[0], v0[1]); w.y = pack2(v0[2], v0[3]); w.z = pack2(v1[0], v1[1]); w.w = pack2(v1[2], v1[3]); *(uint4*)(rowp + 128 * bj) = w; }
            }
    }
};
struct EpiRes {
    static constexpr bool PERM = false, AFTER_DRAIN = false;
    bf16_t* XB; float* out; const float* gate; int final; int pm0;
    DI void operator()(const f32x4 (&acc)[2][2][4][2], const Unit& u, int wr, int wc, int fr, int fq) const {
        const int row0 = (u.pm + pm0) * 256 + wr * 64 + fr, col0 = u.pn * 256 + wc * 32 + 4 * fq;
#pragma unroll
        for (int ai = 0; ai < 2; ++ai) {
            const float* gr = gate + (size_t)row_bi(row0 + ai * 128) * 6144 + col0;
            f32x4 g[2][2]; uint2 x[4][2][2];
#pragma unroll
            for (int bj = 0; bj < 2; ++bj)
#pragma unroll
                for (int n = 0; n < 2; ++n) g[bj][n] = *(const f32x4*)(gr + bj * 128 + n * 16);
#pragma unroll
            for (int m = 0; m < 4; ++m) { const bf16_t* xr = XB + (size_t)(row0 + ai * 128 + m * 16) * 1024 + col0;
#pragma unroll
                for (int bj = 0; bj < 2; ++bj)
#pragma unroll
                    for (int n = 0; n < 2; ++n) x[m][bj][n] = *(const uint2*)(xr + bj * 128 + n * 16); }
#pragma unroll
            for (int m = 0; m < 4; ++m) { const size_t ro = (size_t)(row0 + ai * 128 + m * 16) * 1024 + col0;
#pragma unroll
                for (int bj = 0; bj < 2; ++bj)
#pragma unroll
                    for (int n = 0; n < 2; ++n) { const uint2 xv = x[m][bj][n]; const f32x4 xf = {bflo(xv.x), bfhi(xv.x), bflo(xv.y), bfhi(xv.y)}; const f32x4 r = xf + g[bj][n] * acc[ai][bj][m][n];
                        if (final) *(f32x4*)(out + ro + bj * 128 + n * 16) = r;
                        else { uint2 w; w.x = pack2(r[0], r[1]); w.y = pack2(r[2], r[3]); *(uint2*)(XB + ro + bj * 128 + n * 16) = w; } } }
        }
    }
};
struct EpiSwi {
    static constexpr bool PERM = true, AFTER_DRAIN = false;
    bf16_t* ACT;
    DI void operator()(const f32x4 (&acc)[2][2][4][2], const Unit& u, int wr, int wc, int fr, int fq) const {
        const int row0 = u.pm * 256 + wr * 64 + fr, col0 = u.pn * 128 + wc * 32 + 8 * fq;
#pragma unroll
        for (int ai = 0; ai < 2; ++ai)
#pragma unroll
            for (int m = 0; m < 4; ++m) { bf16_t* rowp = ACT + (size_t)(row0 + ai * 128 + m * 16) * 2816 + col0; float r[8];
#pragma unroll
                for (int n = 0; n < 2; ++n) { const f32x4 a = acc[ai][0][m][n], g = acc[ai][1][m][n];
#pragma unroll
                    for (int j = 0; j < 4; ++j) r[4 * n + j] = a[j] / (1.f + __expf(-a[j])) * g[j]; }
                uint4 w; w.x = pack2(r[0], r[1]); w.y = pack2(r[2], r[3]); w.z = pack2(r[4], r[5]); w.w = pack2(r[6], r[7]); *(uint4*)rowp = w; }
    }
};
template <class Epi> DI void run_gemm(LAS unsigned char* lds, const bf16_t* A, const bf16_t* Bt, int M, int N, int K, const Epi& E, int rot = 0) {
    asm volatile("" : "+s"(M), "+s"(N), "+s"(K));
    Gemm g{A, Bt, M, N, K}; StaticOrder S; S.init(M, N, (int)gridDim.x, (int)((bid_() + rot) % gridDim.x));
    gemm_phase<Epi, StaticOrder, false>(lds, g, S, E, nullptr);
}

DI int colmap(int w, int n) {
    if (w == 0) return n < 2352 ? n : -1;
    if (w == 1) { const int pn = n >> 8, c = n & 255, bj = c >> 7, wc = (c >> 5) & 3, cc = c & 31; return pn < 2 ? (4 * pn + wc) * 96 + 32 * bj + cc : (2 * wc + bj) * 96 + 64 + cc; }
    if (w == 2) { const int pn = n >> 8, c = n & 255, bj = c >> 7, wc = (c >> 5) & 3, cc = c & 31; return (4 * pn + wc) * 64 + 32 * bj + cc; }
    if (w == 5) { const int pn = n >> 8, c = n & 255; return c < 128 ? 128 * pn + c : 2816 + 128 * pn + (c - 128); }
    return n;
}
DI void phase_prep(const Params& p, LAS unsigned char* lds) {
    const int tid = tid_();
    LAS bf16_t* T = (LAS bf16_t*)lds;
    for (int ti = bid_(); ti < 2 * 1560; ti += gridDim.x) {
        const int l = ti / 1560, r = ti % 1560;
        int w, t0, K, ld; size_t doff; const float* src;
        if (r < 320) { w = 0; t0 = 0; K = 1024; ld = 2352; doff = WOFF_IN; src = p.in[12]; }
        else if (r < 344) { w = 1; t0 = 320; K = 256; ld = 768; doff = WOFF_UQ; src = p.in[15]; }
        else if (r < 360) { w = 2; t0 = 344; K = 256; ld = 512; doff = WOFF_UK; src = p.in[16]; }
        else if (r < 376) { w = 3; t0 = 360; K = 256; ld = 512; doff = WOFF_UV; src = p.in[17]; }
        else if (r < 504) { w = 4; t0 = 376; K = 1024; ld = 1024; doff = WOFF_O; src = p.in[26]; }
        else if (r < 1208) { w = 5; t0 = 504; K = 1024; ld = 5632; doff = WOFF_FI; src = p.in[27]; }
        else { w = 6; t0 = 1208; K = 2816; ld = 1024; doff = WOFF_FO; src = p.in[28]; }
        src += (size_t)l * K * ld;
        const int kt = K >> 7, tr = r - t0, n0 = (tr / kt) * 64, k0 = (tr % kt) * 128;
        bf16_t* dst = (bf16_t*)(p.ws + OFF_W + (size_t)l * WL + doff);
        const int nn = tid & 63, col = colmap(w, n0 + nn);
        float tv[16];
#pragma unroll
        for (int i = 0; i < 16; ++i) { const int kk = (tid >> 6) + 8 * i; tv[i] = col >= 0 ? src[(size_t)(k0 + kk) * ld + col] : 0.f; }
#pragma unroll
        for (int i = 0; i < 16; ++i) { const int kk = (tid >> 6) + 8 * i; T[nn * 130 + kk] = f2bf(tv[i]); }
        __syncthreads();
#pragma unroll
        for (int j = 0; j < 2; ++j) { const int q = tid + 512 * j, row = q >> 4, seg = q & 15; const LAS unsigned* tp = (const LAS unsigned*)(T + row * 130 + seg * 8);
          uint4 o; o.x = tp[0]; o.y = tp[1]; o.z = tp[2]; o.w = tp[3]; *(uint4*)(dst + (size_t)(n0 + row) * K + k0 + seg * 8) = o; }
        __syncthreads();
    }
    float* mod = (float*)(p.ws + OFF_MOD);
    for (int it = bid_(); it < 192; it += gridDim.x) {
        const int l = it / 96, cgp = it % 96;
        LAS float* sl = (LAS float*)lds;
        for (int i = tid; i < 36 * 1024; i += NT) { const int bi = i >> 10, k = i & 1023; const float c = bi < 4 ? p.in[2][bi * 1024 + k] : p.in[3][(bi - 4) * 1024 + k]; sl[i] = c / (1.f + expf(-c)); }
        __syncthreads();
        const int cl = tid & 63, kq = tid >> 6;
        float acc[36];
#pragma unroll
        for (int bi = 0; bi < 36; ++bi) acc[bi] = 0.f;
        const float* wm = p.in[8] + (size_t)l * 1024 * 6144 + cgp * 64 + cl;
#pragma unroll 4
        for (int k = kq * 128; k < kq * 128 + 128; k += 4) {
            const float w0 = wm[(size_t)k * 6144], w1 = wm[(size_t)(k + 1) * 6144], w2 = wm[(size_t)(k + 2) * 6144], w3 = wm[(size_t)(k + 3) * 6144];
#pragma unroll
            for (int bi = 0; bi < 36; ++bi) { const f32x4 s = *(const LAS f32x4*)(sl + bi * 1024 + k); acc[bi] += s[0] * w0 + s[1] * w1 + s[2] * w2 + s[3] * w3; }
        }
        __syncthreads();
        LAS float* red = (LAS float*)lds;
#pragma unroll
        for (int bi = 0; bi < 36; ++bi) red[(kq * 36 + bi) * 64 + cl] = acc[bi];
        __syncthreads();
        for (int o = tid; o < 36 * 64; o += NT) { const int bi = o >> 6, c = o & 63; float s = 0.f;
#pragma unroll
            for (int q = 0; q < 8; ++q) s += red[(q * 36 + bi) * 64 + c];
            const int colg = cgp * 64 + c; mod[((size_t)l * 36 + bi) * 6144 + colg] = s + p.in[9][l * 6144 + colg]; }
        __syncthreads();
    }
    float* rope = (float*)(p.ws + OFF_ROPE);
    for (int i = bid_() * NT + tid; i < 8192 * 16; i += gridDim.x * NT) { const int pos = i >> 4, j = i & 15;
        const float inv = exp2f(-(float)j * (13.287712379549449f / 16.f)); const float ang = (float)pos * inv; rope[2 * i] = cosf(ang); rope[2 * i + 1] = sinf(ang); }
}

template <bool FROM_INPUT>
DI void phase_hrows(const Params& p, int l, const float* xa, const float* xb, const float* g, int shoff, int scoff, int row_lo = 0, int row_hi = MT, int b0 = 0, int nb = 0) {
    const int tid = tid_(), lane = tid & 63, wid = __builtin_amdgcn_readfirstlane(tid >> 6);
    const float* mod = (const float*)(p.ws + OFF_MOD) + (size_t)l * 36 * 6144;
    bf16_t* H = (bf16_t*)(p.ws + OFF_H); bf16_t* XB = (bf16_t*)(p.ws + OFF_XB);
    if (nb == 0) nb = (int)gridDim.x;
    const int stride = nb * 8;
    int row = row_lo + ((int)bid_() - b0) * 8 + wid;
    float4 v[4];
#define HR_LOAD(dst, rr) do { if (FROM_INPUT) { const float* xr_ = (rr) < MP ? xa + (size_t)(rr) * 1024 : xb + (size_t)((rr) - MP) * 1024; \
            _Pragma("unroll") for (int i = 0; i < 4; ++i) dst[i] = *(const float4*)(xr_ + i * 256 + lane * 4); } \
        else { const bf16_t* xr_ = XB + (size_t)(rr) * 1024; \
            _Pragma("unroll") for (int i = 0; i < 4; ++i) { const uint2 u_ = *(const uint2*)(xr_ + i * 256 + lane * 4); dst[i].x = bflo(u_.x); dst[i].y = bfhi(u_.x); dst[i].z = bflo(u_.y); dst[i].w = bfhi(u_.y); } } } while (0)
    if (row < row_hi) HR_LOAD(v, row);
    while (row < row_hi) {
        const int nrow = row + stride; float4 nv[4];
        if (nrow < row_hi) HR_LOAD(nv, nrow);
        float ss = 0.f;
#pragma unroll
        for (int i = 0; i < 4; ++i) ss += v[i].x * v[i].x + v[i].y * v[i].y + v[i].z * v[i].z + v[i].w * v[i].w;
        ss = wave_sum(ss);
        const float rs = rsqrtf(ss * (1.f / 1024.f) + EPS);
        const float* mp = mod + (size_t)row_bi(row) * 6144;
#pragma unroll
        for (int i = 0; i < 4; ++i) { const int col = i * 256 + lane * 4;
            const float4 gg = *(const float4*)(g + col), sc = *(const float4*)(mp + scoff + col), sh = *(const float4*)(mp + shoff + col);
            uint2 w; w.x = pack2(v[i].x * rs * gg.x * (1.f + sc.x) + sh.x, v[i].y * rs * gg.y * (1.f + sc.y) + sh.y);
            w.y = pack2(v[i].z * rs * gg.z * (1.f + sc.z) + sh.z, v[i].w * rs * gg.w * (1.f + sc.w) + sh.w);
            *(uint2*)(H + (size_t)row * 1024 + col) = w;
            if (FROM_INPUT) { uint2 xw; xw.x = pack2(v[i].x, v[i].y); xw.y = pack2(v[i].z, v[i].w); *(uint2*)(XB + (size_t)row * 1024 + col) = xw; } }
#pragma unroll
        for (int i = 0; i < 4; ++i) v[i] = nv[i];
        row = nrow;
    }
#undef HR_LOAD
}
DI void phase_cache(const Params& p, int l, int b0, int nb) {
    const size_t gt = (size_t)(bid_() - b0) * NT + tid_(), gs = (size_t)nb * NT;
    bf16_t* ckv_s = (bf16_t*)(p.ws + OFF_CKV) + (size_t)MP * 256;
    bf16_t* kr_s = (bf16_t*)(p.ws + OFF_KROPE) + (size_t)MP * 32;
    const float4* s1 = (const float4*)(p.in[4] + (size_t)l * 32 * 4096 * 256);
    for (size_t i0 = gt; i0 < 8388608; i0 += gs * 8) { float4 v[8];
#pragma unroll
        for (int u = 0; u < 8; ++u) { const size_t i = i0 + u * gs; if (i < 8388608) v[u] = s1[i]; }
#pragma unroll
        for (int u = 0; u < 8; ++u) { const size_t i = i0 + u * gs; if (i < 8388608) { const size_t e = i * 4, b = e >> 20, rem = e & 1048575;
            uint2 w; w.x = pack2(v[u].x, v[u].y); w.y = pack2(v[u].z, v[u].w); *(uint2*)(ckv_s + b * KEYS_S * 256 + rem) = w; } } }
    unsigned zz = 0u; asm volatile("" : "+v"(zz));
    for (size_t i = gt; i < 393216; i += gs) { const size_t e = i * 4, b = e / 49152, rem = e % 49152; uint2 w; w.x = zz; w.y = zz; *(uint2*)(ckv_s + b * KEYS_S * 256 + 4160 * 256 + rem) = w; }
    const float4* s2 = (const float4*)(p.in[5] + (size_t)l * 32 * 4096 * 32);
    for (size_t i0 = gt; i0 < 1048576; i0 += gs * 8) { float4 v[8];
#pragma unroll
        for (int u = 0; u < 8; ++u) { const size_t i = i0 + u * gs; if (i < 1048576) v[u] = s2[i]; }
#pragma unroll
        for (int u = 0; u < 8; ++u) { const size_t i = i0 + u * gs; if (i < 1048576) { const size_t e = i * 4, b = e >> 17, rem = e & 131071;
            uint2 w; w.x = pack2(v[u].x, v[u].y); w.y = pack2(v[u].z, v[u].w); *(uint2*)(kr_s + b * KEYS_S * 32 + rem) = w; } } }
}
DI void phase_post(const Params& p, int l) {
    const int tid = tid_(), lane = tid & 63, wid = __builtin_amdgcn_readfirstlane(tid >> 6);
    const bf16_t* Z = (const bf16_t*)(p.ws + OFF_Z);
    bf16_t* CQN = (bf16_t*)(p.ws + OFF_CQN); bf16_t* CKV = (bf16_t*)(p.ws + OFF_CKV); bf16_t* KRO = (bf16_t*)(p.ws + OFF_KROPE);
    const float* rope = (const float*)(p.ws + OFF_ROPE);
    const float* gcq = p.in[13] + l * 256; const float* gckv = p.in[14] + l * 256; const float* gk = p.in[19] + l * 96 + 64;
    const int stride = gridDim.x * 8;
    int row = bid_() * 8 + wid;
    uint2 u1, u2; bf16_t u3;
    if (row < MT) { const bf16_t* zr = Z + (size_t)row * ZLD; u1 = *(const uint2*)(zr + 4 * lane); u2 = *(const uint2*)(zr + 256 + 4 * lane); u3 = zr[512 + (lane & 31)]; }
    while (row < MT) {
        const int nrow = row + stride; uint2 n1, n2; bf16_t n3;
        if (nrow < MT) { const bf16_t* zr = Z + (size_t)nrow * ZLD; n1 = *(const uint2*)(zr + 4 * lane); n2 = *(const uint2*)(zr + 256 + 4 * lane); n3 = zr[512 + (lane & 31)]; }
        int pos; size_t grow; float* o_ckv; float* o_kr;
        if (row < MP) { const int b = row >> 13, t = row & 8191; pos = t; grow = row; o_ckv = p.out + OUT_CKVP + ((size_t)(l * 4 + b) * 8192 + t) * 256; o_kr = p.out + OUT_KRP + ((size_t)(l * 4 + b) * 8192 + t) * 32; }
        else { const int r = row - MP, b = r >> 6, t = r & 63; pos = 4096 + t; grow = (size_t)MP + (size_t)b * KEYS_S + 4096 + t; o_ckv = p.out + OUT_CKVS + ((size_t)(l * 32 + b) * 64 + t) * 256; o_kr = p.out + OUT_KRS + ((size_t)(l * 32 + b) * 64 + t) * 32; }
        { const uint2 u = u1; const float a0 = bflo(u.x), a1 = bfhi(u.x), a2 = bflo(u.y), a3 = bfhi(u.y);
          const float ss = wave_sum(a0 * a0 + a1 * a1 + a2 * a2 + a3 * a3); const float rs = rsqrtf(ss * (1.f / 256.f) + EPS); const float4 g = *(const float4*)(gcq + 4 * lane);
          uint2 w; w.x = pack2(a0 * rs * g.x, a1 * rs * g.y); w.y = pack2(a2 * rs * g.z, a3 * rs * g.w); *(uint2*)(CQN + (size_t)row * 256 + 4 * lane) = w; }
        { const uint2 u = u2; const float a0 = bflo(u.x), a1 = bfhi(u.x), a2 = bflo(u.y), a3 = bfhi(u.y);
          const float ss = wave_sum(a0 * a0 + a1 * a1 + a2 * a2 + a3 * a3); const float rs = rsqrtf(ss * (1.f / 256.f) + EPS); const float4 g = *(const float4*)(gckv + 4 * lane);
          float4 o; o.x = a0 * rs * g.x; o.y = a1 * rs * g.y; o.z = a2 * rs * g.z; o.w = a3 * rs * g.w; *(float4*)(o_ckv + 4 * lane) = o;
          uint2 w; w.x = pack2(o.x, o.y); w.y = pack2(o.z, o.w); *(uint2*)(CKV + grow * 256 + 4 * lane) = w; }
        { const int i = lane & 31; const float a = bf2f(u3); float ss = a * a; ss += __shfl_xor(ss, 16); ss += __shfl_xor(ss, 8); ss += __shfl_xor(ss, 4); ss += __shfl_xor(ss, 2); ss += __shfl_xor(ss, 1);
          const float xn = a * rsqrtf(ss * (1.f / 32.f) + EPS) * gk[i]; const float other = __shfl_xor(xn, 16);
          const float2 cs = *(const float2*)(rope + ((size_t)pos * 16 + (i & 15)) * 2);
          const float o = i < 16 ? xn * cs.x - other * cs.y : xn * cs.x + other * cs.y;
          if (lane < 32) { o_kr[i] = o; KRO[grow * 32 + i] = f2bf(o); } }
        u1 = n1; u2 = n2; u3 = n3; row = nrow;
    }
}

DI f32x16 mfma32(bf16x8 a, bf16x8 b, f32x16 c) { return __builtin_amdgcn_mfma_f32_32x32x16_bf16(a, b, c, 0, 0, 0); }
DI f32x4 mfma16(bf16x8 a, bf16x8 b, f32x4 c) { return __builtin_amdgcn_mfma_f32_16x16x32_bf16(a, b, c, 0, 0, 0); }
DI bf16x8 pack8(const f32x16& s, int b) { u32x4 r; r[0] = pack2(s[b], s[b + 1]); r[1] = pack2(s[b + 2], s[b + 3]); r[2] = pack2(s[b + 4], s[b + 5]); r[3] = pack2(s[b + 6], s[b + 7]); return __builtin_bit_cast(bf16x8, r); }

template <int NH>
DI void attn_core(LAS unsigned char* lds, const bf16_t* qptr, const bf16_t* kn, size_t kn_hs, const bf16_t* kr, const bf16_t* vt, size_t vt_hs, int KL,
                  int kt0, int kstep, int nit, int nvalid, int tile_lim, int hh, f32x16 (&o)[2], float& m_run, float& l_run) {
    constexpr int BUFSZ = NH * 17920 + 5120;
    const int tid = tid_(), lane = tid & 63, r = lane & 31, h = lane >> 5;
    bf16x8 qf[6];
#pragma unroll
    for (int ks = 0; ks < 6; ++ks) qf[ks] = *(const bf16x8*)(qptr + ks * 16 + h * 8);
#pragma unroll
    for (int i = 0; i < 16; ++i) { o[0][i] = 0.f; o[1][i] = 0.f; }
    m_run = neg_big(); l_run = 0.f;
    u32x4 rkn[NH], rvt[NH], rkr = {0u, 0u, 0u, 0u};
    const int lrow = tid >> 3, lseg = tid & 7;
#define ATT_GLOAD(kt) do { const size_t key0_ = (size_t)(kt) * 64; \
        _Pragma("unroll") for (int hx = 0; hx < NH; ++hx) { rkn[hx] = *(const u32x4*)(kn + hx * kn_hs + (key0_ + lrow) * 64 + lseg * 8); rvt[hx] = *(const u32x4*)(vt + hx * vt_hs + (size_t)lrow * KL + key0_ + lseg * 8); } \
        if (tid < 256) rkr = *(const u32x4*)(kr + (key0_ + (tid >> 2)) * 32 + (tid & 3) * 8); } while (0)
#define ATT_LSTORE(buf) do { LAS unsigned char* B_ = lds + (buf) * BUFSZ; \
        _Pragma("unroll") for (int hx = 0; hx < NH; ++hx) { *(LAS u32x4*)(B_ + hx * 9216 + lrow * 144 + lseg * 16) = rkn[hx]; \
            LAS u32x2* pv_ = (LAS u32x2*)(B_ + NH * 9216 + 5120 + hx * 8704 + lrow * 136 + lseg * 16); u32x2 a_, b_; a_[0] = rvt[hx][0]; a_[1] = rvt[hx][1]; b_[0] = rvt[hx][2]; b_[1] = rvt[hx][3]; pv_[0] = a_; pv_[1] = b_; } \
        if (tid < 256) *(LAS u32x4*)(B_ + NH * 9216 + (tid >> 2) * 80 + (tid & 3) * 16) = rkr; } while (0)
    ATT_GLOAD(kt0); ATT_LSTORE(0);
    __syncthreads();
    for (int it = 0; it < nit; ++it) {
        const int ktn = kt0 + (it + 1) * kstep;
        const bool more = (it + 1 < nit) && (ktn < tile_lim);
        if (more) ATT_GLOAD(ktn);
        if (it < nvalid) {
            const LAS unsigned char* B = lds + (it & 1) * BUFSZ;
            const LAS unsigned char* knb = B + hh * 9216; const LAS unsigned char* krb = B + NH * 9216; const LAS unsigned char* vtb = B + NH * 9216 + 5120 + hh * 8704;
            f32x16 s0, s1;
#pragma unroll
            for (int i = 0; i < 16; ++i) { s0[i] = 0.f; s1[i] = 0.f; }
#pragma unroll
            for (int ks = 0; ks < 4; ++ks) { const bf16x8 a0 = *(const LAS bf16x8*)(knb + r * 144 + ks * 32 + h * 16), a1 = *(const LAS bf16x8*)(knb + (32 + r) * 144 + ks * 32 + h * 16);
                s0 = mfma32(a0, qf[ks], s0); s1 = mfma32(a1, qf[ks], s1); }
#pragma unroll
            for (int ks = 0; ks < 2; ++ks) { const bf16x8 a0 = *(const LAS bf16x8*)(krb + r * 80 + ks * 32 + h * 16), a1 = *(const LAS bf16x8*)(krb + (32 + r) * 80 + ks * 32 + h * 16);
                s0 = mfma32(a0, qf[4 + ks], s0); s1 = mfma32(a1, qf[4 + ks], s1); }
            float mx = s0[0];
#pragma unroll
            for (int i = 0; i < 16; ++i) { mx = fmaxf(mx, s0[i]); mx = fmaxf(mx, s1[i]); }
            mx = fmaxf(mx, __shfl_xor(mx, 32));
            const float mnew = fmaxf(m_run, mx), alpha = __builtin_amdgcn_exp2f(m_run - mnew);
            m_run = mnew;
            float ps = 0.f;
#pragma unroll
            for (int i = 0; i < 16; ++i) { s0[i] = __builtin_amdgcn_exp2f(s0[i] - mnew); s1[i] = __builtin_amdgcn_exp2f(s1[i] - mnew); ps += s0[i] + s1[i]; }
            l_run = l_run * alpha + ps;
#pragma unroll
            for (int i = 0; i < 16; ++i) { o[0][i] *= alpha; o[1][i] *= alpha; }
            bf16x8 pf[4];
            pf[0] = pack8(s0, 0); pf[1] = pack8(s0, 8); pf[2] = pack8(s1, 0); pf[3] = pack8(s1, 8);
#pragma unroll
            for (int dh = 0; dh < 2; ++dh)
#pragma unroll
                for (int s4 = 0; s4 < 4; ++s4) { const LAS u32x2* pa = (const LAS u32x2*)(vtb + (32 * dh + r) * 136 + (16 * s4 + 4 * h) * 2); const u32x2 lo = pa[0], hi = pa[2];
                    u32x4 av; av[0] = lo[0]; av[1] = lo[1]; av[2] = hi[0]; av[3] = hi[1]; o[dh] = mfma32(__builtin_bit_cast(bf16x8, av), pf[s4], o[dh]); }
        }
        if (more) ATT_LSTORE((it + 1) & 1);
        __syncthreads();
    }
#undef ATT_GLOAD
#undef ATT_LSTORE
}
DI void attn_core64(LAS unsigned char* lds, const bf16_t* qptr, const bf16_t* kn, const bf16_t* kr, const bf16_t* vt, int KL, int nit, int nvalid,
                    f32x16 (&o)[2][2], float (&m_run)[2], float (&l_run)[2]) {
    constexpr int BUFSZ = 17920 + 5120;
    const int tid = tid_(), lane = tid & 63, r = lane & 31, h = lane >> 5;
    bf16x8 qf[2][2];
    LAS bf16x8* qr = (LAS bf16x8*)(lds + 2 * BUFSZ + (tid >> 6) * 8192) + lane;
#pragma unroll
    for (int g = 0; g < 2; ++g) {
#pragma unroll
        for (int ks = 0; ks < 2; ++ks) qf[g][ks] = *(const bf16x8*)(qptr + g * 32 * 96 + ks * 16 + h * 8);
#pragma unroll
        for (int ks = 0; ks < 4; ++ks) qr[(g * 4 + ks) * 64] = *(const bf16x8*)(qptr + g * 32 * 96 + (2 + ks) * 16 + h * 8); }
#pragma unroll
    for (int g = 0; g < 2; ++g) { m_run[g] = neg_big(); l_run[g] = 0.f;
#pragma unroll
        for (int i = 0; i < 16; ++i) { o[g][0][i] = 0.f; o[g][1][i] = 0.f; } }
    u32x4 rkn, rvt, rkr = {0u, 0u, 0u, 0u};
    const int lrow = tid >> 3, lseg = tid & 7;
#define A64_GLOAD(kt) do { const size_t key0_ = (size_t)(kt) * 64; rkn = *(const u32x4*)(kn + (key0_ + lrow) * 64 + lseg * 8); rvt = *(const u32x4*)(vt + (size_t)lrow * KL + key0_ + lseg * 8); \
        if (tid < 256) rkr = *(const u32x4*)(kr + (key0_ + (tid >> 2)) * 32 + (tid & 3) * 8); } while (0)
#define A64_LSTORE(buf) do { LAS unsigned char* B_ = lds + (buf) * BUFSZ; *(LAS u32x4*)(B_ + lrow * 144 + lseg * 16) = rkn; \
        LAS u32x2* pv_ = (LAS u32x2*)(B_ + 9216 + 5120 + lrow * 136 + lseg * 16); u32x2 a_, b_; a_[0] = rvt[0]; a_[1] = rvt[1]; b_[0] = rvt[2]; b_[1] = rvt[3]; pv_[0] = a_; pv_[1] = b_; \
        if (tid < 256) *(LAS u32x4*)(B_ + 9216 + (tid >> 2) * 80 + (tid & 3) * 16) = rkr; } while (0)
    A64_GLOAD(0); A64_LSTORE(0);
    __syncthreads();
    for (int it = 0; it < nit; ++it) {
        const bool more = (it + 1 < nit);
        if (more) A64_GLOAD(it + 1);
        if (it < nvalid) {
            const LAS unsigned char* B = lds + (it & 1) * BUFSZ;
            const LAS unsigned char* knb = B; const LAS unsigned char* krb = B + 9216; const LAS unsigned char* vtb = B + 9216 + 5120;
            f32x16 s[2][2];
#pragma unroll
            for (int g = 0; g < 2; ++g)
#pragma unroll
                for (int i = 0; i < 16; ++i) { s[g][0][i] = 0.f; s[g][1][i] = 0.f; }
            __builtin_amdgcn_s_setprio(1);
#define A64_KA0(ks) ((ks) < 4 ? *(const LAS bf16x8*)(knb + r * 144 + (ks) * 32 + h * 16) : *(const LAS bf16x8*)(krb + r * 80 + ((ks) - 4) * 32 + h * 16))
#define A64_KA1(ks) ((ks) < 4 ? *(const LAS bf16x8*)(knb + (32 + r) * 144 + (ks) * 32 + h * 16) : *(const LAS bf16x8*)(krb + (32 + r) * 80 + ((ks) - 4) * 32 + h * 16))
#define A64_Q(g, ks) ((ks) < 2 ? qf[g][(ks) < 2 ? (ks) : 0] : qr[((g) * 4 + (ks) - 2) * 64])
            { bf16x8 a0 = A64_KA0(0), a1 = A64_KA1(0), q0 = A64_Q(0, 0), q1 = A64_Q(1, 0);
#pragma unroll
              for (int ks = 0; ks < 6; ++ks) {
                  bf16x8 na0 = a0, na1 = a1, nq0 = q0, nq1 = q1;
                  if (ks < 5) { na0 = A64_KA0(ks + 1); na1 = A64_KA1(ks + 1); nq0 = A64_Q(0, ks + 1); nq1 = A64_Q(1, ks + 1); }
                  __builtin_amdgcn_sched_barrier(0);
                  s[0][0] = mfma32(a0, q0, s[0][0]); s[1][0] = mfma32(a0, q1, s[1][0]); s[0][1] = mfma32(a1, q0, s[0][1]); s[1][1] = mfma32(a1, q1, s[1][1]);
                  __builtin_amdgcn_sched_barrier(0);
                  a0 = na0; a1 = na1; q0 = nq0; q1 = nq1; } }
#undef A64_KA0
#undef A64_KA1
#undef A64_Q
            __builtin_amdgcn_s_setprio(0);
            __builtin_amdgcn_sched_barrier(0);
            bf16x8 pf[2][4];
#pragma unroll
            for (int g = 0; g < 2; ++g) {
                float mx = s[g][0][0];
#pragma unroll
                for (int i = 0; i < 16; ++i) { mx = fmaxf(mx, s[g][0][i]); mx = fmaxf(mx, s[g][1][i]); }
                mx = fmaxf(mx, __shfl_xor(mx, 32));
                const float mnew = mx > m_run[g] + 8.f ? mx : m_run[g], alpha = __builtin_amdgcn_exp2f(m_run[g] - mnew);
                const bool resc = __builtin_amdgcn_ballot_w64(mnew != m_run[g]) != 0ull;
                m_run[g] = mnew;
                float ps = 0.f;
#pragma unroll
                for (int i = 0; i < 16; ++i) { s[g][0][i] = __builtin_amdgcn_exp2f(s[g][0][i] - mnew); s[g][1][i] = __builtin_amdgcn_exp2f(s[g][1][i] - mnew); ps += s[g][0][i] + s[g][1][i]; }
                l_run[g] = l_run[g] * alpha + ps;
                if (resc) {
#pragma unroll
                    for (int i = 0; i < 16; ++i) { o[g][0][i] *= alpha; o[g][1][i] *= alpha; } }
                pf[g][0] = pack8(s[g][0], 0); pf[g][1] = pack8(s[g][0], 8); pf[g][2] = pack8(s[g][1], 0); pf[g][3] = pack8(s[g][1], 8);
                __builtin_amdgcn_sched_barrier(0);
            }
            __builtin_amdgcn_s_setprio(1);
#define A64_VF(idx, lo_, hi_) const LAS u32x2* pa_##lo_ = (const LAS u32x2*)(vtb + (32 * ((idx) >> 2) + r) * 136 + (16 * ((idx) & 3) + 4 * h) * 2); u32x2 lo_ = pa_##lo_[0], hi_ = pa_##lo_[2]
            { A64_VF(0, lo, hi);
#pragma unroll
              for (int idx = 0; idx < 8; ++idx) {
                  u32x2 nlo = lo, nhi = hi;
                  if (idx < 7) { const LAS u32x2* pn = (const LAS u32x2*)(vtb + (32 * ((idx + 1) >> 2) + r) * 136 + (16 * ((idx + 1) & 3) + 4 * h) * 2); nlo = pn[0]; nhi = pn[2]; }
                  __builtin_amdgcn_sched_barrier(0);
                  u32x4 av; av[0] = lo[0]; av[1] = lo[1]; av[2] = hi[0]; av[3] = hi[1]; const bf16x8 avb = __builtin_bit_cast(bf16x8, av);
                  o[0][idx >> 2] = mfma32(avb, pf[0][idx & 3], o[0][idx >> 2]); o[1][idx >> 2] = mfma32(avb, pf[1][idx & 3], o[1][idx >> 2]);
                  __builtin_amdgcn_sched_barrier(0);
                  lo = nlo; hi = nhi; } }
#undef A64_VF
            __builtin_amdgcn_s_setprio(0);
        }
        if (more) A64_LSTORE((it + 1) & 1);
        __syncthreads();
    }
#undef A64_GLOAD
#undef A64_LSTORE
}
DI void phase_attn_p(const Params& p, LAS unsigned char* lds) {
    const int tid = tid_(), lane = tid & 63, wid = __builtin_amdgcn_readfirstlane(tid >> 6), r = lane & 31, h = lane >> 5;
    const bf16_t* Q = (const bf16_t*)(p.ws + OFF_Q); const bf16_t* KN = (const bf16_t*)(p.ws + OFF_KN); const bf16_t* VT = (const bf16_t*)(p.ws + OFF_VT);
    const bf16_t* KRO = (const bf16_t*)(p.ws + OFF_KROPE); bf16_t* O = (bf16_t*)(p.ws + OFF_O);
    for (int pair = bid_(); pair < 256; pair += gridDim.x) {
        const int bh = (pair & 7) * 4 + (pair >> 6), qa = (pair >> 3) & 7, b = bh >> 3, hd = bh & 7;
        for (int sub = 0; sub < 2; ++sub) {
            const int qb = sub ? qa : 15 - qa;
            const int t0 = qb * 512 + wid * 64 + r;
            f32x16 o[2][2]; float m_run[2], l_run[2];
            attn_core64(lds, Q + ((size_t)bh * 8192 + t0) * 96, KN + (size_t)bh * 8192 * 64, KRO + (size_t)b * 8192 * 32, VT + (size_t)bh * 64 * 8192, 8192,
                        8 * qb + 8, 8 * qb + wid + 1, o, m_run, l_run);
#pragma unroll
            for (int g = 0; g < 2; ++g) {
                const float inv = 1.f / (l_run[g] + __shfl_xor(l_run[g], 32));
                bf16_t* orow = O + ((size_t)b * 8192 + t0 + g * 32) * 512 + hd * 64;
#pragma unroll
                for (int dh = 0; dh < 2; ++dh)
#pragma unroll
                    for (int q4 = 0; q4 < 4; ++q4) { uint2 w; w.x = pack2(o[g][dh][4 * q4] * inv, o[g][dh][4 * q4 + 1] * inv); w.y = pack2(o[g][dh][4 * q4 + 2] * inv, o[g][dh][4 * q4 + 3] * inv); *(uint2*)(orow + 32 * dh + 8 * q4 + 4 * h) = w; }
            }
        }
    }
}
DI void phase_attn_s(const Params& p, LAS unsigned char* lds) {
    const int tid = tid_(), lane = tid & 63, wid = __builtin_amdgcn_readfirstlane(tid >> 6), r = lane & 31, h = lane >> 5;
    const bf16_t* Q = (const bf16_t*)(p.ws + OFF_Q); const bf16_t* KN = (const bf16_t*)(p.ws + OFF_KN); const bf16_t* VT = (const bf16_t*)(p.ws + OFF_VT);
    const bf16_t* KRO = (const bf16_t*)(p.ws + OFF_KROPE); float* PART = (float*)(p.ws + OFF_PART);
    for (int c = bid_(); c < 256; c += gridDim.x) {
        const int b = c >> 3, hg = (c >> 2) & 1, split = c & 3, hh = wid >> 1, head = hg * 4 + hh, t = (wid & 1) * 32 + r;
        f32x16 o[2]; float m_run, l_run;
        attn_core<4>(lds, Q + (size_t)MP * 768 + ((size_t)(b * 8 + head) * 64 + t) * 96, KN + (size_t)MP * 512 + (size_t)(b * 8 + hg * 4) * KEYS_S * 64, (size_t)KEYS_S * 64,
                     KRO + (size_t)MP * 32 + (size_t)b * KEYS_S * 32, VT + (size_t)MP * 512 + (size_t)(b * 8 + hg * 4) * 64 * KEYS_S, (size_t)64 * KEYS_S, KEYS_S,
                     split, 4, 17, split == 0 ? 17 : 16, 65, hh, o, m_run, l_run);
        const float lt = l_run + __shfl_xor(l_run, 32);
        float* pr = PART + (((size_t)(b * 8 + head) * 4 + split) * 64 + t) * 66;
#pragma unroll
        for (int dh = 0; dh < 2; ++dh)
#pragma unroll
            for (int g = 0; g < 4; ++g) { float2 a, bb; a.x = o[dh][4 * g]; a.y = o[dh][4 * g + 1]; bb.x = o[dh][4 * g + 2]; bb.y = o[dh][4 * g + 3]; float* d = pr + 32 * dh + 8 * g + 4 * h; *(float2*)d = a; *(float2*)(d + 2) = bb; }
        if (h == 0) { float2 ml; ml.x = m_run; ml.y = lt; *(float2*)(pr + 64) = ml; }
    }
}

constexpr int R_QF = 0, R_KF = 16384, R_G = 32768, R_VTI = 49152, R_KTI = 58368, R_QTI = 67584, R_STI = 76800, R_PPI = 86016, R_QHI = 95232, R_KHI = 102144,
              R_GA = 115968, R_WA = 120064, R_SEG = 122240, R_OF = 0, R_WALL = 124288, R_BA = 132480, R_LB = 132992, R_QD = 134016, R_KD = 143232;
struct RecPre { u32x4 uv, ua, uq, ug, gz; f32x4 s0, s1; };
DI uint4 to_u4(u32x4 v) { uint4 r; r.x = v[0]; r.y = v[1]; r.z = v[2]; r.w = v[3]; return r; }
DI float4 to_f4(f32x4 v) { float4 r; r.x = v[0]; r.y = v[1]; r.z = v[2]; r.w = v[3]; return r; }
DI void rec_tables(const Params& p, int l, LAS unsigned char* lds) {
    const int tid = tid_();
    LAS float* WALL = (LAS float*)(lds + R_WALL); LAS float* BA = (LAS float*)(lds + R_BA); LAS float* LB = (LAS float*)(lds + R_LB);
#pragma unroll
    for (int i = 0; i < 4; ++i) WALL[tid + 512 * i] = p.in[23][l * 2048 + tid + 512 * i];
    if (tid < 128) BA[tid] = p.in[24][l * 128 + tid];
    if (tid < 256) { float lb = 0.f; if (l == 1) { const float l0 = p.in[21][tid], l1 = p.in[21][256 + tid]; lb = 1.f / (1.f + expf(l0 - l1)); } LB[tid] = lb; }
    __syncthreads();
}
template <int DK, bool HG>
DI void rec_issue(const Params& p, int cid, int hd, bool passC, RecPre& r) {
    const int tid = tid_();
    const bf16_t* Z = (const bf16_t*)(p.ws + OFF_Z);
    const size_t row0 = (size_t)cid * 64;
    const int lj = tid >> 3, ls8 = (tid & 7) * 8;
    const bf16_t* zr = Z + (row0 + lj) * ZLD;
    r.uv = *(const u32x4*)(zr + (HG ? 1056 : 1824) + hd * 64 + ls8);
    if (HG) { r.ua = *(const u32x4*)(zr + 800 + hd * 64 + ls8); if (passC) r.uq = *(const u32x4*)(zr + 544 + hd * 64 + ls8); }
    else { if (tid < 256) { const bf16_t* z2 = Z + (row0 + (tid >> 2)) * ZLD; r.ua = *(const u32x4*)(z2 + 1696 + hd * 32 + (tid & 3) * 8); if (passC) r.uq = *(const u32x4*)(z2 + 1568 + hd * 32 + (tid & 3) * 8); }
           if (tid < 128) r.ug = *(const u32x4*)(Z + (row0 + (tid >> 1)) * ZLD + 2336 + (tid & 1) * 8); }
    if (passC) {
        const float* S = (const float*)(p.ws + (HG ? OFF_UHG : OFF_UGL)) + ((size_t)cid * 4 + hd) * DK * 64;
            if (tid < DK * 8) { const int k = tid >> 3, v0 = (tid & 7) * 8; r.s0 = *(const f32x4*)(S + k * 64 + v0); r.s1 = *(const f32x4*)(S + k * 64 + v0 + 4); }
        r.gz = *(const u32x4*)(zr + (HG ? 1312 : 2080) + hd * 64 + ls8);
    }
}
template <int DK, bool HG>
DI void rec_load(const RecPre& pre, LAS unsigned char* lds, int hd, bool need_q) {
    const int tid = tid_();
    LAS float* QF = (LAS float*)(lds + R_QF); LAS float* KF = (LAS float*)(lds + R_KF); LAS float* G = (LAS float*)(lds + R_G);
    LAS bf16_t* VTI = (LAS bf16_t*)(lds + R_VTI); LAS float* GA = (LAS float*)(lds + R_GA); LAS float* SEG = (LAS float*)(lds + R_SEG);
    const LAS float* WA = (const LAS float*)(lds + (HG ? R_LB : R_WALL)) + (HG ? hd * 64 : hd * 32);
    const LAS float* BA = (const LAS float*)(lds + R_BA) + hd * 32;
    const int lj = tid >> 3, ls8 = (tid & 7) * 8;
    const uint4 uv = to_u4(pre.uv), ua = to_u4(pre.ua), uq = to_u4(pre.uq);
    if (!HG) {
        if (tid < 128) { const int j = tid >> 1, hf = tid & 1; const uint4 u = to_u4(pre.ug); LAS float* ga = GA + j * 16 + hf * 8;
            ga[0] = bflo(u.x); ga[1] = bfhi(u.x); ga[2] = bflo(u.y); ga[3] = bfhi(u.y); ga[4] = bflo(u.z); ga[5] = bfhi(u.z); ga[6] = bflo(u.w); ga[7] = bfhi(u.w); }
        __syncthreads();
    }
    { const float va[8] = {bflo(ua.x), bfhi(ua.x), bflo(ua.y), bfhi(ua.y), bflo(ua.z), bfhi(ua.z), bflo(ua.w), bfhi(ua.w)};
      const float vq[8] = {bflo(uq.x), bfhi(uq.x), bflo(uq.y), bfhi(uq.y), bflo(uq.z), bfhi(uq.z), bflo(uq.w), bfhi(uq.w)};
      if (HG) { float gg[8], kk[8];
#pragma unroll
          for (int x = 0; x < 8; ++x) { const float lb = WA[ls8 + x], e = __expf(fminf(-va[x], 80.f)), s = 1.f / (1.f + e); gg[x] = logf(lb + (1.f - lb) * s); kk[x] = (1.f - lb) * e * s; }
          LAS f32x4* gp = (LAS f32x4*)(G + lj * 64 + ls8); LAS f32x4* kp = (LAS f32x4*)(KF + lj * 64 + ls8);
          gp[0] = (f32x4){gg[0], gg[1], gg[2], gg[3]}; gp[1] = (f32x4){gg[4], gg[5], gg[6], gg[7]}; kp[0] = (f32x4){kk[0], kk[1], kk[2], kk[3]}; kp[1] = (f32x4){kk[4], kk[5], kk[6], kk[7]};
          if (need_q) { LAS f32x4* qp = (LAS f32x4*)(QF + lj * 64 + ls8); qp[0] = (f32x4){vq[0], vq[1], vq[2], vq[3]}; qp[1] = (f32x4){vq[4], vq[5], vq[6], vq[7]}; } }
      else {
          { const int kq = (tid & 7) * 4; f32x4 x = *(const LAS f32x4*)(BA + kq);
#pragma unroll
            for (int r = 0; r < 16; ++r) { const float ga = GA[lj * 16 + r]; const f32x4 wv = *(const LAS f32x4*)(WA + r * 128 + kq); x += ga * wv; }
            f32x4 o;
#pragma unroll
            for (int y = 0; y < 4; ++y) o[y] = (fminf(x[y], 0.f) - log1pf(__expf(-fabsf(x[y])))) * (1.f / 16.f);
            *(LAS f32x4*)(G + lj * 32 + kq) = o; }
          if (tid < 256) { const int j2 = tid >> 2, k2 = (tid & 3) * 8; LAS f32x4* kp = (LAS f32x4*)(KF + j2 * 32 + k2); kp[0] = (f32x4){va[0], va[1], va[2], va[3]}; kp[1] = (f32x4){va[4], va[5], va[6], va[7]};
              if (need_q) { const float qs = 0.17677669529663687f; LAS f32x4* qp = (LAS f32x4*)(QF + j2 * 32 + k2); qp[0] = (f32x4){vq[0] * qs, vq[1] * qs, vq[2] * qs, vq[3] * qs}; qp[1] = (f32x4){vq[4] * qs, vq[5] * qs, vq[6] * qs, vq[7] * qs}; } } }
      const unsigned vv[4] = {uv.x, uv.y, uv.z, uv.w};
#pragma unroll
      for (int x = 0; x < 4; ++x) { VTI[(ls8 + 2 * x) * 72 + lj] = (bf16_t)(vv[x] & 0xFFFFu); VTI[(ls8 + 2 * x + 1) * 72 + lj] = (bf16_t)(vv[x] >> 16); } }
    __syncthreads();
    constexpr int NSEG = NT / DK, JS = 64 / NSEG;
    const int seg = tid / DK, k = tid % DK;
    float loc[JS]; float s = 0.f;
#pragma unroll
    for (int jj = 0; jj < JS; ++jj) { s += G[(seg * JS + jj) * DK + k]; loc[jj] = s; }
    SEG[seg * DK + k] = s;
    __syncthreads();
    float off = 0.f;
#pragma unroll
    for (int s2 = 0; s2 < NSEG; ++s2) { const float t = SEG[s2 * DK + k]; off += s2 < seg ? t : 0.f; }
#pragma unroll
    for (int jj = 0; jj < JS; ++jj) G[(seg * JS + jj) * DK + k] = loc[jj] + off;
    __syncthreads();
}
template <int DK, bool HG>
DI void rec_passA_item(const Params& p, int l, LAS unsigned char* lds, int cid, int hd, const RecPre& pre) {
    const int tid = tid_(), lane = tid & 63, wid = __builtin_amdgcn_readfirstlane(tid >> 6), fr = lane & 15, fq = lane >> 4;
    rec_load<DK, HG>(pre, lds, hd, false);
    LAS float* KF = (LAS float*)(lds + R_KF); LAS float* G = (LAS float*)(lds + R_G);
    LAS bf16_t* VTI = (LAS bf16_t*)(lds + R_VTI); LAS bf16_t* KTI = (LAS bf16_t*)(lds + R_KTI);
    float* U = (float*)(p.ws + (HG ? OFF_UHG : OFF_UGL)); float* D = (float*)(p.ws + (HG ? OFF_DHG : OFF_DGL));
    for (int e = tid; e < 64 * DK; e += NT) { const int j = e / DK, k = e % DK; KTI[k * 72 + j] = f2bf(KF[e] * __expf(G[63 * DK + k] - G[e])); }
    if (tid < DK) D[((size_t)cid * 4 + hd) * DK + tid] = __expf(G[63 * DK + tid]);
    __syncthreads();
    for (int tile = wid; tile < (DK / 16) * 4; tile += 8) {
        const int tk = tile >> 2, tv = tile & 3; f32x4 acc = {0.f, 0.f, 0.f, 0.f};
#pragma unroll
        for (int s = 0; s < 2; ++s) { const bf16x8 a = *(const LAS bf16x8*)(KTI + (16 * tk + fr) * 72 + 32 * s + 8 * fq), b = *(const LAS bf16x8*)(VTI + (16 * tv + fr) * 72 + 32 * s + 8 * fq); acc = mfma16(a, b, acc); }
#pragma unroll
        for (int reg = 0; reg < 4; ++reg) U[(((size_t)cid * 4 + hd) * DK + 16 * tk + 4 * fq + reg) * 64 + 16 * tv + fr] = acc[reg];
    }
    __syncthreads();
}
template <int DK, bool HG>
DI void rec_passC_item(const Params& p, int l, LAS unsigned char* lds, int cid, int hd, const RecPre& pre) {
    const int tid = tid_(), lane = tid & 63, wid = __builtin_amdgcn_readfirstlane(tid >> 6), fr = lane & 15, fq = lane >> 4;
    rec_load<DK, HG>(pre, lds, hd, true);
    LAS float* QF = (LAS float*)(lds + R_QF); LAS float* KF = (LAS float*)(lds + R_KF); LAS float* G = (LAS float*)(lds + R_G); LAS float* OF = (LAS float*)(lds + R_OF);
    LAS bf16_t* VTI = (LAS bf16_t*)(lds + R_VTI); LAS bf16_t* QTI = (LAS bf16_t*)(lds + R_QTI); LAS bf16_t* STI = (LAS bf16_t*)(lds + R_STI);
    LAS bf16_t* PPI = (LAS bf16_t*)(lds + R_PPI); LAS bf16_t* QHI = (LAS bf16_t*)(lds + R_QHI); LAS bf16_t* KHI = (LAS bf16_t*)(lds + R_KHI);
    const bf16_t* Z = (const bf16_t*)(p.ws + OFF_Z); bf16_t* H = (bf16_t*)(p.ws + OFF_H);
    for (int e = tid; e < 64 * DK; e += NT) { const int i = e / DK, k = e % DK; QTI[i * 72 + k] = f2bf(QF[e] * __expf(G[e])); }
    if (tid < DK * 8) { const int k = tid >> 3, v0 = (tid & 7) * 8; const float4 s0 = to_f4(pre.s0), s1 = to_f4(pre.s1);
        STI[(v0 + 0) * 72 + k] = f2bf(s0.x); STI[(v0 + 1) * 72 + k] = f2bf(s0.y); STI[(v0 + 2) * 72 + k] = f2bf(s0.z); STI[(v0 + 3) * 72 + k] = f2bf(s0.w);
        STI[(v0 + 4) * 72 + k] = f2bf(s1.x); STI[(v0 + 5) * 72 + k] = f2bf(s1.y); STI[(v0 + 6) * 72 + k] = f2bf(s1.z); STI[(v0 + 7) * 72 + k] = f2bf(s1.w); }
    for (int e = tid; e < 48 * DK; e += NT) { const int ii = e / DK, k = e % DK, I = 1 + (ii >> 4), i = 16 + ii; const float ref = G[(16 * I - 1) * DK + k];
        QHI[ii * 72 + k] = f2bf(QF[i * DK + k] * __expf(G[i * DK + k] - ref)); }
    for (int e = tid; e < 96 * DK; e += NT) { const int rr = e / DK, k = e % DK, I = rr < 16 ? 1 : (rr < 48 ? 2 : 3), j = rr - 8 * I * (I - 1); const float ref = G[(16 * I - 1) * DK + k];
        KHI[rr * 72 + k] = f2bf(KF[j * DK + k] * __expf(ref - G[j * DK + k])); }
    { LAS bf16_t* QD = (LAS bf16_t*)(lds + R_QD); LAS bf16_t* KD = (LAS bf16_t*)(lds + R_KD);
      for (int e = tid; e < 64 * DK; e += NT) { const int i = e / DK, k = e % DK; const float ref = G[(16 * (i >> 4) + 7) * DK + k], gi = G[e];
          QD[i * 72 + k] = f2bf(QF[e] * __expf(fminf(fmaxf(gi - ref, -80.f), 80.f))); KD[i * 72 + k] = f2bf(KF[e] * __expf(fminf(fmaxf(ref - gi, -80.f), 80.f))); } }
    for (int e = tid; e < 1536; e += NT) { const int bidx = e >> 8, w = e & 255; const int I = bidx < 3 ? 0 : (bidx < 5 ? 1 : 2), J = bidx < 3 ? bidx + 1 : (bidx < 5 ? bidx - 1 : 3);
        PPI[(16 * I + (w >> 4)) * 72 + 16 * J + (w & 15)] = 0; }
    __syncthreads();
    if (wid >= 6) { const LAS bf16_t* QD = (const LAS bf16_t*)(lds + R_QD); const LAS bf16_t* KD = (const LAS bf16_t*)(lds + R_KD);
#pragma unroll
        for (int t2 = 0; t2 < 2; ++t2) { const int I = (wid - 6) * 2 + t2; f32x4 acc = {0.f, 0.f, 0.f, 0.f};
#pragma unroll
            for (int s = 0; s < DK / 32; ++s) { const bf16x8 a = *(const LAS bf16x8*)(QD + (16 * I + fr) * 72 + 32 * s + 8 * fq), b = *(const LAS bf16x8*)(KD + (16 * I + fr) * 72 + 32 * s + 8 * fq); acc = mfma16(a, b, acc); }
#pragma unroll
            for (int reg = 0; reg < 4; ++reg) PPI[(16 * I + 4 * fq + reg) * 72 + 16 * I + fr] = f2bf(fr <= 4 * fq + reg ? acc[reg] : 0.f); } }
    if (wid < 6) { const int I = wid < 1 ? 1 : (wid < 3 ? 2 : 3), J = wid < 1 ? 0 : (wid < 3 ? wid - 1 : wid - 3); f32x4 acc = {0.f, 0.f, 0.f, 0.f};
#pragma unroll
        for (int s = 0; s < DK / 32; ++s) { const bf16x8 a = *(const LAS bf16x8*)(QHI + ((I - 1) * 16 + fr) * 72 + 32 * s + 8 * fq), b = *(const LAS bf16x8*)(KHI + (8 * I * (I - 1) + 16 * J + fr) * 72 + 32 * s + 8 * fq); acc = mfma16(a, b, acc); }
#pragma unroll
        for (int reg = 0; reg < 4; ++reg) PPI[(16 * I + 4 * fq + reg) * 72 + 16 * J + fr] = f2bf(acc[reg]); }
    __syncthreads();
#pragma unroll
    for (int tt = 0; tt < 2; ++tt) { const int tile = wid * 2 + tt, ti = tile >> 2, tv = tile & 3; f32x4 acc = {0.f, 0.f, 0.f, 0.f};
#pragma unroll
        for (int s = 0; s < DK / 32; ++s) { const bf16x8 a = *(const LAS bf16x8*)(QTI + (16 * ti + fr) * 72 + 32 * s + 8 * fq), b = *(const LAS bf16x8*)(STI + (16 * tv + fr) * 72 + 32 * s + 8 * fq); acc = mfma16(a, b, acc); }
#pragma unroll
        for (int s = 0; s < 2; ++s) { const bf16x8 a = *(const LAS bf16x8*)(PPI + (16 * ti + fr) * 72 + 32 * s + 8 * fq), b = *(const LAS bf16x8*)(VTI + (16 * tv + fr) * 72 + 32 * s + 8 * fq); acc = mfma16(a, b, acc); }
#pragma unroll
        for (int reg = 0; reg < 4; ++reg) OF[(16 * ti + 4 * fq + reg) * 65 + 16 * tv + fr] = acc[reg]; }
    __syncthreads();
    { const int i = tid >> 3, part = tid & 7; float v[8]; float ss = 0.f;
#pragma unroll
      for (int x = 0; x < 8; ++x) { v[x] = OF[i * 65 + part * 8 + x]; ss += v[x] * v[x]; }
      ss += __shfl_xor(ss, 1); ss += __shfl_xor(ss, 2); ss += __shfl_xor(ss, 4);
      const float rs = rsqrtf(ss * (1.f / 64.f) + EPS);
      const size_t row = (size_t)cid * 64 + i;
      const uint4 gz = to_u4(pre.gz);
      const float* go = p.in[HG ? 22 : 25] + l * 64 + part * 8;
      const float gt[8] = {bflo(gz.x), bfhi(gz.x), bflo(gz.y), bfhi(gz.y), bflo(gz.z), bfhi(gz.z), bflo(gz.w), bfhi(gz.w)};
      float r[8];
#pragma unroll
      for (int x = 0; x < 8; ++x) r[x] = v[x] * rs * go[x] * (gt[x] / (1.f + __expf(-gt[x])));
      uint4 w; w.x = pack2(r[0], r[1]); w.y = pack2(r[2], r[3]); w.z = pack2(r[4], r[5]); w.w = pack2(r[6], r[7]);
      *(uint4*)(H + row * 1024 + 512 + (HG ? 0 : 256) + hd * 64 + part * 8) = w; }
    __syncthreads();
}
template <int DK>
DI void scan_prompt(float* U, const float* D, float* outp, int e) {
    const int v = e & 63, k = (e >> 6) % DK, hd = (e / (64 * DK)) & 3, b = e / (256 * DK);
    float S = 0.f;
    for (int n0 = 0; n0 < 128; n0 += 16) {
        float u[16], d[16];
#pragma unroll
        for (int i = 0; i < 16; ++i) { const size_t ch = ((size_t)(b * 128 + n0 + i) * 4 + hd); u[i] = U[(ch * DK + k) * 64 + v]; d[i] = D[ch * DK + k]; }
#pragma unroll
        for (int i = 0; i < 16; ++i) { const size_t ch = ((size_t)(b * 128 + n0 + i) * 4 + hd); U[(ch * DK + k) * 64 + v] = S; S = d[i] * S + u[i]; }
    }
    outp[e] = S;
}
template <int DK>
DI void scan_sample(float* U, const float* D, const float* s0p, float* outp, int e) {
    const int v = e & 63, k = (e >> 6) % DK, hd = (e / (64 * DK)) & 3, b = e / (256 * DK);
    const size_t ch = (size_t)(512 + b) * 4 + hd; const size_t idx = (ch * DK + k) * 64 + v;
    const float s0 = s0p[e], u = U[idx], d = D[ch * DK + k];
    U[idx] = s0; outp[e] = d * s0 + u;
}
DI void phase_scan(const Params& p, int l) {
    const int g = bid_() * NT + tid_(), gs = gridDim.x * NT;
    float* UH = (float*)(p.ws + OFF_UHG); const float* DH = (const float*)(p.ws + OFF_DHG); float* UG = (float*)(p.ws + OFF_UGL); const float* DG = (const float*)(p.ws + OFF_DGL);
    for (int e = g; e < 98304; e += gs) {
        if (e < 65536) scan_prompt<64>(UH, DH, p.out + OUT_HGP + (size_t)l * 65536, e);
        else scan_prompt<32>(UG, DG, p.out + OUT_GLP + (size_t)l * 32768, e - 65536);
    }
    for (int e = g; e < 786432; e += gs) {
        if (e < 524288) scan_sample<64>(UH, DH, p.in[6] + (size_t)l * 524288, p.out + OUT_HGS + (size_t)l * 524288, e);
        else scan_sample<32>(UG, DG, p.in[7] + (size_t)l * 262144, p.out + OUT_GLS + (size_t)l * 262144, e - 524288);
    }
}
DI void phase_mlaout(const Params& p, int l) {
    const int tid = tid_(), lane = tid & 63, wid = __builtin_amdgcn_readfirstlane(tid >> 6);
    const bf16_t* O = (const bf16_t*)(p.ws + OFF_O); const float* PART = (const float*)(p.ws + OFF_PART); bf16_t* H = (bf16_t*)(p.ws + OFF_H);
    const float* g = p.in[20] + l * 512 + 8 * lane;
    for (int row = bid_() * 8 + wid; row < MT; row += gridDim.x * 8) {
        float v[8];
        if (row < MP) { const uint4 u = *(const uint4*)(O + (size_t)row * 512 + 8 * lane);
            v[0] = bflo(u.x); v[1] = bfhi(u.x); v[2] = bflo(u.y); v[3] = bfhi(u.y); v[4] = bflo(u.z); v[5] = bfhi(u.z); v[6] = bflo(u.w); v[7] = bfhi(u.w); }
        else { const int r = row - MP, b = r >> 6, t = r & 63, head = lane >> 3, dv0 = (lane & 7) * 8;
            const float* pb = PART + (((size_t)(b * 8 + head) * 4) * 64 + t) * 66;
            float m[4], lsum[4]; float M = neg_big();
#pragma unroll
            for (int s = 0; s < 4; ++s) { m[s] = pb[(size_t)s * 64 * 66 + 64]; lsum[s] = pb[(size_t)s * 64 * 66 + 65]; M = fmaxf(M, m[s]); }
            float L = 0.f;
#pragma unroll
            for (int x = 0; x < 8; ++x) v[x] = 0.f;
#pragma unroll
            for (int s = 0; s < 4; ++s) { const float w = exp2f(m[s] - M); L += w * lsum[s];
#pragma unroll
                for (int x = 0; x < 8; ++x) v[x] += w * pb[(size_t)s * 64 * 66 + dv0 + x]; }
            const float inv = 1.f / L;
#pragma unroll
            for (int x = 0; x < 8; ++x) v[x] *= inv; }
        float ss = 0.f;
#pragma unroll
        for (int x = 0; x < 8; ++x) ss += v[x] * v[x];
        ss = wave_sum(ss);
        const float rs = rsqrtf(ss * (1.f / 512.f) + EPS);
        uint4 w; w.x = pack2(v[0] * rs * g[0], v[1] * rs * g[1]); w.y = pack2(v[2] * rs * g[2], v[3] * rs * g[3]); w.z = pack2(v[4] * rs * g[4], v[5] * rs * g[5]); w.w = pack2(v[6] * rs * g[6], v[7] * rs * g[7]);
        *(uint4*)(H + (size_t)row * 1024 + 8 * lane) = w;
    }
}

DI void gsync(const Params& p, LAS unsigned char* lds) { XcdBarrier b; b.bar = (unsigned*)(p.ws + OFF_BAR); b.x = xb_xcc_id(); b.st = (volatile LAS unsigned*)(lds + LDS_BYTES - 16); xcd_barrier(b); }
__global__ void __launch_bounds__(512, 2) mk_fwd(Params p) {
    extern __shared__ __attribute__((aligned(16))) unsigned char shm[];
    LAS unsigned char* lds = (LAS unsigned char*)shm;
    cg::grid_group grid = cg::this_grid();
    bf16_t* H = (bf16_t*)(p.ws + OFF_H); bf16_t* Z = (bf16_t*)(p.ws + OFF_Z); bf16_t* CQN = (bf16_t*)(p.ws + OFF_CQN); bf16_t* CKV = (bf16_t*)(p.ws + OFF_CKV);
    bf16_t* Q = (bf16_t*)(p.ws + OFF_Q); bf16_t* KN = (bf16_t*)(p.ws + OFF_KN); bf16_t* VT = (bf16_t*)(p.ws + OFF_VT); bf16_t* ACT = (bf16_t*)(p.ws + OFF_ACT);
    const float* rope = (const float*)(p.ws + OFF_ROPE); bf16_t* XB = (bf16_t*)(p.ws + OFF_XB);
    volatile LAS unsigned* xst = (volatile LAS unsigned*)(lds + LDS_BYTES - 16);
    if (threadIdx.x == 0) { xst[0] = 0u; xst[1] = 0u; }
    __syncthreads();
    (void)xcd_barrier_post((unsigned*)(p.ws + OFF_BAR), xst);
    phase_prep(p, lds);
    grid.sync();
#pragma unroll 1
    for (int l = 0; l < 2; ++l) {
        const unsigned char* W = p.ws + OFF_W + (size_t)l * WL;
        const float* modl = (const float*)(p.ws + OFF_MOD) + (size_t)l * 36 * 6144;
        const int hb0 = (int)gridDim.x > 64 ? 32 : 0, hnb = (int)gridDim.x - hb0;
        if (l == 0) { phase_hrows<true>(p, l, p.in[0], p.in[1], p.in[10] + l * 1024, 0, 1024); gsync(p, lds); }
        run_gemm(lds, H, (const bf16_t*)(W + WOFF_IN), MT, 2560, 1024, EpiZ{Z, ZLD});
        {
          const int G = (int)gridDim.x, rem = ((MT / 256) * (2560 / 256)) % G;
          if (rem > 0 && G - rem >= G / 2) { if ((int)bid_() >= rem) phase_cache(p, l, rem, G - rem); } else phase_cache(p, l, 0, G); }
        gsync(p, lds);
        phase_post(p, l);
        rec_tables(p, l, lds);
        { RecPre pre = {}; int it = bid_(); if (it < 2176) rec_issue<64, true>(p, it >> 2, it & 3, false, pre);
          for (; it < 2176; it += gridDim.x) { const RecPre cur = pre; const int nx = it + gridDim.x; if (nx < 2176) rec_issue<64, true>(p, nx >> 2, nx & 3, false, pre); rec_passA_item<64, true>(p, l, lds, it >> 2, it & 3, cur); } }
        { RecPre pre = {}; int it = (int)((bid_() + gridDim.x / 2) % gridDim.x); if (it < 2176) rec_issue<32, false>(p, it >> 2, it & 3, false, pre);
          for (; it < 2176; it += gridDim.x) { const RecPre cur = pre; const int nx = it + gridDim.x; if (nx < 2176) rec_issue<32, false>(p, nx >> 2, nx & 3, false, pre); rec_passA_item<32, false>(p, l, lds, it >> 2, it & 3, cur); } }
        gsync(p, lds);
        run_gemm(lds, CQN, (const bf16_t*)(W + WOFF_UQ), MT, 768, 256, EpiQ{Q, p.in[18] + l * 96, rope});
        run_gemm(lds, CKV, (const bf16_t*)(W + WOFF_UK), KR_ROWS, 512, 256, EpiKN{KN, p.in[19] + l * 96}, 104);
        run_gemm(lds, (const bf16_t*)(W + WOFF_UV), CKV, 512, KR_ROWS, 256, EpiVT{VT}, 40);
        phase_scan(p, l);
        gsync(p, lds);
        phase_attn_p(p, lds);
        phase_attn_s(p, lds);
        rec_tables(p, l, lds);
        { RecPre pre = {}; int it = bid_(); if (it < 2176) rec_issue<64, true>(p, it >> 2, it & 3, true, pre);
          for (; it < 2176; it += gridDim.x) { const RecPre cur = pre; const int nx = it + gridDim.x; if (nx < 2176) rec_issue<64, true>(p, nx >> 2, nx & 3, true, pre); rec_passC_item<64, true>(p, l, lds, it >> 2, it & 3, cur); } }
        { RecPre pre = {}; int it = (int)((bid_() + gridDim.x / 2) % gridDim.x); if (it < 2176) rec_issue<32, false>(p, it >> 2, it & 3, true, pre);
          for (; it < 2176; it += gridDim.x) { const RecPre cur = pre; const int nx = it + gridDim.x; if (nx < 2176) rec_issue<32, false>(p, nx >> 2, nx & 3, true, pre); rec_passC_item<32, false>(p, l, lds, it >> 2, it & 3, cur); } }
        gsync(p, lds);
        phase_mlaout(p, l);
        gsync(p, lds);
        run_gemm(lds, H, (const bf16_t*)(W + WOFF_O), MP, 1024, 1024, EpiRes{XB, p.out, modl + 2048, 0, 0});
        gsync(p, lds);
        run_gemm(lds, H + (size_t)MP * 1024, (const bf16_t*)(W + WOFF_O), MS, 1024, 1024, EpiRes{XB, p.out, modl + 2048, 0, MP / 256});
        if ((int)bid_() >= hb0) phase_hrows<false>(p, l, nullptr, nullptr, p.in[11] + l * 1024, 3072, 4096, 0, MP, hb0, hnb);
        gsync(p, lds);
        phase_hrows<false>(p, l, nullptr, nullptr, p.in[11] + l * 1024, 3072, 4096, MP, MT);
        gsync(p, lds);
        run_gemm(lds, H, (const bf16_t*)(W + WOFF_FI), MT, 5632, 1024, EpiSwi{ACT});
        gsync(p, lds);
        if (l == 0) {
            run_gemm(lds, ACT, (const bf16_t*)(W + WOFF_FO), MP, 1024, 2816, EpiRes{XB, p.out, modl + 5120, 0, 0});
            gsync(p, lds);
            run_gemm(lds, ACT + (size_t)MP * 2816, (const bf16_t*)(W + WOFF_FO), MS, 1024, 2816, EpiRes{XB, p.out, modl + 5120, 0, MP / 256});
            if ((int)bid_() >= hb0) phase_hrows<false>(p, 1, nullptr, nullptr, p.in[10] + 1024, 0, 1024, 0, MP, hb0, hnb);
            gsync(p, lds);
            phase_hrows<false>(p, 1, nullptr, nullptr, p.in[10] + 1024, 0, 1024, MP, MT);
            gsync(p, lds);
        } else run_gemm(lds, ACT, (const bf16_t*)(W + WOFF_FO), MT, 1024, 2816, EpiRes{XB, p.out, modl + 5120, 1, 0});
    }
}

extern "C" void kernel_launch(void* const* d_in, const int* in_sizes, int n_in, void* d_out, int out_size, void* d_ws, size_t ws_size, hipStream_t stream) {
    static int grid = 0;
    if (grid == 0) {
        int dev = 0, cus = 0, per_cu = 0;
        hipGetDevice(&dev);
        hipDeviceGetAttribute(&cus, hipDeviceAttributeMultiprocessorCount, dev);
        hipFuncSetAttribute((const void*)mk_fwd, hipFuncAttributeMaxDynamicSharedMemorySize, LDS_BYTES);
        hipOccupancyMaxActiveBlocksPerMultiprocessor(&per_cu, (const void*)mk_fwd, NT, LDS_BYTES);
        if (per_cu < 1) { fprintf(stderr, "kernel_launch: occupancy query says %d blocks per CU\n", per_cu); per_cu = 1; }
        (void)hipGetLastError();
        grid = cus;
        if (ws_size < WS_END) { fprintf(stderr, "kernel_launch: workspace too small: %zu < %zu\n", ws_size, (size_t)WS_END); grid = -1; }
    }
    if (grid < 0) return;
    if (hipMemsetAsync((char*)d_ws + OFF_BAR, 0, XCD_BAR_WORDS * 4, stream) != hipSuccess) { fprintf(stderr, "kernel_launch: memset failed\n"); return; }
    Params p{};
    for (int i = 0; i < 29; ++i) p.in[i] = (const float*)d_in[i];
    p.out = (float*)d_out; p.ws = (unsigned char*)d_ws;
    void* args[] = {&p};
    hipError_t e = hipLaunchCooperativeKernel((const void*)mk_fwd, dim3(grid), dim3(NT), args, LDS_BYTES, stream);
    if (e != hipSuccess) fprintf(stderr, "cooperative launch failed: %s (grid %d)\n", hipGetErrorString(e), grid);
}
```

```cpp
#include <hip/hip_runtime.h>
#include <hip/hip_cooperative_groups.h>
#include <cstdio>
namespace cg = cooperative_groups;
namespace pg8 {
#define PG8_LAS __attribute__((address_space(3)))
typedef unsigned short bf16_t;
typedef short bf16x8 __attribute__((ext_vector_type(8)));
typedef float f32x4 __attribute__((ext_vector_type(4)));
typedef unsigned u32x4 __attribute__((ext_vector_type(4)));
constexpr int BM = 256, BK = 64, HALF = 128, HTB = HALF * BK * 2  , STAGE_BYTES = 8 * HTB, NXCD = 8, WGM = 8;

__host__ __device__ __forceinline__ int lds_byte(int r, int c) { const int st = (r >> 4) * 2 + (c >> 5), rr = r & 15, cc = c & 31, ob = rr * 64 + cc * 2; return st * 1024 + (ob ^ (((ob >> 9) & 1) << 5)); }
__host__ __device__ __forceinline__ void stage_rc(int b, int& R, int& C) { const int st = b / 1024, sb = b % 1024, swz = sb ^ (((sb >> 9) & 1) << 5); R = (st >> 1) * 16 + swz / 64; C = (st & 1) * 32 + (swz % 64) / 2; }
__host__ __device__ __forceinline__ int perm32(int rho) { const int n = rho >> 4, i = rho & 15; return 8 * (i >> 2) + 4 * n + (i & 3); }

struct Unit { int pm, pn; };
struct Gemm { const bf16_t* A; const bf16_t* Bt; int M, N, K; };

struct StaticOrder {
    int nM, nN, nwg, G, c;
    __host__ __device__ void init(int M, int N, int G_, int c_) { nM = M / BM; nN = N / BM; nwg = nM * nN; G = G_; c = c_; }
    __host__ __device__ bool next(int i, Unit& u) const {
        const long L = (long)i * G + c; if (L >= nwg) return false;
        int wgid = (int)L; { const int q = nwg / NXCD, r = nwg % NXCD, xcd = wgid % NXCD, off = wgid / NXCD; wgid = (xcd < r ? xcd * (q + 1) : r * (q + 1) + (xcd - r) * q) + off; }
        const int nig = WGM * nN, gid = wgid / nig, fm = gid * WGM, gsz = (nM - fm) < WGM ? (nM - fm) : WGM;
        u.pm = fm + ((wgid % nig) % gsz); u.pn = (wgid % nig) / gsz; return true;
    }
    __device__ __forceinline__ void a_ready(const Unit&) const {}
    __device__ __forceinline__ void done(const Unit&) const {}
};
template <class Epi, class Sched, bool STAMP = false>
__device__ __forceinline__ void gemm_phase(PG8_LAS unsigned char* lds, const Gemm g, const Sched& S, const Epi& E, unsigned long long* stamps) {
    int tid = threadIdx.x; asm volatile("" : "+v"(tid)); const int wid = __builtin_amdgcn_readfirstlane(tid >> 6), lane = tid & 63, wr = wid >> 2, wc = wid & 3, fr = lane & 15, fq = lane >> 4;
    const int K = g.K, nt = K / BK;
    int ts_lo = 0, ts_hi = 0, nts = 0; const unsigned long long rt_entry = STAMP ? (unsigned long long)wall_clock64() : 0ull;
#define PG8_STAMP() do { if (STAMP && wid == 0 && nts < 64) { const unsigned long long _c = (unsigned long long)clock64(); \
        ts_lo = (lane == nts) ? (int)(unsigned)_c : ts_lo; ts_hi = (lane == nts) ? (int)(unsigned)(_c >> 32) : ts_hi; ++nts; } } while (0)
    PG8_STAMP();
    unsigned voffA[2], voffB[2];
#pragma unroll
    for (int i = 0; i < 2; ++i) { int R, C; stage_rc(tid * 16 + i * 8192, R, C); const int Rb = Epi::PERM ? ((R & ~31) + perm32(R & 31)) : R;
        voffA[i] = (unsigned)(R * K + C) * 2u; voffB[i] = (unsigned)(Rb * K + C) * 2u; }
    const size_t kstep = (size_t)(BK * 2);
    const size_t hstep = (size_t)HALF * K * 2;
    const size_t tstep = 2 * hstep;
    const unsigned ldsw = (unsigned)wid * 1024u;
    const int aoff = lds_byte(wr * 64 + fr, fq * 8), boff = lds_byte(wc * 32 + fr, fq * 8);
#define PG8_SA(b, h) (((b) * 2 + (h)) * HTB)
#define PG8_SB(b, h) ((4 + (b) * 2 + (h)) * HTB)
#define PG8_STAGE(bufoff, gbase, voff) do { _Pragma("unroll") for (int _i = 0; _i < 2; ++_i) \
        __builtin_amdgcn_global_load_lds((const unsigned*)((const char*)(gbase) + (voff)[_i]), (PG8_LAS unsigned*)(lds + (bufoff) + ldsw + _i * 8192), 16, 0, 0); } while (0)
#define PG8_LDA(dst, b, h) do { _Pragma("unroll") for (int m = 0; m < 4; ++m) _Pragma("unroll") for (int k = 0; k < 2; ++k) dst[m][k] = *(const PG8_LAS bf16x8*)(lds + PG8_SA(b, h) + aoff + m * 2048 + k * 1024); } while (0)
#define PG8_LDB(dst, b, h) do { _Pragma("unroll") for (int n = 0; n < 2; ++n) _Pragma("unroll") for (int k = 0; k < 2; ++k) dst[n][k] = *(const PG8_LAS bf16x8*)(lds + PG8_SB(b, h) + boff + n * 2048 + k * 1024); } while (0)
#define PG8_MMA(ai, bj, At, Bt) do { __builtin_amdgcn_s_setprio(1); _Pragma("unroll") for (int m = 0; m < 4; ++m) _Pragma("unroll") for (int n = 0; n < 2; ++n) _Pragma("unroll") for (int k = 0; k < 2; ++k) \
        acc[ai][bj][m][n] = __builtin_amdgcn_mfma_f32_16x16x32_bf16(Bt[n][k], At[m][k], acc[ai][bj][m][n], 0, 0, 0); __builtin_amdgcn_s_setprio(0); } while (0)
#define PG8_WAIT_V(n) asm volatile("s_waitcnt vmcnt(" #n ")" ::: "memory")
#define PG8_WAIT_L(n) asm volatile("s_waitcnt lgkmcnt(" #n ")" ::: "memory")
#define PG8_BAR __builtin_amdgcn_s_barrier()
#define PG8_SCHED __builtin_amdgcn_sched_barrier(0)
    Unit cur, nxt; int ui = 0;
    if (!S.next(0, cur)) return;
    f32x4 acc[2][2][4][2];
#pragma unroll
    for (int a = 0; a < 2; ++a)
#pragma unroll
        for (int b = 0; b < 2; ++b)
#pragma unroll
            for (int m = 0; m < 4; ++m)
#pragma unroll
                for (int n = 0; n < 2; ++n) acc[a][b][m][n] = (f32x4){0.f, 0.f, 0.f, 0.f};
    bf16x8 At[4][2], B0[2][2], B1[2][2];
    const char* cA = (const char*)g.A + (size_t)cur.pm * tstep; const char* cB = (const char*)g.Bt + (size_t)cur.pn * tstep;
    S.a_ready(cur);
    PG8_STAGE(PG8_SB(0, 0), cB, voffB); PG8_STAGE(PG8_SA(0, 0), cA, voffA); PG8_STAGE(PG8_SB(0, 1), cB + hstep, voffB); PG8_STAGE(PG8_SA(0, 1), cA + hstep, voffA);
    if (wr == 1) PG8_BAR;
    PG8_WAIT_V(4); PG8_BAR;
    PG8_STAGE(PG8_SB(1, 0), cB + kstep, voffB); PG8_STAGE(PG8_SA(1, 0), cA + kstep, voffA); PG8_STAGE(PG8_SB(1, 1), cB + hstep + kstep, voffB);
    PG8_WAIT_V(6); PG8_BAR;
    PG8_STAMP();
    for (;;) {
        const bool has_next = S.next(ui + 1, nxt);
        const char* nA = has_next ? (const char*)g.A + (size_t)nxt.pm * tstep : cA; const char* nB = has_next ? (const char*)g.Bt + (size_t)nxt.pn * tstep : cB;
        for (int t = 0; t < nt; t += 2) {
            const bool last = (t == nt - 2);
            const char* a1 = cA + (size_t)(t + 1) * kstep;
            const char* a2 = last ? nA : cA + (size_t)(t + 2) * kstep; const char* b2 = last ? nB : cB + (size_t)(t + 2) * kstep;
            const char* a3 = a2 + kstep; const char* b3 = b2 + kstep;
            if (last && has_next) S.a_ready(nxt);
            PG8_LDB(B0, 0, 0); PG8_SCHED; PG8_LDA(At, 0, 0); PG8_STAGE(PG8_SA(1, 1), a1 + hstep, voffA);
            PG8_WAIT_L(8); PG8_BAR; PG8_WAIT_L(0); PG8_MMA(0, 0, At, B0); PG8_BAR; PG8_SCHED;
            PG8_LDB(B1, 0, 1); PG8_STAGE(PG8_SB(0, 0), b2, voffB);
            PG8_BAR; PG8_WAIT_L(0); PG8_MMA(0, 1, At, B1); PG8_BAR;
            PG8_LDA(At, 0, 1); PG8_STAGE(PG8_SA(0, 0), a2, voffA);
            PG8_BAR; PG8_WAIT_L(0); PG8_MMA(1, 0, At, B0); PG8_BAR; PG8_SCHED;
            PG8_STAGE(PG8_SB(0, 1), b2 + hstep, voffB);
            PG8_WAIT_V(6); PG8_BAR; PG8_MMA(1, 1, At, B1); PG8_BAR;
            PG8_LDB(B0, 1, 0); PG8_SCHED; PG8_LDA(At, 1, 0); PG8_STAGE(PG8_SA(0, 1), a2 + hstep, voffA);
            PG8_WAIT_L(8); PG8_BAR; PG8_WAIT_L(0); PG8_MMA(0, 0, At, B0); PG8_BAR; PG8_SCHED;
            PG8_LDB(B1, 1, 1); PG8_STAGE(PG8_SB(1, 0), b3, voffB);
            PG8_BAR; PG8_WAIT_L(0); PG8_MMA(0, 1, At, B1); PG8_BAR;
            PG8_LDA(At, 1, 1); PG8_STAGE(PG8_SA(1, 0), a3, voffA);
            PG8_BAR; PG8_WAIT_L(0); PG8_MMA(1, 0, At, B0); PG8_BAR; PG8_SCHED;
            PG8_STAGE(PG8_SB(1, 1), b3 + hstep, voffB);
            PG8_WAIT_V(6); PG8_BAR; PG8_MMA(1, 1, At, B1); PG8_BAR;
        }
        PG8_STAMP();
        if constexpr (!Epi::AFTER_DRAIN) { E(acc, cur, wr, wc, fr, fq); S.done(cur); }
        PG8_STAMP();
        if (!has_next) break;
#pragma unroll
        for (int a = 0; a < 2; ++a)
#pragma unroll
            for (int b = 0; b < 2; ++b)
#pragma unroll
                for (int m = 0; m < 4; ++m)
#pragma unroll
                    for (int n = 0; n < 2; ++n) acc[a][b][m][n] = (f32x4){0.f, 0.f, 0.f, 0.f};
        cur = nxt; cA = nA; cB = nB; ++ui;
    }
    PG8_WAIT_V(0);
    if (wr == 0) PG8_BAR;
    PG8_BAR;
    if constexpr (Epi::AFTER_DRAIN) { E.fused(acc, cur, wr, wc, fr, fq, lds, wid, lane); S.done(cur); }
    PG8_STAMP();
    if (STAMP && wid == 0) { stamps[lane] = lane < nts ? (((unsigned long long)(unsigned)ts_hi << 32) | (unsigned)ts_lo) : 0ull;
        if (lane == 62) stamps[62] = rt_entry; if (lane == 63) stamps[63] = (unsigned long long)wall_clock64(); }
#undef PG8_STAMP
#undef PG8_SA
#undef PG8_SB
#undef PG8_STAGE
#undef PG8_LDA
#undef PG8_LDB
#undef PG8_MMA
#undef PG8_WAIT_V
#undef PG8_WAIT_L
#undef PG8_BAR
#undef PG8_SCHED
}
}
#define XB_TMO      128
#define XB_XCNT(j)  (256  + 64 * (j))
#define XB_XSUB(j)  (1280 + 64 * (j))
#define XB_XGEN(j)  (2304 + 64 * (j))
#define XB_TOP      3328
#define XB_TOPGEN   3392
#define XCD_BAR_WORDS 3456
#define XB_SPIN_CAP (1u << 22)

__device__ __forceinline__ unsigned xb_ld(unsigned* p)              { return __hip_atomic_load(p, __ATOMIC_RELAXED, __HIP_MEMORY_SCOPE_AGENT); }
__device__ __forceinline__ unsigned xb_add(unsigned* p, unsigned v) { return __hip_atomic_fetch_add(p, v, __ATOMIC_RELAXED, __HIP_MEMORY_SCOPE_AGENT); }
__device__ __forceinline__ unsigned xb_xcc_id() { return (unsigned)__builtin_amdgcn_s_getreg((3 << 11) | 20) & 0xFu; }
#define XB_SPIN(cond, bar) do { unsigned _sp = 0; while (cond) { __builtin_amdgcn_s_sleep(1); \
    if ((++_sp & 255u) == 0u) { if (xb_ld(&(bar)[XB_TMO])) break; if (_sp > XB_SPIN_CAP) { atomicAdd(&(bar)[XB_TMO], 1u); break; } } } } while (0)

struct XcdBarrier {
    unsigned* bar; unsigned x;
    volatile PG8_LAS unsigned* st;
};

__device__ __forceinline__ XcdBarrier xcd_barrier_post(unsigned* bar, volatile PG8_LAS unsigned* st) {
    XcdBarrier b; b.bar = bar; b.x = xb_xcc_id(); b.st = st;
    if (threadIdx.x == 0) (void)xb_add(&bar[XB_XCNT(b.x)], 1u);
    return b;
}
__device__ __forceinline__ void xcd_barrier_complete(unsigned* bar, unsigned x, unsigned& nloc, unsigned& nx) {
    const unsigned G = gridDim.x * gridDim.y * gridDim.z;
    unsigned sum, cnt, mine, sp = 0u;
    for (;;) {
        sum = 0u; cnt = 0u; mine = 0u;
#pragma unroll
        for (unsigned j = 0; j < 16; ++j) { const unsigned c = xb_ld(&bar[XB_XCNT(j)]); sum += c; cnt += (c > 0u) ? 1u : 0u; mine = (j == x) ? c : mine; }
        if (sum == G) break;
        __builtin_amdgcn_s_sleep(1);
        if ((++sp & 255u) == 0u) { if (xb_ld(&bar[XB_TMO])) break; if (sp > XB_SPIN_CAP) { atomicAdd(&bar[XB_TMO], 1u); break; } }
    }
    nloc = mine > 0u ? mine : 1u; nx = cnt > 0u ? cnt : 1u;
}

__device__ __forceinline__ void xcd_barrier(const XcdBarrier& b) {
    asm volatile("s_waitcnt vmcnt(0)" ::: "memory");
    __syncthreads();
    if (threadIdx.x == 0) {
        unsigned* bar = b.bar;
        __builtin_amdgcn_s_waitcnt(0);
        unsigned nloc = b.st[0], nx = b.st[1];
        if (nloc == 0u) { xcd_barrier_complete(bar, b.x, nloc, nx); b.st[0] = nloc; b.st[1] = nx; }
        const unsigned old = xb_add(&bar[XB_XSUB(b.x)], 1u);
        const unsigned gen = old / nloc;
        if (old + 1u == (gen + 1u) * nloc) {
            __builtin_amdgcn_fence(__ATOMIC_RELEASE, "agent");
            asm volatile("s_waitcnt vmcnt(0)" ::: "memory");
            const unsigned og = xb_add(&bar[XB_TOP], 1u);
            const unsigned tg = og / nx;
            if (og + 1u == (tg + 1u) * nx) xb_add(&bar[XB_TOPGEN], 1u);
            else XB_SPIN(xb_ld(&bar[XB_TOPGEN]) == tg, bar);
            __builtin_amdgcn_fence(__ATOMIC_ACQUIRE, "agent");
            xb_add(&bar[XB_XGEN(b.x)], 1u);
            asm volatile("s_waitcnt vmcnt(0)" ::: "memory");
        } else {
            XB_SPIN(xb_ld(&bar[XB_XGEN(b.x)]) == gen, bar);
            __builtin_amdgcn_fence(__ATOMIC_ACQUIRE, "agent");
            asm volatile("s_waitcnt vmcnt(0)" ::: "memory");
        }
    }
    __syncthreads();
}

using namespace pg8;
typedef float f32x16 __attribute__((ext_vector_type(16)));
typedef unsigned u32x2 __attribute__((ext_vector_type(2)));
#define LAS PG8_LAS
#define DI __device__ __forceinline__

constexpr int NT = 512;
constexpr int MP = 32768, MS = 2048, MT = MP + MS;
constexpr int KEYS_S = 4352;
constexpr int KR_ROWS = MP + 32 * KEYS_S;
constexpr int ZLD = 2560;
constexpr float EPS = 1e-6f;
constexpr float QSCALE = 0.10206207261596577f * 1.4426950408889634f;
constexpr int LDS_BYTES = 160 * 1024;

constexpr size_t SZ_WIN = 2560ull * 1024 * 2, SZ_WUQ = 768ull * 256 * 2, SZ_WUK = 512ull * 256 * 2, SZ_WUV = 512ull * 256 * 2,
                 SZ_WO = 1024ull * 1024 * 2, SZ_WFI = 5632ull * 1024 * 2, SZ_WFO = 1024ull * 2816 * 2;
constexpr size_t WOFF_IN = 0, WOFF_UQ = WOFF_IN + SZ_WIN, WOFF_UK = WOFF_UQ + SZ_WUQ, WOFF_UV = WOFF_UK + SZ_WUK, WOFF_O = WOFF_UV + SZ_WUV,
                 WOFF_FI = WOFF_O + SZ_WO, WOFF_FO = WOFF_FI + SZ_WFI, WL = WOFF_FO + SZ_WFO;
constexpr size_t OFF_W = 0;
constexpr size_t OFF_MOD = OFF_W + 2 * WL;
constexpr size_t OFF_ROPE = OFF_MOD + 2ull * 36 * 6144 * 4;
constexpr size_t OFF_H = OFF_ROPE + 8192ull * 16 * 2 * 4;
constexpr size_t OFF_Z = OFF_H + (size_t)MT * 1024 * 2;
constexpr size_t OFF_CQN = OFF_Z + (size_t)MT * ZLD * 2;
constexpr size_t OFF_CKV = OFF_CQN + (size_t)MT * 256 * 2;
constexpr size_t OFF_KROPE = OFF_CKV + (size_t)KR_ROWS * 256 * 2;
constexpr size_t OFF_Q = OFF_KROPE + (size_t)KR_ROWS * 32 * 2;
constexpr size_t OFF_KN = OFF_Q + (size_t)MT * 768 * 2;
constexpr size_t OFF_VT = OFF_KN + (size_t)KR_ROWS * 512 * 2;
constexpr size_t OFF_O = OFF_VT + (size_t)KR_ROWS * 512 * 2;
constexpr size_t OFF_PART = OFF_O + (size_t)MP * 512 * 2;
constexpr size_t OFF_UHG = OFF_PART + 32ull * 8 * 4 * 64 * 66 * 4;
constexpr size_t OFF_DHG = OFF_UHG + 544ull * 4 * 64 * 64 * 4;
constexpr size_t OFF_UGL = OFF_DHG + 544ull * 4 * 64 * 4;
constexpr size_t OFF_DGL = OFF_UGL + 544ull * 4 * 32 * 64 * 4;
constexpr size_t OFF_BAR = OFF_DGL + 544ull * 4 * 32 * 4;
constexpr size_t OFF_XB = OFF_BAR + 16384;
constexpr size_t WS_END = OFF_XB + (size_t)MT * 1024 * 2;
constexpr size_t OFF_ACT = OFF_KN;
static_assert((size_t)MT * 2816 * 2 <= 2 * (size_t)KR_ROWS * 512 * 2, "act alias");

constexpr size_t OUT_Y = 0, OUT_CKVP = 35651584, OUT_KRP = 52428800, OUT_HGP = 54525952, OUT_GLP = 54657024,
                 OUT_CKVS = 54722560, OUT_KRS = 55771136, OUT_HGS = 55902208, OUT_GLS = 56950784;

DI int tid_() { int t = threadIdx.x; asm volatile("" : "+v"(t)); return t; }
DI int bid_() { int b = blockIdx.x; asm volatile("" : "+s"(b)); return b; }
DI float neg_big() { float v = -1e30f; asm volatile("" : "+v"(v)); return v; }
struct Params { const float* in[29]; float* out; unsigned char* ws; };

typedef __bf16 hbf2 __attribute__((ext_vector_type(2)));
typedef float f32x2_ __attribute__((ext_vector_type(2)));
DI unsigned pack2(float a, float b) { f32x2_ v = {a, b}; return __builtin_bit_cast(unsigned, __builtin_convertvector(v, hbf2)); }
DI bf16_t f2bf(float f) { return (bf16_t)(pack2(f, f) & 0xFFFFu); }
DI float bf2f(bf16_t b) { return __uint_as_float(((unsigned)b) << 16); }
DI float bflo(unsigned u) { return __uint_as_float(u << 16); }
DI float bfhi(unsigned u) { return __uint_as_float(u & 0xFFFF0000u); }
DI float wave_sum(float v) { v += __shfl_xor(v, 32); v += __shfl_xor(v, 16); v += __shfl_xor(v, 8); v += __shfl_xor(v, 4); v += __shfl_xor(v, 2); v += __shfl_xor(v, 1); return v; }
DI float sigmoidf_(float x) { return 1.f / (1.f + expf(-x)); }
DI int row_bi(int row) { return row < MP ? (row >> 13) : 4 + ((row - MP) >> 6); }

struct EpiZ {
    static constexpr bool PERM = true, AFTER_DRAIN = false;
    bf16_t* O; int ldc;
    DI void operator()(const f32x4 (&acc)[2][2][4][2], const Unit& u, int wr, int wc, int fr, int fq) const {
        const int row0 = u.pm * 256 + wr * 64 + fr, col0 = u.pn * 256 + wc * 32 + 8 * fq;
#pragma unroll
        for (int ai = 0; ai < 2; ++ai)
#pragma unroll
            for (int m = 0; m < 4; ++m) { bf16_t* rowp = O + (size_t)(row0 + ai * 128 + m * 16) * ldc + col0;
#pragma unroll
                for (int bj = 0; bj < 2; ++bj) { const f32x4 v0 = acc[ai][bj][m][0], v1 = acc[ai][bj][m][1]; uint4 w; w.x = pack2(v0[0], v0[1]); w.y = pack2(v0[2], v0[3]); w.z = pack2(v1[0], v1[1]); w.w = pack2(v1[2], v1[3]); *(uint4*)(rowp + bj * 128) = w; } }
    }
};
struct EpiQ {
    static constexpr bool PERM = false, AFTER_DRAIN = false;
    bf16_t* Q; const float* qn_; const float* rope_;
    DI void operator()(const f32x4 (&acc)[2][2][4][2], const Unit& u, int wr, int wc, int fr, int fq) const {
        const float* qn = qn_; const float* rope = rope_; asm volatile("" : "+s"(qn), "+s"(rope));
        float eps_ = EPS; asm volatile("" : "+v"(eps_));
        const int row0 = u.pm * 256 + wr * 64 + fr;
#pragma unroll
        for (int ai = 0; ai < 2; ++ai)
#pragma unroll
            for (int m = 0; m < 4; ++m) {
                const int row = row0 + ai * 128 + m * 16;
                int pos; size_t base, hs;
                if (row < MP) { const int b = row >> 13, t = row & 8191; pos = t; base = ((size_t)(b * 8) * 8192 + t) * 96; hs = 8192 * 96; }
                else { const int r = row - MP, b = r >> 6, t = r & 63; pos = 4096 + t; base = (size_t)MP * 768 + ((size_t)(b * 8) * 64 + t) * 96; hs = 64 * 96; }
                if (u.pn < 2) {
                    const int head = 4 * u.pn + wc;
                    float ss = 0.f;
#pragma unroll
                    for (int bj = 0; bj < 2; ++bj)
#pragma unroll
                        for (int n = 0; n < 2; ++n) { const f32x4 v = acc[ai][bj][m][n]; ss += v[0] * v[0] + v[1] * v[1] + v[2] * v[2] + v[3] * v[3]; }
                    ss += __shfl_xor(ss, 16); ss += __shfl_xor(ss, 32);
                    const float rs = rsqrtf(ss * (1.f / 64.f) + eps_) * QSCALE;
#pragma unroll
                    for (int bj = 0; bj < 2; ++bj)
#pragma unroll
                        for (int n = 0; n < 2; ++n) { const int d = 32 * bj + 16 * n + 4 * fq; const f32x4 v = acc[ai][bj][m][n]; const float4 g = *(const float4*)(qn + d);
                            uint2 w; w.x = pack2(v[0] * rs * g.x, v[1] * rs * g.y); w.y = pack2(v[2] * rs * g.z, v[3] * rs * g.w); *(uint2*)(Q + base + head * hs + d) = w; }
                } else {
#pragma unroll
                    for (int bj = 0; bj < 2; ++bj) {
                        const int head = 2 * wc + bj;
                        const f32x4 v1 = acc[ai][bj][m][0], v2 = acc[ai][bj][m][1];
                        float ss = v1[0] * v1[0] + v1[1] * v1[1] + v1[2] * v1[2] + v1[3] * v1[3] + v2[0] * v2[0] + v2[1] * v2[1] + v2[2] * v2[2] + v2[3] * v2[3];
                        ss += __shfl_xor(ss, 16); ss += __shfl_xor(ss, 32);
                        const float rs = rsqrtf(ss * (1.f / 32.f) + eps_);
                        const float4 g1 = *(const float4*)(qn + 64 + 4 * fq), g2 = *(const float4*)(qn + 80 + 4 * fq);
                        const float4 cs0 = *(const float4*)(rope + ((size_t)pos * 16 + 4 * fq) * 2), cs1 = *(const float4*)(rope + ((size_t)pos * 16 + 4 * fq) * 2 + 4);
                        const float x10 = v1[0] * rs * g1.x, x11 = v1[1] * rs * g1.y, x12 = v1[2] * rs * g1.z, x13 = v1[3] * rs * g1.w;
                        const float x20 = v2[0] * rs * g2.x, x21 = v2[1] * rs * g2.y, x22 = v2[2] * rs * g2.z, x23 = v2[3] * rs * g2.w;
                        uint2 w1, w2;
                        w1.x = pack2((x10 * cs0.x - x20 * cs0.y) * QSCALE, (x11 * cs0.z - x21 * cs0.w) * QSCALE);
                        w1.y = pack2((x12 * cs1.x - x22 * cs1.y) * QSCALE, (x13 * cs1.z - x23 * cs1.w) * QSCALE);
                        w2.x = pack2((x20 * cs0.x + x10 * cs0.y) * QSCALE, (x21 * cs0.z + x11 * cs0.w) * QSCALE);
                        w2.y = pack2((x22 * cs1.x + x12 * cs1.y) * QSCALE, (x23 * cs1.z + x13 * cs1.w) * QSCALE);
                        *(uint2*)(Q + base + head * hs + 64 + 4 * fq) = w1; *(uint2*)(Q + base + head * hs + 80 + 4 * fq) = w2;
                    }
                }
            }
    }
};
struct EpiKN {
    static constexpr bool PERM = true, AFTER_DRAIN = false;
    bf16_t* KN; const float* kn_;
    DI void operator()(const f32x4 (&acc)[2][2][4][2], const Unit& u, int wr, int wc, int fr, int fq) const {
        const float* kn = kn_; asm volatile("" : "+s"(kn));
        float eps_ = EPS; asm volatile("" : "+v"(eps_));
        float4 gk[2][2];
#pragma unroll
        for (int bj = 0; bj < 2; ++bj)
#pragma unroll
            for (int n = 0; n < 2; ++n) gk[bj][n] = *(const float4*)(kn + 32 * bj + 8 * fq + 4 * n);
        size_t base, hs;
        if (u.pm < 128) { const int b = u.pm >> 5, key0 = (u.pm & 31) * 256; base = ((size_t)(b * 8) * 8192 + key0) * 64; hs = (size_t)8192 * 64; }
        else { const int q = u.pm - 128, b = q / 17, key0 = (q % 17) * 256; base = (size_t)MP * 512 + ((size_t)(b * 8) * KEYS_S + key0) * 64; hs = (size_t)KEYS_S * 64; }
        const int head = 4 * u.pn + wc;
#pragma unroll
        for (int ai = 0; ai < 2; ++ai)
#pragma unroll
            for (int m = 0; m < 4; ++m) {
                const int key = 128 * ai + 64 * wr + 16 * m + fr;
                float ss = 0.f;
#pragma unroll
                for (int bj = 0; bj < 2; ++bj)
#pragma unroll
                    for (int n = 0; n < 2; ++n) { const f32x4 v = acc[ai][bj][m][n]; ss += v[0] * v[0] + v[1] * v[1] + v[2] * v[2] + v[3] * v[3]; }
                ss += __shfl_xor(ss, 16); ss += __shfl_xor(ss, 32);
                const float rs = rsqrtf(ss * (1.f / 64.f) + eps_);
#pragma unroll
                for (int bj = 0; bj < 2; ++bj) { const f32x4 v0 = acc[ai][bj][m][0], v1 = acc[ai][bj][m][1]; const float4 g0 = gk[bj][0], g1 = gk[bj][1];
                    uint4 w; w.x = pack2(v0[0] * rs * g0.x, v0[1] * rs * g0.y); w.y = pack2(v0[2] * rs * g0.z, v0[3] * rs * g0.w); w.z = pack2(v1[0] * rs * g1.x, v1[1] * rs * g1.y); w.w = pack2(v1[2] * rs * g1.z, v1[3] * rs * g1.w);
                    *(uint4*)(KN + base + head * hs + (size_t)key * 64 + 32 * bj + 8 * fq) = w; }
            }
    }
};
struct EpiVT {
    static constexpr bool PERM = true, AFTER_DRAIN = false;
    bf16_t* VT;
    DI void operator()(const f32x4 (&acc)[2][2][4][2], const Unit& u, int wr, int wc, int fr, int fq) const {
        size_t base; int KL;
        if (u.pn < 128) { const int b = u.pn >> 5, key0 = (u.pn & 31) * 256; base = (size_t)(b * 8) * 64 * 8192 + key0; KL = 8192; }
        else { const int q = u.pn - 128, b = q / 17, key0 = (q % 17) * 256; base = (size_t)MP * 512 + (size_t)(b * 8) * 64 * KEYS_S + key0; KL = KEYS_S; }
#pragma unroll
        for (int ai = 0; ai < 2; ++ai)
#pragma unroll
            for (int m = 0; m < 4; ++m) {
                const int r = 256 * u.pm + 128 * ai + 64 * wr + 16 * m + fr;
                bf16_t* rowp = VT + base + (size_t)r * KL + 32 * wc + 8 * fq;
#pragma unroll
                for (int bj = 0; bj < 2; ++bj) { const f32x4 v0 = acc[ai][bj][m][0], v1 = acc[ai][bj][m][1]; uint4 w; w.x = pack2(v0[0], v0[1]); w.y = pack2(v0[2], v0[3]); w.z = pack2(v1[0], v1[1]); w.w = pack2(v1[2], v1[3]); *(uint4*)(rowp + 128 * bj) = w; }
            }
    }
};
struct EpiRes {
    static constexpr bool PERM = false, AFTER_DRAIN = false;
    bf16_t* XB; float* out; const float* gate; int final; int pm0;
    DI void operator()(const f32x4 (&acc)[2][2][4][2], const Unit& u, int wr, int wc, int fr, int fq) const {
        const int row0 = (u.pm + pm0) * 256 + wr * 64 + fr, col0 = u.pn * 256 + wc * 32 + 4 * fq;
#pragma unroll
        for (int ai = 0; ai < 2; ++ai) {
            const float* gr = gate + (size_t)row_bi(row0 + ai * 128) * 6144 + col0;
            f32x4 g[2][2]; uint2 x[4][2][2];
#pragma unroll
            for (int bj = 0; bj < 2; ++bj)
#pragma unroll
                for (int n = 0; n < 2; ++n) g[bj][n] = *(const f32x4*)(gr + bj * 128 + n * 16);
#pragma unroll
            for (int m = 0; m < 4; ++m) { const bf16_t* xr = XB + (size_t)(row0 + ai * 128 + m * 16) * 1024 + col0;
#pragma unroll
                for (int bj = 0; bj < 2; ++bj)
#pragma unroll
                    for (int n = 0; n < 2; ++n) x[m][bj][n] = *(const uint2*)(xr + bj * 128 + n * 16); }
#pragma unroll
            for (int m = 0; m < 4; ++m) { const size_t ro = (size_t)(row0 + ai * 128 + m * 16) * 1024 + col0;
#pragma unroll
                for (int bj = 0; bj < 2; ++bj)
#pragma unroll
                    for (int n = 0; n < 2; ++n) { const uint2 xv = x[m][bj][n]; const f32x4 xf = {bflo(xv.x), bfhi(xv.x), bflo(xv.y), bfhi(xv.y)}; const f32x4 r = xf + g[bj][n] * acc[ai][bj][m][n];
                        if (final) *(f32x4*)(out + ro + bj * 128 + n * 16) = r;
                        else { uint2 w; w.x = pack2(r[0], r[1]); w.y = pack2(r[2], r[3]); *(uint2*)(XB + ro + bj * 128 + n * 16) = w; } } }
        }
    }
};
struct EpiSwi {
    static constexpr bool PERM = true, AFTER_DRAIN = false;
    bf16_t* ACT; int pm0;
    DI void operator()(const f32x4 (&acc)[2][2][4][2], const Unit& u, int wr, int wc, int fr, int fq) const {
        const int row0 = (u.pm + pm0) * 256 + wr * 64 + fr, col0 = u.pn * 128 + wc * 32 + 8 * fq;
#pragma unroll
        for (int ai = 0; ai < 2; ++ai)
#pragma unroll
            for (int m = 0; m < 4; ++m) { bf16_t* rowp = ACT + (size_t)(row0 + ai * 128 + m * 16) * 2816 + col0; float r[8];
#pragma unroll
                for (int n = 0; n < 2; ++n) { const f32x4 a = acc[ai][0][m][n], g = acc[ai][1][m][n];
#pragma unroll
                    for (int j = 0; j < 4; ++j) r[4 * n + j] = a[j] / (1.f + __expf(-a[j])) * g[j]; }
                uint4 w; w.x = pack2(r[0], r[1]); w.y = pack2(r[2], r[3]); w.z = pack2(r[4], r[5]); w.w = pack2(r[6], r[7]); *(uint4*)rowp = w; }
    }
};
struct SkewOrder : StaticOrder {
    int nsb, skip;
    __device__ bool next(int i, Unit& u) const {
        const int R = nwg / G; long L;
        if (c < nsb) { if (i >= R - skip) return false; L = (long)i * G + c; }
        else if (i < R) L = (long)i * G + c;
        else if (i == R) { const int j = c - nsb; if (j >= nsb * skip) return false; L = (long)(R - skip + j / nsb) * G + (j % nsb); }
        else return false;
        StaticOrder t = *this; t.c = (int)(L % G); return t.StaticOrder::next((int)(L / G), u);
    }
};
template <class Epi> DI void run_gemm_skew(LAS unsigned char* lds, const bf16_t* A, const bf16_t* Bt, int M, int N, int K, const Epi& E, int nsb, int skip) {
    asm volatile("" : "+s"(M), "+s"(N), "+s"(K));
    Gemm g{A, Bt, M, N, K}; SkewOrder S; S.init(M, N, (int)gridDim.x, (int)bid_()); S.nsb = nsb; S.skip = skip;
    gemm_phase<Epi, SkewOrder, false>(lds, g, S, E, nullptr);
}
template <class Epi> DI void run_gemm(LAS unsigned char* lds, const bf16_t* A, const bf16_t* Bt, int M, int N, int K, const Epi& E, int rot = 0) {
    asm volatile("" : "+s"(M), "+s"(N), "+s"(K));
    Gemm g{A, Bt, M, N, K}; StaticOrder S; S.init(M, N, (int)gridDim.x, (int)((bid_() + rot) % gridDim.x));
    gemm_phase<Epi, StaticOrder, false>(lds, g, S, E, nullptr);
}

DI int colmap(int w, int n) {
    if (w == 0) return n < 2352 ? n : -1;
    if (w == 1) { const int pn = n >> 8, c = n & 255, bj = c >> 7, wc = (c >> 5) & 3, cc = c & 31; return pn < 2 ? (4 * pn + wc) * 96 + 32 * bj + cc : (2 * wc + bj) * 96 + 64 + cc; }
    if (w == 2) { const int pn = n >> 8, c = n & 255, bj = c >> 7, wc = (c >> 5) & 3, cc = c & 31; return (4 * pn + wc) * 64 + 32 * bj + cc; }
    if (w == 5) { const int pn = n >> 8, c = n & 255; return c < 128 ? 128 * pn + c : 2816 + 128 * pn + (c - 128); }
    return n;
}
DI void phase_prep(const Params& p, LAS unsigned char* lds) {
    const int tid = tid_();
    LAS bf16_t* T = (LAS bf16_t*)lds;
    for (int ti = bid_(); ti < 2 * 1560; ti += gridDim.x) {
        const int l = ti / 1560, r = ti % 1560;
        int w, t0, K, ld; size_t doff; const float* src;
        if (r < 320) { w = 0; t0 = 0; K = 1024; ld = 2352; doff = WOFF_IN; src = p.in[12]; }
        else if (r < 344) { w = 1; t0 = 320; K = 256; ld = 768; doff = WOFF_UQ; src = p.in[15]; }
        else if (r < 360) { w = 2; t0 = 344; K = 256; ld = 512; doff = WOFF_UK; src = p.in[16]; }
        else if (r < 376) { w = 3; t0 = 360; K = 256; ld = 512; doff = WOFF_UV; src = p.in[17]; }
        else if (r < 504) { w = 4; t0 = 376; K = 1024; ld = 1024; doff = WOFF_O; src = p.in[26]; }
        else if (r < 1208) { w = 5; t0 = 504; K = 1024; ld = 5632; doff = WOFF_FI; src = p.in[27]; }
        else { w = 6; t0 = 1208; K = 2816; ld = 1024; doff = WOFF_FO; src = p.in[28]; }
        src += (size_t)l * K * ld;
        const int kt = K >> 7, tr = r - t0, n0 = (tr / kt) * 64, k0 = (tr % kt) * 128;
        bf16_t* dst = (bf16_t*)(p.ws + OFF_W + (size_t)l * WL + doff);
        const int nn = tid & 63, col = colmap(w, n0 + nn);
        float tv[16];
#pragma unroll
        for (int i = 0; i < 16; ++i) { const int kk = (tid >> 6) + 8 * i; tv[i] = col >= 0 ? src[(size_t)(k0 + kk) * ld + col] : 0.f; }
#pragma unroll
        for (int i = 0; i < 16; ++i) { const int kk = (tid >> 6) + 8 * i; T[nn * 130 + kk] = f2bf(tv[i]); }
        __syncthreads();
#pragma unroll
        for (int j = 0; j < 2; ++j) { const int q = tid + 512 * j, row = q >> 4, seg = q & 15; const LAS unsigned* tp = (const LAS unsigned*)(T + row * 130 + seg * 8);
          uint4 o; o.x = tp[0]; o.y = tp[1]; o.z = tp[2]; o.w = tp[3]; *(uint4*)(dst + (size_t)(n0 + row) * K + k0 + seg * 8) = o; }
        __syncthreads();
    }
    float* mod = (float*)(p.ws + OFF_MOD);
    for (int it = bid_(); it < 192; it += gridDim.x) {
        const int l = it / 96, cgp = it % 96;
        LAS float* sl = (LAS float*)lds;
        for (int i = tid; i < 36 * 1024; i += NT) { const int bi = i >> 10, k = i & 1023; const float c = bi < 4 ? p.in[2][bi * 1024 + k] : p.in[3][(bi - 4) * 1024 + k]; sl[i] = c / (1.f + expf(-c)); }
        __syncthreads();
        const int cl = tid & 63, kq = tid >> 6;
        float acc[36];
#pragma unroll
        for (int bi = 0; bi < 36; ++bi) acc[bi] = 0.f;
        const float* wm = p.in[8] + (size_t)l * 1024 * 6144 + cgp * 64 + cl;
#pragma unroll 4
        for (int k = kq * 128; k < kq * 128 + 128; k += 4) {
            const float w0 = wm[(size_t)k * 6144], w1 = wm[(size_t)(k + 1) * 6144], w2 = wm[(size_t)(k + 2) * 6144], w3 = wm[(size_t)(k + 3) * 6144];
#pragma unroll
            for (int bi = 0; bi < 36; ++bi) { const f32x4 s = *(const LAS f32x4*)(sl + bi * 1024 + k); acc[bi] += s[0] * w0 + s[1] * w1 + s[2] * w2 + s[3] * w3; }
        }
        __syncthreads();
        LAS float* red = (LAS float*)lds;
#pragma unroll
        for (int bi = 0; bi < 36; ++bi) red[(kq * 36 + bi) * 64 + cl] = acc[bi];
        __syncthreads();
        for (int o = tid; o < 36 * 64; o += NT) { const int bi = o >> 6, c = o & 63; float s = 0.f;
#pragma unroll
            for (int q = 0; q < 8; ++q) s += red[(q * 36 + bi) * 64 + c];
            const int colg = cgp * 64 + c; mod[((size_t)l * 36 + bi) * 6144 + colg] = s + p.in[9][l * 6144 + colg]; }
        __syncthreads();
    }
    float* rope = (float*)(p.ws + OFF_ROPE);
    for (int i = bid_() * NT + tid; i < 8192 * 16; i += gridDim.x * NT) { const int pos = i >> 4, j = i & 15;
        const float inv = exp2f(-(float)j * (13.287712379549449f / 16.f)); const float ang = (float)pos * inv; rope[2 * i] = cosf(ang); rope[2 * i + 1] = sinf(ang); }
}

template <bool FROM_INPUT>
DI void phase_hrows(const Params& p, int l, const float* xa, const float* xb, const float* g, int shoff, int scoff, int row_lo = 0, int row_hi = MT, int b0 = 0, int nb = 0) {
    const int tid = tid_(), lane = tid & 63, wid = __builtin_amdgcn_readfirstlane(tid >> 6);
    const float* mod = (const float*)(p.ws + OFF_MOD) + (size_t)l * 36 * 6144;
    bf16_t* H = (bf16_t*)(p.ws + OFF_H); bf16_t* XB = (bf16_t*)(p.ws + OFF_XB);
    if (nb == 0) nb = (int)gridDim.x;
    const int stride = nb * 8;
    int row = row_lo + ((int)bid_() - b0) * 8 + wid;
    float4 v[4];
#define HR_LOAD(dst, rr) do { if (FROM_INPUT) { const float* xr_ = (rr) < MP ? xa + (size_t)(rr) * 1024 : xb + (size_t)((rr) - MP) * 1024; \
            _Pragma("unroll") for (int i = 0; i < 4; ++i) dst[i] = *(const float4*)(xr_ + i * 256 + lane * 4); } \
        else { const bf16_t* xr_ = XB + (size_t)(rr) * 1024; \
            _Pragma("unroll") for (int i = 0; i < 4; ++i) { const uint2 u_ = *(const uint2*)(xr_ + i * 256 + lane * 4); dst[i].x = bflo(u_.x); dst[i].y = bfhi(u_.x); dst[i].z = bflo(u_.y); dst[i].w = bfhi(u_.y); } } } while (0)
    if (row < row_hi) HR_LOAD(v, row);
    while (row < row_hi) {
        const int nrow = row + stride; float4 nv[4];
        if (nrow < row_hi) HR_LOAD(nv, nrow);
        float ss = 0.f;
#pragma unroll
        for (int i = 0; i < 4; ++i) ss += v[i].x * v[i].x + v[i].y * v[i].y + v[i].z * v[i].z + v[i].w * v[i].w;
        ss = wave_sum(ss);
        const float rs = rsqrtf(ss * (1.f / 1024.f) + EPS);
        const float* mp = mod + (size_t)row_bi(row) * 6144;
#pragma unroll
        for (int i = 0; i < 4; ++i) { const int col = i * 256 + lane * 4;
            const float4 gg = *(const float4*)(g + col), sc = *(const float4*)(mp + scoff + col), sh = *(const float4*)(mp + shoff + col);
            uint2 w; w.x = pack2(v[i].x * rs * gg.x * (1.f + sc.x) + sh.x, v[i].y * rs * gg.y * (1.f + sc.y) + sh.y);
            w.y = pack2(v[i].z * rs * gg.z * (1.f + sc.z) + sh.z, v[i].w * rs * gg.w * (1.f + sc.w) + sh.w);
            *(uint2*)(H + (size_t)row * 1024 + col) = w;
            if (FROM_INPUT) { uint2 xw; xw.x = pack2(v[i].x, v[i].y); xw.y = pack2(v[i].z, v[i].w); *(uint2*)(XB + (size_t)row * 1024 + col) = xw; } }
#pragma unroll
        for (int i = 0; i < 4; ++i) v[i] = nv[i];
        row = nrow;
    }
#undef HR_LOAD
}
DI void phase_cache(const Params& p, int l, int b0, int nb) {
    const size_t gt = (size_t)(bid_() - b0) * NT + tid_(), gs = (size_t)nb * NT;
    bf16_t* ckv_s = (bf16_t*)(p.ws + OFF_CKV) + (size_t)MP * 256;
    bf16_t* kr_s = (bf16_t*)(p.ws + OFF_KROPE) + (size_t)MP * 32;
    const float4* s1 = (const float4*)(p.in[4] + (size_t)l * 32 * 4096 * 256);
    for (size_t i0 = gt; i0 < 8388608; i0 += gs * 8) { float4 v[8];
#pragma unroll
        for (int u = 0; u < 8; ++u) { const size_t i = i0 + u * gs; if (i < 8388608) v[u] = s1[i]; }
#pragma unroll
        for (int u = 0; u < 8; ++u) { const size_t i = i0 + u * gs; if (i < 8388608) { const size_t e = i * 4, b = e >> 20, rem = e & 1048575;
            uint2 w; w.x = pack2(v[u].x, v[u].y); w.y = pack2(v[u].z, v[u].w); *(uint2*)(ckv_s + b * KEYS_S * 256 + rem) = w; } } }
    unsigned zz = 0u; asm volatile("" : "+v"(zz));
    for (size_t i = gt; i < 393216; i += gs) { const size_t e = i * 4, b = e / 49152, rem = e % 49152; uint2 w; w.x = zz; w.y = zz; *(uint2*)(ckv_s + b * KEYS_S * 256 + 4160 * 256 + rem) = w; }
    const float4* s2 = (const float4*)(p.in[5] + (size_t)l * 32 * 4096 * 32);
    for (size_t i0 = gt; i0 < 1048576; i0 += gs * 8) { float4 v[8];
#pragma unroll
        for (int u = 0; u < 8; ++u) { const size_t i = i0 + u * gs; if (i < 1048576) v[u] = s2[i]; }
#pragma unroll
        for (int u = 0; u < 8; ++u) { const size_t i = i0 + u * gs; if (i < 1048576) { const size_t e = i * 4, b = e >> 17, rem = e & 131071;
            uint2 w; w.x = pack2(v[u].x, v[u].y); w.y = pack2(v[u].z, v[u].w); *(uint2*)(kr_s + b * KEYS_S * 32 + rem) = w; } } }
}
DI void phase_post(const Params& p, int l) {
    const int tid = tid_(), lane = tid & 63, wid = __builtin_amdgcn_readfirstlane(tid >> 6);
    const bf16_t* Z = (const bf16_t*)(p.ws + OFF_Z);
    bf16_t* CQN = (bf16_t*)(p.ws + OFF_CQN); bf16_t* CKV = (bf16_t*)(p.ws + OFF_CKV); bf16_t* KRO = (bf16_t*)(p.ws + OFF_KROPE);
    const float* rope = (const float*)(p.ws + OFF_ROPE);
    const float* gcq = p.in[13] + l * 256; const float* gckv = p.in[14] + l * 256; const float* gk = p.in[19] + l * 96 + 64;
    const int stride = gridDim.x * 8;
    int row = bid_() * 8 + wid;
    uint2 u1, u2; bf16_t u3;
    if (row < MT) { const bf16_t* zr = Z + (size_t)row * ZLD; u1 = *(const uint2*)(zr + 4 * lane); u2 = *(const uint2*)(zr + 256 + 4 * lane); u3 = zr[512 + (lane & 31)]; }
    while (row < MT) {
        const int nrow = row + stride; uint2 n1, n2; bf16_t n3;
        if (nrow < MT) { const bf16_t* zr = Z + (size_t)nrow * ZLD; n1 = *(const uint2*)(zr + 4 * lane); n2 = *(const uint2*)(zr + 256 + 4 * lane); n3 = zr[512 + (lane & 31)]; }
        int pos; size_t grow; float* o_ckv; float* o_kr;
        if (row < MP) { const int b = row >> 13, t = row & 8191; pos = t; grow = row; o_ckv = p.out + OUT_CKVP + ((size_t)(l * 4 + b) * 8192 + t) * 256; o_kr = p.out + OUT_KRP + ((size_t)(l * 4 + b) * 8192 + t) * 32; }
        else { const int r = row - MP, b = r >> 6, t = r & 63; pos = 4096 + t; grow = (size_t)MP + (size_t)b * KEYS_S + 4096 + t; o_ckv = p.out + OUT_CKVS + ((size_t)(l * 32 + b) * 64 + t) * 256; o_kr = p.out + OUT_KRS + ((size_t)(l * 32 + b) * 64 + t) * 32; }
        { const uint2 u = u1; const float a0 = bflo(u.x), a1 = bfhi(u.x), a2 = bflo(u.y), a3 = bfhi(u.y);
          const float ss = wave_sum(a0 * a0 + a1 * a1 + a2 * a2 + a3 * a3); const float rs = rsqrtf(ss * (1.f / 256.f) + EPS); const float4 g = *(const float4*)(gcq + 4 * lane);
          uint2 w; w.x = pack2(a0 * rs * g.x, a1 * rs * g.y); w.y = pack2(a2 * rs * g.z, a3 * rs * g.w); *(uint2*)(CQN + (size_t)row * 256 + 4 * lane) = w; }
        { const uint2 u = u2; const float a0 = bflo(u.x), a1 = bfhi(u.x), a2 = bflo(u.y), a3 = bfhi(u.y);
          const float ss = wave_sum(a0 * a0 + a1 * a1 + a2 * a2 + a3 * a3); const float rs = rsqrtf(ss * (1.f / 256.f) + EPS); const float4 g = *(const float4*)(gckv + 4 * lane);
          float4 o; o.x = a0 * rs * g.x; o.y = a1 * rs * g.y; o.z = a2 * rs * g.z; o.w = a3 * rs * g.w; *(float4*)(o_ckv + 4 * lane) = o;
          uint2 w; w.x = pack2(o.x, o.y); w.y = pack2(o.z, o.w); *(uint2*)(CKV + grow * 256 + 4 * lane) = w; }
        { const int i = lane & 31; const float a = bf2f(u3); float ss = a * a; ss += __shfl_xor(ss, 16); ss += __shfl_xor(ss, 8); ss += __shfl_xor(ss, 4); ss += __shfl_xor(ss, 2); ss += __shfl_xor(ss, 1);
          const float xn = a * rsqrtf(ss * (1.f / 32.f) + EPS) * gk[i]; const float other = __shfl_xor(xn, 16);
          const float2 cs = *(const float2*)(rope + ((size_t)pos * 16 + (i & 15)) * 2);
          const float o = i < 16 ? xn * cs.x - other * cs.y : xn * cs.x + other * cs.y;
          if (lane < 32) { o_kr[i] = o; KRO[grow * 32 + i] = f2bf(o); } }
        u1 = n1; u2 = n2; u3 = n3; row = nrow;
    }
}

DI f32x16 mfma32(bf16x8 a, bf16x8 b, f32x16 c) { return __builtin_amdgcn_mfma_f32_32x32x16_bf16(a, b, c, 0, 0, 0); }
DI f32x4 mfma16(bf16x8 a, bf16x8 b, f32x4 c) { return __builtin_amdgcn_mfma_f32_16x16x32_bf16(a, b, c, 0, 0, 0); }
DI bf16x8 pack8(const f32x16& s, int b) { u32x4 r; r[0] = pack2(s[b], s[b + 1]); r[1] = pack2(s[b + 2], s[b + 3]); r[2] = pack2(s[b + 4], s[b + 5]); r[3] = pack2(s[b + 6], s[b + 7]); return __builtin_bit_cast(bf16x8, r); }

template <int NH>
DI void attn_core(LAS unsigned char* lds, const bf16_t* qptr, const bf16_t* kn, size_t kn_hs, const bf16_t* kr, const bf16_t* vt, size_t vt_hs, int KL,
                  int kt0, int kstep, int nit, int nvalid, int tile_lim, int hh, f32x16 (&o)[2], float& m_run, float& l_run) {
    constexpr int BUFSZ = NH * 17920 + 5120;
    const int tid = tid_(), lane = tid & 63, r = lane & 31, h = lane >> 5;
    bf16x8 qf[6];
#pragma unroll
    for (int ks = 0; ks < 6; ++ks) qf[ks] = *(const bf16x8*)(qptr + ks * 16 + h * 8);
#pragma unroll
    for (int i = 0; i < 16; ++i) { o[0][i] = 0.f; o[1][i] = 0.f; }
    m_run = neg_big(); l_run = 0.f;
    u32x4 rkn[NH], rvt[NH], rkr = {0u, 0u, 0u, 0u};
    const int lrow = tid >> 3, lseg = tid & 7;
#define ATT_GLOAD(kt) do { const size_t key0_ = (size_t)(kt) * 64; \
        _Pragma("unroll") for (int hx = 0; hx < NH; ++hx) { rkn[hx] = *(const u32x4*)(kn + hx * kn_hs + (key0_ + lrow) * 64 + lseg * 8); rvt[hx] = *(const u32x4*)(vt + hx * vt_hs + (size_t)lrow * KL + key0_ + lseg * 8); } \
        if (tid < 256) rkr = *(const u32x4*)(kr + (key0_ + (tid >> 2)) * 32 + (tid & 3) * 8); } while (0)
#define ATT_LSTORE(buf) do { LAS unsigned char* B_ = lds + (buf) * BUFSZ; \
        _Pragma("unroll") for (int hx = 0; hx < NH; ++hx) { *(LAS u32x4*)(B_ + hx * 9216 + lrow * 144 + lseg * 16) = rkn[hx]; \
            LAS u32x2* pv_ = (LAS u32x2*)(B_ + NH * 9216 + 5120 + hx * 8704 + lrow * 136 + lseg * 16); u32x2 a_, b_; a_[0] = rvt[hx][0]; a_[1] = rvt[hx][1]; b_[0] = rvt[hx][2]; b_[1] = rvt[hx][3]; pv_[0] = a_; pv_[1] = b_; } \
        if (tid < 256) *(LAS u32x4*)(B_ + NH * 9216 + (tid >> 2) * 80 + (tid & 3) * 16) = rkr; } while (0)
    ATT_GLOAD(kt0); ATT_LSTORE(0);
    __syncthreads();
    for (int it = 0; it < nit; ++it) {
        const int ktn = kt0 + (it + 1) * kstep;
        const bool more = (it + 1 < nit) && (ktn < tile_lim);
        if (more) ATT_GLOAD(ktn);
        if (it < nvalid) {
            const LAS unsigned char* B = lds + (it & 1) * BUFSZ;
            const LAS unsigned char* knb = B + hh * 9216; const LAS unsigned char* krb = B + NH * 9216; const LAS unsigned char* vtb = B + NH * 9216 + 5120 + hh * 8704;
            f32x16 s0, s1;
#pragma unroll
            for (int i = 0; i < 16; ++i) { s0[i] = 0.f; s1[i] = 0.f; }
#pragma unroll
            for (int ks = 0; ks < 4; ++ks) { const bf16x8 a0 = *(const LAS bf16x8*)(knb + r * 144 + ks * 32 + h * 16), a1 = *(const LAS bf16x8*)(knb + (32 + r) * 144 + ks * 32 + h * 16);
                s0 = mfma32(a0, qf[ks], s0); s1 = mfma32(a1, qf[ks], s1); }
#pragma unroll
            for (int ks = 0; ks < 2; ++ks) { const bf16x8 a0 = *(const LAS bf16x8*)(krb + r * 80 + ks * 32 + h * 16), a1 = *(const LAS bf16x8*)(krb + (32 + r) * 80 + ks * 32 + h * 16);
                s0 = mfma32(a0, qf[4 + ks], s0); s1 = mfma32(a1, qf[4 + ks], s1); }
            float mx = s0[0];
#pragma unroll
            for (int i = 0; i < 16; ++i) { mx = fmaxf(mx, s0[i]); mx = fmaxf(mx, s1[i]); }
            mx = fmaxf(mx, __shfl_xor(mx, 32));
            const float mnew = fmaxf(m_run, mx), alpha = __builtin_amdgcn_exp2f(m_run - mnew);
            m_run = mnew;
            float ps = 0.f;
#pragma unroll
            for (int i = 0; i < 16; ++i) { s0[i] = __builtin_amdgcn_exp2f(s0[i] - mnew); s1[i] = __builtin_amdgcn_exp2f(s1[i] - mnew); ps += s0[i] + s1[i]; }
            l_run = l_run * alpha + ps;
#pragma unroll
            for (int i = 0; i < 16; ++i) { o[0][i] *= alpha; o[1][i] *= alpha; }
            bf16x8 pf[4];
            pf[0] = pack8(s0, 0); pf[1] = pack8(s0, 8); pf[2] = pack8(s1, 0); pf[3] = pack8(s1, 8);
#pragma unroll
            for (int dh = 0; dh < 2; ++dh)
#pragma unroll
                for (int s4 = 0; s4 < 4; ++s4) { const LAS u32x2* pa = (const LAS u32x2*)(vtb + (32 * dh + r) * 136 + (16 * s4 + 4 * h) * 2); const u32x2 lo = pa[0], hi = pa[2];
                    u32x4 av; av[0] = lo[0]; av[1] = lo[1]; av[2] = hi[0]; av[3] = hi[1]; o[dh] = mfma32(__builtin_bit_cast(bf16x8, av), pf[s4], o[dh]); }
        }
        if (more) ATT_LSTORE((it + 1) & 1);
        __syncthreads();
    }
#undef ATT_GLOAD
#undef ATT_LSTORE
}
DI void attn_core64(LAS unsigned char* lds, const bf16_t* qptr, const bf16_t* kn, const bf16_t* kr, const bf16_t* vt, int KL, int nit, int nvalid,
                    f32x16 (&o)[2][2], float (&m_run)[2], float (&l_run)[2]) {
    constexpr int BUFSZ = 17920 + 5120;
    const int tid = tid_(), lane = tid & 63, r = lane & 31, h = lane >> 5;
    bf16x8 qf[2][2];
    LAS bf16x8* qr = (LAS bf16x8*)(lds + 2 * BUFSZ + (tid >> 6) * 8192) + lane;
#pragma unroll
    for (int g = 0; g < 2; ++g) {
#pragma unroll
        for (int ks = 0; ks < 2; ++ks) qf[g][ks] = *(const bf16x8*)(qptr + g * 32 * 96 + ks * 16 + h * 8);
#pragma unroll
        for (int ks = 0; ks < 4; ++ks) qr[(g * 4 + ks) * 64] = *(const bf16x8*)(qptr + g * 32 * 96 + (2 + ks) * 16 + h * 8); }
#pragma unroll
    for (int g = 0; g < 2; ++g) { m_run[g] = neg_big(); l_run[g] = 0.f;
#pragma unroll
        for (int i = 0; i < 16; ++i) { o[g][0][i] = 0.f; o[g][1][i] = 0.f; } }
    u32x4 rkn, rvt, rkr = {0u, 0u, 0u, 0u};
    const int lrow = tid >> 3, lseg = tid & 7;
#define A64_GLOAD(kt) do { const size_t key0_ = (size_t)(kt) * 64; rkn = *(const u32x4*)(kn + (key0_ + lrow) * 64 + lseg * 8); rvt = *(const u32x4*)(vt + (size_t)lrow * KL + key0_ + lseg * 8); \
        if (tid < 256) rkr = *(const u32x4*)(kr + (key0_ + (tid >> 2)) * 32 + (tid & 3) * 8); } while (0)
#define A64_LSTORE(buf) do { LAS unsigned char* B_ = lds + (buf) * BUFSZ; *(LAS u32x4*)(B_ + lrow * 144 + lseg * 16) = rkn; \
        LAS u32x2* pv_ = (LAS u32x2*)(B_ + 9216 + 5120 + lrow * 136 + lseg * 16); u32x2 a_, b_; a_[0] = rvt[0]; a_[1] = rvt[1]; b_[0] = rvt[2]; b_[1] = rvt[3]; pv_[0] = a_; pv_[1] = b_; \
        if (tid < 256) *(LAS u32x4*)(B_ + 9216 + (tid >> 2) * 80 + (tid & 3) * 16) = rkr; } while (0)
    A64_GLOAD(0); A64_LSTORE(0);
    __syncthreads();
    for (int it = 0; it < nit; ++it) {
        const bool more = (it + 1 < nit);
        if (more) A64_GLOAD(it + 1);
        if (it < nvalid) {
            const LAS unsigned char* B = lds + (it & 1) * BUFSZ;
            const LAS unsigned char* knb = B; const LAS unsigned char* krb = B + 9216; const LAS unsigned char* vtb = B + 9216 + 5120;
            f32x16 s[2][2];
#pragma unroll
            for (int g = 0; g < 2; ++g)
#pragma unroll
                for (int i = 0; i < 16; ++i) { s[g][0][i] = 0.f; s[g][1][i] = 0.f; }
            __builtin_amdgcn_s_setprio(1);
#define A64_KA0(ks) ((ks) < 4 ? *(const LAS bf16x8*)(knb + r * 144 + (ks) * 32 + h * 16) : *(const LAS bf16x8*)(krb + r * 80 + ((ks) - 4) * 32 + h * 16))
#define A64_KA1(ks) ((ks) < 4 ? *(const LAS bf16x8*)(knb + (32 + r) * 144 + (ks) * 32 + h * 16) : *(const LAS bf16x8*)(krb + (32 + r) * 80 + ((ks) - 4) * 32 + h * 16))
#define A64_Q(g, ks) ((ks) < 2 ? qf[g][(ks) < 2 ? (ks) : 0] : qr[((g) * 4 + (ks) - 2) * 64])
            { bf16x8 a0 = A64_KA0(0), a1 = A64_KA1(0), q0 = A64_Q(0, 0), q1 = A64_Q(1, 0);
#pragma unroll
              for (int ks = 0; ks < 6; ++ks) {
                  bf16x8 na0 = a0, na1 = a1, nq0 = q0, nq1 = q1;
                  if (ks < 5) { na0 = A64_KA0(ks + 1); na1 = A64_KA1(ks + 1); nq0 = A64_Q(0, ks + 1); nq1 = A64_Q(1, ks + 1); }
                  __builtin_amdgcn_sched_barrier(0);
                  s[0][0] = mfma32(a0, q0, s[0][0]); s[1][0] = mfma32(a0, q1, s[1][0]); s[0][1] = mfma32(a1, q0, s[0][1]); s[1][1] = mfma32(a1, q1, s[1][1]);
                  __builtin_amdgcn_sched_barrier(0);
                  a0 = na0; a1 = na1; q0 = nq0; q1 = nq1; } }
#undef A64_KA0
#undef A64_KA1
#undef A64_Q
            __builtin_amdgcn_s_setprio(0);
            __builtin_amdgcn_sched_barrier(0);
            bf16x8 pf[2][4];
#pragma unroll
            for (int g = 0; g < 2; ++g) {
                float mx = s[g][0][0];
#pragma unroll
                for (int i = 0; i < 16; ++i) { mx = fmaxf(mx, s[g][0][i]); mx = fmaxf(mx, s[g][1][i]); }
                mx = fmaxf(mx, __shfl_xor(mx, 32));
                const float mnew = mx > m_run[g] + 8.f ? mx : m_run[g], alpha = __builtin_amdgcn_exp2f(m_run[g] - mnew);
                const bool resc = __builtin_amdgcn_ballot_w64(mnew != m_run[g]) != 0ull;
                m_run[g] = mnew;
                float ps = 0.f;
#pragma unroll
                for (int i = 0; i < 16; ++i) { s[g][0][i] = __builtin_amdgcn_exp2f(s[g][0][i] - mnew); s[g][1][i] = __builtin_amdgcn_exp2f(s[g][1][i] - mnew); ps += s[g][0][i] + s[g][1][i]; }
                l_run[g] = l_run[g] * alpha + ps;
                if (resc) {
#pragma unroll
                    for (int i = 0; i < 16; ++i) { o[g][0][i] *= alpha; o[g][1][i] *= alpha; } }
                pf[g][0] = pack8(s[g][0], 0); pf[g][1] = pack8(s[g][0], 8); pf[g][2] = pack8(s[g][1], 0); pf[g][3] = pack8(s[g][1], 8);
                __builtin_amdgcn_sched_barrier(0);
            }
            __builtin_amdgcn_s_setprio(1);
#define A64_VF(idx, lo_, hi_) const LAS u32x2* pa_##lo_ = (const LAS u32x2*)(vtb + (32 * ((idx) >> 2) + r) * 136 + (16 * ((idx) & 3) + 4 * h) * 2); u32x2 lo_ = pa_##lo_[0], hi_ = pa_##lo_[2]
            { A64_VF(0, lo, hi);
#pragma unroll
              for (int idx = 0; idx < 8; ++idx) {
                  u32x2 nlo = lo, nhi = hi;
                  if (idx < 7) { const LAS u32x2* pn = (const LAS u32x2*)(vtb + (32 * ((idx + 1) >> 2) + r) * 136 + (16 * ((idx + 1) & 3) + 4 * h) * 2); nlo = pn[0]; nhi = pn[2]; }
                  __builtin_amdgcn_sched_barrier(0);
                  u32x4 av; av[0] = lo[0]; av[1] = lo[1]; av[2] = hi[0]; av[3] = hi[1]; const bf16x8 avb = __builtin_bit_cast(bf16x8, av);
                  o[0][idx >> 2] = mfma32(avb, pf[0][idx & 3], o[0][idx >> 2]); o[1][idx >> 2] = mfma32(avb, pf[1][idx & 3], o[1][idx >> 2]);
                  __builtin_amdgcn_sched_barrier(0);
                  lo = nlo; hi = nhi; } }
#undef A64_VF
            __builtin_amdgcn_s_setprio(0);
        }
        if (more) A64_LSTORE((it + 1) & 1);
        __syncthreads();
    }
#undef A64_GLOAD
#undef A64_LSTORE
}
DI void phase_attn_p(const Params& p, LAS unsigned char* lds) {
    const int tid = tid_(), lane = tid & 63, wid = __builtin_amdgcn_readfirstlane(tid >> 6), r = lane & 31, h = lane >> 5;
    const bf16_t* Q = (const bf16_t*)(p.ws + OFF_Q); const bf16_t* KN = (const bf16_t*)(p.ws + OFF_KN); const bf16_t* VT = (const bf16_t*)(p.ws + OFF_VT);
    const bf16_t* KRO = (const bf16_t*)(p.ws + OFF_KROPE); bf16_t* O = (bf16_t*)(p.ws + OFF_O);
    for (int pair = bid_(); pair < 256; pair += gridDim.x) {
        const int bh = (pair & 7) * 4 + (pair >> 6), qa = (pair >> 3) & 7, b = bh >> 3, hd = bh & 7;
        for (int sub = 0; sub < 2; ++sub) {
            const int qb = sub ? qa : 15 - qa;
            const int t0 = qb * 512 + wid * 64 + r;
            f32x16 o[2][2]; float m_run[2], l_run[2];
            attn_core64(lds, Q + ((size_t)bh * 8192 + t0) * 96, KN + (size_t)bh * 8192 * 64, KRO + (size_t)b * 8192 * 32, VT + (size_t)bh * 64 * 8192, 8192,
                        8 * qb + 8, 8 * qb + wid + 1, o, m_run, l_run);
#pragma unroll
            for (int g = 0; g < 2; ++g) {
                const float inv = 1.f / (l_run[g] + __shfl_xor(l_run[g], 32));
                bf16_t* orow = O + ((size_t)b * 8192 + t0 + g * 32) * 512 + hd * 64;
#pragma unroll
                for (int dh = 0; dh < 2; ++dh)
#pragma unroll
                    for (int q4 = 0; q4 < 4; ++q4) { uint2 w; w.x = pack2(o[g][dh][4 * q4] * inv, o[g][dh][4 * q4 + 1] * inv); w.y = pack2(o[g][dh][4 * q4 + 2] * inv, o[g][dh][4 * q4 + 3] * inv); *(uint2*)(orow + 32 * dh + 8 * q4 + 4 * h) = w; }
            }
        }
    }
}
DI void phase_attn_s(const Params& p, LAS unsigned char* lds) {
    const int tid = tid_(), lane = tid & 63, wid = __builtin_amdgcn_readfirstlane(tid >> 6), r = lane & 31, h = lane >> 5;
    const bf16_t* Q = (const bf16_t*)(p.ws + OFF_Q); const bf16_t* KN = (const bf16_t*)(p.ws + OFF_KN); const bf16_t* VT = (const bf16_t*)(p.ws + OFF_VT);
    const bf16_t* KRO = (const bf16_t*)(p.ws + OFF_KROPE); float* PART = (float*)(p.ws + OFF_PART);
    for (int c = bid_(); c < 256; c += gridDim.x) {
        const int b = c >> 3, hg = (c >> 2) & 1, split = c & 3, hh = wid >> 1, head = hg * 4 + hh, t = (wid & 1) * 32 + r;
        f32x16 o[2]; float m_run, l_run;
        attn_core<4>(lds, Q + (size_t)MP * 768 + ((size_t)(b * 8 + head) * 64 + t) * 96, KN + (size_t)MP * 512 + (size_t)(b * 8 + hg * 4) * KEYS_S * 64, (size_t)KEYS_S * 64,
                     KRO + (size_t)MP * 32 + (size_t)b * KEYS_S * 32, VT + (size_t)MP * 512 + (size_t)(b * 8 + hg * 4) * 64 * KEYS_S, (size_t)64 * KEYS_S, KEYS_S,
                     split, 4, 17, split == 0 ? 17 : 16, 65, hh, o, m_run, l_run);
        const float lt = l_run + __shfl_xor(l_run, 32);
        float* pr = PART + (((size_t)(b * 8 + head) * 4 + split) * 64 + t) * 66;
#pragma unroll
        for (int dh = 0; dh < 2; ++dh)
#pragma unroll
            for (int g = 0; g < 4; ++g) { float2 a, bb; a.x = o[dh][4 * g]; a.y = o[dh][4 * g + 1]; bb.x = o[dh][4 * g + 2]; bb.y = o[dh][4 * g + 3]; float* d = pr + 32 * dh + 8 * g + 4 * h; *(float2*)d = a; *(float2*)(d + 2) = bb; }
        if (h == 0) { float2 ml; ml.x = m_run; ml.y = lt; *(float2*)(pr + 64) = ml; }
    }
}

constexpr int R_QF = 0, R_KF = 16384, R_G = 32768, R_VTI = 49152, R_KTI = 58368, R_QTI = 67584, R_STI = 76800, R_PPI = 86016, R_QHI = 95232, R_KHI = 102144,
              R_GA = 115968, R_WA = 120064, R_SEG = 122240, R_OF = 0, R_WALL = 124288, R_BA = 132480, R_LB = 132992, R_QD = 134016, R_KD = 143232;
struct RecPre { u32x4 uv, ua, uq, ug, gz; f32x4 s0, s1; };
DI uint4 to_u4(u32x4 v) { uint4 r; r.x = v[0]; r.y = v[1]; r.z = v[2]; r.w = v[3]; return r; }
DI float4 to_f4(f32x4 v) { float4 r; r.x = v[0]; r.y = v[1]; r.z = v[2]; r.w = v[3]; return r; }
DI void rec_tables(const Params& p, int l, LAS unsigned char* lds) {
    const int tid = tid_();
    LAS float* WALL = (LAS float*)(lds + R_WALL); LAS float* BA = (LAS float*)(lds + R_BA); LAS float* LB = (LAS float*)(lds + R_LB);
#pragma unroll
    for (int i = 0; i < 4; ++i) WALL[tid + 512 * i] = p.in[23][l * 2048 + tid + 512 * i];
    if (tid < 128) BA[tid] = p.in[24][l * 128 + tid];
    if (tid < 256) { float lb = 0.f; if (l == 1) { const float l0 = p.in[21][tid], l1 = p.in[21][256 + tid]; lb = 1.f / (1.f + expf(l0 - l1)); } LB[tid] = lb; }
    __syncthreads();
}
template <int DK, bool HG>
DI void rec_issue(const Params& p, int cid, int hd, bool passC, RecPre& r) {
    const int tid = tid_();
    const bf16_t* Z = (const bf16_t*)(p.ws + OFF_Z);
    const size_t row0 = (size_t)cid * 64;
    const int lj = tid >> 3, ls8 = (tid & 7) * 8;
    const bf16_t* zr = Z + (row0 + lj) * ZLD;
    r.uv = *(const u32x4*)(zr + (HG ? 1056 : 1824) + hd * 64 + ls8);
    if (HG) { r.ua = *(const u32x4*)(zr + 800 + hd * 64 + ls8); if (passC) r.uq = *(const u32x4*)(zr + 544 + hd * 64 + ls8); }
    else { if (tid < 256) { const bf16_t* z2 = Z + (row0 + (tid >> 2)) * ZLD; r.ua = *(const u32x4*)(z2 + 1696 + hd * 32 + (tid & 3) * 8); if (passC) r.uq = *(const u32x4*)(z2 + 1568 + hd * 32 + (tid & 3) * 8); }
           if (tid < 128) r.ug = *(const u32x4*)(Z + (row0 + (tid >> 1)) * ZLD + 2336 + (tid & 1) * 8); }
    if (passC) {
        const float* S = (const float*)(p.ws + (HG ? OFF_UHG : OFF_UGL)) + ((size_t)cid * 4 + hd) * DK * 64;
            if (tid < DK * 8) { const int k = tid >> 3, v0 = (tid & 7) * 8; r.s0 = *(const f32x4*)(S + k * 64 + v0); r.s1 = *(const f32x4*)(S + k * 64 + v0 + 4); }
        r.gz = *(const u32x4*)(zr + (HG ? 1312 : 2080) + hd * 64 + ls8);
    }
}
template <int DK, bool HG>
DI void rec_load(const RecPre& pre, LAS unsigned char* lds, int hd, bool need_q) {
    const int tid = tid_();
    LAS float* QF = (LAS float*)(lds + R_QF); LAS float* KF = (LAS float*)(lds + R_KF); LAS float* G = (LAS float*)(lds + R_G);
    LAS bf16_t* VTI = (LAS bf16_t*)(lds + R_VTI); LAS float* GA = (LAS float*)(lds + R_GA); LAS float* SEG = (LAS float*)(lds + R_SEG);
    const LAS float* WA = (const LAS float*)(lds + (HG ? R_LB : R_WALL)) + (HG ? hd * 64 : hd * 32);
    const LAS float* BA = (const LAS float*)(lds + R_BA) + hd * 32;
    const int lj = tid >> 3, ls8 = (tid & 7) * 8;
    const uint4 uv = to_u4(pre.uv), ua = to_u4(pre.ua), uq = to_u4(pre.uq);
    if (!HG) {
        if (tid < 128) { const int j = tid >> 1, hf = tid & 1; const uint4 u = to_u4(pre.ug); LAS float* ga = GA + j * 16 + hf * 8;
            ga[0] = bflo(u.x); ga[1] = bfhi(u.x); ga[2] = bflo(u.y); ga[3] = bfhi(u.y); ga[4] = bflo(u.z); ga[5] = bfhi(u.z); ga[6] = bflo(u.w); ga[7] = bfhi(u.w); }
        __syncthreads();
    }
    { const float va[8] = {bflo(ua.x), bfhi(ua.x), bflo(ua.y), bfhi(ua.y), bflo(ua.z), bfhi(ua.z), bflo(ua.w), bfhi(ua.w)};
      const float vq[8] = {bflo(uq.x), bfhi(uq.x), bflo(uq.y), bfhi(uq.y), bflo(uq.z), bfhi(uq.z), bflo(uq.w), bfhi(uq.w)};
      if (HG) { float gg[8], kk[8];
#pragma unroll
          for (int x = 0; x < 8; ++x) { const float lb = WA[ls8 + x], e = __expf(fminf(-va[x], 80.f)), s = 1.f / (1.f + e); gg[x] = logf(lb + (1.f - lb) * s); kk[x] = (1.f - lb) * e * s; }
          LAS f32x4* gp = (LAS f32x4*)(G + lj * 64 + ls8); LAS f32x4* kp = (LAS f32x4*)(KF + lj * 64 + ls8);
          gp[0] = (f32x4){gg[0], gg[1], gg[2], gg[3]}; gp[1] = (f32x4){gg[4], gg[5], gg[6], gg[7]}; kp[0] = (f32x4){kk[0], kk[1], kk[2], kk[3]}; kp[1] = (f32x4){kk[4], kk[5], kk[6], kk[7]};
          if (need_q) { LAS f32x4* qp = (LAS f32x4*)(QF + lj * 64 + ls8); qp[0] = (f32x4){vq[0], vq[1], vq[2], vq[3]}; qp[1] = (f32x4){vq[4], vq[5], vq[6], vq[7]}; } }
      else {
          { const int kq = (tid & 7) * 4; f32x4 x = *(const LAS f32x4*)(BA + kq);
#pragma unroll
            for (int r = 0; r < 16; ++r) { const float ga = GA[lj * 16 + r]; const f32x4 wv = *(const LAS f32x4*)(WA + r * 128 + kq); x += ga * wv; }
            f32x4 o;
#pragma unroll
            for (int y = 0; y < 4; ++y) o[y] = (fminf(x[y], 0.f) - log1pf(__expf(-fabsf(x[y])))) * (1.f / 16.f);
            *(LAS f32x4*)(G + lj * 32 + kq) = o; }
          if (tid < 256) { const int j2 = tid >> 2, k2 = (tid & 3) * 8; LAS f32x4* kp = (LAS f32x4*)(KF + j2 * 32 + k2); kp[0] = (f32x4){va[0], va[1], va[2], va[3]}; kp[1] = (f32x4){va[4], va[5], va[6], va[7]};
              if (need_q) { const float qs = 0.17677669529663687f; LAS f32x4* qp = (LAS f32x4*)(QF + j2 * 32 + k2); qp[0] = (f32x4){vq[0] * qs, vq[1] * qs, vq[2] * qs, vq[3] * qs}; qp[1] = (f32x4){vq[4] * qs, vq[5] * qs, vq[6] * qs, vq[7] * qs}; } } }
      const unsigned vv[4] = {uv.x, uv.y, uv.z, uv.w};
#pragma unroll
      for (int x = 0; x < 4; ++x) { VTI[(ls8 + 2 * x) * 72 + lj] = (bf16_t)(vv[x] & 0xFFFFu); VTI[(ls8 + 2 * x + 1) * 72 + lj] = (bf16_t)(vv[x] >> 16); } }
    __syncthreads();
    constexpr int NSEG = NT / DK, JS = 64 / NSEG;
    const int seg = tid / DK, k = tid % DK;
    float loc[JS]; float s = 0.f;
#pragma unroll
    for (int jj = 0; jj < JS; ++jj) { s += G[(seg * JS + jj) * DK + k]; loc[jj] = s; }
    SEG[seg * DK + k] = s;
    __syncthreads();
    float off = 0.f;
#pragma unroll
    for (int s2 = 0; s2 < NSEG; ++s2) { const float t = SEG[s2 * DK + k]; off += s2 < seg ? t : 0.f; }
#pragma unroll
    for (int jj = 0; jj < JS; ++jj) G[(seg * JS + jj) * DK + k] = loc[jj] + off;
    __syncthreads();
}
template <int DK, bool HG>
DI void rec_passA_item(const Params& p, int l, LAS unsigned char* lds, int cid, int hd, const RecPre& pre) {
    const int tid = tid_(), lane = tid & 63, wid = __builtin_amdgcn_readfirstlane(tid >> 6), fr = lane & 15, fq = lane >> 4;
    rec_load<DK, HG>(pre, lds, hd, false);
    LAS float* KF = (LAS float*)(lds + R_KF); LAS float* G = (LAS float*)(lds + R_G);
    LAS bf16_t* VTI = (LAS bf16_t*)(lds + R_VTI); LAS bf16_t* KTI = (LAS bf16_t*)(lds + R_KTI);
    float* U = (float*)(p.ws + (HG ? OFF_UHG : OFF_UGL)); float* D = (float*)(p.ws + (HG ? OFF_DHG : OFF_DGL));
    for (int e = tid; e < 64 * DK; e += NT) { const int j = e / DK, k = e % DK; KTI[k * 72 + j] = f2bf(KF[e] * __expf(G[63 * DK + k] - G[e])); }
    if (tid < DK) D[((size_t)cid * 4 + hd) * DK + tid] = __expf(G[63 * DK + tid]);
    __syncthreads();
    for (int tile = wid; tile < (DK / 16) * 4; tile += 8) {
        const int tk = tile >> 2, tv = tile & 3; f32x4 acc = {0.f, 0.f, 0.f, 0.f};
#pragma unroll
        for (int s = 0; s < 2; ++s) { const bf16x8 a = *(const LAS bf16x8*)(KTI + (16 * tk + fr) * 72 + 32 * s + 8 * fq), b = *(const LAS bf16x8*)(VTI + (16 * tv + fr) * 72 + 32 * s + 8 * fq); acc = mfma16(a, b, acc); }
#pragma unroll
        for (int reg = 0; reg < 4; ++reg) U[(((size_t)cid * 4 + hd) * DK + 16 * tk + 4 * fq + reg) * 64 + 16 * tv + fr] = acc[reg];
    }
    __syncthreads();
}
template <int DK, bool HG>
DI void rec_passC_item(const Params& p, int l, LAS unsigned char* lds, int cid, int hd, const RecPre& pre) {
    const int tid = tid_(), lane = tid & 63, wid = __builtin_amdgcn_readfirstlane(tid >> 6), fr = lane & 15, fq = lane >> 4;
    rec_load<DK, HG>(pre, lds, hd, true);
    LAS float* QF = (LAS float*)(lds + R_QF); LAS float* KF = (LAS float*)(lds + R_KF); LAS float* G = (LAS float*)(lds + R_G); LAS float* OF = (LAS float*)(lds + R_OF);
    LAS bf16_t* VTI = (LAS bf16_t*)(lds + R_VTI); LAS bf16_t* QTI = (LAS bf16_t*)(lds + R_QTI); LAS bf16_t* STI = (LAS bf16_t*)(lds + R_STI);
    LAS bf16_t* PPI = (LAS bf16_t*)(lds + R_PPI); LAS bf16_t* QHI = (LAS bf16_t*)(lds + R_QHI); LAS bf16_t* KHI = (LAS bf16_t*)(lds + R_KHI);
    const bf16_t* Z = (const bf16_t*)(p.ws + OFF_Z); bf16_t* H = (bf16_t*)(p.ws + OFF_H);
    for (int e = tid; e < 64 * DK; e += NT) { const int i = e / DK, k = e % DK; QTI[i * 72 + k] = f2bf(QF[e] * __expf(G[e])); }
    if (tid < DK * 8) { const int k = tid >> 3, v0 = (tid & 7) * 8; const float4 s0 = to_f4(pre.s0), s1 = to_f4(pre.s1);
        STI[(v0 + 0) * 72 + k] = f2bf(s0.x); STI[(v0 + 1) * 72 + k] = f2bf(s0.y); STI[(v0 + 2) * 72 + k] = f2bf(s0.z); STI[(v0 + 3) * 72 + k] = f2bf(s0.w);
        STI[(v0 + 4) * 72 + k] = f2bf(s1.x); STI[(v0 + 5) * 72 + k] = f2bf(s1.y); STI[(v0 + 6) * 72 + k] = f2bf(s1.z); STI[(v0 + 7) * 72 + k] = f2bf(s1.w); }
    for (int e = tid; e < 48 * DK; e += NT) { const int ii = e / DK, k = e % DK, I = 1 + (ii >> 4), i = 16 + ii; const float ref = G[(16 * I - 1) * DK + k];
        QHI[ii * 72 + k] = f2bf(QF[i * DK + k] * __expf(G[i * DK + k] - ref)); }
    for (int e = tid; e < 96 * DK; e += NT) { const int rr = e / DK, k = e % DK, I = rr < 16 ? 1 : (rr < 48 ? 2 : 3), j = rr - 8 * I * (I - 1); const float ref = G[(16 * I - 1) * DK + k];
        KHI[rr * 72 + k] = f2bf(KF[j * DK + k] * __expf(ref - G[j * DK + k])); }
    { LAS bf16_t* QD = (LAS bf16_t*)(lds + R_QD); LAS bf16_t* KD = (LAS bf16_t*)(lds + R_KD);
      for (int e = tid; e < 64 * DK; e += NT) { const int i = e / DK, k = e % DK; const float ref = G[(16 * (i >> 4) + 7) * DK + k], gi = G[e];
          QD[i * 72 + k] = f2bf(QF[e] * __expf(fminf(fmaxf(gi - ref, -80.f), 80.f))); KD[i * 72 + k] = f2bf(KF[e] * __expf(fminf(fmaxf(ref - gi, -80.f), 80.f))); } }
    for (int e = tid; e < 1536; e += NT) { const int bidx = e >> 8, w = e & 255; const int I = bidx < 3 ? 0 : (bidx < 5 ? 1 : 2), J = bidx < 3 ? bidx + 1 : (bidx < 5 ? bidx - 1 : 3);
        PPI[(16 * I + (w >> 4)) * 72 + 16 * J + (w & 15)] = 0; }
    __syncthreads();
    if (wid >= 6) { const LAS bf16_t* QD = (const LAS bf16_t*)(lds + R_QD); const LAS bf16_t* KD = (const LAS bf16_t*)(lds + R_KD);
#pragma unroll
        for (int t2 = 0; t2 < 2; ++t2) { const int I = (wid - 6) * 2 + t2; f32x4 acc = {0.f, 0.f, 0.f, 0.f};
#pragma unroll
            for (int s = 0; s < DK / 32; ++s) { const bf16x8 a = *(const LAS bf16x8*)(QD + (16 * I + fr) * 72 + 32 * s + 8 * fq), b = *(const LAS bf16x8*)(KD + (16 * I + fr) * 72 + 32 * s + 8 * fq); acc = mfma16(a, b, acc); }
#pragma unroll
            for (int reg = 0; reg < 4; ++reg) PPI[(16 * I + 4 * fq + reg) * 72 + 16 * I + fr] = f2bf(fr <= 4 * fq + reg ? acc[reg] : 0.f); } }
    if (wid < 6) { const int I = wid < 1 ? 1 : (wid < 3 ? 2 : 3), J = wid < 1 ? 0 : (wid < 3 ? wid - 1 : wid - 3); f32x4 acc = {0.f, 0.f, 0.f, 0.f};
#pragma unroll
        for (int s = 0; s < DK / 32; ++s) { const bf16x8 a = *(const LAS bf16x8*)(QHI + ((I - 1) * 16 + fr) * 72 + 32 * s + 8 * fq), b = *(const LAS bf16x8*)(KHI + (8 * I * (I - 1) + 16 * J + fr) * 72 + 32 * s + 8 * fq); acc = mfma16(a, b, acc); }
#pragma unroll
        for (int reg = 0; reg < 4; ++reg) PPI[(16 * I + 4 * fq + reg) * 72 + 16 * J + fr] = f2bf(acc[reg]); }
    __syncthreads();
#pragma unroll
    for (int tt = 0; tt < 2; ++tt) { const int tile = wid * 2 + tt, ti = tile >> 2, tv = tile & 3; f32x4 acc = {0.f, 0.f, 0.f, 0.f};
#pragma unroll
        for (int s = 0; s < DK / 32; ++s) { const bf16x8 a = *(const LAS bf16x8*)(QTI + (16 * ti + fr) * 72 + 32 * s + 8 * fq), b = *(const LAS bf16x8*)(STI + (16 * tv + fr) * 72 + 32 * s + 8 * fq); acc = mfma16(a, b, acc); }
#pragma unroll
        for (int s = 0; s < 2; ++s) { const bf16x8 a = *(const LAS bf16x8*)(PPI + (16 * ti + fr) * 72 + 32 * s + 8 * fq), b = *(const LAS bf16x8*)(VTI + (16 * tv + fr) * 72 + 32 * s + 8 * fq); acc = mfma16(a, b, acc); }
#pragma unroll
        for (int reg = 0; reg < 4; ++reg) OF[(16 * ti + 4 * fq + reg) * 65 + 16 * tv + fr] = acc[reg]; }
    __syncthreads();
    { const int i = tid >> 3, part = tid & 7; float v[8]; float ss = 0.f;
#pragma unroll
      for (int x = 0; x < 8; ++x) { v[x] = OF[i * 65 + part * 8 + x]; ss += v[x] * v[x]; }
      ss += __shfl_xor(ss, 1); ss += __shfl_xor(ss, 2); ss += __shfl_xor(ss, 4);
      const float rs = rsqrtf(ss * (1.f / 64.f) + EPS);
      const size_t row = (size_t)cid * 64 + i;
      const uint4 gz = to_u4(pre.gz);
      const float* go = p.in[HG ? 22 : 25] + l * 64 + part * 8;
      const float gt[8] = {bflo(gz.x), bfhi(gz.x), bflo(gz.y), bfhi(gz.y), bflo(gz.z), bfhi(gz.z), bflo(gz.w), bfhi(gz.w)};
      float r[8];
#pragma unroll
      for (int x = 0; x < 8; ++x) r[x] = v[x] * rs * go[x] * (gt[x] / (1.f + __expf(-gt[x])));
      uint4 w; w.x = pack2(r[0], r[1]); w.y = pack2(r[2], r[3]); w.z = pack2(r[4], r[5]); w.w = pack2(r[6], r[7]);
      *(uint4*)(H + row * 1024 + 512 + (HG ? 0 : 256) + hd * 64 + part * 8) = w; }
    __syncthreads();
}
template <int DK>
DI void scan_prompt(float* U, const float* D, float* outp, int e) {
    const int v = e & 63, k = (e >> 6) % DK, hd = (e / (64 * DK)) & 3, b = e / (256 * DK);
    float S = 0.f;
    for (int n0 = 0; n0 < 128; n0 += 16) {
        float u[16], d[16];
#pragma unroll
        for (int i = 0; i < 16; ++i) { const size_t ch = ((size_t)(b * 128 + n0 + i) * 4 + hd); u[i] = U[(ch * DK + k) * 64 + v]; d[i] = D[ch * DK + k]; }
#pragma unroll
        for (int i = 0; i < 16; ++i) { const size_t ch = ((size_t)(b * 128 + n0 + i) * 4 + hd); U[(ch * DK + k) * 64 + v] = S; S = d[i] * S + u[i]; }
    }
    outp[e] = S;
}
template <int DK>
DI void scan_sample(float* U, const float* D, const float* s0p, float* outp, int e) {
    const int v = e & 63, k = (e >> 6) % DK, hd = (e / (64 * DK)) & 3, b = e / (256 * DK);
    const size_t ch = (size_t)(512 + b) * 4 + hd; const size_t idx = (ch * DK + k) * 64 + v;
    const float s0 = s0p[e], u = U[idx], d = D[ch * DK + k];
    U[idx] = s0; outp[e] = d * s0 + u;
}
DI void phase_scan(const Params& p, int l) {
    const int g = bid_() * NT + tid_(), gs = gridDim.x * NT;
    float* UH = (float*)(p.ws + OFF_UHG); const float* DH = (const float*)(p.ws + OFF_DHG); float* UG = (float*)(p.ws + OFF_UGL); const float* DG = (const float*)(p.ws + OFF_DGL);
    for (int e = g; e < 98304; e += gs) {
        if (e < 65536) scan_prompt<64>(UH, DH, p.out + OUT_HGP + (size_t)l * 65536, e);
        else scan_prompt<32>(UG, DG, p.out + OUT_GLP + (size_t)l * 32768, e - 65536);
    }
    for (int e = g; e < 786432; e += gs) {
        if (e < 524288) scan_sample<64>(UH, DH, p.in[6] + (size_t)l * 524288, p.out + OUT_HGS + (size_t)l * 524288, e);
        else scan_sample<32>(UG, DG, p.in[7] + (size_t)l * 262144, p.out + OUT_GLS + (size_t)l * 262144, e - 524288);
    }
}
DI void phase_mlaout(const Params& p, int l) {
    const int tid = tid_(), lane = tid & 63, wid = __builtin_amdgcn_readfirstlane(tid >> 6);
    const bf16_t* O = (const bf16_t*)(p.ws + OFF_O); const float* PART = (const float*)(p.ws + OFF_PART); bf16_t* H = (bf16_t*)(p.ws + OFF_H);
    const float* g = p.in[20] + l * 512 + 8 * lane;
    for (int row = bid_() * 8 + wid; row < MT; row += gridDim.x * 8) {
        float v[8];
        if (row < MP) { const uint4 u = *(const uint4*)(O + (size_t)row * 512 + 8 * lane);
            v[0] = bflo(u.x); v[1] = bfhi(u.x); v[2] = bflo(u.y); v[3] = bfhi(u.y); v[4] = bflo(u.z); v[5] = bfhi(u.z); v[6] = bflo(u.w); v[7] = bfhi(u.w); }
        else { const int r = row - MP, b = r >> 6, t = r & 63, head = lane >> 3, dv0 = (lane & 7) * 8;
            const float* pb = PART + (((size_t)(b * 8 + head) * 4) * 64 + t) * 66;
            float m[4], lsum[4]; float M = neg_big();
#pragma unroll
            for (int s = 0; s < 4; ++s) { m[s] = pb[(size_t)s * 64 * 66 + 64]; lsum[s] = pb[(size_t)s * 64 * 66 + 65]; M = fmaxf(M, m[s]); }
            float L = 0.f;
#pragma unroll
            for (int x = 0; x < 8; ++x) v[x] = 0.f;
#pragma unroll
            for (int s = 0; s < 4; ++s) { const float w = exp2f(m[s] - M); L += w * lsum[s];
#pragma unroll
                for (int x = 0; x < 8; ++x) v[x] += w * pb[(size_t)s * 64 * 66 + dv0 + x]; }
            const float inv = 1.f / L;
#pragma unroll
            for (int x = 0; x < 8; ++x) v[x] *= inv; }
        float ss = 0.f;
#pragma unroll
        for (int x = 0; x < 8; ++x) ss += v[x] * v[x];
        ss = wave_sum(ss);
        const float rs = rsqrtf(ss * (1.f / 512.f) + EPS);
        uint4 w; w.x = pack2(v[0] * rs * g[0], v[1] * rs * g[1]); w.y = pack2(v[2] * rs * g[2], v[3] * rs * g[3]); w.z = pack2(v[4] * rs * g[4], v[5] * rs * g[5]); w.w = pack2(v[6] * rs * g[6], v[7] * rs * g[7]);
        *(uint4*)(H + (size_t)row * 1024 + 8 * lane) = w;
    }
}

DI void gsync(const Params& p, LAS unsigned char* lds) { XcdBarrier b; b.bar = (unsigned*)(p.ws + OFF_BAR); b.x = xb_xcc_id(); b.st = (volatile LAS unsigned*)(lds + LDS_BYTES - 16); xcd_barrier(b); }
__global__ void __launch_bounds__(512, 2) mk_fwd(Params p) {
    extern __shared__ __attribute__((aligned(16))) unsigned char shm[];
    LAS unsigned char* lds = (LAS unsigned char*)shm;
    cg::grid_group grid = cg::this_grid();
    bf16_t* H = (bf16_t*)(p.ws + OFF_H); bf16_t* Z = (bf16_t*)(p.ws + OFF_Z); bf16_t* CQN = (bf16_t*)(p.ws + OFF_CQN); bf16_t* CKV = (bf16_t*)(p.ws + OFF_CKV);
    bf16_t* Q = (bf16_t*)(p.ws + OFF_Q); bf16_t* KN = (bf16_t*)(p.ws + OFF_KN); bf16_t* VT = (bf16_t*)(p.ws + OFF_VT); bf16_t* ACT = (bf16_t*)(p.ws + OFF_ACT);
    const float* rope = (const float*)(p.ws + OFF_ROPE); bf16_t* XB = (bf16_t*)(p.ws + OFF_XB);
    volatile LAS unsigned* xst = (volatile LAS unsigned*)(lds + LDS_BYTES - 16);
    if (threadIdx.x == 0) { xst[0] = 0u; xst[1] = 0u; }
    __syncthreads();
    (void)xcd_barrier_post((unsigned*)(p.ws + OFF_BAR), xst);
    phase_prep(p, lds);
    grid.sync();
#pragma unroll 1
    for (int l = 0; l < 2; ++l) {
        const unsigned char* W = p.ws + OFF_W + (size_t)l * WL;
        const float* modl = (const float*)(p.ws + OFF_MOD) + (size_t)l * 36 * 6144;
        const int hb0 = (int)gridDim.x > 64 ? 32 : 0, hnb = (int)gridDim.x - hb0;
        if (l == 0) { phase_hrows<true>(p, l, p.in[0], p.in[1], p.in[10] + l * 1024, 0, 1024); gsync(p, lds); }
        run_gemm(lds, H, (const bf16_t*)(W + WOFF_IN), MT, 2560, 1024, EpiZ{Z, ZLD});
        {
          const int G = (int)gridDim.x, rem = ((MT / 256) * (2560 / 256)) % G;
          if (rem > 0 && G - rem >= G / 2) { if ((int)bid_() >= rem) phase_cache(p, l, rem, G - rem); } else phase_cache(p, l, 0, G); }
        gsync(p, lds);
        phase_post(p, l);
        rec_tables(p, l, lds);
        { RecPre pre = {}; int it = bid_(); if (it < 2176) rec_issue<64, true>(p, it >> 2, it & 3, false, pre);
          for (; it < 2176; it += gridDim.x) { const RecPre cur = pre; const int nx = it + gridDim.x; if (nx < 2176) rec_issue<64, true>(p, nx >> 2, nx & 3, false, pre); rec_passA_item<64, true>(p, l, lds, it >> 2, it & 3, cur); } }
        { RecPre pre = {}; int it = (int)((bid_() + gridDim.x / 2) % gridDim.x); if (it < 2176) rec_issue<32, false>(p, it >> 2, it & 3, false, pre);
          for (; it < 2176; it += gridDim.x) { const RecPre cur = pre; const int nx = it + gridDim.x; if (nx < 2176) rec_issue<32, false>(p, nx >> 2, nx & 3, false, pre); rec_passA_item<32, false>(p, l, lds, it >> 2, it & 3, cur); } }
        gsync(p, lds);
        run_gemm(lds, CQN, (const bf16_t*)(W + WOFF_UQ), MT, 768, 256, EpiQ{Q, p.in[18] + l * 96, rope});
        run_gemm(lds, CKV, (const bf16_t*)(W + WOFF_UK), KR_ROWS, 512, 256, EpiKN{KN, p.in[19] + l * 96}, 104);
        run_gemm(lds, (const bf16_t*)(W + WOFF_UV), CKV, 512, KR_ROWS, 256, EpiVT{VT}, 40);
        phase_scan(p, l);
        gsync(p, lds);
        phase_attn_p(p, lds);
        phase_attn_s(p, lds);
        rec_tables(p, l, lds);
        { RecPre pre = {}; int it = bid_(); if (it < 2176) rec_issue<64, true>(p, it >> 2, it & 3, true, pre);
          for (; it < 2176; it += gridDim.x) { const RecPre cur = pre; const int nx = it + gridDim.x; if (nx < 2176) rec_issue<64, true>(p, nx >> 2, nx & 3, true, pre); rec_passC_item<64, true>(p, l, lds, it >> 2, it & 3, cur); } }
        { RecPre pre = {}; int it = (int)((bid_() + gridDim.x / 2) % gridDim.x); if (it < 2176) rec_issue<32, false>(p, it >> 2, it & 3, true, pre);
          for (; it < 2176; it += gridDim.x) { const RecPre cur = pre; const int nx = it + gridDim.x; if (nx < 2176) rec_issue<32, false>(p, nx >> 2, nx & 3, true, pre); rec_passC_item<32, false>(p, l, lds, it >> 2, it & 3, cur); } }
        gsync(p, lds);
        phase_mlaout(p, l);
        gsync(p, lds);
        run_gemm(lds, H, (const bf16_t*)(W + WOFF_O), MP, 1024, 1024, EpiRes{XB, p.out, modl + 2048, 0, 0});
        gsync(p, lds);
        run_gemm(lds, H + (size_t)MP * 1024, (const bf16_t*)(W + WOFF_O), MS, 1024, 1024, EpiRes{XB, p.out, modl + 2048, 0, MP / 256});
        if ((int)bid_() >= hb0) phase_hrows<false>(p, l, nullptr, nullptr, p.in[11] + l * 1024, 3072, 4096, 0, MP, hb0, hnb);
        gsync(p, lds);
        phase_hrows<false>(p, l, nullptr, nullptr, p.in[11] + l * 1024, 3072, 4096, MP, MT);
        gsync(p, lds);
        const bool skew_ok = l == 1 && ((MP / 256) * 22) % (int)gridDim.x == 0 && (int)gridDim.x >= 128;
        if (!skew_ok) { run_gemm(lds, H, (const bf16_t*)(W + WOFF_FI), MT, 5632, 1024, EpiSwi{ACT, 0}); gsync(p, lds); }
        if (l == 0) {
            run_gemm(lds, ACT, (const bf16_t*)(W + WOFF_FO), MP, 1024, 2816, EpiRes{XB, p.out, modl + 5120, 0, 0});
            gsync(p, lds);
            run_gemm(lds, ACT + (size_t)MP * 2816, (const bf16_t*)(W + WOFF_FO), MS, 1024, 2816, EpiRes{XB, p.out, modl + 5120, 0, MP / 256});
            if ((int)bid_() >= hb0) phase_hrows<false>(p, 1, nullptr, nullptr, p.in[10] + 1024, 0, 1024, 0, MP, hb0, hnb);
            gsync(p, lds);
            phase_hrows<false>(p, 1, nullptr, nullptr, p.in[10] + 1024, 0, 1024, MP, MT);
            gsync(p, lds);
        } else if (skew_ok) {
            run_gemm(lds, H + (size_t)MP * 1024, (const bf16_t*)(W + WOFF_FI), MS, 5632, 1024, EpiSwi{ACT, MP / 256});
            gsync(p, lds);
            run_gemm(lds, ACT + (size_t)MP * 2816, (const bf16_t*)(W + WOFF_FO), MS, 1024, 2816, EpiRes{XB, p.out, modl + 5120, 1, MP / 256});
            run_gemm_skew(lds, H, (const bf16_t*)(W + WOFF_FI), MP, 5632, 1024, EpiSwi{ACT, 0}, 32, 2);
            gsync(p, lds);
            run_gemm(lds, ACT, (const bf16_t*)(W + WOFF_FO), MP, 1024, 2816, EpiRes{XB, p.out, modl + 5120, 1, 0});
        } else run_gemm(lds, ACT, (const bf16_t*)(W + WOFF_FO), MT, 1024, 2816, EpiRes{XB, p.out, modl + 5120, 1, 0});
    }
}

extern "C" void kernel_launch(void* const* d_in, const int* in_sizes, int n_in, void* d_out, int out_size, void* d_ws, size_t ws_size, hipStream_t stream) {
    static int grid = 0;
    if (grid == 0) {
        int dev = 0, cus = 0, per_cu = 0;
        hipGetDevice(&dev);
        hipDeviceGetAttribute(&cus, hipDeviceAttributeMultiprocessorCount, dev);
        hipFuncSetAttribute((const void*)mk_fwd, hipFuncAttributeMaxDynamicSharedMemorySize, LDS_BYTES);
        hipOccupancyMaxActiveBlocksPerMultiprocessor(&per_cu, (const void*)mk_fwd, NT, LDS_BYTES);
        if (per_cu < 1) { fprintf(stderr, "kernel_launch: occupancy query says %d blocks per CU\n", per_cu); per_cu = 1; }
        (void)hipGetLastError();
        grid = cus;
        if (ws_size < WS_END) { fprintf(stderr, "kernel_launch: workspace too small: %zu < %zu\n", ws_size, (size_t)WS_END); grid = -1; }
    }
    if (grid < 0) return;
    if (hipMemsetAsync((char*)d_ws + OFF_BAR, 0, XCD_BAR_WORDS * 4, stream) != hipSuccess) { fprintf(stderr, "kernel_launch: memset failed\n"); return; }
    Params p{};
    for (int i = 0; i < 29; ++i) p.in[i] = (const float*)d_in[i];
    p.out = (float*)d_out; p.ws = (unsigned char*)d_ws;
    void* args[] = {&p};
    hipError_t e = hipLaunchCooperativeKernel((const void*)mk_fwd, dim3(grid), dim3(NT), args, LDS_BYTES, stream);
    if (e != hipSuccess) fprintf(stderr, "cooperative launch failed: %s (grid %d)\n", hipGetErrorString(e), grid);
}
```

```cpp
#include <hip/hip_runtime.h>
#include <hip/hip_cooperative_groups.h>
#include <cstdio>
namespace cg = cooperative_groups;
namespace pg8 {
#define PG8_LAS __attribute__((address_space(3)))
typedef unsigned short bf16_t;
typedef short bf16x8 __attribute__((ext_vector_type(8)));
typedef float f32x4 __attribute__((ext_vector_type(4)));
typedef unsigned u32x4 __attribute__((ext_vector_type(4)));
constexpr int BM = 256, BK = 64, HALF = 128, HTB = HALF * BK * 2  , STAGE_BYTES = 8 * HTB, NXCD = 8, WGM = 8;

__host__ __device__ __forceinline__ int lds_byte(int r, int c) { const int st = (r >> 4) * 2 + (c >> 5), rr = r & 15, cc = c & 31, ob = rr * 64 + cc * 2; return st * 1024 + (ob ^ (((ob >> 9) & 1) << 5)); }
__host__ __device__ __forceinline__ void stage_rc(int b, int& R, int& C) { const int st = b / 1024, sb = b % 1024, swz = sb ^ (((sb >> 9) & 1) << 5); R = (st >> 1) * 16 + swz / 64; C = (st & 1) * 32 + (swz % 64) / 2; }
__host__ __device__ __forceinline__ int perm32(int rho) { const int n = rho >> 4, i = rho & 15; return 8 * (i >> 2) + 4 * n + (i & 3); }

struct Unit { int pm, pn; };
struct Gemm { const bf16_t* A; const bf16_t* Bt; int M, N, K; };

struct StaticOrder {
    int nM, nN, nwg, G, c;
    __host__ __device__ void init(int M, int N, int G_, int c_) { nM = M / BM; nN = N / BM; nwg = nM * nN; G = G_; c = c_; }
    __host__ __device__ bool next(int i, Unit& u) const {
        const long L = (long)i * G + c; if (L >= nwg) return false;
        int wgid = (int)L; { const int q = nwg / NXCD, r = nwg % NXCD, xcd = wgid % NXCD, off = wgid / NXCD; wgid = (xcd < r ? xcd * (q + 1) : r * (q + 1) + (xcd - r) * q) + off; }
        const int nig = WGM * nN, gid = wgid / nig, fm = gid * WGM, gsz = (nM - fm) < WGM ? (nM - fm) : WGM;
        u.pm = fm + ((wgid % nig) % gsz); u.pn = (wgid % nig) / gsz; return true;
    }
    __device__ __forceinline__ void a_ready(const Unit&) const {}
    __device__ __forceinline__ void done(const Unit&) const {}
};
template <class Epi, class Sched, bool STAMP = false>
__device__ __forceinline__ void gemm_phase(PG8_LAS unsigned char* lds, const Gemm g, const Sched& S, const Epi& E, unsigned long long* stamps) {
    int tid = threadIdx.x; asm volatile("" : "+v"(tid)); const int wid = __builtin_amdgcn_readfirstlane(tid >> 6), lane = tid & 63, wr = wid >> 2, wc = wid & 3, fr = lane & 15, fq = lane >> 4;
    const int K = g.K, nt = K / BK;
    int ts_lo = 0, ts_hi = 0, nts = 0; const unsigned long long rt_entry = STAMP ? (unsigned long long)wall_clock64() : 0ull;
#define PG8_STAMP() do { if (STAMP && wid == 0 && nts < 64) { const unsigned long long _c = (unsigned long long)clock64(); \
        ts_lo = (lane == nts) ? (int)(unsigned)_c : ts_lo; ts_hi = (lane == nts) ? (int)(unsigned)(_c >> 32) : ts_hi; ++nts; } } while (0)
    PG8_STAMP();
    unsigned voffA[2], voffB[2];
#pragma unroll
    for (int i = 0; i < 2; ++i) { int R, C; stage_rc(tid * 16 + i * 8192, R, C); const int Rb = Epi::PERM ? ((R & ~31) + perm32(R & 31)) : R;
        voffA[i] = (unsigned)(R * K + C) * 2u; voffB[i] = (unsigned)(Rb * K + C) * 2u; }
    const size_t kstep = (size_t)(BK * 2);
    const size_t hstep = (size_t)HALF * K * 2;
    const size_t tstep = 2 * hstep;
    const unsigned ldsw = (unsigned)wid * 1024u;
    const int aoff = lds_byte(wr * 64 + fr, fq * 8), boff = lds_byte(wc * 32 + fr, fq * 8);
#define PG8_SA(b, h) (((b) * 2 + (h)) * HTB)
#define PG8_SB(b, h) ((4 + (b) * 2 + (h)) * HTB)
#define PG8_STAGE(bufoff, gbase, voff) do { _Pragma("unroll") for (int _i = 0; _i < 2; ++_i) \
        __builtin_amdgcn_global_load_lds((const unsigned*)((const char*)(gbase) + (voff)[_i]), (PG8_LAS unsigned*)(lds + (bufoff) + ldsw + _i * 8192), 16, 0, 0); } while (0)
#define PG8_LDA(dst, b, h) do { _Pragma("unroll") for (int m = 0; m < 4; ++m) _Pragma("unroll") for (int k = 0; k < 2; ++k) dst[m][k] = *(const PG8_LAS bf16x8*)(lds + PG8_SA(b, h) + aoff + m * 2048 + k * 1024); } while (0)
#define PG8_LDB(dst, b, h) do { _Pragma("unroll") for (int n = 0; n < 2; ++n) _Pragma("unroll") for (int k = 0; k < 2; ++k) dst[n][k] = *(const PG8_LAS bf16x8*)(lds + PG8_SB(b, h) + boff + n * 2048 + k * 1024); } while (0)
#define PG8_MMA(ai, bj, At, Bt) do { __builtin_amdgcn_s_setprio(1); _Pragma("unroll") for (int m = 0; m < 4; ++m) _Pragma("unroll") for (int n = 0; n < 2; ++n) _Pragma("unroll") for (int k = 0; k < 2; ++k) \
        acc[ai][bj][m][n] = __builtin_amdgcn_mfma_f32_16x16x32_bf16(Bt[n][k], At[m][k], acc[ai][bj][m][n], 0, 0, 0); __builtin_amdgcn_s_setprio(0); } while (0)
#define PG8_WAIT_V(n) asm volatile("s_waitcnt vmcnt(" #n ")" ::: "memory")
#define PG8_WAIT_L(n) asm volatile("s_waitcnt lgkmcnt(" #n ")" ::: "memory")
#define PG8_BAR __builtin_amdgcn_s_barrier()
#define PG8_SCHED __builtin_amdgcn_sched_barrier(0)
    Unit cur, nxt; int ui = 0;
    if (!S.next(0, cur)) return;
    f32x4 acc[2][2][4][2];
#pragma unroll
    for (int a = 0; a < 2; ++a)
#pragma unroll
        for (int b = 0; b < 2; ++b)
#pragma unroll
            for (int m = 0; m < 4; ++m)
#pragma unroll
                for (int n = 0; n < 2; ++n) acc[a][b][m][n] = (f32x4){0.f, 0.f, 0.f, 0.f};
    bf16x8 At[4][2], B0[2][2], B1[2][2];
    const char* cA = (const char*)g.A + (size_t)cur.pm * tstep; const char* cB = (const char*)g.Bt + (size_t)cur.pn * tstep;
    S.a_ready(cur);
    PG8_STAGE(PG8_SB(0, 0), cB, voffB); PG8_STAGE(PG8_SA(0, 0), cA, voffA); PG8_STAGE(PG8_SB(0, 1), cB + hstep, voffB); PG8_STAGE(PG8_SA(0, 1), cA + hstep, voffA);
    if (wr == 1) PG8_BAR;
    PG8_WAIT_V(4); PG8_BAR;
    PG8_STAGE(PG8_SB(1, 0), cB + kstep, voffB); PG8_STAGE(PG8_SA(1, 0), cA + kstep, voffA); PG8_STAGE(PG8_SB(1, 1), cB + hstep + kstep, voffB);
    PG8_WAIT_V(6); PG8_BAR;
    PG8_STAMP();
    for (;;) {
        const bool has_next = S.next(ui + 1, nxt);
        const char* nA = has_next ? (const char*)g.A + (size_t)nxt.pm * tstep : cA; const char* nB = has_next ? (const char*)g.Bt + (size_t)nxt.pn * tstep : cB;
        for (int t = 0; t < nt; t += 2) {
            const bool last = (t == nt - 2);
            const char* a1 = cA + (size_t)(t + 1) * kstep;
            const char* a2 = last ? nA : cA + (size_t)(t + 2) * kstep; const char* b2 = last ? nB : cB + (size_t)(t + 2) * kstep;
            const char* a3 = a2 + kstep; const char* b3 = b2 + kstep;
            if (last && has_next) S.a_ready(nxt);
            PG8_LDB(B0, 0, 0); PG8_SCHED; PG8_LDA(At, 0, 0); PG8_STAGE(PG8_SA(1, 1), a1 + hstep, voffA);
            PG8_WAIT_L(8); PG8_BAR; PG8_WAIT_L(0); PG8_MMA(0, 0, At, B0); PG8_BAR; PG8_SCHED;
            PG8_LDB(B1, 0, 1); PG8_STAGE(PG8_SB(0, 0), b2, voffB);
            PG8_BAR; PG8_WAIT_L(0); PG8_MMA(0, 1, At, B1); PG8_BAR;
            PG8_LDA(At, 0, 1); PG8_STAGE(PG8_SA(0, 0), a2, voffA);
            PG8_BAR; PG8_WAIT_L(0); PG8_MMA(1, 0, At, B0); PG8_BAR; PG8_SCHED;
            PG8_STAGE(PG8_SB(0, 1), b2 + hstep, voffB);
            PG8_WAIT_V(6); PG8_BAR; PG8_MMA(1, 1, At, B1); PG8_BAR;
            PG8_LDB(B0, 1, 0); PG8_SCHED; PG8_LDA(At, 1, 0); PG8_STAGE(PG8_SA(0, 1), a2 + hstep, voffA);
            PG8_WAIT_L(8); PG8_BAR; PG8_WAIT_L(0); PG8_MMA(0, 0, At, B0); PG8_BAR; PG8_SCHED;
            PG8_LDB(B1, 1, 1); PG8_STAGE(PG8_SB(1, 0), b3, voffB);
            PG8_BAR; PG8_WAIT_L(0); PG8_MMA(0, 1, At, B1); PG8_BAR;
            PG8_LDA(At, 1, 1); PG8_STAGE(PG8_SA(1, 0), a3, voffA);
            PG8_BAR; PG8_WAIT_L(0); PG8_MMA(1, 0, At, B0); PG8_BAR; PG8_SCHED;
            PG8_STAGE(PG8_SB(1, 1), b3 + hstep, voffB);
            PG8_WAIT_V(6); PG8_BAR; PG8_MMA(1, 1, At, B1); PG8_BAR;
        }
        PG8_STAMP();
        if constexpr (!Epi::AFTER_DRAIN) { E(acc, cur, wr, wc, fr, fq); S.done(cur); }
        PG8_STAMP();
        if (!has_next) break;
#pragma unroll
        for (int a = 0; a < 2; ++a)
#pragma unroll
            for (int b = 0; b < 2; ++b)
#pragma unroll
                for (int m = 0; m < 4; ++m)
#pragma unroll
                    for (int n = 0; n < 2; ++n) acc[a][b][m][n] = (f32x4){0.f, 0.f, 0.f, 0.f};
        cur = nxt; cA = nA; cB = nB; ++ui;
    }
    PG8_WAIT_V(0);
    if (wr == 0) PG8_BAR;
    PG8_BAR;
    if constexpr (Epi::AFTER_DRAIN) { E.fused(acc, cur, wr, wc, fr, fq, lds, wid, lane); S.done(cur); }
    PG8_STAMP();
    if (STAMP && wid == 0) { stamps[lane] = lane < nts ? (((unsigned long long)(unsigned)ts_hi << 32) | (unsigned)ts_lo) : 0ull;
        if (lane == 62) stamps[62] = rt_entry; if (lane == 63) stamps[63] = (unsigned long long)wall_clock64(); }
#undef PG8_STAMP
#undef PG8_SA
#undef PG8_SB
#undef PG8_STAGE
#undef PG8_LDA
#undef PG8_LDB
#undef PG8_MMA
#undef PG8_WAIT_V
#undef PG8_WAIT_L
#undef PG8_BAR
#undef PG8_SCHED
}
}
#define XB_TMO      128
#define XB_XCNT(j)  (256  + 64 * (j))
#define XB_XSUB(j)  (1280 + 64 * (j))
#define XB_XGEN(j)  (2304 + 64 * (j))
#define XB_TOP      3328
#define XB_TOPGEN   3392
#define XCD_BAR_WORDS 3456
#define XB_SPIN_CAP (1u << 22)

__device__ __forceinline__ unsigned xb_ld(unsigned* p)              { return __hip_atomic_load(p, __ATOMIC_RELAXED, __HIP_MEMORY_SCOPE_AGENT); }
__device__ __forceinline__ unsigned xb_add(unsigned* p, unsigned v) { return __hip_atomic_fetch_add(p, v, __ATOMIC_RELAXED, __HIP_MEMORY_SCOPE_AGENT); }
__device__ __forceinline__ unsigned xb_xcc_id() { return (unsigned)__builtin_amdgcn_s_getreg((3 << 11) | 20) & 0xFu; }
#define XB_SPIN(cond, bar) do { unsigned _sp = 0; while (cond) { __builtin_amdgcn_s_sleep(1); \
    if ((++_sp & 255u) == 0u) { if (xb_ld(&(bar)[XB_TMO])) break; if (_sp > XB_SPIN_CAP) { atomicAdd(&(bar)[XB_TMO], 1u); break; } } } } while (0)

struct XcdBarrier {
    unsigned* bar; unsigned x;
    volatile PG8_LAS unsigned* st;
};

__device__ __forceinline__ XcdBarrier xcd_barrier_post(unsigned* bar, volatile PG8_LAS unsigned* st) {
    XcdBarrier b; b.bar = bar; b.x = xb_xcc_id(); b.st = st;
    if (threadIdx.x == 0) (void)xb_add(&bar[XB_XCNT(b.x)], 1u);
    return b;
}
__device__ __forceinline__ void xcd_barrier_complete(unsigned* bar, unsigned x, unsigned& nloc, unsigned& nx) {
    const unsigned G = gridDim.x * gridDim.y * gridDim.z;
    unsigned sum, cnt, mine, sp = 0u;
    for (;;) {
        sum = 0u; cnt = 0u; mine = 0u;
#pragma unroll
        for (unsigned j = 0; j < 16; ++j) { const unsigned c = xb_ld(&bar[XB_XCNT(j)]); sum += c; cnt += (c > 0u) ? 1u : 0u; mine = (j == x) ? c : mine; }
        if (sum == G) break;
        __builtin_amdgcn_s_sleep(1);
        if ((++sp & 255u) == 0u) { if (xb_ld(&bar[XB_TMO])) break; if (sp > XB_SPIN_CAP) { atomicAdd(&bar[XB_TMO], 1u); break; } }
    }
    nloc = mine > 0u ? mine : 1u; nx = cnt > 0u ? cnt : 1u;
}

__device__ __forceinline__ void xcd_barrier(const XcdBarrier& b) {
    asm volatile("s_waitcnt vmcnt(0)" ::: "memory");
    __syncthreads();
    if (threadIdx.x == 0) {
        unsigned* bar = b.bar;
        __builtin_amdgcn_s_waitcnt(0);
        unsigned nloc = b.st[0], nx = b.st[1];
        if (nloc == 0u) { xcd_barrier_complete(bar, b.x, nloc, nx); b.st[0] = nloc; b.st[1] = nx; }
        const unsigned old = xb_add(&bar[XB_XSUB(b.x)], 1u);
        const unsigned gen = old / nloc;
        if (old + 1u == (gen + 1u) * nloc) {
            __builtin_amdgcn_fence(__ATOMIC_RELEASE, "agent");
            asm volatile("s_waitcnt vmcnt(0)" ::: "memory");
            const unsigned og = xb_add(&bar[XB_TOP], 1u);
            const unsigned tg = og / nx;
            if (og + 1u == (tg + 1u) * nx) xb_add(&bar[XB_TOPGEN], 1u);
            else XB_SPIN(xb_ld(&bar[XB_TOPGEN]) == tg, bar);
            __builtin_amdgcn_fence(__ATOMIC_ACQUIRE, "agent");
            xb_add(&bar[XB_XGEN(b.x)], 1u);
            asm volatile("s_waitcnt vmcnt(0)" ::: "memory");
        } else {
            XB_SPIN(xb_ld(&bar[XB_XGEN(b.x)]) == gen, bar);
            __builtin_amdgcn_fence(__ATOMIC_ACQUIRE, "agent");
            asm volatile("s_waitcnt vmcnt(0)" ::: "memory");
        }
    }
    __syncthreads();
}

using namespace pg8;
typedef float f32x16 __attribute__((ext_vector_type(16)));
typedef unsigned u32x2 __attribute__((ext_vector_type(2)));
#define LAS PG8_LAS
#define DI __device__ __forceinline__

constexpr int NT = 512;
constexpr int MP = 32768, MS = 2048, MT = MP + MS;
constexpr int KEYS_S = 4352;
constexpr int KR_ROWS = MP + 32 * KEYS_S;
constexpr int ZLD = 2560;
constexpr float EPS = 1e-6f;
constexpr float QSCALE = 0.10206207261596577f * 1.4426950408889634f;
constexpr int LDS_BYTES = 160 * 1024;

constexpr size_t SZ_WIN = 2560ull * 1024 * 2, SZ_WUQ = 768ull * 256 * 2, SZ_WUK = 512ull * 256 * 2, SZ_WUV = 512ull * 256 * 2,
                 SZ_WO = 1024ull * 1024 * 2, SZ_WFI = 5632ull * 1024 * 2, SZ_WFO = 1024ull * 2816 * 2;
constexpr size_t WOFF_IN = 0, WOFF_UQ = WOFF_IN + SZ_WIN, WOFF_UK = WOFF_UQ + SZ_WUQ, WOFF_UV = WOFF_UK + SZ_WUK, WOFF_O = WOFF_UV + SZ_WUV,
                 WOFF_FI = WOFF_O + SZ_WO, WOFF_FO = WOFF_FI + SZ_WFI, WL = WOFF_FO + SZ_WFO;
constexpr size_t OFF_W = 0;
constexpr size_t OFF_MOD = OFF_W + 2 * WL;
constexpr size_t OFF_ROPE = OFF_MOD + 2ull * 36 * 6144 * 4;
constexpr size_t OFF_H = OFF_ROPE + 8192ull * 16 * 2 * 4;
constexpr size_t OFF_Z = OFF_H + (size_t)MT * 1024 * 2;
constexpr size_t OFF_CQN = OFF_Z + (size_t)MT * ZLD * 2;
constexpr size_t OFF_CKV = OFF_CQN + (size_t)MT * 256 * 2;
constexpr size_t OFF_KROPE = OFF_CKV + (size_t)KR_ROWS * 256 * 2;
constexpr size_t OFF_Q = OFF_KROPE + (size_t)KR_ROWS * 32 * 2;
constexpr size_t OFF_KN = OFF_Q + (size_t)MT * 768 * 2;
constexpr size_t OFF_VT = OFF_KN + (size_t)KR_ROWS * 512 * 2;
constexpr size_t OFF_O = OFF_VT + (size_t)KR_ROWS * 512 * 2;
constexpr size_t OFF_PART = OFF_O + (size_t)MP * 512 * 2;
constexpr size_t OFF_UHG = OFF_PART + 32ull * 8 * 4 * 64 * 66 * 4;
constexpr size_t OFF_DHG = OFF_UHG + 544ull * 4 * 64 * 64 * 4;
constexpr size_t OFF_UGL = OFF_DHG + 544ull * 4 * 64 * 4;
constexpr size_t OFF_DGL = OFF_UGL + 544ull * 4 * 32 * 64 * 4;
constexpr size_t OFF_BAR = OFF_DGL + 544ull * 4 * 32 * 4;
constexpr size_t OFF_XB = OFF_BAR + 16384;
constexpr size_t WS_END = OFF_XB + (size_t)MT * 1024 * 2;
constexpr size_t OFF_ACT = OFF_KN;
static_assert((size_t)MT * 2816 * 2 <= 2 * (size_t)KR_ROWS * 512 * 2, "act alias");

constexpr size_t OUT_Y = 0, OUT_CKVP = 35651584, OUT_KRP = 52428800, OUT_HGP = 54525952, OUT_GLP = 54657024,
                 OUT_CKVS = 54722560, OUT_KRS = 55771136, OUT_HGS = 55902208, OUT_GLS = 56950784;

DI int tid_() { int t = threadIdx.x; asm volatile("" : "+v"(t)); return t; }
DI int bid_() { int b = blockIdx.x; asm volatile("" : "+s"(b)); return b; }
DI float neg_big() { float v = -1e30f; asm volatile("" : "+v"(v)); return v; }
struct Params { const float* in[29]; float* out; unsigned char* ws; };

typedef __bf16 hbf2 __attribute__((ext_vector_type(2)));
typedef float f32x2_ __attribute__((ext_vector_type(2)));
DI unsigned pack2(float a, float b) { f32x2_ v = {a, b}; return __builtin_bit_cast(unsigned, __builtin_convertvector(v, hbf2)); }
DI bf16_t f2bf(float f) { return (bf16_t)(pack2(f, f) & 0xFFFFu); }
DI float bf2f(bf16_t b) { return __uint_as_float(((unsigned)b) << 16); }
DI float bflo(unsigned u) { return __uint_as_float(u << 16); }
DI float bfhi(unsigned u) { return __uint_as_float(u & 0xFFFF0000u); }
DI float wave_sum(float v) { v += __shfl_xor(v, 32); v += __shfl_xor(v, 16); v += __shfl_xor(v, 8); v += __shfl_xor(v, 4); v += __shfl_xor(v, 2); v += __shfl_xor(v, 1); return v; }
DI float sigmoidf_(float x) { return 1.f / (1.f + expf(-x)); }
DI int row_bi(int row) { return row < MP ? (row >> 13) : 4 + ((row - MP) >> 6); }

struct EpiZ {
    static constexpr bool PERM = true, AFTER_DRAIN = false;
    bf16_t* O; int ldc;
    DI void operator()(const f32x4 (&acc)[2][2][4][2], const Unit& u, int wr, int wc, int fr, int fq) const {
        const int row0 = u.pm * 256 + wr * 64 + fr, col0 = u.pn * 256 + wc * 32 + 8 * fq;
#pragma unroll
        for (int ai = 0; ai < 2; ++ai)
#pragma unroll
            for (int m = 0; m < 4; ++m) { bf16_t* rowp = O + (size_t)(row0 + ai * 128 + m * 16) * ldc + col0;
#pragma unroll
                for (int bj = 0; bj < 2; ++bj) { const f32x4 v0 = acc[ai][bj][m][0], v1 = acc[ai][bj][m][1]; uint4 w; w.x = pack2(v0[0], v0[1]); w.y = pack2(v0[2], v0[3]); w.z = pack2(v1[0], v1[1]); w.w = pack2(v1[2], v1[3]); *(uint4*)(rowp + bj * 128) = w; } }
    }
};
struct EpiQ {
    static constexpr bool PERM = false, AFTER_DRAIN = false;
    bf16_t* Q; const float* qn_; const float* rope_;
    DI void operator()(const f32x4 (&acc)[2][2][4][2], const Unit& u, int wr, int wc, int fr, int fq) const {
        const float* qn = qn_; const float* rope = rope_; asm volatile("" : "+s"(qn), "+s"(rope));
        float eps_ = EPS; asm volatile("" : "+v"(eps_));
        const int row0 = u.pm * 256 + wr * 64 + fr;
#pragma unroll
        for (int ai = 0; ai < 2; ++ai)
#pragma unroll
            for (int m = 0; m < 4; ++m) {
                const int row = row0 + ai * 128 + m * 16;
                int pos; size_t base, hs;
                if (row < MP) { const int b = row >> 13, t = row & 8191; pos = t; base = ((size_t)(b * 8) * 8192 + t) * 96; hs = 8192 * 96; }
                else { const int r = row - MP, b = r >> 6, t = r & 63; pos = 4096 + t; base = (size_t)MP * 768 + ((size_t)(b * 8) * 64 + t) * 96; hs = 64 * 96; }
                if (u.pn < 2) {
                    const int head = 4 * u.pn + wc;
                    float ss = 0.f;
#pragma unroll
                    for (int bj = 0; bj < 2; ++bj)
#pragma unroll
                        for (int n = 0; n < 2; ++n) { const f32x4 v = acc[ai][bj][m][n]; ss += v[0] * v[0] + v[1] * v[1] + v[2] * v[2] + v[3] * v[3]; }
                    ss += __shfl_xor(ss, 16); ss += __shfl_xor(ss, 32);
                    const float rs = rsqrtf(ss * (1.f / 64.f) + eps_) * QSCALE;
#pragma unroll
                    for (int bj = 0; bj < 2; ++bj)
#pragma unroll
                        for (int n = 0; n < 2; ++n) { const int d = 32 * bj + 16 * n + 4 * fq; const f32x4 v = acc[ai][bj][m][n]; const float4 g = *(const float4*)(qn + d);
                            uint2 w; w.x = pack2(v[0] * rs * g.x, v[1] * rs * g.y); w.y = pack2(v[2] * rs * g.z, v[3] * rs * g.w); *(uint2*)(Q + base + head * hs + d) = w; }
                } else {
#pragma unroll
                    for (int bj = 0; bj < 2; ++bj) {
                        const int head = 2 * wc + bj;
                        const f32x4 v1 = acc[ai][bj][m][0], v2 = acc[ai][bj][m][1];
                        float ss = v1[0] * v1[0] + v1[1] * v1[1] + v1[2] * v1[2] + v1[3] * v1[3] + v2[0] * v2[0] + v2[1] * v2[1] + v2[2] * v2[2] + v2[3] * v2[3];
                        ss += __shfl_xor(ss, 16); ss += __shfl_xor(ss, 32);
                        const float rs = rsqrtf(ss * (1.f / 32.f) + eps_);
                        const float4 g1 = *(const float4*)(qn + 64 + 4 * fq), g2 = *(const float4*)(qn + 80 + 4 * fq);
                        const float4 cs0 = *(const float4*)(rope + ((size_t)pos * 16 + 4 * fq) * 2), cs1 = *(const float4*)(rope + ((size_t)pos * 16 + 4 * fq) * 2 + 4);
                        const float x10 = v1[0] * rs * g1.x, x11 = v1[1] * rs * g1.y, x12 = v1[2] * rs * g1.z, x13 = v1[3] * rs * g1.w;
                        const float x20 = v2[0] * rs * g2.x, x21 = v2[1] * rs * g2.y, x22 = v2[2] * rs * g2.z, x23 = v2[3] * rs * g2.w;
                        uint2 w1, w2;
                        w1.x = pack2((x10 * cs0.x - x20 * cs0.y) * QSCALE, (x11 * cs0.z - x21 * cs0.w) * QSCALE);
                        w1.y = pack2((x12 * cs1.x - x22 * cs1.y) * QSCALE, (x13 * cs1.z - x23 * cs1.w) * QSCALE);
                        w2.x = pack2((x20 * cs0.x + x10 * cs0.y) * QSCALE, (x21 * cs0.z + x11 * cs0.w) * QSCALE);
                        w2.y = pack2((x22 * cs1.x + x12 * cs1.y) * QSCALE, (x23 * cs1.z + x13 * cs1.w) * QSCALE);
                        *(uint2*)(Q + base + head * hs + 64 + 4 * fq) = w1; *(uint2*)(Q + base + head * hs + 80 + 4 * fq) = w2;
                    }
                }
            }
    }
};
struct EpiKN {
    static constexpr bool PERM = true, AFTER_DRAIN = false;
    bf16_t* KN; const float* kn_;
    DI void operator()(const f32x4 (&acc)[2][2][4][2], const Unit& u, int wr, int wc, int fr, int fq) const {
        const float* kn = kn_; asm volatile("" : "+s"(kn));
        float eps_ = EPS; asm volatile("" : "+v"(eps_));
        float4 gk[2][2];
#pragma unroll
        for (int bj = 0; bj < 2; ++bj)
#pragma unroll
            for (int n = 0; n < 2; ++n) gk[bj][n] = *(const float4*)(kn + 32 * bj + 8 * fq + 4 * n);
        size_t base, hs;
        if (u.pm < 128) { const int b = u.pm >> 5, key0 = (u.pm & 31) * 256; base = ((size_t)(b * 8) * 8192 + key0) * 64; hs = (size_t)8192 * 64; }
        else { const int q = u.pm - 128, b = q / 17, key0 = (q % 17) * 256; base = (size_t)MP * 512 + ((size_t)(b * 8) * KEYS_S + key0) * 64; hs = (size_t)KEYS_S * 64; }
        const int head = 4 * u.pn + wc;
#pragma unroll
        for (int ai = 0; ai < 2; ++ai)
#pragma unroll
            for (int m = 0; m < 4; ++m) {
                const int key = 128 * ai + 64 * wr + 16 * m + fr;
                float ss = 0.f;
#pragma unroll
                for (int bj = 0; bj < 2; ++bj)
#pragma unroll
                    for (int n = 0; n < 2; ++n) { const f32x4 v = acc[ai][bj][m][n]; ss += v[0] * v[0] + v[1] * v[1] + v[2] * v[2] + v[3] * v[3]; }
                ss += __shfl_xor(ss, 16); ss += __shfl_xor(ss, 32);
                const float rs = rsqrtf(ss * (1.f / 64.f) + eps_);
#pragma unroll
                for (int bj = 0; bj < 2; ++bj) { const f32x4 v0 = acc[ai][bj][m][0], v1 = acc[ai][bj][m][1]; const float4 g0 = gk[bj][0], g1 = gk[bj][1];
                    uint4 w; w.x = pack2(v0[0] * rs * g0.x, v0[1] * rs * g0.y); w.y = pack2(v0[2] * rs * g0.z, v0[3] * rs * g0.w); w.z = pack2(v1[0] * rs * g1.x, v1[1] * rs * g1.y); w.w = pack2(v1[2] * rs * g1.z, v1[3] * rs * g1.w);
                    *(uint4*)(KN + base + head * hs + (size_t)key * 64 + 32 * bj + 8 * fq) = w; }
            }
    }
};
struct EpiVT {
    static constexpr bool PERM = true, AFTER_DRAIN = false;
    bf16_t* VT;
    DI void operator()(const f32x4 (&acc)[2][2][4][2], const Unit& u, int wr, int wc, int fr, int fq) const {
        size_t base; int KL;
        if (u.pn < 128) { const int b = u.pn >> 5, key0 = (u.pn & 31) * 256; base = (size_t)(b * 8) * 64 * 8192 + key0; KL = 8192; }
        else { const int q = u.pn - 128, b = q / 17, key0 = (q % 17) * 256; base = (size_t)MP * 512 + (size_t)(b * 8) * 64 * KEYS_S + key0; KL = KEYS_S; }
#pragma unroll
        for (int ai = 0; ai < 2; ++ai)
#pragma unroll
            for (int m = 0; m < 4; ++m) {
                const int r = 256 * u.pm + 128 * ai + 64 * wr + 16 * m + fr;
                bf16_t* rowp = VT + base + (size_t)r * KL + 32 * wc + 8 * fq;
#pragma unroll
                for (int bj = 0; bj < 2; ++bj) { const f32x4 v0 = acc[ai][bj][m][0], v1 = acc[ai][bj][m][1]; uint4 w; w.x = pack2(v0[0], v0[1]); w.y = pack2(v0[2], v0[3]); w.z = pack2(v1[0], v1[1]); w.w = pack2(v1[2], v1[3]); *(uint4*)(rowp + 128 * bj) = w; }
            }
    }
};
struct EpiRes {
    static constexpr bool PERM = false, AFTER_DRAIN = false;
    bf16_t* XB; float* out; const float* gate; int final; int pm0;
    DI void operator()(const f32x4 (&acc)[2][2][4][2], const Unit& u, int wr, int wc, int fr, int fq) const {
        const int row0 = (u.pm + pm0) * 256 + wr * 64 + fr, col0 = u.pn * 256 + wc * 32 + 4 * fq;
#pragma unroll
        for (int ai = 0; ai < 2; ++ai) {
            const float* gr = gate + (size_t)row_bi(row0 + ai * 128) * 6144 + col0;
            f32x4 g[2][2]; uint2 x[4][2][2];
#pragma unroll
            for (int bj = 0; bj < 2; ++bj)
#pragma unroll
                for (int n = 0; n < 2; ++n) g[bj][n] = *(const f32x4*)(gr + bj * 128 + n * 16);
#pragma unroll
            for (int m = 0; m < 4; ++m) { const bf16_t* xr = XB + (size_t)(row0 + ai * 128 + m * 16) * 1024 + col0;
#pragma unroll
                for (int bj = 0; bj < 2; ++bj)
#pragma unroll
                    for (int n = 0; n < 2; ++n) x[m][bj][n] = *(const uint2*)(xr + bj * 128 + n * 16); }
#pragma unroll
            for (int m = 0; m < 4; ++m) { const size_t ro = (size_t)(row0 + ai * 128 + m * 16) * 1024 + col0;
#pragma unroll
                for (int bj = 0; bj < 2; ++bj)
#pragma unroll
                    for (int n = 0; n < 2; ++n) { const uint2 xv = x[m][bj][n]; const f32x4 xf = {bflo(xv.x), bfhi(xv.x), bflo(xv.y), bfhi(xv.y)}; const f32x4 r = xf + g[bj][n] * acc[ai][bj][m][n];
                        if (final) *(f32x4*)(out + ro + bj * 128 + n * 16) = r;
                        else { uint2 w; w.x = pack2(r[0], r[1]); w.y = pack2(r[2], r[3]); *(uint2*)(XB + ro + bj * 128 + n * 16) = w; } } }
        }
    }
};
struct EpiSwi {
    static constexpr bool PERM = true, AFTER_DRAIN = false;
    bf16_t* ACT; int pm0;
    DI void operator()(const f32x4 (&acc)[2][2][4][2], const Unit& u, int wr, int wc, int fr, int fq) const {
        const int row0 = (u.pm + pm0) * 256 + wr * 64 + fr, col0 = u.pn * 128 + wc * 32 + 8 * fq;
#pragma unroll
        for (int ai = 0; ai < 2; ++ai)
#pragma unroll
            for (int m = 0; m < 4; ++m) { bf16_t* rowp = ACT + (size_t)(row0 + ai * 128 + m * 16) * 2816 + col0; float r[8];
#pragma unroll
                for (int n = 0; n < 2; ++n) { const f32x4 a = acc[ai][0][m][n], g = acc[ai][1][m][n];
#pragma unroll
                    for (int j = 0; j < 4; ++j) r[4 * n + j] = a[j] / (1.f + __expf(-a[j])) * g[j]; }
                uint4 w; w.x = pack2(r[0], r[1]); w.y = pack2(r[2], r[3]); w.z = pack2(r[4], r[5]); w.w = pack2(r[6], r[7]); *(uint4*)rowp = w; }
    }
};
struct SkewOrder : StaticOrder {
    int nsb, skip;
    __device__ bool next(int i, Unit& u) const {
        const int R = nwg / G; long L;
        if (c < nsb) { if (i >= R - skip) return false; L = (long)i * G + c; }
        else if (i < R) L = (long)i * G + c;
        else if (i == R) { const int j = c - nsb; if (j >= nsb * skip) return false; L = (long)(R - skip + j / nsb) * G + (j % nsb); }
        else return false;
        StaticOrder t = *this; t.c = (int)(L % G); return t.StaticOrder::next((int)(L / G), u);
    }
};
template <class Epi> DI void run_gemm_skew(LAS unsigned char* lds, const bf16_t* A, const bf16_t* Bt, int M, int N, int K, const Epi& E, int nsb, int skip) {
    asm volatile("" : "+s"(M), "+s"(N), "+s"(K));
    Gemm g{A, Bt, M, N, K}; SkewOrder S; S.init(M, N, (int)gridDim.x, (int)bid_()); S.nsb = nsb; S.skip = skip;
    gemm_phase<Epi, SkewOrder, false>(lds, g, S, E, nullptr);
}
template <class Epi> DI void run_gemm(LAS unsigned char* lds, const bf16_t* A, const bf16_t* Bt, int M, int N, int K, const Epi& E, int rot = 0) {
    asm volatile("" : "+s"(M), "+s"(N), "+s"(K));
    Gemm g{A, Bt, M, N, K}; StaticOrder S; S.init(M, N, (int)gridDim.x, (int)((bid_() + rot) % gridDim.x));
    gemm_phase<Epi, StaticOrder, false>(lds, g, S, E, nullptr);
}

DI int colmap(int w, int n) {
    if (w == 0) return n < 2352 ? n : -1;
    if (w == 1) { const int pn = n >> 8, c = n & 255, bj = c >> 7, wc = (c >> 5) & 3, cc = c & 31; return pn < 2 ? (4 * pn + wc) * 96 + 32 * bj + cc : (2 * wc + bj) * 96 + 64 + cc; }
    if (w == 2) { const int pn = n >> 8, c = n & 255, bj = c >> 7, wc = (c >> 5) & 3, cc = c & 31; return (4 * pn + wc) * 64 + 32 * bj + cc; }
    if (w == 5) { const int pn = n >> 8, c = n & 255; return c < 128 ? 128 * pn + c : 2816 + 128 * pn + (c - 128); }
    return n;
}
DI void phase_prep(const Params& p, LAS unsigned char* lds) {
    const int tid = tid_();
    LAS bf16_t* T = (LAS bf16_t*)lds;
    for (int ti = bid_(); ti < 2 * 1560; ti += gridDim.x) {
        const int l = ti / 1560, r = ti % 1560;
        int w, t0, K, ld; size_t doff; const float* src;
        if (r < 320) { w = 0; t0 = 0; K = 1024; ld = 2352; doff = WOFF_IN; src = p.in[12]; }
        else if (r < 344) { w = 1; t0 = 320; K = 256; ld = 768; doff = WOFF_UQ; src = p.in[15]; }
        else if (r < 360) { w = 2; t0 = 344; K = 256; ld = 512; doff = WOFF_UK; src = p.in[16]; }
        else if (r < 376) { w = 3; t0 = 360; K = 256; ld = 512; doff = WOFF_UV; src = p.in[17]; }
        else if (r < 504) { w = 4; t0 = 376; K = 1024; ld = 1024; doff = WOFF_O; src = p.in[26]; }
        else if (r < 1208) { w = 5; t0 = 504; K = 1024; ld = 5632; doff = WOFF_FI; src = p.in[27]; }
        else { w = 6; t0 = 1208; K = 2816; ld = 1024; doff = WOFF_FO; src = p.in[28]; }
        src += (size_t)l * K * ld;
        const int kt = K >> 7, tr = r - t0, n0 = (tr / kt) * 64, k0 = (tr % kt) * 128;
        bf16_t* dst = (bf16_t*)(p.ws + OFF_W + (size_t)l * WL + doff);
        const int nn = tid & 63, col = colmap(w, n0 + nn);
        float tv[16];
#pragma unroll
        for (int i = 0; i < 16; ++i) { const int kk = (tid >> 6) + 8 * i; tv[i] = col >= 0 ? src[(size_t)(k0 + kk) * ld + col] : 0.f; }
#pragma unroll
        for (int i = 0; i < 16; ++i) { const int kk = (tid >> 6) + 8 * i; T[nn * 130 + kk] = f2bf(tv[i]); }
        __syncthreads();
#pragma unroll
        for (int j = 0; j < 2; ++j) { const int q = tid + 512 * j, row = q >> 4, seg = q & 15; const LAS unsigned* tp = (const LAS unsigned*)(T + row * 130 + seg * 8);
          uint4 o; o.x = tp[0]; o.y = tp[1]; o.z = tp[2]; o.w = tp[3]; *(uint4*)(dst + (size_t)(n0 + row) * K + k0 + seg * 8) = o; }
        __syncthreads();
    }
    float* mod = (float*)(p.ws + OFF_MOD);
    for (int it = bid_(); it < 192; it += gridDim.x) {
        const int l = it / 96, cgp = it % 96;
        LAS float* sl = (LAS float*)lds;
        for (int i = tid; i < 36 * 1024; i += NT) { const int bi = i >> 10, k = i & 1023; const float c = bi < 4 ? p.in[2][bi * 1024 + k] : p.in[3][(bi - 4) * 1024 + k]; sl[i] = c / (1.f + expf(-c)); }
        __syncthreads();
        const int cl = tid & 63, kq = tid >> 6;
        float acc[36];
#pragma unroll
        for (int bi = 0; bi < 36; ++bi) acc[bi] = 0.f;
        const float* wm = p.in[8] + (size_t)l * 1024 * 6144 + cgp * 64 + cl;
#pragma unroll 4
        for (int k = kq * 128; k < kq * 128 + 128; k += 4) {
            const float w0 = wm[(size_t)k * 6144], w1 = wm[(size_t)(k + 1) * 6144], w2 = wm[(size_t)(k + 2) * 6144], w3 = wm[(size_t)(k + 3) * 6144];
#pragma unroll
            for (int bi = 0; bi < 36; ++bi) { const f32x4 s = *(const LAS f32x4*)(sl + bi * 1024 + k); acc[bi] += s[0] * w0 + s[1] * w1 + s[2] * w2 + s[3] * w3; }
        }
        __syncthreads();
        LAS float* red = (LAS float*)lds;
#pragma unroll
        for (int bi = 0; bi < 36; ++bi) red[(kq * 36 + bi) * 64 + cl] = acc[bi];
        __syncthreads();
        for (int o = tid; o < 36 * 64; o += NT) { const int bi = o >> 6, c = o & 63; float s = 0.f;
#pragma unroll
            for (int q = 0; q < 8; ++q) s += red[(q * 36 + bi) * 64 + c];
            const int colg = cgp * 64 + c; mod[((size_t)l * 36 + bi) * 6144 + colg] = s + p.in[9][l * 6144 + colg]; }
        __syncthreads();
    }
    float* rope = (float*)(p.ws + OFF_ROPE);
    for (int i = bid_() * NT + tid; i < 8192 * 16; i += gridDim.x * NT) { const int pos = i >> 4, j = i & 15;
        const float inv = exp2f(-(float)j * (13.287712379549449f / 16.f)); const float ang = (float)pos * inv; rope[2 * i] = cosf(ang); rope[2 * i + 1] = sinf(ang); }
}

template <bool FROM_INPUT>
DI void phase_hrows(const Params& p, int l, const float* xa, const float* xb, const float* g, int shoff, int scoff, int row_lo = 0, int row_hi = MT, int b0 = 0, int nb = 0) {
    const int tid = tid_(), lane = tid & 63, wid = __builtin_amdgcn_readfirstlane(tid >> 6);
    const float* mod = (const float*)(p.ws + OFF_MOD) + (size_t)l * 36 * 6144;
    bf16_t* H = (bf16_t*)(p.ws + OFF_H); bf16_t* XB = (bf16_t*)(p.ws + OFF_XB);
    if (nb == 0) nb = (int)gridDim.x;
    const int stride = nb * 8;
    int row = row_lo + ((int)bid_() - b0) * 8 + wid;
    float4 v[4];
#define HR_LOAD(dst, rr) do { if (FROM_INPUT) { const float* xr_ = (rr) < MP ? xa + (size_t)(rr) * 1024 : xb + (size_t)((rr) - MP) * 1024; \
            _Pragma("unroll") for (int i = 0; i < 4; ++i) dst[i] = *(const float4*)(xr_ + i * 256 + lane * 4); } \
        else { const bf16_t* xr_ = XB + (size_t)(rr) * 1024; \
            _Pragma("unroll") for (int i = 0; i < 4; ++i) { const uint2 u_ = *(const uint2*)(xr_ + i * 256 + lane * 4); dst[i].x = bflo(u_.x); dst[i].y = bfhi(u_.x); dst[i].z = bflo(u_.y); dst[i].w = bfhi(u_.y); } } } while (0)
    if (row < row_hi) HR_LOAD(v, row);
    while (row < row_hi) {
        const int nrow = row + stride; float4 nv[4];
        if (nrow < row_hi) HR_LOAD(nv, nrow);
        float ss = 0.f;
#pragma unroll
        for (int i = 0; i < 4; ++i) ss += v[i].x * v[i].x + v[i].y * v[i].y + v[i].z * v[i].z + v[i].w * v[i].w;
        ss = wave_sum(ss);
        const float rs = rsqrtf(ss * (1.f / 1024.f) + EPS);
        const float* mp = mod + (size_t)row_bi(row) * 6144;
#pragma unroll
        for (int i = 0; i < 4; ++i) { const int col = i * 256 + lane * 4;
            const float4 gg = *(const float4*)(g + col), sc = *(const float4*)(mp + scoff + col), sh = *(const float4*)(mp + shoff + col);
            uint2 w; w.x = pack2(v[i].x * rs * gg.x * (1.f + sc.x) + sh.x, v[i].y * rs * gg.y * (1.f + sc.y) + sh.y);
            w.y = pack2(v[i].z * rs * gg.z * (1.f + sc.z) + sh.z, v[i].w * rs * gg.w * (1.f + sc.w) + sh.w);
            *(uint2*)(H + (size_t)row * 1024 + col) = w;
            if (FROM_INPUT) { uint2 xw; xw.x = pack2(v[i].x, v[i].y); xw.y = pack2(v[i].z, v[i].w); *(uint2*)(XB + (size_t)row * 1024 + col) = xw; } }
#pragma unroll
        for (int i = 0; i < 4; ++i) v[i] = nv[i];
        row = nrow;
    }
#undef HR_LOAD
}
DI void phase_cache(const Params& p, int l, int b0, int nb) {
    const size_t gt = (size_t)(bid_() - b0) * NT + tid_(), gs = (size_t)nb * NT;
    bf16_t* ckv_s = (bf16_t*)(p.ws + OFF_CKV) + (size_t)MP * 256;
    bf16_t* kr_s = (bf16_t*)(p.ws + OFF_KROPE) + (size_t)MP * 32;
    const float4* s1 = (const float4*)(p.in[4] + (size_t)l * 32 * 4096 * 256);
    for (size_t i0 = gt; i0 < 8388608; i0 += gs * 8) { float4 v[8];
#pragma unroll
        for (int u = 0; u < 8; ++u) { const size_t i = i0 + u * gs; if (i < 8388608) v[u] = s1[i]; }
#pragma unroll
        for (int u = 0; u < 8; ++u) { const size_t i = i0 + u * gs; if (i < 8388608) { const size_t e = i * 4, b = e >> 20, rem = e & 1048575;
            uint2 w; w.x = pack2(v[u].x, v[u].y); w.y = pack2(v[u].z, v[u].w); *(uint2*)(ckv_s + b * KEYS_S * 256 + rem) = w; } } }
    unsigned zz = 0u; asm volatile("" : "+v"(zz));
    for (size_t i = gt; i < 393216; i += gs) { const size_t e = i * 4, b = e / 49152, rem = e % 49152; uint2 w; w.x = zz; w.y = zz; *(uint2*)(ckv_s + b * KEYS_S * 256 + 4160 * 256 + rem) = w; }
    const float4* s2 = (const float4*)(p.in[5] + (size_t)l * 32 * 4096 * 32);
    for (size_t i0 = gt; i0 < 1048576; i0 += gs * 8) { float4 v[8];
#pragma unroll
        for (int u = 0; u < 8; ++u) { const size_t i = i0 + u * gs; if (i < 1048576) v[u] = s2[i]; }
#pragma unroll
        for (int u = 0; u < 8; ++u) { const size_t i = i0 + u * gs; if (i < 1048576) { const size_t e = i * 4, b = e >> 17, rem = e & 131071;
            uint2 w; w.x = pack2(v[u].x, v[u].y); w.y = pack2(v[u].z, v[u].w); *(uint2*)(kr_s + b * KEYS_S * 32 + rem) = w; } } }
}
DI void phase_post(const Params& p, int l) {
    const int tid = tid_(), lane = tid & 63, wid = __builtin_amdgcn_readfirstlane(tid >> 6);
    const bf16_t* Z = (const bf16_t*)(p.ws + OFF_Z);
    bf16_t* CQN = (bf16_t*)(p.ws + OFF_CQN); bf16_t* CKV = (bf16_t*)(p.ws + OFF_CKV); bf16_t* KRO = (bf16_t*)(p.ws + OFF_KROPE);
    const float* rope = (const float*)(p.ws + OFF_ROPE);
    const float* gcq = p.in[13] + l * 256; const float* gckv = p.in[14] + l * 256; const float* gk = p.in[19] + l * 96 + 64;
    const int stride = gridDim.x * 8;
    int row = bid_() * 8 + wid;
    uint2 u1, u2; bf16_t u3;
    if (row < MT) { const bf16_t* zr = Z + (size_t)row * ZLD; u1 = *(const uint2*)(zr + 4 * lane); u2 = *(const uint2*)(zr + 256 + 4 * lane); u3 = zr[512 + (lane & 31)]; }
    while (row < MT) {
        const int nrow = row + stride; uint2 n1, n2; bf16_t n3;
        if (nrow < MT) { const bf16_t* zr = Z + (size_t)nrow * ZLD; n1 = *(const uint2*)(zr + 4 * lane); n2 = *(const uint2*)(zr + 256 + 4 * lane); n3 = zr[512 + (lane & 31)]; }
        int pos; size_t grow; float* o_ckv; float* o_kr;
        if (row < MP) { const int b = row >> 13, t = row & 8191; pos = t; grow = row; o_ckv = p.out + OUT_CKVP + ((size_t)(l * 4 + b) * 8192 + t) * 256; o_kr = p.out + OUT_KRP + ((size_t)(l * 4 + b) * 8192 + t) * 32; }
        else { const int r = row - MP, b = r >> 6, t = r & 63; pos = 4096 + t; grow = (size_t)MP + (size_t)b * KEYS_S + 4096 + t; o_ckv = p.out + OUT_CKVS + ((size_t)(l * 32 + b) * 64 + t) * 256; o_kr = p.out + OUT_KRS + ((size_t)(l * 32 + b) * 64 + t) * 32; }
        { const uint2 u = u1; const float a0 = bflo(u.x), a1 = bfhi(u.x), a2 = bflo(u.y), a3 = bfhi(u.y);
          const float ss = wave_sum(a0 * a0 + a1 * a1 + a2 * a2 + a3 * a3); const float rs = rsqrtf(ss * (1.f / 256.f) + EPS); const float4 g = *(const float4*)(gcq + 4 * lane);
          uint2 w; w.x = pack2(a0 * rs * g.x, a1 * rs * g.y); w.y = pack2(a2 * rs * g.z, a3 * rs * g.w); *(uint2*)(CQN + (size_t)row * 256 + 4 * lane) = w; }
        { const uint2 u = u2; const float a0 = bflo(u.x), a1 = bfhi(u.x), a2 = bflo(u.y), a3 = bfhi(u.y);
          const float ss = wave_sum(a0 * a0 + a1 * a1 + a2 * a2 + a3 * a3); const float rs = rsqrtf(ss * (1.f / 256.f) + EPS); const float4 g = *(const float4*)(gckv + 4 * lane);
          float4 o; o.x = a0 * rs * g.x; o.y = a1 * rs * g.y; o.z = a2 * rs * g.z; o.w = a3 * rs * g.w; *(float4*)(o_ckv + 4 * lane) = o;
          uint2 w; w.x = pack2(o.x, o.y); w.y = pack2(o.z, o.w); *(uint2*)(CKV + grow * 256 + 4 * lane) = w; }
        { const int i = lane & 31; const float a = bf2f(u3); float ss = a * a; ss += __shfl_xor(ss, 16); ss += __shfl_xor(ss, 8); ss += __shfl_xor(ss, 4); ss += __shfl_xor(ss, 2); ss += __shfl_xor(ss, 1);
          const float xn = a * rsqrtf(ss * (1.f / 32.f) + EPS) * gk[i]; const float other = __shfl_xor(xn, 16);
          const float2 cs = *(const float2*)(rope + ((size_t)pos * 16 + (i & 15)) * 2);
          const float o = i < 16 ? xn * cs.x - other * cs.y : xn * cs.x + other * cs.y;
          if (lane < 32) { o_kr[i] = o; KRO[grow * 32 + i] = f2bf(o); } }
        u1 = n1; u2 = n2; u3 = n3; row = nrow;
    }
}

DI f32x16 mfma32(bf16x8 a, bf16x8 b, f32x16 c) { return __builtin_amdgcn_mfma_f32_32x32x16_bf16(a, b, c, 0, 0, 0); }
DI f32x4 mfma16(bf16x8 a, bf16x8 b, f32x4 c) { return __builtin_amdgcn_mfma_f32_16x16x32_bf16(a, b, c, 0, 0, 0); }
DI bf16x8 pack8(const f32x16& s, int b) { u32x4 r; r[0] = pack2(s[b], s[b + 1]); r[1] = pack2(s[b + 2], s[b + 3]); r[2] = pack2(s[b + 4], s[b + 5]); r[3] = pack2(s[b + 6], s[b + 7]); return __builtin_bit_cast(bf16x8, r); }

template <int NH>
DI void attn_core(LAS unsigned char* lds, const bf16_t* qptr, const bf16_t* kn, size_t kn_hs, const bf16_t* kr, const bf16_t* vt, size_t vt_hs, int KL,
                  int kt0, int kstep, int nit, int nvalid, int tile_lim, int hh, f32x16 (&o)[2], float& m_run, float& l_run) {
    constexpr int BUFSZ = NH * 17920 + 5120;
    const int tid = tid_(), lane = tid & 63, r = lane & 31, h = lane >> 5;
    bf16x8 qf[6];
#pragma unroll
    for (int ks = 0; ks < 6; ++ks) qf[ks] = *(const bf16x8*)(qptr + ks * 16 + h * 8);
#pragma unroll
    for (int i = 0; i < 16; ++i) { o[0][i] = 0.f; o[1][i] = 0.f; }
    m_run = neg_big(); l_run = 0.f;
    u32x4 rkn[NH], rvt[NH], rkr = {0u, 0u, 0u, 0u};
    const int lrow = tid >> 3, lseg = tid & 7;
#define ATT_GLOAD(kt) do { const size_t key0_ = (size_t)(kt) * 64; \
        _Pragma("unroll") for (int hx = 0; hx < NH; ++hx) { rkn[hx] = *(const u32x4*)(kn + hx * kn_hs + (key0_ + lrow) * 64 + lseg * 8); rvt[hx] = *(const u32x4*)(vt + hx * vt_hs + (size_t)lrow * KL + key0_ + lseg * 8); } \
        if (tid < 256) rkr = *(const u32x4*)(kr + (key0_ + (tid >> 2)) * 32 + (tid & 3) * 8); } while (0)
#define ATT_LSTORE(buf) do { LAS unsigned char* B_ = lds + (buf) * BUFSZ; \
        _Pragma("unroll") for (int hx = 0; hx < NH; ++hx) { *(LAS u32x4*)(B_ + hx * 9216 + lrow * 144 + lseg * 16) = rkn[hx]; \
            LAS u32x2* pv_ = (LAS u32x2*)(B_ + NH * 9216 + 5120 + hx * 8704 + lrow * 136 + lseg * 16); u32x2 a_, b_; a_[0] = rvt[hx][0]; a_[1] = rvt[hx][1]; b_[0] = rvt[hx][2]; b_[1] = rvt[hx][3]; pv_[0] = a_; pv_[1] = b_; } \
        if (tid < 256) *(LAS u32x4*)(B_ + NH * 9216 + (tid >> 2) * 80 + (tid & 3) * 16) = rkr; } while (0)
    ATT_GLOAD(kt0); ATT_LSTORE(0);
    __syncthreads();
    for (int it = 0; it < nit; ++it) {
        const int ktn = kt0 + (it + 1) * kstep;
        const bool more = (it + 1 < nit) && (ktn < tile_lim);
        if (more) ATT_GLOAD(ktn);
        if (it < nvalid) {
            const LAS unsigned char* B = lds + (it & 1) * BUFSZ;
            const LAS unsigned char* knb = B + hh * 9216; const LAS unsigned char* krb = B + NH * 9216; const LAS unsigned char* vtb = B + NH * 9216 + 5120 + hh * 8704;
            f32x16 s0, s1;
#pragma unroll
            for (int i = 0; i < 16; ++i) { s0[i] = 0.f; s1[i] = 0.f; }
#pragma unroll
            for (int ks = 0; ks < 4; ++ks) { const bf16x8 a0 = *(const LAS bf16x8*)(knb + r * 144 + ks * 32 + h * 16), a1 = *(const LAS bf16x8*)(knb + (32 + r) * 144 + ks * 32 + h * 16);
                s0 = mfma32(a0, qf[ks], s0); s1 = mfma32(a1, qf[ks], s1); }
#pragma unroll
            for (int ks = 0; ks < 2; ++ks) { const bf16x8 a0 = *(const LAS bf16x8*)(krb + r * 80 + ks * 32 + h * 16), a1 = *(const LAS bf16x8*)(krb + (32 + r) * 80 + ks * 32 + h * 16);
                s0 = mfma32(a0, qf[4 + ks], s0); s1 = mfma32(a1, qf[4 + ks], s1); }
            float mx = s0[0];
#pragma unroll
            for (int i = 0; i < 16; ++i) { mx = fmaxf(mx, s0[i]); mx = fmaxf(mx, s1[i]); }
            mx = fmaxf(mx, __shfl_xor(mx, 32));
            const float mnew = fmaxf(m_run, mx), alpha = __builtin_amdgcn_exp2f(m_run - mnew);
            m_run = mnew;
            float ps = 0.f;
#pragma unroll
            for (int i = 0; i < 16; ++i) { s0[i] = __builtin_amdgcn_exp2f(s0[i] - mnew); s1[i] = __builtin_amdgcn_exp2f(s1[i] - mnew); ps += s0[i] + s1[i]; }
            l_run = l_run * alpha + ps;
#pragma unroll
            for (int i = 0; i < 16; ++i) { o[0][i] *= alpha; o[1][i] *= alpha; }
            bf16x8 pf[4];
            pf[0] = pack8(s0, 0); pf[1] = pack8(s0, 8); pf[2] = pack8(s1, 0); pf[3] = pack8(s1, 8);
#pragma unroll
            for (int dh = 0; dh < 2; ++dh)
#pragma unroll
                for (int s4 = 0; s4 < 4; ++s4) { const LAS u32x2* pa = (const LAS u32x2*)(vtb + (32 * dh + r) * 136 + (16 * s4 + 4 * h) * 2); const u32x2 lo = pa[0], hi = pa[2];
                    u32x4 av; av[0] = lo[0]; av[1] = lo[1]; av[2] = hi[0]; av[3] = hi[1]; o[dh] = mfma32(__builtin_bit_cast(bf16x8, av), pf[s4], o[dh]); }
        }
        if (more) ATT_LSTORE((it + 1) & 1);
        __syncthreads();
    }
#undef ATT_GLOAD
#undef ATT_LSTORE
}
DI void attn_core64(LAS unsigned char* lds, const bf16_t* qptr, const bf16_t* kn, const bf16_t* kr, const bf16_t* vt, int KL, int nit, int nvalid,
                    f32x16 (&o)[2][2], float (&m_run)[2], float (&l_run)[2]) {
    constexpr int BUFSZ = 17920 + 5120;
    const int tid = tid_(), lane = tid & 63, r = lane & 31, h = lane >> 5;
    bf16x8 qf[2][2];
    LAS bf16x8* qr = (LAS bf16x8*)(lds + 2 * BUFSZ + (tid >> 6) * 8192) + lane;
#pragma unroll
    for (int g = 0; g < 2; ++g) {
#pragma unroll
        for (int ks = 0; ks < 2; ++ks) qf[g][ks] = *(const bf16x8*)(qptr + g * 32 * 96 + ks * 16 + h * 8);
#pragma unroll
        for (int ks = 0; ks < 4; ++ks) qr[(g * 4 + ks) * 64] = *(const bf16x8*)(qptr + g * 32 * 96 + (2 + ks) * 16 + h * 8); }
#pragma unroll
    for (int g = 0; g < 2; ++g) { m_run[g] = neg_big(); l_run[g] = 0.f;
#pragma unroll
        for (int i = 0; i < 16; ++i) { o[g][0][i] = 0.f; o[g][1][i] = 0.f; } }
    u32x4 rkn, rvt, rkr = {0u, 0u, 0u, 0u};
    const int lrow = tid >> 3, lseg = tid & 7;
#define A64_GLOAD(kt) do { const size_t key0_ = (size_t)(kt) * 64; rkn = *(const u32x4*)(kn + (key0_ + lrow) * 64 + lseg * 8); rvt = *(const u32x4*)(vt + (size_t)lrow * KL + key0_ + lseg * 8); \
        if (tid < 256) rkr = *(const u32x4*)(kr + (key0_ + (tid >> 2)) * 32 + (tid & 3) * 8); } while (0)
#define A64_LSTORE(buf) do { LAS unsigned char* B_ = lds + (buf) * BUFSZ; *(LAS u32x4*)(B_ + lrow * 144 + lseg * 16) = rkn; \
        LAS u32x2* pv_ = (LAS u32x2*)(B_ + 9216 + 5120 + lrow * 136 + lseg * 16); u32x2 a_, b_; a_[0] = rvt[0]; a_[1] = rvt[1]; b_[0] = rvt[2]; b_[1] = rvt[3]; pv_[0] = a_; pv_[1] = b_; \
        if (tid < 256) *(LAS u32x4*)(B_ + 9216 + (tid >> 2) * 80 + (tid & 3) * 16) = rkr; } while (0)
    A64_GLOAD(0); A64_LSTORE(0);
    __syncthreads();
    for (int it = 0; it < nit; ++it) {
        const bool more = (it + 1 < nit);
        if (more) A64_GLOAD(it + 1);
        if (it < nvalid) {
            const LAS unsigned char* B = lds + (it & 1) * BUFSZ;
            const LAS unsigned char* knb = B; const LAS unsigned char* krb = B + 9216; const LAS unsigned char* vtb = B + 9216 + 5120;
            f32x16 s[2][2];
#pragma unroll
            for (int g = 0; g < 2; ++g)
#pragma unroll
                for (int i = 0; i < 16; ++i) { s[g][0][i] = 0.f; s[g][1][i] = 0.f; }
#define A64_KA0(ks) ((ks) < 4 ? *(const LAS bf16x8*)(knb + r * 144 + (ks) * 32 + h * 16) : *(const LAS bf16x8*)(krb + r * 80 + ((ks) - 4) * 32 + h * 16))
#define A64_KA1(ks) ((ks) < 4 ? *(const LAS bf16x8*)(knb + (32 + r) * 144 + (ks) * 32 + h * 16) : *(const LAS bf16x8*)(krb + (32 + r) * 80 + ((ks) - 4) * 32 + h * 16))
#define A64_Q(g, ks) ((ks) < 2 ? qf[g][(ks) < 2 ? (ks) : 0] : qr[((g) * 4 + (ks) - 2) * 64])
            { bf16x8 a0 = A64_KA0(0), a1 = A64_KA1(0), q0 = A64_Q(0, 0), q1 = A64_Q(1, 0);
#pragma unroll
              for (int ks = 0; ks < 6; ++ks) {
                  bf16x8 na0 = a0, na1 = a1, nq0 = q0, nq1 = q1;
                  if (ks < 5) { na0 = A64_KA0(ks + 1); na1 = A64_KA1(ks + 1); nq0 = A64_Q(0, ks + 1); nq1 = A64_Q(1, ks + 1); }
                  __builtin_amdgcn_sched_barrier(0);
                  s[0][0] = mfma32(a0, q0, s[0][0]); s[1][0] = mfma32(a0, q1, s[1][0]); s[0][1] = mfma32(a1, q0, s[0][1]); s[1][1] = mfma32(a1, q1, s[1][1]);
                  __builtin_amdgcn_sched_barrier(0);
                  a0 = na0; a1 = na1; q0 = nq0; q1 = nq1; } }
#undef A64_KA0
#undef A64_KA1
#undef A64_Q
            __builtin_amdgcn_sched_barrier(0);
            bf16x8 pf[2][4];
#pragma unroll
            for (int g = 0; g < 2; ++g) {
                float mx = s[g][0][0];
#pragma unroll
                for (int i = 0; i < 16; ++i) { mx = fmaxf(mx, s[g][0][i]); mx = fmaxf(mx, s[g][1][i]); }
                mx = fmaxf(mx, __shfl_xor(mx, 32));
                const float mnew = mx > m_run[g] + 8.f ? mx : m_run[g], alpha = __builtin_amdgcn_exp2f(m_run[g] - mnew);
                const bool resc = __builtin_amdgcn_ballot_w64(mnew != m_run[g]) != 0ull;
                m_run[g] = mnew;
                float ps = 0.f;
#pragma unroll
                for (int i = 0; i < 16; ++i) { s[g][0][i] = __builtin_amdgcn_exp2f(s[g][0][i] - mnew); s[g][1][i] = __builtin_amdgcn_exp2f(s[g][1][i] - mnew); ps += s[g][0][i] + s[g][1][i]; }
                l_run[g] = l_run[g] * alpha + ps;
                if (resc) {
#pragma unroll
                    for (int i = 0; i < 16; ++i) { o[g][0][i] *= alpha; o[g][1][i] *= alpha; } }
                pf[g][0] = pack8(s[g][0], 0); pf[g][1] = pack8(s[g][0], 8); pf[g][2] = pack8(s[g][1], 0); pf[g][3] = pack8(s[g][1], 8);
                __builtin_amdgcn_sched_barrier(0);
            }
#define A64_VF(idx, lo_, hi_) const LAS u32x2* pa_##lo_ = (const LAS u32x2*)(vtb + (32 * ((idx) >> 2) + r) * 136 + (16 * ((idx) & 3) + 4 * h) * 2); u32x2 lo_ = pa_##lo_[0], hi_ = pa_##lo_[2]
            { A64_VF(0, lo, hi);
#pragma unroll
              for (int idx = 0; idx < 8; ++idx) {
                  u32x2 nlo = lo, nhi = hi;
                  if (idx < 7) { const LAS u32x2* pn = (const LAS u32x2*)(vtb + (32 * ((idx + 1) >> 2) + r) * 136 + (16 * ((idx + 1) & 3) + 4 * h) * 2); nlo = pn[0]; nhi = pn[2]; }
                  __builtin_amdgcn_sched_barrier(0);
                  u32x4 av; av[0] = lo[0]; av[1] = lo[1]; av[2] = hi[0]; av[3] = hi[1]; const bf16x8 avb = __builtin_bit_cast(bf16x8, av);
                  o[0][idx >> 2] = mfma32(avb, pf[0][idx & 3], o[0][idx >> 2]); o[1][idx >> 2] = mfma32(avb, pf[1][idx & 3], o[1][idx >> 2]);
                  __builtin_amdgcn_sched_barrier(0);
                  lo = nlo; hi = nhi; } }
#undef A64_VF
        }
        if (more) A64_LSTORE((it + 1) & 1);
        __syncthreads();
    }
#undef A64_GLOAD
#undef A64_LSTORE
}
DI void phase_attn_p(const Params& p, LAS unsigned char* lds) {
    const int tid = tid_(), lane = tid & 63, wid = __builtin_amdgcn_readfirstlane(tid >> 6), r = lane & 31, h = lane >> 5;
    const bf16_t* Q = (const bf16_t*)(p.ws + OFF_Q); const bf16_t* KN = (const bf16_t*)(p.ws + OFF_KN); const bf16_t* VT = (const bf16_t*)(p.ws + OFF_VT);
    const bf16_t* KRO = (const bf16_t*)(p.ws + OFF_KROPE); bf16_t* O = (bf16_t*)(p.ws + OFF_O);
    for (int pair = bid_(); pair < 256; pair += gridDim.x) {
        const int bh = (pair & 7) * 4 + (pair >> 6), qa = (pair >> 3) & 7, b = bh >> 3, hd = bh & 7;
        for (int sub = 0; sub < 2; ++sub) {
            const int qb = sub ? qa : 15 - qa;
            const int t0 = qb * 512 + wid * 64 + r;
            f32x16 o[2][2]; float m_run[2], l_run[2];
            attn_core64(lds, Q + ((size_t)bh * 8192 + t0) * 96, KN + (size_t)bh * 8192 * 64, KRO + (size_t)b * 8192 * 32, VT + (size_t)bh * 64 * 8192, 8192,
                        8 * qb + 8, 8 * qb + wid + 1, o, m_run, l_run);
#pragma unroll
            for (int g = 0; g < 2; ++g) {
                const float inv = 1.f / (l_run[g] + __shfl_xor(l_run[g], 32));
                bf16_t* orow = O + ((size_t)b * 8192 + t0 + g * 32) * 512 + hd * 64;
#pragma unroll
                for (int dh = 0; dh < 2; ++dh)
#pragma unroll
                    for (int q4 = 0; q4 < 4; ++q4) { uint2 w; w.x = pack2(o[g][dh][4 * q4] * inv, o[g][dh][4 * q4 + 1] * inv); w.y = pack2(o[g][dh][4 * q4 + 2] * inv, o[g][dh][4 * q4 + 3] * inv); *(uint2*)(orow + 32 * dh + 8 * q4 + 4 * h) = w; }
            }
        }
    }
}
DI void phase_attn_s(const Params& p, LAS unsigned char* lds) {
    const int tid = tid_(), lane = tid & 63, wid = __builtin_amdgcn_readfirstlane(tid >> 6), r = lane & 31, h = lane >> 5;
    const bf16_t* Q = (const bf16_t*)(p.ws + OFF_Q); const bf16_t* KN = (const bf16_t*)(p.ws + OFF_KN); const bf16_t* VT = (const bf16_t*)(p.ws + OFF_VT);
    const bf16_t* KRO = (const bf16_t*)(p.ws + OFF_KROPE); float* PART = (float*)(p.ws + OFF_PART);
    for (int c = bid_(); c < 256; c += gridDim.x) {
        const int b = c >> 3, hg = (c >> 2) & 1, split = c & 3, hh = wid >> 1, head = hg * 4 + hh, t = (wid & 1) * 32 + r;
        f32x16 o[2]; float m_run, l_run;
        attn_core<4>(lds, Q + (size_t)MP * 768 + ((size_t)(b * 8 + head) * 64 + t) * 96, KN + (size_t)MP * 512 + (size_t)(b * 8 + hg * 4) * KEYS_S * 64, (size_t)KEYS_S * 64,
                     KRO + (size_t)MP * 32 + (size_t)b * KEYS_S * 32, VT + (size_t)MP * 512 + (size_t)(b * 8 + hg * 4) * 64 * KEYS_S, (size_t)64 * KEYS_S, KEYS_S,
                     split, 4, 17, split == 0 ? 17 : 16, 65, hh, o, m_run, l_run);
        const float lt = l_run + __shfl_xor(l_run, 32);
        float* pr = PART + (((size_t)(b * 8 + head) * 4 + split) * 64 + t) * 66;
#pragma unroll
        for (int dh = 0; dh < 2; ++dh)
#pragma unroll
            for (int g = 0; g < 4; ++g) { float2 a, bb; a.x = o[dh][4 * g]; a.y = o[dh][4 * g + 1]; bb.x = o[dh][4 * g + 2]; bb.y = o[dh][4 * g + 3]; float* d = pr + 32 * dh + 8 * g + 4 * h; *(float2*)d = a; *(float2*)(d + 2) = bb; }
        if (h == 0) { float2 ml; ml.x = m_run; ml.y = lt; *(float2*)(pr + 64) = ml; }
    }
}

constexpr int R_QF = 0, R_KF = 16384, R_G = 32768, R_VTI = 49152, R_KTI = 58368, R_QTI = 67584, R_STI = 76800, R_PPI = 86016, R_QHI = 95232, R_KHI = 102144,
              R_GA = 115968, R_WA = 120064, R_SEG = 122240, R_OF = 0, R_WALL = 124288, R_BA = 132480, R_LB = 132992, R_QD = 134016, R_KD = 143232;
struct RecPre { u32x4 uv, ua, uq, ug, gz; f32x4 s0, s1; };
DI uint4 to_u4(u32x4 v) { uint4 r; r.x = v[0]; r.y = v[1]; r.z = v[2]; r.w = v[3]; return r; }
DI float4 to_f4(f32x4 v) { float4 r; r.x = v[0]; r.y = v[1]; r.z = v[2]; r.w = v[3]; return r; }
DI void rec_tables(const Params& p, int l, LAS unsigned char* lds) {
    const int tid = tid_();
    LAS float* WALL = (LAS float*)(lds + R_WALL); LAS float* BA = (LAS float*)(lds + R_BA); LAS float* LB = (LAS float*)(lds + R_LB);
#pragma unroll
    for (int i = 0; i < 4; ++i) WALL[tid + 512 * i] = p.in[23][l * 2048 + tid + 512 * i];
    if (tid < 128) BA[tid] = p.in[24][l * 128 + tid];
    if (tid < 256) { float lb = 0.f; if (l == 1) { const float l0 = p.in[21][tid], l1 = p.in[21][256 + tid]; lb = 1.f / (1.f + expf(l0 - l1)); } LB[tid] = lb; }
    __syncthreads();
}
template <int DK, bool HG>
DI void rec_issue(const Params& p, int cid, int hd, bool passC, RecPre& r) {
    const int tid = tid_();
    const bf16_t* Z = (const bf16_t*)(p.ws + OFF_Z);
    const size_t row0 = (size_t)cid * 64;
    const int lj = tid >> 3, ls8 = (tid & 7) * 8;
    const bf16_t* zr = Z + (row0 + lj) * ZLD;
    r.uv = *(const u32x4*)(zr + (HG ? 1056 : 1824) + hd * 64 + ls8);
    if (HG) { r.ua = *(const u32x4*)(zr + 800 + hd * 64 + ls8); if (passC) r.uq = *(const u32x4*)(zr + 544 + hd * 64 + ls8); }
    else { if (tid < 256) { const bf16_t* z2 = Z + (row0 + (tid >> 2)) * ZLD; r.ua = *(const u32x4*)(z2 + 1696 + hd * 32 + (tid & 3) * 8); if (passC) r.uq = *(const u32x4*)(z2 + 1568 + hd * 32 + (tid & 3) * 8); }
           if (tid < 128) r.ug = *(const u32x4*)(Z + (row0 + (tid >> 1)) * ZLD + 2336 + (tid & 1) * 8); }
    if (passC) {
        const float* S = (const float*)(p.ws + (HG ? OFF_UHG : OFF_UGL)) + ((size_t)cid * 4 + hd) * DK * 64;
            if (tid < DK * 8) { const int k = tid >> 3, v0 = (tid & 7) * 8; r.s0 = *(const f32x4*)(S + k * 64 + v0); r.s1 = *(const f32x4*)(S + k * 64 + v0 + 4); }
        r.gz = *(const u32x4*)(zr + (HG ? 1312 : 2080) + hd * 64 + ls8);
    }
}
template <int DK, bool HG>
DI void rec_load(const RecPre& pre, LAS unsigned char* lds, int hd, bool need_q) {
    const int tid = tid_();
    LAS float* QF = (LAS float*)(lds + R_QF); LAS float* KF = (LAS float*)(lds + R_KF); LAS float* G = (LAS float*)(lds + R_G);
    LAS bf16_t* VTI = (LAS bf16_t*)(lds + R_VTI); LAS float* GA = (LAS float*)(lds + R_GA); LAS float* SEG = (LAS float*)(lds + R_SEG);
    const LAS float* WA = (const LAS float*)(lds + (HG ? R_LB : R_WALL)) + (HG ? hd * 64 : hd * 32);
    const LAS float* BA = (const LAS float*)(lds + R_BA) + hd * 32;
    const int lj = tid >> 3, ls8 = (tid & 7) * 8;
    const uint4 uv = to_u4(pre.uv), ua = to_u4(pre.ua), uq = to_u4(pre.uq);
    if (!HG) {
        if (tid < 128) { const int j = tid >> 1, hf = tid & 1; const uint4 u = to_u4(pre.ug); LAS float* ga = GA + j * 16 + hf * 8;
            ga[0] = bflo(u.x); ga[1] = bfhi(u.x); ga[2] = bflo(u.y); ga[3] = bfhi(u.y); ga[4] = bflo(u.z); ga[5] = bfhi(u.z); ga[6] = bflo(u.w); ga[7] = bfhi(u.w); }
        __syncthreads();
    }
    { const float va[8] = {bflo(ua.x), bfhi(ua.x), bflo(ua.y), bfhi(ua.y), bflo(ua.z), bfhi(ua.z), bflo(ua.w), bfhi(ua.w)};
      const float vq[8] = {bflo(uq.x), bfhi(uq.x), bflo(uq.y), bfhi(uq.y), bflo(uq.z), bfhi(uq.z), bflo(uq.w), bfhi(uq.w)};
      if (HG) { float gg[8], kk[8];
#pragma unroll
          for (int x = 0; x < 8; ++x) { const float lb = WA[ls8 + x], e = __expf(fminf(-va[x], 80.f)), s = 1.f / (1.f + e); gg[x] = logf(lb + (1.f - lb) * s); kk[x] = (1.f - lb) * e * s; }
          LAS f32x4* gp = (LAS f32x4*)(G + lj * 64 + ls8); LAS f32x4* kp = (LAS f32x4*)(KF + lj * 64 + ls8);
          gp[0] = (f32x4){gg[0], gg[1], gg[2], gg[3]}; gp[1] = (f32x4){gg[4], gg[5], gg[6], gg[7]}; kp[0] = (f32x4){kk[0], kk[1], kk[2], kk[3]}; kp[1] = (f32x4){kk[4], kk[5], kk[6], kk[7]};
          if (need_q) { LAS f32x4* qp = (LAS f32x4*)(QF + lj * 64 + ls8); qp[0] = (f32x4){vq[0], vq[1], vq[2], vq[3]}; qp[1] = (f32x4){vq[4], vq[5], vq[6], vq[7]}; } }
      else {
          { const int kq = (tid & 7) * 4; f32x4 x = *(const LAS f32x4*)(BA + kq);
#pragma unroll
            for (int r = 0; r < 16; ++r) { const float ga = GA[lj * 16 + r]; const f32x4 wv = *(const LAS f32x4*)(WA + r * 128 + kq); x += ga * wv; }
            f32x4 o;
#pragma unroll
            for (int y = 0; y < 4; ++y) o[y] = (fminf(x[y], 0.f) - log1pf(__expf(-fabsf(x[y])))) * (1.f / 16.f);
            *(LAS f32x4*)(G + lj * 32 + kq) = o; }
          if (tid < 256) { const int j2 = tid >> 2, k2 = (tid & 3) * 8; LAS f32x4* kp = (LAS f32x4*)(KF + j2 * 32 + k2); kp[0] = (f32x4){va[0], va[1], va[2], va[3]}; kp[1] = (f32x4){va[4], va[5], va[6], va[7]};
              if (need_q) { const float qs = 0.17677669529663687f; LAS f32x4* qp = (LAS f32x4*)(QF + j2 * 32 + k2); qp[0] = (f32x4){vq[0] * qs, vq[1] * qs, vq[2] * qs, vq[3] * qs}; qp[1] = (f32x4){vq[4] * qs, vq[5] * qs, vq[6] * qs, vq[7] * qs}; } } }
      const unsigned vv[4] = {uv.x, uv.y, uv.z, uv.w};
#pragma unroll
      for (int x = 0; x < 4; ++x) { VTI[(ls8 + 2 * x) * 72 + lj] = (bf16_t)(vv[x] & 0xFFFFu); VTI[(ls8 + 2 * x + 1) * 72 + lj] = (bf16_t)(vv[x] >> 16); } }
    __syncthreads();
    constexpr int NSEG = NT / DK, JS = 64 / NSEG;
    const int seg = tid / DK, k = tid % DK;
    float loc[JS]; float s = 0.f;
#pragma unroll
    for (int jj = 0; jj < JS; ++jj) { s += G[(seg * JS + jj) * DK + k]; loc[jj] = s; }
    SEG[seg * DK + k] = s;
    __syncthreads();
    float off = 0.f;
#pragma unroll
    for (int s2 = 0; s2 < NSEG; ++s2) { const float t = SEG[s2 * DK + k]; off += s2 < seg ? t : 0.f; }
#pragma unroll
    for (int jj = 0; jj < JS; ++jj) G[(seg * JS + jj) * DK + k] = loc[jj] + off;
    __syncthreads();
}
template <int DK, bool HG>
DI void rec_passA_item(const Params& p, int l, LAS unsigned char* lds, int cid, int hd, const RecPre& pre) {
    const int tid = tid_(), lane = tid & 63, wid = __builtin_amdgcn_readfirstlane(tid >> 6), fr = lane & 15, fq = lane >> 4;
    rec_load<DK, HG>(pre, lds, hd, false);
    LAS float* KF = (LAS float*)(lds + R_KF); LAS float* G = (LAS float*)(lds + R_G);
    LAS bf16_t* VTI = (LAS bf16_t*)(lds + R_VTI); LAS bf16_t* KTI = (LAS bf16_t*)(lds + R_KTI);
    float* U = (float*)(p.ws + (HG ? OFF_UHG : OFF_UGL)); float* D = (float*)(p.ws + (HG ? OFF_DHG : OFF_DGL));
    for (int e = tid; e < 64 * DK; e += NT) { const int j = e / DK, k = e % DK; KTI[k * 72 + j] = f2bf(KF[e] * __expf(G[63 * DK + k] - G[e])); }
    if (tid < DK) D[((size_t)cid * 4 + hd) * DK + tid] = __expf(G[63 * DK + tid]);
    __syncthreads();
    for (int tile = wid; tile < (DK / 16) * 4; tile += 8) {
        const int tk = tile >> 2, tv = tile & 3; f32x4 acc = {0.f, 0.f, 0.f, 0.f};
#pragma unroll
        for (int s = 0; s < 2; ++s) { const bf16x8 a = *(const LAS bf16x8*)(KTI + (16 * tk + fr) * 72 + 32 * s + 8 * fq), b = *(const LAS bf16x8*)(VTI + (16 * tv + fr) * 72 + 32 * s + 8 * fq); acc = mfma16(a, b, acc); }
#pragma unroll
        for (int reg = 0; reg < 4; ++reg) U[(((size_t)cid * 4 + hd) * DK + 16 * tk + 4 * fq + reg) * 64 + 16 * tv + fr] = acc[reg];
    }
    __syncthreads();
}
template <int DK, bool HG>
DI void rec_passC_item(const Params& p, int l, LAS unsigned char* lds, int cid, int hd, const RecPre& pre) {
    const int tid = tid_(), lane = tid & 63, wid = __builtin_amdgcn_readfirstlane(tid >> 6), fr = lane & 15, fq = lane >> 4;
    rec_load<DK, HG>(pre, lds, hd, true);
    LAS float* QF = (LAS float*)(lds + R_QF); LAS float* KF = (LAS float*)(lds + R_KF); LAS float* G = (LAS float*)(lds + R_G); LAS float* OF = (LAS float*)(lds + R_OF);
    LAS bf16_t* VTI = (LAS bf16_t*)(lds + R_VTI); LAS bf16_t* QTI = (LAS bf16_t*)(lds + R_QTI); LAS bf16_t* STI = (LAS bf16_t*)(lds + R_STI);
    LAS bf16_t* PPI = (LAS bf16_t*)(lds + R_PPI); LAS bf16_t* QHI = (LAS bf16_t*)(lds + R_QHI); LAS bf16_t* KHI = (LAS bf16_t*)(lds + R_KHI);
    const bf16_t* Z = (const bf16_t*)(p.ws + OFF_Z); bf16_t* H = (bf16_t*)(p.ws + OFF_H);
    for (int e = tid; e < 64 * DK; e += NT) { const int i = e / DK, k = e % DK; QTI[i * 72 + k] = f2bf(QF[e] * __expf(G[e])); }
    if (tid < DK * 8) { const int k = tid >> 3, v0 = (tid & 7) * 8; const float4 s0 = to_f4(pre.s0), s1 = to_f4(pre.s1);
        STI[(v0 + 0) * 72 + k] = f2bf(s0.x); STI[(v0 + 1) * 72 + k] = f2bf(s0.y); STI[(v0 + 2) * 72 + k] = f2bf(s0.z); STI[(v0 + 3) * 72 + k] = f2bf(s0.w);
        STI[(v0 + 4) * 72 + k] = f2bf(s1.x); STI[(v0 + 5) * 72 + k] = f2bf(s1.y); STI[(v0 + 6) * 72 + k] = f2bf(s1.z); STI[(v0 + 7) * 72 + k] = f2bf(s1.w); }
    for (int e = tid; e < 48 * DK; e += NT) { const int ii = e / DK, k = e % DK, I = 1 + (ii >> 4), i = 16 + ii; const float ref = G[(16 * I - 1) * DK + k];
        QHI[ii * 72 + k] = f2bf(QF[i * DK + k] * __expf(G[i * DK + k] - ref)); }
    for (int e = tid; e < 96 * DK; e += NT) { const int rr = e / DK, k = e % DK, I = rr < 16 ? 1 : (rr < 48 ? 2 : 3), j = rr - 8 * I * (I - 1); const float ref = G[(16 * I - 1) * DK + k];
        KHI[rr * 72 + k] = f2bf(KF[j * DK + k] * __expf(ref - G[j * DK + k])); }
    { LAS bf16_t* QD = (LAS bf16_t*)(lds + R_QD); LAS bf16_t* KD = (LAS bf16_t*)(lds + R_KD);
      for (int e = tid; e < 64 * DK; e += NT) { const int i = e / DK, k = e % DK; const float ref = G[(16 * (i >> 4) + 7) * DK + k], gi = G[e];
          QD[i * 72 + k] = f2bf(QF[e] * __expf(fminf(fmaxf(gi - ref, -80.f), 80.f))); KD[i * 72 + k] = f2bf(KF[e] * __expf(fminf(fmaxf(ref - gi, -80.f), 80.f))); } }
    for (int e = tid; e < 1536; e += NT) { const int bidx = e >> 8, w = e & 255; const int I = bidx < 3 ? 0 : (bidx < 5 ? 1 : 2), J = bidx < 3 ? bidx + 1 : (bidx < 5 ? bidx - 1 : 3);
        PPI[(16 * I + (w >> 4)) * 72 + 16 * J + (w & 15)] = 0; }
    __syncthreads();
    if (wid >= 6) { const LAS bf16_t* QD = (const LAS bf16_t*)(lds + R_QD); const LAS bf16_t* KD = (const LAS bf16_t*)(lds + R_KD);
#pragma unroll
        for (int t2 = 0; t2 < 2; ++t2) { const int I = (wid - 6) * 2 + t2; f32x4 acc = {0.f, 0.f, 0.f, 0.f};
#pragma unroll
            for (int s = 0; s < DK / 32; ++s) { const bf16x8 a = *(const LAS bf16x8*)(QD + (16 * I + fr) * 72 + 32 * s + 8 * fq), b = *(const LAS bf16x8*)(KD + (16 * I + fr) * 72 + 32 * s + 8 * fq); acc = mfma16(a, b, acc); }
#pragma unroll
            for (int reg = 0; reg < 4; ++reg) PPI[(16 * I + 4 * fq + reg) * 72 + 16 * I + fr] = f2bf(fr <= 4 * fq + reg ? acc[reg] : 0.f); } }
    if (wid < 6) { const int I = wid < 1 ? 1 : (wid < 3 ? 2 : 3), J = wid < 1 ? 0 : (wid < 3 ? wid - 1 : wid - 3); f32x4 acc = {0.f, 0.f, 0.f, 0.f};
#pragma unroll
        for (int s = 0; s < DK / 32; ++s) { const bf16x8 a = *(const LAS bf16x8*)(QHI + ((I - 1) * 16 + fr) * 72 + 32 * s + 8 * fq), b = *(const LAS bf16x8*)(KHI + (8 * I * (I - 1) + 16 * J + fr) * 72 + 32 * s + 8 * fq); acc = mfma16(a, b, acc); }
#pragma unroll
        for (int reg = 0; reg < 4; ++reg) PPI[(16 * I + 4 * fq + reg) * 72 + 16 * J + fr] = f2bf(acc[reg]); }
    __syncthreads();
#pragma unroll
    for (int tt = 0; tt < 2; ++tt) { const int tile = wid * 2 + tt, ti = tile >> 2, tv = tile & 3; f32x4 acc = {0.f, 0.f, 0.f, 0.f};
#pragma unroll
        for (int s = 0; s < DK / 32; ++s) { const bf16x8 a = *(const LAS bf16x8*)(QTI + (16 * ti + fr) * 72 + 32 * s + 8 * fq), b = *(const LAS bf16x8*)(STI + (16 * tv + fr) * 72 + 32 * s + 8 * fq); acc = mfma16(a, b, acc); }
#pragma unroll
        for (int s = 0; s < 2; ++s) { const bf16x8 a = *(const LAS bf16x8*)(PPI + (16 * ti + fr) * 72 + 32 * s + 8 * fq), b = *(const LAS bf16x8*)(VTI + (16 * tv + fr) * 72 + 32 * s + 8 * fq); acc = mfma16(a, b, acc); }
#pragma unroll
        for (int reg = 0; reg < 4; ++reg) OF[(16 * ti + 4 * fq + reg) * 65 + 16 * tv + fr] = acc[reg]; }
    __syncthreads();
    { const int i = tid >> 3, part = tid & 7; float v[8]; float ss = 0.f;
#pragma unroll
      for (int x = 0; x < 8; ++x) { v[x] = OF[i * 65 + part * 8 + x]; ss += v[x] * v[x]; }
      ss += __shfl_xor(ss, 1); ss += __shfl_xor(ss, 2); ss += __shfl_xor(ss, 4);
      const float rs = rsqrtf(ss * (1.f / 64.f) + EPS);
      const size_t row = (size_t)cid * 64 + i;
      const uint4 gz = to_u4(pre.gz);
      const float* go = p.in[HG ? 22 : 25] + l * 64 + part * 8;
      const float gt[8] = {bflo(gz.x), bfhi(gz.x), bflo(gz.y), bfhi(gz.y), bflo(gz.z), bfhi(gz.z), bflo(gz.w), bfhi(gz.w)};
      float r[8];
#pragma unroll
      for (int x = 0; x < 8; ++x) r[x] = v[x] * rs * go[x] * (gt[x] / (1.f + __expf(-gt[x])));
      uint4 w; w.x = pack2(r[0], r[1]); w.y = pack2(r[2], r[3]); w.z = pack2(r[4], r[5]); w.w = pack2(r[6], r[7]);
      *(uint4*)(H + row * 1024 + 512 + (HG ? 0 : 256) + hd * 64 + part * 8) = w; }
    __syncthreads();
}
template <int DK>
DI void scan_prompt(float* U, const float* D, float* outp, int e) {
    const int v = e & 63, k = (e >> 6) % DK, hd = (e / (64 * DK)) & 3, b = e / (256 * DK);
    float S = 0.f;
    for (int n0 = 0; n0 < 128; n0 += 16) {
        float u[16], d[16];
#pragma unroll
        for (int i = 0; i < 16; ++i) { const size_t ch = ((size_t)(b * 128 + n0 + i) * 4 + hd); u[i] = U[(ch * DK + k) * 64 + v]; d[i] = D[ch * DK + k]; }
#pragma unroll
        for (int i = 0; i < 16; ++i) { const size_t ch = ((size_t)(b * 128 + n0 + i) * 4 + hd); U[(ch * DK + k) * 64 + v] = S; S = d[i] * S + u[i]; }
    }
    outp[e] = S;
}
template <int DK>
DI void scan_sample(float* U, const float* D, const float* s0p, float* outp, int e) {
    const int v = e & 63, k = (e >> 6) % DK, hd = (e / (64 * DK)) & 3, b = e / (256 * DK);
    const size_t ch = (size_t)(512 + b) * 4 + hd; const size_t idx = (ch * DK + k) * 64 + v;
    const float s0 = s0p[e], u = U[idx], d = D[ch * DK + k];
    U[idx] = s0; outp[e] = d * s0 + u;
}
DI void phase_scan(const Params& p, int l) {
    const int g = bid_() * NT + tid_(), gs = gridDim.x * NT;
    float* UH = (float*)(p.ws + OFF_UHG); const float* DH = (const float*)(p.ws + OFF_DHG); float* UG = (float*)(p.ws + OFF_UGL); const float* DG = (const float*)(p.ws + OFF_DGL);
    for (int e = g; e < 98304; e += gs) {
        if (e < 65536) scan_prompt<64>(UH, DH, p.out + OUT_HGP + (size_t)l * 65536, e);
        else scan_prompt<32>(UG, DG, p.out + OUT_GLP + (size_t)l * 32768, e - 65536);
    }
    for (int e = g; e < 786432; e += gs) {
        if (e < 524288) scan_sample<64>(UH, DH, p.in[6] + (size_t)l * 524288, p.out + OUT_HGS + (size_t)l * 524288, e);
        else scan_sample<32>(UG, DG, p.in[7] + (size_t)l * 262144, p.out + OUT_GLS + (size_t)l * 262144, e - 524288);
    }
}
DI void phase_mlaout(const Params& p, int l) {
    const int tid = tid_(), lane = tid & 63, wid = __builtin_amdgcn_readfirstlane(tid >> 6);
    const bf16_t* O = (const bf16_t*)(p.ws + OFF_O); const float* PART = (const float*)(p.ws + OFF_PART); bf16_t* H = (bf16_t*)(p.ws + OFF_H);
    const float* g = p.in[20] + l * 512 + 8 * lane;
    for (int row = bid_() * 8 + wid; row < MT; row += gridDim.x * 8) {
        float v[8];
        if (row < MP) { const uint4 u = *(const uint4*)(O + (size_t)row * 512 + 8 * lane);
            v[0] = bflo(u.x); v[1] = bfhi(u.x); v[2] = bflo(u.y); v[3] = bfhi(u.y); v[4] = bflo(u.z); v[5] = bfhi(u.z); v[6] = bflo(u.w); v[7] = bfhi(u.w); }
        else { const int r = row - MP, b = r >> 6, t = r & 63, head = lane >> 3, dv0 = (lane & 7) * 8;
            const float* pb = PART + (((size_t)(b * 8 + head) * 4) * 64 + t) * 66;
            float m[4], lsum[4]; float M = neg_big();
#pragma unroll
            for (int s = 0; s < 4; ++s) { m[s] = pb[(size_t)s * 64 * 66 + 64]; lsum[s] = pb[(size_t)s * 64 * 66 + 65]; M = fmaxf(M, m[s]); }
            float L = 0.f;
#pragma unroll
            for (int x = 0; x < 8; ++x) v[x] = 0.f;
#pragma unroll
            for (int s = 0; s < 4; ++s) { const float w = exp2f(m[s] - M); L += w * lsum[s];
#pragma unroll
                for (int x = 0; x < 8; ++x) v[x] += w * pb[(size_t)s * 64 * 66 + dv0 + x]; }
            const float inv = 1.f / L;
#pragma unroll
            for (int x = 0; x < 8; ++x) v[x] *= inv; }
        float ss = 0.f;
#pragma unroll
        for (int x = 0; x < 8; ++x) ss += v[x] * v[x];
        ss = wave_sum(ss);
        const float rs = rsqrtf(ss * (1.f / 512.f) + EPS);
        uint4 w; w.x = pack2(v[0] * rs * g[0], v[1] * rs * g[1]); w.y = pack2(v[2] * rs * g[2], v[3] * rs * g[3]); w.z = pack2(v[4] * rs * g[4], v[5] * rs * g[5]); w.w = pack2(v[6] * rs * g[6], v[7] * rs * g[7]);
        *(uint4*)(H + (size_t)row * 1024 + 8 * lane) = w;
    }
}

DI void gsync(const Params& p, LAS unsigned char* lds) { XcdBarrier b; b.bar = (unsigned*)(p.ws + OFF_BAR); b.x = xb_xcc_id(); b.st = (volatile LAS unsigned*)(lds + LDS_BYTES - 16); xcd_barrier(b); }
__global__ void __launch_bounds__(512, 2) mk_fwd(Params p) {
    extern __shared__ __attribute__((aligned(16))) unsigned char shm[];
    LAS unsigned char* lds = (LAS unsigned char*)shm;
    cg::grid_group grid = cg::this_grid();
    bf16_t* H = (bf16_t*)(p.ws + OFF_H); bf16_t* Z = (bf16_t*)(p.ws + OFF_Z); bf16_t* CQN = (bf16_t*)(p.ws + OFF_CQN); bf16_t* CKV = (bf16_t*)(p.ws + OFF_CKV);
    bf16_t* Q = (bf16_t*)(p.ws + OFF_Q); bf16_t* KN = (bf16_t*)(p.ws + OFF_KN); bf16_t* VT = (bf16_t*)(p.ws + OFF_VT); bf16_t* ACT = (bf16_t*)(p.ws + OFF_ACT);
    const float* rope = (const float*)(p.ws + OFF_ROPE); bf16_t* XB = (bf16_t*)(p.ws + OFF_XB);
    volatile LAS unsigned* xst = (volatile LAS unsigned*)(lds + LDS_BYTES - 16);
    if (threadIdx.x == 0) { xst[0] = 0u; xst[1] = 0u; }
    __syncthreads();
    (void)xcd_barrier_post((unsigned*)(p.ws + OFF_BAR), xst);
    phase_prep(p, lds);
    grid.sync();
#pragma unroll 1
    for (int l = 0; l < 2; ++l) {
        const unsigned char* W = p.ws + OFF_W + (size_t)l * WL;
        const float* modl = (const float*)(p.ws + OFF_MOD) + (size_t)l * 36 * 6144;
        const int hb0 = (int)gridDim.x > 64 ? 32 : 0, hnb = (int)gridDim.x - hb0;
        if (l == 0) { phase_hrows<true>(p, l, p.in[0], p.in[1], p.in[10] + l * 1024, 0, 1024); gsync(p, lds); }
        run_gemm(lds, H, (const bf16_t*)(W + WOFF_IN), MT, 2560, 1024, EpiZ{Z, ZLD});
        {
          const int G = (int)gridDim.x, rem = ((MT / 256) * (2560 / 256)) % G;
          if (rem > 0 && G - rem >= G / 2) { if ((int)bid_() >= rem) phase_cache(p, l, rem, G - rem); } else phase_cache(p, l, 0, G); }
        gsync(p, lds);
        phase_post(p, l);
        rec_tables(p, l, lds);
        { RecPre pre = {}; int it = bid_(); if (it < 2176) rec_issue<64, true>(p, it >> 2, it & 3, false, pre);
          for (; it < 2176; it += gridDim.x) { const RecPre cur = pre; const int nx = it + gridDim.x; if (nx < 2176) rec_issue<64, true>(p, nx >> 2, nx & 3, false, pre); rec_passA_item<64, true>(p, l, lds, it >> 2, it & 3, cur); } }
        { RecPre pre = {}; int it = (int)((bid_() + gridDim.x / 2) % gridDim.x); if (it < 2176) rec_issue<32, false>(p, it >> 2, it & 3, false, pre);
          for (; it < 2176; it += gridDim.x) { const RecPre cur = pre; const int nx = it + gridDim.x; if (nx < 2176) rec_issue<32, false>(p, nx >> 2, nx & 3, false, pre); rec_passA_item<32, false>(p, l, lds, it >> 2, it & 3, cur); } }
        gsync(p, lds);
        run_gemm(lds, CQN, (const bf16_t*)(W + WOFF_UQ), MT, 768, 256, EpiQ{Q, p.in[18] + l * 96, rope});
        run_gemm(lds, CKV, (const bf16_t*)(W + WOFF_UK), KR_ROWS, 512, 256, EpiKN{KN, p.in[19] + l * 96}, 104);
        run_gemm(lds, (const bf16_t*)(W + WOFF_UV), CKV, 512, KR_ROWS, 256, EpiVT{VT}, 40);
        phase_scan(p, l);
        gsync(p, lds);
        phase_attn_p(p, lds);
        phase_attn_s(p, lds);
        rec_tables(p, l, lds);
        { RecPre pre = {}; int it = bid_(); if (it < 2176) rec_issue<64, true>(p, it >> 2, it & 3, true, pre);
          for (; it < 2176; it += gridDim.x) { const RecPre cur = pre; const int nx = it + gridDim.x; if (nx < 2176) rec_issue<64, true>(p, nx >> 2, nx & 3, true, pre); rec_passC_item<64, true>(p, l, lds, it >> 2, it & 3, cur); } }
        { RecPre pre = {}; int it = (int)((bid_() + gridDim.x / 2) % gridDim.x); if (it < 2176) rec_issue<32, false>(p, it >> 2, it & 3, true, pre);
          for (; it < 2176; it += gridDim.x) { const RecPre cur = pre; const int nx = it + gridDim.x; if (nx < 2176) rec_issue<32, false>(p, nx >> 2, nx & 3, true, pre); rec_passC_item<32, false>(p, l, lds, it >> 2, it & 3, cur); } }
        gsync(p, lds);
        phase_mlaout(p, l);
        gsync(p, lds);
        run_gemm(lds, H, (const bf16_t*)(W + WOFF_O), MP, 1024, 1024, EpiRes{XB, p.out, modl + 2048, 0, 0});
        gsync(p, lds);
        run_gemm(lds, H + (size_t)MP * 1024, (const bf16_t*)(W + WOFF_O), MS, 1024, 1024, EpiRes{XB, p.out, modl + 2048, 0, MP / 256});
        if ((int)bid_() >= hb0) phase_hrows<false>(p, l, nullptr, nullptr, p.in[11] + l * 1024, 3072, 4096, 0, MP, hb0, hnb);
        gsync(p, lds);
        phase_hrows<false>(p, l, nullptr, nullptr, p.in[11] + l * 1024, 3072, 4096, MP, MT);
        gsync(p, lds);
        const bool skew_ok = l == 1 && ((MP / 256) * 22) % (int)gridDim.x == 0 && (int)gridDim.x >= 128;
        if (!skew_ok) { run_gemm(lds, H, (const bf16_t*)(W + WOFF_FI), MT, 5632, 1024, EpiSwi{ACT, 0}); gsync(p, lds); }
        if (l == 0) {
            run_gemm(lds, ACT, (const bf16_t*)(W + WOFF_FO), MP, 1024, 2816, EpiRes{XB, p.out, modl + 5120, 0, 0});
            gsync(p, lds);
            run_gemm(lds, ACT + (size_t)MP * 2816, (const bf16_t*)(W + WOFF_FO), MS, 1024, 2816, EpiRes{XB, p.out, modl + 5120, 0, MP / 256});
            if ((int)bid_() >= hb0) phase_hrows<false>(p, 1, nullptr, nullptr, p.in[10] + 1024, 0, 1024, 0, MP, hb0, hnb);
            gsync(p, lds);
            phase_hrows<false>(p, 1, nullptr, nullptr, p.in[10] + 1024, 0, 1024, MP, MT);
            gsync(p, lds);
        } else if (skew_ok) {
            run_gemm(lds, H + (size_t)MP * 1024, (const bf16_t*)(W + WOFF_FI), MS, 5632, 1024, EpiSwi{ACT, MP / 256});
            gsync(p, lds);
            run_gemm(lds, ACT + (size_t)MP * 2816, (const bf16_t*)(W + WOFF_FO), MS, 1024, 2816, EpiRes{XB, p.out, modl + 5120, 1, MP / 256});
            run_gemm_skew(lds, H, (const bf16_t*)(W + WOFF_FI), MP, 5632, 1024, EpiSwi{ACT, 0}, 32, 2);
            gsync(p, lds);
            run_gemm(lds, ACT, (const bf16_t*)(W + WOFF_FO), MP, 1024, 2816, EpiRes{XB, p.out, modl + 5120, 1, 0});
        } else run_gemm(lds, ACT, (const bf16_t*)(W + WOFF_FO), MT, 1024, 2816, EpiRes{XB, p.out, modl + 5120, 1, 0});
    }
}

extern "C" void kernel_launch(void* const* d_in, const int* in_sizes, int n_in, void* d_out, int out_size, void* d_ws, size_t ws_size, hipStream_t stream) {
    static int grid = 0;
    if (grid == 0) {
        int dev = 0, cus = 0, per_cu = 0;
        hipGetDevice(&dev);
        hipDeviceGetAttribute(&cus, hipDeviceAttributeMultiprocessorCount, dev);
        hipFuncSetAttribute((const void*)mk_fwd, hipFuncAttributeMaxDynamicSharedMemorySize, LDS_BYTES);
        hipOccupancyMaxActiveBlocksPerMultiprocessor(&per_cu, (const void*)mk_fwd, NT, LDS_BYTES);
        if (per_cu < 1) { fprintf(stderr, "kernel_launch: occupancy query says %d blocks per CU\n", per_cu); per_cu = 1; }
        (void)hipGetLastError();
        grid = cus;
        if (ws_size < WS_END) { fprintf(stderr, "kernel_launch: workspace too small: %zu < %zu\n", ws_size, (size_t)WS_END); grid = -1; }
    }
    if (grid < 0) return;
    if (hipMemsetAsync((char*)d_ws + OFF_BAR, 0, XCD_BAR_WORDS * 4, stream) != hipSuccess) { fprintf(stderr, "kernel_launch: memset failed\n"); return; }
    Params p{};
    for (int i = 0; i < 29; ++i) p.in[i] = (const float*)d_in[i];
    p.out = (float*)d_out; p.ws = (unsigned char*)d_ws;
    void* args[] = {&p};
    hipError_t e = hipLaunchCooperativeKernel((const void*)mk_fwd, dim3(grid), dim3(NT), args, LDS_BYTES, stream);
    if (e != hipSuccess) fprintf(stderr, "cooperative launch failed: %s (grid %d)\n", hipGetErrorString(e), grid);
}
```
